# Optimizing an MI355X kernel written in HIP

```python
import math
import jax
import jax.numpy as jnp
from jax import lax
import numpy as np

D_MODEL = 1024
BATCH = 8
SEQ = 2048
DEPTH = 1

EPS = 1e-6
NEG_INF = -1e30
FORCE_BONUS = 1e4

NSA_HEADS = 8
NSA_KV_GROUPS = 2
NSA_HPG = NSA_HEADS // NSA_KV_GROUPS
NSA_HEAD_DIM = 64
CMP_BLOCK = 32
CMP_STRIDE = 16
CMP_HIDDEN = 128
SEL_BLOCK = 64
SEL_TOPK = 16
N_LOCAL_FORCED = 2
WINDOW = 512
SEL_Q_CHUNK = 64
Q_BLOCK = 128

MLA_HEADS = 8
MLA_Q_LORA = 256
MLA_KV_LORA = 128
MLA_NOPE_DIM = 64
MLA_ROPE_DIM = 32
MLA_V_DIM = 64
ROPE_THETA = 10000.0

PEER_HEADS = 8
PEER_N_KEYS = 128
PEER_N_EXPERTS = PEER_N_KEYS * PEER_N_KEYS
PEER_QUERY_DIM = 256
PEER_TOPK = 16
PEER_TOKEN_CHUNK = 256

NSA_Q_W = NSA_HEADS * NSA_HEAD_DIM
NSA_KV_W = NSA_KV_GROUPS * NSA_HEAD_DIM
NSA_GATE_W = 3 * NSA_HEADS
MLA_OUT_W = MLA_HEADS * MLA_V_DIM
IN_SPLITS = (NSA_Q_W, NSA_KV_W, NSA_KV_W, NSA_KV_W, NSA_KV_W, NSA_KV_W, NSA_KV_W, NSA_GATE_W,
             MLA_Q_LORA, MLA_KV_LORA, MLA_ROPE_DIM, D_MODEL, D_MODEL)
IN_WIDTH = sum(IN_SPLITS)

kernel_name = 'nsa_mla_peer_hybrid_block'


def rms_norm(x, g):
    xf = x.astype(jnp.float32)
    y = xf * lax.rsqrt(jnp.mean(xf * xf, axis=-1, keepdims=True) + EPS)
    return (y * g.astype(jnp.float32)).astype(x.dtype)


def masked_softmax(s, mask):
    s = jnp.where(mask, s.astype(jnp.float32), NEG_INF)
    m = jnp.max(s, axis=-1, keepdims=True)
    p = jnp.where(mask, jnp.exp(s - m), 0.0)
    return p / jnp.maximum(jnp.sum(p, axis=-1, keepdims=True), 1e-30)


def alibi_slopes(n):
    return 2.0 ** (-8.0 * jnp.arange(1, n + 1, dtype=jnp.float32) / n)


def rope_cos_sin(positions, dim):
    inv = ROPE_THETA ** (-jnp.arange(0, dim, 2, dtype=jnp.float32) / dim)
    ang = positions.astype(jnp.float32)[..., None] * inv
    return jnp.cos(ang), jnp.sin(ang)


def apply_rope(x, cos, sin):
    x1, x2 = jnp.split(x.astype(jnp.float32), 2, axis=-1)
    return jnp.concatenate([x1 * cos - x2 * sin, x1 * sin + x2 * cos], axis=-1)


def _to_chunks(a, axis, n):
    shp = a.shape
    a = a.reshape(shp[:axis] + (n, shp[axis] // n) + shp[axis + 1:])
    return jnp.moveaxis(a, axis, 0)


def _from_chunks(a, axis):
    a = jnp.moveaxis(a, 0, axis)
    shp = a.shape
    return a.reshape(shp[:axis] + (shp[axis] * shp[axis + 1],) + shp[axis + 2:])


def _split_columns(a, sizes):
    offsets = np.cumsum(np.array(sizes))[:-1].tolist()
    return jnp.split(a, offsets, axis=-1)


def nsa_compress(kv_heads, pos_emb, w1, w2):
    T = kv_heads.shape[2]
    nc = (T - CMP_BLOCK) // CMP_STRIDE + 1
    idx = jnp.arange(nc)[:, None] * CMP_STRIDE + jnp.arange(CMP_BLOCK)[None, :]
    blocks = kv_heads[:, :, idx, :] + pos_emb.astype(jnp.float32)
    flat = blocks.reshape(blocks.shape[:3] + (CMP_BLOCK * NSA_HEAD_DIM,))
    return jax.nn.gelu(flat @ w1.astype(jnp.float32)) @ w2.astype(jnp.float32)


def nsa_attention(q, k_cmp, v_cmp, k_sel, v_sel, k_win, v_win, gate_logits,
                  cmp_pos_k, cmp_w1_k, cmp_w2_k, cmp_pos_v, cmp_w1_v, cmp_w2_v):
    f32 = jnp.float32
    B, T, _ = q.shape
    G, HPG, dk = NSA_KV_GROUPS, NSA_HPG, NSA_HEAD_DIM
    slopes = alibi_slopes(NSA_HEADS).reshape(G, HPG)
    pos = jnp.arange(T)
    qh = q.astype(f32).reshape(B, T, G, HPG, dk).transpose(0, 2, 3, 1, 4) * (dk ** -0.5)

    def heads(a):
        return a.astype(f32).reshape(B, T, G, dk).transpose(0, 2, 1, 3)

    kc = nsa_compress(heads(k_cmp), cmp_pos_k, cmp_w1_k, cmp_w2_k)
    vc = nsa_compress(heads(v_cmp), cmp_pos_v, cmp_w1_v, cmp_w2_v)
    nc = kc.shape[2]
    cmp_start = jnp.arange(nc) * CMP_STRIDE
    dist_c = pos[:, None] - (cmp_start + CMP_BLOCK - 1)[None, :]
    s_c = jnp.einsum('bghtd,bgnd->bghtn', qh, kc) - slopes[None, :, :, None, None] * dist_c
    p_c = masked_softmax(s_c, dist_c >= 0)
    o_cmp = jnp.einsum('bghtn,bgnd->bghtd', p_c, vc)

    ns = T // SEL_BLOCK
    sel_start = jnp.arange(ns) * SEL_BLOCK
    overlap = jnp.clip(jnp.minimum(cmp_start[:, None] + CMP_BLOCK, sel_start[None, :] + SEL_BLOCK)
                       - jnp.maximum(cmp_start[:, None], sel_start[None, :]), 0, None).astype(f32) / CMP_BLOCK
    importance = jnp.einsum('bghtn,ns->bgts', p_c, overlap)
    back = (pos // SEL_BLOCK)[:, None] - jnp.arange(ns)[None, :]
    causal_blk = back >= 0
    forced = causal_blk & ((back < N_LOCAL_FORCED) | (jnp.arange(ns)[None, :] == 0))
    sel_score = jnp.where(causal_blk, importance + FORCE_BONUS * forced.astype(f32), NEG_INF)
    top_s, sel_idx = lax.top_k(sel_score, min(SEL_TOPK, ns))
    sel_ok = top_s > 0.5 * NEG_INF
    ks_blocks = heads(k_sel).reshape(B, G, ns, SEL_BLOCK, dk)
    vs_blocks = heads(v_sel).reshape(B, G, ns, SEL_BLOCK, dk)
    bi = jnp.arange(B)[:, None, None, None]
    gi = jnp.arange(G)[None, :, None, None]

    def sel_chunk(args):
        qc, idx, ok, tq = args
        c, k = idx.shape[2], idx.shape[3]
        kg = ks_blocks[bi, gi, idx]
        vg = vs_blocks[bi, gi, idx]
        s = jnp.einsum('bghqd,bgqkld->bghqkl', qc, kg)
        kpos = idx[..., None] * SEL_BLOCK + jnp.arange(SEL_BLOCK)
        dist = tq[None, None, :, None, None] - kpos
        mask = ok[..., None] & (dist >= 0)
        s = s - slopes[None, :, :, None, None, None] * dist[:, :, None]
        p = masked_softmax(s.reshape(B, G, HPG, c, k * SEL_BLOCK), mask.reshape(B, G, 1, c, k * SEL_BLOCK))
        return jnp.einsum('bghqm,bgqmd->bghqd', p, vg.reshape(B, G, c, k * SEL_BLOCK, dk))

    nq = T // SEL_Q_CHUNK
    o_sel = _from_chunks(lax.map(sel_chunk, (_to_chunks(qh, 3, nq), _to_chunks(sel_idx, 2, nq),
                                             _to_chunks(sel_ok, 2, nq), pos.reshape(nq, SEL_Q_CHUNK))), 3)

    nb = T // Q_BLOCK
    kw_all = heads(k_win)
    vw_all = heads(v_win)
    band = jnp.arange(nb)[:, None] * Q_BLOCK - WINDOW + jnp.arange(WINDOW + Q_BLOCK)[None, :]

    def win_chunk(args):
        qc, kpos, tq = args
        kidx = jnp.clip(kpos, 0, T - 1)
        kb = kw_all[:, :, kidx]
        vb = vw_all[:, :, kidx]
        s = jnp.einsum('bghqd,bgkd->bghqk', qc, kb)
        dist = tq[:, None] - kpos[None, :]
        mask = (kpos[None, :] >= 0) & (dist >= 0) & (dist < WINDOW)
        s = s - slopes[None, :, :, None, None] * dist
        return jnp.einsum('bghqk,bgkd->bghqd', masked_softmax(s, mask), vb)

    o_win = _from_chunks(lax.map(win_chunk, (_to_chunks(qh, 3, nb), band, pos.reshape(nb, Q_BLOCK))), 3)

    gates = jax.nn.sigmoid(gate_logits.astype(f32)).reshape(B, T, 3, G, HPG).transpose(2, 0, 3, 4, 1)[..., None]
    o = gates[0] * o_cmp + gates[1] * o_sel + gates[2] * o_win
    return o.transpose(0, 3, 1, 2, 4).reshape(B, T, NSA_Q_W).astype(q.dtype)


def mla_attention(c_q, c_kv, k_rope, positions, q_norm_g, kv_norm_g, w_uq, w_ukv):
    f32 = jnp.float32
    B, T, _ = c_q.shape
    H = MLA_HEADS
    q = (rms_norm(c_q, q_norm_g) @ w_uq).astype(f32).reshape(B, T, H, MLA_NOPE_DIM + MLA_ROPE_DIM)
    kv = (rms_norm(c_kv, kv_norm_g) @ w_ukv).astype(f32).reshape(B, T, H, MLA_NOPE_DIM + MLA_V_DIM)
    q_nope, q_pe = q[..., :MLA_NOPE_DIM], q[..., MLA_NOPE_DIM:]
    k_nope, v = kv[..., :MLA_NOPE_DIM], kv[..., MLA_NOPE_DIM:]
    cos, sin = rope_cos_sin(positions, MLA_ROPE_DIM)
    q_pe = apply_rope(q_pe, cos[:, :, None], sin[:, :, None])
    k_pe = apply_rope(k_rope, cos, sin)
    qf = jnp.concatenate([q_nope, q_pe], axis=-1) * ((MLA_NOPE_DIM + MLA_ROPE_DIM) ** -0.5)
    kf = jnp.concatenate([k_nope, jnp.broadcast_to(k_pe[:, :, None, :], (B, T, H, MLA_ROPE_DIM))], axis=-1)
    qh = qf.transpose(0, 2, 1, 3)
    kh = kf.transpose(0, 2, 1, 3)
    vh = v.transpose(0, 2, 1, 3)
    pos = jnp.arange(T)
    nb = T // Q_BLOCK

    def blk(args):
        qc, tq = args
        s = jnp.einsum('bhqd,bhkd->bhqk', qc, kh)
        p = masked_softmax(s, tq[:, None] >= pos[None, :])
        return jnp.einsum('bhqk,bhkd->bhqd', p, vh)

    o = _from_chunks(lax.map(blk, (_to_chunks(qh, 2, nb), pos.reshape(nb, Q_BLOCK))), 2)
    return o.transpose(0, 2, 1, 3).reshape(B, T, MLA_OUT_W).astype(c_q.dtype)


def peer_ffn(x, w_query, sub_keys_1, sub_keys_2, expert_down, expert_up):
    f32 = jnp.float32
    B, T, D = x.shape
    H, K = PEER_HEADS, PEER_TOPK
    q = (x @ w_query).astype(f32).reshape(B, T, H, 2, PEER_QUERY_DIM // 2)
    s1 = jnp.einsum('bthd,nd->bthn', q[..., 0, :], sub_keys_1.astype(f32))
    s2 = jnp.einsum('bthd,nd->bthn', q[..., 1, :], sub_keys_2.astype(f32))
    v1, i1 = lax.top_k(s1, K)
    v2, i2 = lax.top_k(s2, K)
    cand_s = (v1[..., :, None] + v2[..., None, :]).reshape(B, T, H, K * K)
    cand_e = (i1[..., :, None] * PEER_N_KEYS + i2[..., None, :]).reshape(B, T, H, K * K)
    top_s, top_pos = lax.top_k(cand_s, K)
    experts = jnp.take_along_axis(cand_e, top_pos, axis=-1)
    g = jax.nn.softmax(top_s, axis=-1)
    n_tok = B * T
    c = math.gcd(n_tok, PEER_TOKEN_CHUNK)
    n_chunk = n_tok // c

    def expert_chunk(args):
        xt, e, gt = args
        u = expert_down[e].astype(f32)
        hdn = jax.nn.gelu(jnp.einsum('chkd,cd->chk', u, xt.astype(f32)))
        return jnp.einsum('chk,chkd->cd', gt * hdn, expert_up[e].astype(f32))

    y = lax.map(expert_chunk, (x.reshape(n_chunk, c, D), experts.reshape(n_chunk, c, H, K),
                               g.reshape(n_chunk, c, H, K)))
    return y.reshape(B, T, D).astype(x.dtype)


def setup_inputs(seed: int = 0) -> dict:
    key = jax.random.key(seed)
    ks = jax.random.split(key, 24)
    f32 = jnp.float32

    def nrm(k, shape, scale):
        return jax.random.normal(k, shape, f32) * scale

    def gain(k, n):
        return 1.0 + 0.02 * jax.random.normal(k, (DEPTH, n), f32)

    dk = NSA_HEAD_DIM
    return {
        'x': jax.random.normal(ks[0], (BATCH, SEQ, D_MODEL), f32),
        'positions': jnp.broadcast_to(jnp.arange(SEQ, dtype=jnp.int32)[None, :], (BATCH, SEQ)),
        'norm1_g': gain(ks[1], D_MODEL),
        'w_in': nrm(ks[2], (DEPTH, D_MODEL, IN_WIDTH), D_MODEL ** -0.5),
        'nsa_cmp_pos_k': nrm(ks[3], (DEPTH, CMP_BLOCK, dk), 0.1),
        'nsa_cmp_w1_k': nrm(ks[4], (DEPTH, CMP_BLOCK * dk, CMP_HIDDEN), (CMP_BLOCK * dk) ** -0.5),
        'nsa_cmp_w2_k': nrm(ks[5], (DEPTH, CMP_HIDDEN, dk), CMP_HIDDEN ** -0.5),
        'nsa_cmp_pos_v': nrm(ks[6], (DEPTH, CMP_BLOCK, dk), 0.1),
        'nsa_cmp_w1_v': nrm(ks[7], (DEPTH, CMP_BLOCK * dk, CMP_HIDDEN), (CMP_BLOCK * dk) ** -0.5),
        'nsa_cmp_w2_v': nrm(ks[8], (DEPTH, CMP_HIDDEN, dk), CMP_HIDDEN ** -0.5),
        'mla_q_norm_g': gain(ks[9], MLA_Q_LORA),
        'mla_kv_norm_g': gain(ks[10], MLA_KV_LORA),
        'mla_w_uq': nrm(ks[11], (DEPTH, MLA_Q_LORA, MLA_HEADS * (MLA_NOPE_DIM + MLA_ROPE_DIM)), MLA_Q_LORA ** -0.5),
        'mla_w_ukv': nrm(ks[12], (DEPTH, MLA_KV_LORA, MLA_HEADS * (MLA_NOPE_DIM + MLA_V_DIM)), MLA_KV_LORA ** -0.5),
        'w_branch_nsa': nrm(ks[13], (DEPTH, NSA_Q_W, D_MODEL), NSA_Q_W ** -0.5),
        'w_branch_mla': nrm(ks[14], (DEPTH, MLA_OUT_W, D_MODEL), MLA_OUT_W ** -0.5),
        'w_out': nrm(ks[15], (DEPTH, D_MODEL, D_MODEL), D_MODEL ** -0.5),
        'norm2_g': gain(ks[16], D_MODEL),
        'peer_w_query': nrm(ks[17], (DEPTH, D_MODEL, PEER_HEADS * PEER_QUERY_DIM), D_MODEL ** -0.5),
        'peer_sub_keys_1': nrm(ks[18], (DEPTH, PEER_N_KEYS, PEER_QUERY_DIM // 2), (PEER_QUERY_DIM // 2) ** -0.5),
        'peer_sub_keys_2': nrm(ks[19], (DEPTH, PEER_N_KEYS, PEER_QUERY_DIM // 2), (PEER_QUERY_DIM // 2) ** -0.5),
        'peer_expert_down': nrm(ks[20], (DEPTH, PEER_N_EXPERTS, D_MODEL), D_MODEL ** -0.5),
        'peer_expert_up': nrm(ks[21], (DEPTH, PEER_N_EXPERTS, D_MODEL), PEER_HEADS ** -0.5),
        'norm_f_g': 1.0 + 0.02 * jax.random.normal(ks[22], (D_MODEL,), f32),
    }


def reference(x, positions, norm1_g, w_in, nsa_cmp_pos_k, nsa_cmp_w1_k, nsa_cmp_w2_k,
              nsa_cmp_pos_v, nsa_cmp_w1_v, nsa_cmp_w2_v, mla_q_norm_g, mla_kv_norm_g,
              mla_w_uq, mla_w_ukv, w_branch_nsa, w_branch_mla, w_out, norm2_g,
              peer_w_query, peer_sub_keys_1, peer_sub_keys_2, peer_expert_down,
              peer_expert_up, norm_f_g):
    h = x
    for layer in range(DEPTH):
        xn = rms_norm(h, norm1_g[layer])
        (nsa_q, k_cmp, v_cmp, k_sel, v_sel, k_win, v_win, nsa_gates,
         mla_cq, mla_ckv, mla_kr, gate_nsa, gate_mla) = _split_columns(xn @ w_in[layer], IN_SPLITS)
        o_nsa = nsa_attention(nsa_q, k_cmp, v_cmp, k_sel, v_sel, k_win, v_win, nsa_gates,
                              nsa_cmp_pos_k[layer], nsa_cmp_w1_k[layer], nsa_cmp_w2_k[layer],
                              nsa_cmp_pos_v[layer], nsa_cmp_w1_v[layer], nsa_cmp_w2_v[layer])
        o_mla = mla_attention(mla_cq, mla_ckv, mla_kr, positions, mla_q_norm_g[layer],
                              mla_kv_norm_g[layer], mla_w_uq[layer], mla_w_ukv[layer])
        y_nsa = o_nsa @ w_branch_nsa[layer]
        y_mla = o_mla @ w_branch_mla[layer]
        merged = jax.nn.sigmoid(gate_nsa) * y_nsa + jax.nn.sigmoid(gate_mla) * y_mla
        h = h + merged @ w_out[layer]
        h = h + peer_ffn(rms_norm(h, norm2_g[layer]), peer_w_query[layer], peer_sub_keys_1[layer],
                         peer_sub_keys_2[layer], peer_expert_down[layer], peer_expert_up[layer])
    return rms_norm(h, norm_f_g)
```

```cpp
#include <hip/hip_runtime.h>
#include <hip/hip_cooperative_groups.h>
#include <cstdio>
#include <cstdint>
#include <cmath>
namespace cg = cooperative_groups;
namespace pg8 {
#define PG8_LAS __attribute__((address_space(3)))
typedef unsigned short bf16_t;
typedef short bf16x8 __attribute__((ext_vector_type(8)));
typedef float f32x4 __attribute__((ext_vector_type(4)));
typedef unsigned u32x4 __attribute__((ext_vector_type(4)));
constexpr int BM = 256, BK = 64, HALF = 128, HTB = HALF * BK * 2  , STAGE_BYTES = 8 * HTB, NXCD = 8, WGM = 8;

__host__ __device__ __forceinline__ int lds_byte(int r, int c) { const int st = (r >> 4) * 2 + (c >> 5), rr = r & 15, cc = c & 31, ob = rr * 64 + cc * 2; return st * 1024 + (ob ^ (((ob >> 9) & 1) << 5)); }
__host__ __device__ __forceinline__ void stage_rc(int b, int& R, int& C) { const int st = b / 1024, sb = b % 1024, swz = sb ^ (((sb >> 9) & 1) << 5); R = (st >> 1) * 16 + swz / 64; C = (st & 1) * 32 + (swz % 64) / 2; }
__host__ __device__ __forceinline__ int perm32(int rho) { const int n = rho >> 4, i = rho & 15; return 8 * (i >> 2) + 4 * n + (i & 3); }

struct Unit { int pm, pn; };
struct Gemm { const bf16_t* A; const bf16_t* Bt; int M, N, K; size_t aRow, aHalf, aTile, aK, bRow; };
__host__ __device__ __forceinline__ Gemm make_gemm(const bf16_t* A, int lda, const bf16_t* Bt, int ldb, int M, int N, int K) {
    Gemm g; g.A = A; g.Bt = Bt; g.M = M; g.N = N; g.K = K; g.aRow = (size_t)lda * 2; g.aHalf = (size_t)HALF * lda * 2; g.aTile = (size_t)BM * lda * 2; g.aK = BK * 2; g.bRow = (size_t)ldb * 2; return g; }

struct StaticOrder {
    int nM, nN, nwg, G, c;
    __host__ __device__ void init(int M, int N, int G_, int c_) { nM = M / BM; nN = N / BM; nwg = nM * nN; G = G_; c = c_; }
    __host__ __device__ bool next(int i, Unit& u) const {
        const long L = (long)i * G + c; if (L >= nwg) return false;
        int wgid = (int)L; { const int q = nwg / NXCD, r = nwg % NXCD, xcd = wgid % NXCD, off = wgid / NXCD; wgid = (xcd < r ? xcd * (q + 1) : r * (q + 1) + (xcd - r) * q) + off; }
        const int nig = WGM * nN, gid = wgid / nig, fm = gid * WGM, gsz = (nM - fm) < WGM ? (nM - fm) : WGM;
        u.pm = fm + ((wgid % nig) % gsz); u.pn = (wgid % nig) / gsz; return true;
    }
};

__device__ __forceinline__ unsigned cvt_pk_bf16(float lo, float hi) { unsigned r; asm volatile("v_cvt_pk_bf16_f32 %0, %1, %2" : "=v"(r) : "v"(lo), "v"(hi)); return r; }

template <class Epi, class Sched, bool ALIGN_EPI>
__device__ __forceinline__ void gemm_phase(PG8_LAS unsigned char* lds, const Gemm g, const Sched& S, const Epi& E) {
    const int tid = threadIdx.x, wid = __builtin_amdgcn_readfirstlane(tid >> 6), lane = tid & 63, wr = wid >> 2, wc = wid & 3, fr = lane & 15, fq = lane >> 4;
    const int K = g.K, nt = K / BK;
    unsigned voffA[2], voffB[2];
#pragma unroll
    for (int i = 0; i < 2; ++i) { int R, C; stage_rc(tid * 16 + i * 8192, R, C); const int Rb = Epi::PERM ? ((R & ~31) + perm32(R & 31)) : R;
        voffA[i] = (unsigned)((size_t)R * g.aRow + (size_t)C * 2); voffB[i] = (unsigned)((size_t)Rb * g.bRow + (size_t)C * 2); }
    const size_t kstepA = g.aK, kstepB = (size_t)(BK * 2);
    const size_t hstepA = g.aHalf, hstepB = (size_t)HALF * g.bRow;
    const size_t tstepA = g.aTile, tstepB = (size_t)BM * g.bRow;
    const unsigned ldsw = (unsigned)wid * 1024u;
    const int aoff = lds_byte(wr * 64 + fr, fq * 8), boff = lds_byte(wc * 32 + fr, fq * 8);
#define PG8_SA(b, h) (((b) * 2 + (h)) * HTB)
#define PG8_SB(b, h) ((4 + (b) * 2 + (h)) * HTB)
#define PG8_STAGE(bufoff, gbase, voff) do { _Pragma("unroll") for (int _i = 0; _i < 2; ++_i) \
        __builtin_amdgcn_global_load_lds((const unsigned*)((const char*)(gbase) + (voff)[_i]), (PG8_LAS unsigned*)(lds + (bufoff) + ldsw + _i * 8192), 16, 0, 0); } while (0)
#define PG8_LDA(dst, b, h) do { _Pragma("unroll") for (int m = 0; m < 4; ++m) _Pragma("unroll") for (int k = 0; k < 2; ++k) dst[m][k] = *(const PG8_LAS bf16x8*)(lds + PG8_SA(b, h) + aoff + m * 2048 + k * 1024); } while (0)
#define PG8_LDB(dst, b, h) do { _Pragma("unroll") for (int n = 0; n < 2; ++n) _Pragma("unroll") for (int k = 0; k < 2; ++k) dst[n][k] = *(const PG8_LAS bf16x8*)(lds + PG8_SB(b, h) + boff + n * 2048 + k * 1024); } while (0)
#define PG8_MMA(ai, bj, At, Bt) do { __builtin_amdgcn_s_setprio(1); _Pragma("unroll") for (int m = 0; m < 4; ++m) _Pragma("unroll") for (int n = 0; n < 2; ++n) _Pragma("unroll") for (int k = 0; k < 2; ++k) \
        acc[ai][bj][m][n] = __builtin_amdgcn_mfma_f32_16x16x32_bf16(Bt[n][k], At[m][k], acc[ai][bj][m][n], 0, 0, 0); __builtin_amdgcn_s_setprio(0); } while (0)
#define PG8_WAIT_V(n) asm volatile("s_waitcnt vmcnt(" #n ")" ::: "memory")
#define PG8_WAIT_L(n) asm volatile("s_waitcnt lgkmcnt(" #n ")" ::: "memory")
#define PG8_BAR __builtin_amdgcn_s_barrier()
#define PG8_SCHED __builtin_amdgcn_sched_barrier(0)
    Unit cur, nxt; int ui = 0;
    if (!S.next(0, cur)) return;
    f32x4 acc[2][2][4][2];
#pragma unroll
    for (int a = 0; a < 2; ++a)
#pragma unroll
        for (int b = 0; b < 2; ++b)
#pragma unroll
            for (int m = 0; m < 4; ++m)
#pragma unroll
                for (int n = 0; n < 2; ++n) acc[a][b][m][n] = (f32x4){0.f, 0.f, 0.f, 0.f};
    bf16x8 At[4][2], B0[2][2], B1[2][2];
    const char* cA = (const char*)g.A + (size_t)cur.pm * tstepA; const char* cB = (const char*)g.Bt + (size_t)cur.pn * tstepB;
    PG8_STAGE(PG8_SB(0, 0), cB, voffB); PG8_STAGE(PG8_SB(0, 1), cB + hstepB, voffB); PG8_STAGE(PG8_SA(0, 0), cA, voffA); PG8_STAGE(PG8_SA(0, 1), cA + hstepA, voffA);
    if (wr == 1) PG8_BAR;
    PG8_WAIT_V(2); PG8_BAR;
    PG8_STAGE(PG8_SB(1, 0), cB + kstepB, voffB); PG8_STAGE(PG8_SA(1, 0), cA + kstepA, voffA); PG8_STAGE(PG8_SB(1, 1), cB + hstepB + kstepB, voffB);
    PG8_WAIT_V(6); PG8_BAR;
    for (;;) {
        const bool has_next = S.next(ui + 1, nxt);
        const char* nA = has_next ? (const char*)g.A + (size_t)nxt.pm * tstepA : cA; const char* nB = has_next ? (const char*)g.Bt + (size_t)nxt.pn * tstepB : cB;
        for (int t = 0; t < nt; t += 2) {
            const bool last = (t == nt - 2);
            const char* a1 = cA + (size_t)(t + 1) * kstepA;
            const char* a2 = last ? nA : cA + (size_t)(t + 2) * kstepA; const char* b2 = last ? nB : cB + (size_t)(t + 2) * kstepB;
            const char* a3 = a2 + kstepA; const char* b3 = b2 + kstepB;
            PG8_LDB(B0, 0, 0); PG8_LDB(B1, 0, 1); PG8_SCHED; PG8_LDA(At, 0, 0); PG8_STAGE(PG8_SA(1, 1), a1 + hstepA, voffA);
            PG8_WAIT_V(8); PG8_WAIT_L(0); PG8_BAR; PG8_MMA(0, 0, At, B0); PG8_MMA(0, 1, At, B1); PG8_BAR; PG8_SCHED;
            PG8_LDA(At, 0, 1); PG8_STAGE(PG8_SB(0, 0), b2, voffB); PG8_STAGE(PG8_SB(0, 1), b2 + hstepB, voffB); PG8_STAGE(PG8_SA(0, 0), a2, voffA);
            PG8_WAIT_V(8); PG8_WAIT_L(0); PG8_BAR; PG8_MMA(1, 0, At, B0); PG8_MMA(1, 1, At, B1); PG8_BAR; PG8_SCHED;
            PG8_LDB(B0, 1, 0); PG8_LDB(B1, 1, 1); PG8_SCHED; PG8_LDA(At, 1, 0); PG8_STAGE(PG8_SA(0, 1), a2 + hstepA, voffA);
            PG8_WAIT_V(8); PG8_WAIT_L(0); PG8_BAR; PG8_MMA(0, 0, At, B0); PG8_MMA(0, 1, At, B1); PG8_BAR; PG8_SCHED;
            PG8_LDA(At, 1, 1); PG8_STAGE(PG8_SB(1, 0), b3, voffB); PG8_STAGE(PG8_SB(1, 1), b3 + hstepB, voffB); PG8_STAGE(PG8_SA(1, 0), a3, voffA);
            PG8_WAIT_V(8); PG8_WAIT_L(0); PG8_BAR; PG8_MMA(1, 0, At, B0); PG8_MMA(1, 1, At, B1); PG8_BAR; PG8_SCHED;
        }
        if constexpr (ALIGN_EPI) { if (wr == 0) PG8_BAR; }
        E(acc, cur, wr, wc, fr, fq);
        if (!has_next) break;
#pragma unroll
        for (int a = 0; a < 2; ++a)
#pragma unroll
            for (int b = 0; b < 2; ++b)
#pragma unroll
                for (int m = 0; m < 4; ++m)
#pragma unroll
                    for (int n = 0; n < 2; ++n) acc[a][b][m][n] = (f32x4){0.f, 0.f, 0.f, 0.f};
        cur = nxt; cA = nA; cB = nB; ++ui;
        if constexpr (ALIGN_EPI) { if (wr == 1) PG8_BAR; }
    }
    PG8_WAIT_V(0);
    if constexpr (!ALIGN_EPI) { if (wr == 0) PG8_BAR; }
    PG8_BAR;
#undef PG8_SA
#undef PG8_SB
#undef PG8_STAGE
#undef PG8_LDA
#undef PG8_LDB
#undef PG8_MMA
#undef PG8_WAIT_V
#undef PG8_WAIT_L
#undef PG8_BAR
#undef PG8_SCHED
}
}
constexpr int NWAVES = 8, NTHREADS = 512;
constexpr int BATCH = 8, SEQ = 2048, DM = 1024, MTOK = BATCH * SEQ;
constexpr int NPROJ = 3840;
constexpr float EPS = 1e-6f, LOG2E = 1.4426950408889634f;
constexpr float QSCALE_NSA = 0.125f * LOG2E;
constexpr float QSCALE_MLA = 0.10206207261596575f * LOG2E;
constexpr size_t MiB = 1u << 20;
enum { I_X = 0, I_POS, I_N1G, I_WIN, I_CPK, I_CW1K, I_CW2K, I_CPV, I_CW1V, I_CW2V, I_QNG, I_KVNG, I_WUQ, I_WUKV, I_WBN, I_WBM, I_WOUT, I_N2G, I_WPQ, I_SK1, I_SK2, I_EDN, I_EUP, I_NFG, N_IN };
constexpr size_t WS_CTL = 0;
constexpr size_t WS_WIN = 1 * MiB;
constexpr size_t WS_WUQ = WS_WIN + (size_t)NPROJ * 1024 * 2;
constexpr size_t WS_WUKV = WS_WUQ + 768 * 256 * 2;
constexpr size_t WS_WBR = 10 * MiB;
constexpr size_t WS_WOUT = 12 * MiB;
constexpr size_t WS_WPQ = 14 * MiB;
constexpr size_t WS_WC1K = 18 * MiB;
constexpr size_t WS_WC1V = WS_WC1K + 256 * 1024 * 2;
constexpr size_t WS_SMALL = 19 * MiB;
constexpr size_t WS_C1K = WS_SMALL;
constexpr size_t WS_C1V = WS_SMALL + 512;
constexpr size_t WS_ORDER = WS_SMALL + 1024;
constexpr size_t WS_SK1 = WS_SMALL + 4096;
constexpr size_t WS_SK2 = WS_SK1 + 32768;
constexpr size_t WS_XN = 20 * MiB;
constexpr size_t WS_MLAQ = WS_XN, WS_EXPD = WS_XN;
constexpr size_t WS_QKV = 52 * MiB;
constexpr size_t WS_MERGED = WS_QKV;
constexpr size_t WS_CQ = 92 * MiB;
constexpr size_t WS_MISC = 100 * MiB;
constexpr size_t WS_ROUTE = 92 * MiB;
constexpr size_t WS_GATES = 108 * MiB;
constexpr size_t WS_QP = WS_GATES;
constexpr size_t WS_MLAKV = 172 * MiB;
constexpr size_t WS_XN2 = WS_MLAKV;
constexpr size_t WS_KPE = 204 * MiB;
constexpr size_t WS_KC = 205 * MiB;
constexpr size_t WS_VC = WS_KC + 16 * 128 * 64 * 2;
constexpr size_t WS_UK = 206 * MiB;
constexpr size_t WS_UV = 208 * MiB;
constexpr size_t WS_OCAT = 210 * MiB;
constexpr size_t WS_EXPU = WS_OCAT;
constexpr size_t WS_END = 242 * MiB;
constexpr int RING_BYTES = 131072;
constexpr int LDS_BYTES = 147456;

#define GAS __attribute__((address_space(1)))
#define LAS __attribute__((address_space(3)))
typedef unsigned short bf16;
typedef unsigned v4u __attribute__((ext_vector_type(4)));
typedef unsigned v2u __attribute__((ext_vector_type(2)));
typedef float f32x4 __attribute__((ext_vector_type(4)));
typedef float f32x16 __attribute__((ext_vector_type(16)));
typedef short bf16x8 __attribute__((ext_vector_type(8)));
typedef short s16x4 __attribute__((ext_vector_type(4)));

__device__ __forceinline__ unsigned f2bf(float f) { unsigned u = __builtin_bit_cast(unsigned, f); return (u + 0x7fffu + ((u >> 16) & 1u)) >> 16; }
__device__ __forceinline__ unsigned pk2(float lo, float hi) { return f2bf(lo) | (f2bf(hi) << 16); }
__device__ __forceinline__ float bf_lo(unsigned u) { return __builtin_bit_cast(float, u << 16); }
__device__ __forceinline__ float bf_hi(unsigned u) { return __builtin_bit_cast(float, u & 0xffff0000u); }
__device__ __forceinline__ float bf2f(bf16 h) { return __builtin_bit_cast(float, (unsigned)h << 16); }
__device__ __forceinline__ float sigmoidf_(float v) { return 1.0f / (1.0f + __expf(-v)); }
__device__ __forceinline__ float gelu_tanh(float v) { const float u = 0.7978845608028654f * (v + 0.044715f * v * v * v); const float e = __expf(2.0f * u); const float th = 1.0f - 2.0f / (e + 1.0f); return 0.5f * v * (1.0f + th); }
__device__ __forceinline__ float wave_sum(float v) {
#pragma unroll
    for (int o = 1; o < 64; o <<= 1) v += __shfl_xor(v, o);
    return v;
}

struct Frame {
    LAS unsigned char* lds;
    int tid, lane, wave, G, bid;
    const float* const* in; const int* pos; float* out; unsigned char* ws;
};

__device__ __forceinline__ int win_srccol(int n) {
    if (n < 1280) return n;
    if (n < 1536) return 1304 + (n - 1280);
    if (n < 1664) return 1560 + (n - 1536);
    if (n < 1696) return 1688 + (n - 1664);
    if (n < 1720) return 1280 + (n - 1696);
    if (n < 1792) return -1;
    return 1720 + (n - 1792);
}
template <bool WIN_PERM>
__device__ __forceinline__ void tr_item(const float* src, int ld_src, int ksrc0, const float* kscale, bf16* dst, int ld_dst, int drow0, int dcol0, int N, LAS float* scr, int item, int lane) {
    const int nblk = N / 32, kb = item / nblk, nb = item % nblk, k0 = 64 * kb, n0 = 32 * nb;
    const int nn = n0 + (lane & 31); const int sc = WIN_PERM ? win_srccol(nn) : nn;
#pragma unroll 8
    for (int i = 0; i < 32; ++i) { const int kk = 2 * i + (lane >> 5); float v = 0.f; if (sc >= 0) v = src[(size_t)(ksrc0 + k0 + kk) * ld_src + sc]; if (kscale) v *= kscale[k0 + kk]; scr[kk * 33 + (lane & 31)] = v; }
    asm volatile("s_waitcnt lgkmcnt(0)" ::: "memory");
    const int c = lane & 7;
#pragma unroll
    for (int j = 0; j < 4; ++j) { const int n = (lane >> 3) + 8 * j; const LAS float* s = scr + (8 * c) * 33 + n;
        v4u o; o.x = pk2(s[0 * 33], s[1 * 33]); o.y = pk2(s[2 * 33], s[3 * 33]); o.z = pk2(s[4 * 33], s[5 * 33]); o.w = pk2(s[6 * 33], s[7 * 33]);
        *(v4u*)(dst + (size_t)(drow0 + n0 + n) * ld_dst + dcol0 + k0 + 8 * c) = o; }
    asm volatile("s_waitcnt lgkmcnt(0)" ::: "memory");
}
__device__ __forceinline__ void rms_row_to_bf16(const float* xrow, const float* gain, bf16* orow, int lane) {
    const f32x4* xr = (const f32x4*)xrow + lane; const f32x4* gr = (const f32x4*)gain + lane;
    f32x4 v[4]; float s = 0.f;
#pragma unroll
    for (int j = 0; j < 4; ++j) { v[j] = xr[64 * j]; s += (v[j].x * v[j].x + v[j].y * v[j].y) + (v[j].z * v[j].z + v[j].w * v[j].w); }
    const float r = 1.0f / sqrtf(wave_sum(s) * (1.f / DM) + EPS);
    unsigned long long* o8 = (unsigned long long*)orow + lane;
#pragma unroll
    for (int j = 0; j < 4; ++j) { const f32x4 g = gr[64 * j]; o8[64 * j] = (unsigned long long)pk2(v[j].x * r * g.x, v[j].y * r * g.y) | ((unsigned long long)pk2(v[j].z * r * g.z, v[j].w * r * g.w) << 32); }
}
__device__ __forceinline__ int unit_cost(int u) {
    if (u < 512) { const int qc = u & 31; return 4 * (4 + (qc + 1) + ((qc + 1) < 9 ? (qc + 1) : 9)); }
    const int qb = (u - 512) & 7; return 5 * (4 * qb + 4) + 4;
}
__device__ __forceinline__ void p0_prologue(Frame& F) {
    LAS float* scr = (LAS float*)(F.lds + F.wave * 16384);
    const int gw = F.bid * NWAVES + F.wave, NGW = F.G * NWAVES, lane = F.lane;
    bf16* const Win_t = (bf16*)(F.ws + WS_WIN); bf16* const Wuq_t = (bf16*)(F.ws + WS_WUQ); bf16* const Wukv_t = (bf16*)(F.ws + WS_WUKV);
    bf16* const Wbr_t = (bf16*)(F.ws + WS_WBR); bf16* const Wout_t = (bf16*)(F.ws + WS_WOUT); bf16* const Wpq_t = (bf16*)(F.ws + WS_WPQ);
    bf16* const Wc1k_t = (bf16*)(F.ws + WS_WC1K); bf16* const Wc1v_t = (bf16*)(F.ws + WS_WC1V);
    constexpr int I_IN = 16 * (NPROJ / 32), I_UQ = 4 * 24, I_UKV = 2 * 32, I_BR = 8 * 32, I_OUT = 16 * 32, I_PQ = 16 * 64, I_C1 = 16 * 4;
    constexpr int NITEMS = I_IN + I_UQ + I_UKV + 2 * I_BR + I_OUT + I_PQ + 4 * I_C1;
    for (int it = gw; it < NITEMS; it += NGW) {
        int r = it;
        if (r < I_IN) { tr_item<true>(F.in[I_WIN], 3768, 0, nullptr, Win_t, 1024, 0, 0, NPROJ, scr, r, lane); continue; } r -= I_IN;
        if (r < I_UQ) { tr_item<false>(F.in[I_WUQ], 768, 0, F.in[I_QNG], Wuq_t, 256, 0, 0, 768, scr, r, lane); continue; } r -= I_UQ;
        if (r < I_UKV) { tr_item<false>(F.in[I_WUKV], 1024, 0, F.in[I_KVNG], Wukv_t, 256, 0, 0, 1024, scr, r, lane); continue; } r -= I_UKV;
        if (r < I_BR) { tr_item<false>(F.in[I_WBN], 1024, 0, nullptr, Wbr_t, 1024, 0, 0, 1024, scr, r, lane); continue; } r -= I_BR;
        if (r < I_BR) { tr_item<false>(F.in[I_WBM], 1024, 0, nullptr, Wbr_t, 1024, 0, 512, 1024, scr, r, lane); continue; } r -= I_BR;
        if (r < I_OUT) { tr_item<false>(F.in[I_WOUT], 1024, 0, nullptr, Wout_t, 1024, 0, 0, 1024, scr, r, lane); continue; } r -= I_OUT;
        if (r < I_PQ) { tr_item<false>(F.in[I_WPQ], 2048, 0, nullptr, Wpq_t, 1024, 0, 0, 2048, scr, r, lane); continue; } r -= I_PQ;
        if (r < I_C1) { tr_item<false>(F.in[I_CW1K], 128, 0, nullptr, Wc1k_t, 1024, 0, 0, 128, scr, r, lane); continue; } r -= I_C1;
        if (r < I_C1) { tr_item<false>(F.in[I_CW1K], 128, 1024, nullptr, Wc1k_t, 1024, 128, 0, 128, scr, r, lane); continue; } r -= I_C1;
        if (r < I_C1) { tr_item<false>(F.in[I_CW1V], 128, 0, nullptr, Wc1v_t, 1024, 0, 0, 128, scr, r, lane); continue; } r -= I_C1;
        tr_item<false>(F.in[I_CW1V], 128, 1024, nullptr, Wc1v_t, 1024, 128, 0, 128, scr, r, lane);
    }
    { bf16* XN = (bf16*)(F.ws + WS_XN); for (int m = gw; m < MTOK; m += NGW) rms_row_to_bf16(F.in[I_X] + (size_t)m * DM, F.in[I_N1G], XN + (size_t)m * DM, lane); }
    const int gt = F.bid * NTHREADS + F.tid, NGT = F.G * NTHREADS;
    for (int i = gt; i < 1024 * 128; i += NGT) { const int n = i >> 7, k = 128 + (i & 127); Wukv_t[n * 256 + k] = 0; }
    { bf16* S1 = (bf16*)(F.ws + WS_SK1); bf16* S2 = (bf16*)(F.ws + WS_SK2);
      for (int i = gt; i < 128 * 128; i += NGT) { S1[i] = (bf16)f2bf(F.in[I_SK1][i]); S2[i] = (bf16)f2bf(F.in[I_SK2][i]); } }
    for (int o = gw; o < 256; o += NGW) {
        const int kv = o >> 7, j = o & 127; const float* pe = F.in[kv ? I_CPV : I_CPK]; const float* w1 = F.in[kv ? I_CW1V : I_CW1K];
        float s = 0.f;
        for (int k = lane; k < 2048; k += 64) s += pe[k] * w1[(size_t)k * 128 + j];
        s = wave_sum(s);
        if (lane == 0) ((float*)(F.ws + (kv ? WS_C1V : WS_C1K)))[j] = s;
    }
    if (F.bid == F.G - 1) {
        unsigned short* ord = (unsigned short*)(F.ws + WS_ORDER);
        for (int u = F.tid; u < 1024; u += NTHREADS) { const int c = unit_cost(u); int rank = 0;
            for (int v = 0; v < 1024; ++v) { const int cv = unit_cost(v); rank += (cv > c || (cv == c && v < u)) ? 1 : 0; }
            ord[rank] = (unsigned short)u; }
    }
}

using pg8::Unit; using pg8::cvt_pk_bf16;
constexpr int PG_HALF = 128, PG_BM = 256;
struct EpiInProj {
    static constexpr bool PERM = true;
    bf16 *QKV, *CQ, *MISC, *GATES;
    __device__ __forceinline__ void operator()(const f32x4 (&acc)[2][2][4][2], const Unit& u, int wr, int wc, int fr, int fq) const {
        bf16* base; int ldc, colt; float sc = 1.f;
        if (u.pn < 5) { base = QKV; ldc = 1280; colt = u.pn * 256; if (u.pn < 2) sc = QSCALE_NSA; }
        else if (u.pn == 5) { base = CQ; ldc = 256; colt = 0; }
        else if (u.pn == 6) { base = MISC; ldc = 256; colt = 0; }
        else { base = GATES; ldc = 2048; colt = (u.pn - 7) * 256; }
        const int row0 = u.pm * PG_BM + wr * 64 + fr, col0 = colt + wc * 32 + 8 * fq;
#pragma unroll
        for (int ai = 0; ai < 2; ++ai)
#pragma unroll
            for (int m = 0; m < 4; ++m) { bf16* rowp = base + (size_t)(row0 + ai * PG_HALF + m * 16) * ldc + col0;
#pragma unroll
                for (int bj = 0; bj < 2; ++bj) { const f32x4 v0 = acc[ai][bj][m][0] * sc, v1 = acc[ai][bj][m][1] * sc;
                    v4u w; w.x = cvt_pk_bf16(v0[0], v0[1]); w.y = cvt_pk_bf16(v0[2], v0[3]); w.z = cvt_pk_bf16(v1[0], v1[1]); w.w = cvt_pk_bf16(v1[2], v1[3]);
                    *(v4u*)(rowp + bj * PG_HALF) = w; } }
    }
};
struct EpiBf16 {
    static constexpr bool PERM = true;
    bf16* O; int ldc;
    __device__ __forceinline__ void operator()(const f32x4 (&acc)[2][2][4][2], const Unit& u, int wr, int wc, int fr, int fq) const {
        const int row0 = u.pm * PG_BM + wr * 64 + fr, col0 = u.pn * PG_BM + wc * 32 + 8 * fq;
#pragma unroll
        for (int ai = 0; ai < 2; ++ai)
#pragma unroll
            for (int m = 0; m < 4; ++m) { bf16* rowp = O + (size_t)(row0 + ai * PG_HALF + m * 16) * ldc + col0;
#pragma unroll
                for (int bj = 0; bj < 2; ++bj) { const f32x4 v0 = acc[ai][bj][m][0], v1 = acc[ai][bj][m][1];
                    v4u w; w.x = cvt_pk_bf16(v0[0], v0[1]); w.y = cvt_pk_bf16(v0[2], v0[3]); w.z = cvt_pk_bf16(v1[0], v1[1]); w.w = cvt_pk_bf16(v1[2], v1[3]);
                    *(v4u*)(rowp + bj * PG_HALF) = w; } }
    }
};
template <int NSRC> struct EpiRowScale {
    static constexpr bool PERM = true;
    const bf16* SRC; bf16* O; int ldc; float cscale;
    __device__ __forceinline__ void operator()(const f32x4 (&acc)[2][2][4][2], const Unit& u, int wr, int wc, int fr, int fq) const {
        const int row0 = u.pm * PG_BM + wr * 64 + fr, col0 = u.pn * PG_BM + wc * 32 + 8 * fq;
#pragma unroll
        for (int ai = 0; ai < 2; ++ai)
#pragma unroll
            for (int m = 0; m < 4; ++m) { const int row = row0 + ai * PG_HALF + m * 16;
                const v4u* sp = (const v4u*)(SRC + (size_t)row * 256 + fq * (NSRC / 4)); float ss = 0.f;
#pragma unroll
                for (int i = 0; i < NSRC / 32; ++i) { const v4u w = sp[i];
                    ss += bf_lo(w.x) * bf_lo(w.x) + bf_hi(w.x) * bf_hi(w.x) + bf_lo(w.y) * bf_lo(w.y) + bf_hi(w.y) * bf_hi(w.y) + bf_lo(w.z) * bf_lo(w.z) + bf_hi(w.z) * bf_hi(w.z) + bf_lo(w.w) * bf_lo(w.w) + bf_hi(w.w) * bf_hi(w.w); }
                ss += __shfl_xor(ss, 16); ss += __shfl_xor(ss, 32);
                const float sc = cscale / sqrtf(ss * (1.0f / NSRC) + EPS);
                bf16* rowp = O + (size_t)row * ldc + col0;
#pragma unroll
                for (int bj = 0; bj < 2; ++bj) { const f32x4 v0 = acc[ai][bj][m][0] * sc, v1 = acc[ai][bj][m][1] * sc;
                    v4u w; w.x = cvt_pk_bf16(v0[0], v0[1]); w.y = cvt_pk_bf16(v0[2], v0[3]); w.z = cvt_pk_bf16(v1[0], v1[1]); w.w = cvt_pk_bf16(v1[2], v1[3]);
                    *(v4u*)(rowp + bj * PG_HALF) = w; } }
    }
};
struct EpiF32 {
    static constexpr bool PERM = false;
    float* C; int ldc; const float* resid;
    __device__ __forceinline__ void operator()(const f32x4 (&acc)[2][2][4][2], const Unit& u, int wr, int wc, int fr, int fq) const {
        const int row0 = u.pm * PG_BM + wr * 64 + fr, col0 = u.pn * PG_BM + wc * 32 + 4 * fq;
#pragma unroll
        for (int ai = 0; ai < 2; ++ai)
#pragma unroll
            for (int m = 0; m < 4; ++m) { const size_t off = (size_t)(row0 + ai * PG_HALF + m * 16) * ldc + col0;
#pragma unroll
                for (int bj = 0; bj < 2; ++bj)
#pragma unroll
                    for (int n = 0; n < 2; ++n) { f32x4 v = acc[ai][bj][m][n]; if (resid) v += *(const f32x4*)(resid + off + bj * PG_HALF + n * 16); *(f32x4*)(C + off + bj * PG_HALF + n * 16) = v; } }
    }
};
template <int PASS> struct EpiGate {
    static constexpr bool PERM = true;
    const bf16* G; bf16* MG; int gcol0;
    __device__ __forceinline__ void operator()(const f32x4 (&acc)[2][2][4][2], const Unit& u, int wr, int wc, int fr, int fq) const {
        const int row0 = u.pm * PG_BM + wr * 64 + fr, col0 = u.pn * PG_BM + wc * 32 + 8 * fq;
#pragma unroll
        for (int ai = 0; ai < 2; ++ai)
#pragma unroll
            for (int m = 0; m < 4; ++m) { const int row = row0 + ai * PG_HALF + m * 16;
#pragma unroll
                for (int bj = 0; bj < 2; ++bj) { const int col = col0 + bj * PG_HALF;
                    const v4u gw = *(const v4u*)(G + (size_t)row * 2048 + gcol0 + col);
                    float v[8]; const f32x4 a0 = acc[ai][bj][m][0], a1 = acc[ai][bj][m][1];
                    v[0] = sigmoidf_(bf_lo(gw.x)) * a0[0]; v[1] = sigmoidf_(bf_hi(gw.x)) * a0[1]; v[2] = sigmoidf_(bf_lo(gw.y)) * a0[2]; v[3] = sigmoidf_(bf_hi(gw.y)) * a0[3];
                    v[4] = sigmoidf_(bf_lo(gw.z)) * a1[0]; v[5] = sigmoidf_(bf_hi(gw.z)) * a1[1]; v[6] = sigmoidf_(bf_lo(gw.w)) * a1[2]; v[7] = sigmoidf_(bf_hi(gw.w)) * a1[3];
                    v4u* mp = (v4u*)(MG + (size_t)row * 1024 + col);
                    if (PASS == 1) { const v4u t = *mp; v[0] += bf_lo(t.x); v[1] += bf_hi(t.x); v[2] += bf_lo(t.y); v[3] += bf_hi(t.y); v[4] += bf_lo(t.z); v[5] += bf_hi(t.z); v[6] += bf_lo(t.w); v[7] += bf_hi(t.w); }
                    v4u w; w.x = cvt_pk_bf16(v[0], v[1]); w.y = cvt_pk_bf16(v[2], v[3]); w.z = cvt_pk_bf16(v[4], v[5]); w.w = cvt_pk_bf16(v[6], v[7]);
                    *mp = w; } }
    }
};
namespace att {
constexpr int KB_BYTES = 12288, VB_BYTES = 12288, BUF_BYTES = KB_BYTES + VB_BYTES;
constexpr int OFF_IMP = 2 * BUF_BYTES;
constexpr int OFF_SC = OFF_IMP + 32768;
constexpr int OFF_SEL = OFF_SC + 8192;
constexpr int OFF_END = OFF_SEL + 512;
static_assert(OFF_END <= RING_BYTES, "attention LDS map");

__device__ __forceinline__ int crow(int r, int hi) { return (r & 3) + 8 * (r >> 2) + 4 * hi; }
__device__ __forceinline__ s16x4 vtr(const LAS unsigned char* p) { typedef short v4i16_t __attribute__((ext_vector_type(4))); return __builtin_bit_cast(s16x4, __builtin_amdgcn_ds_read_tr16_b64_v4i16((LAS v4i16_t*)p)); }
__device__ __forceinline__ unsigned cvtpk(float lo, float hi) { typedef float f2 __attribute__((ext_vector_type(2))); typedef __bf16 b2 __attribute__((ext_vector_type(2))); f2 v = {lo, hi}; b2 b = __builtin_convertvector(v, b2); return __builtin_bit_cast(unsigned, b); }
__device__ __forceinline__ float swapmax(float m) { auto rr = __builtin_amdgcn_permlane32_swap(__float_as_uint(m), __float_as_uint(m), false, false); return fmaxf(__uint_as_float(rr[0]), __uint_as_float(rr[1])); }
__device__ __forceinline__ float swapsum(float m) { auto rr = __builtin_amdgcn_permlane32_swap(__float_as_uint(m), __float_as_uint(m), false, false); return __uint_as_float(rr[0]) + __uint_as_float(rr[1]); }

struct Flash { f32x16 o[3]; float m, l; };
__device__ __forceinline__ void flash_init(Flash& f) { f.o[0] = f32x16{}; f.o[1] = f32x16{}; f.o[2] = f32x16{}; f.m = -1e30f; f.l = 0.f; }

template <int NKC>
__device__ __forceinline__ void issue_tile(LAS unsigned char* lds, int buf, const bf16* Kg, int ldk, const bf16* Kpe, const bf16* Vg, int ldv, int wave, int lane) {
    LAS unsigned char* kb = lds + buf * BUF_BYTES; LAS unsigned char* vb = kb + KB_BYTES;
    __builtin_amdgcn_global_load_lds((const unsigned*)(Kg + (size_t)lane * ldk + wave * 8), (LAS unsigned*)(kb + wave * 1024), 16, 0, 0);
    if (NKC == 12) { if (wave < 4) __builtin_amdgcn_global_load_lds((const unsigned*)(Kpe + (size_t)lane * 32 + wave * 8), (LAS unsigned*)(kb + (8 + wave) * 1024), 16, 0, 0); }
    __builtin_amdgcn_global_load_lds((const unsigned*)(Vg + (size_t)(16 * (wave & 3) + (lane >> 2)) * ldv + (wave >> 2) * 32 + (lane & 3) * 8), (LAS unsigned*)(vb + wave * 1024), 16, 0, 0);
}

template <int NKS, int NVB, bool HAS_BIAS>
__device__ __forceinline__ void tile_compute(Flash& f, const LAS unsigned char* kb, const LAS unsigned char* vb, const bf16x8* qr, float slope, float cb,
                                             int lo, int hi_, bool need_mask, int r32, int hh, int lane) {
    f32x16 p0, p1;
    if (HAS_BIAS) {
        const float cb0 = cb + slope * (float)(4 * hh), cb1 = cb0 + slope * 32.f;
#pragma unroll
        for (int r = 0; r < 16; ++r) { const float cr = (float)((r & 3) + 8 * (r >> 2)); p0[r] = __builtin_fmaf(slope, cr, cb0); p1[r] = __builtin_fmaf(slope, cr, cb1); }
    } else { p0 = f32x16{}; p1 = f32x16{}; }
    const LAS unsigned char* kp = kb + hh * 1024 + r32 * 16;
#pragma unroll
    for (int d0 = 0; d0 < NKS; ++d0) {
        const bf16x8 b0 = *(const LAS bf16x8*)(kp + d0 * 2048);
        const bf16x8 b1 = *(const LAS bf16x8*)(kp + d0 * 2048 + 512);
        p0 = __builtin_amdgcn_mfma_f32_32x32x16_bf16(b0, qr[d0], p0, 0, 0, 0);
        p1 = __builtin_amdgcn_mfma_f32_32x32x16_bf16(b1, qr[d0], p1, 0, 0, 0);
    }
    if (need_mask) {
        const int l0 = lo - 4 * hh, h0 = hi_ - 4 * hh;
#pragma unroll
        for (int r = 0; r < 16; ++r) { const int c = (r & 3) + 8 * (r >> 2);
            if (c < l0 || c > h0) p0[r] = -INFINITY;
            if (c + 32 < l0 || c + 32 > h0) p1[r] = -INFINITY; }
    }
    float mt = fmaxf(p0[0], p1[0]);
#pragma unroll
    for (int r = 1; r < 16; ++r) mt = fmaxf(mt, fmaxf(p0[r], p1[r]));
    mt = swapmax(mt);
    const float mn = fmaxf(f.m, mt);
    const float alpha = __builtin_amdgcn_exp2f(f.m - mn);
    f.m = mn;
    float sum = 0.f;
#pragma unroll
    for (int r = 0; r < 16; ++r) { p0[r] = __builtin_amdgcn_exp2f(p0[r] - mn); p1[r] = __builtin_amdgcn_exp2f(p1[r] - mn); sum += p0[r] + p1[r]; }
    f.l = f.l * alpha + sum;
#pragma unroll
    for (int b = 0; b < NVB; ++b)
#pragma unroll
        for (int r = 0; r < 16; ++r) f.o[b][r] *= alpha;
    v4u pw[4];
    pw[0] = (v4u){cvtpk(p0[0], p0[1]), cvtpk(p0[2], p0[3]), cvtpk(p0[4], p0[5]), cvtpk(p0[6], p0[7])};
    pw[1] = (v4u){cvtpk(p0[8], p0[9]), cvtpk(p0[10], p0[11]), cvtpk(p0[12], p0[13]), cvtpk(p0[14], p0[15])};
    pw[2] = (v4u){cvtpk(p1[0], p1[1]), cvtpk(p1[2], p1[3]), cvtpk(p1[4], p1[5]), cvtpk(p1[6], p1[7])};
    pw[3] = (v4u){cvtpk(p1[8], p1[9]), cvtpk(p1[10], p1[11]), cvtpk(p1[12], p1[13]), cvtpk(p1[14], p1[15])};
    const LAS unsigned char* vp = vb + ((lane >> 4) & 1) * 32 + (lane & 3) * 8 + (4 * hh + ((lane & 15) >> 2)) * 64;
#pragma unroll
    for (int b = 0; b < NVB; ++b)
#pragma unroll
        for (int ks = 0; ks < 4; ++ks) {
            const s16x4 vl = vtr(vp + b * 4096 + ks * 1024), vh = vtr(vp + b * 4096 + ks * 1024 + 512);
            const bf16x8 va = (bf16x8){vl[0], vl[1], vl[2], vl[3], vh[0], vh[1], vh[2], vh[3]};
            f.o[b] = __builtin_amdgcn_mfma_f32_32x32x16_bf16(va, __builtin_bit_cast(bf16x8, pw[ks]), f.o[b], 0, 0, 0);
        }
}
__device__ __forceinline__ void flash_finish(Flash& f, int nvb) {
    const float lt = swapsum(f.l); const float inv = lt > 0.f ? 1.0f / lt : 0.f;
#pragma unroll
    for (int b = 0; b < 3; ++b) if (b < nvb) {
#pragma unroll
        for (int r = 0; r < 16; ++r) f.o[b][r] *= inv; }
}

__device__ __forceinline__ void nsa_unit(Frame& F, int b, int g, int qc) {
    LAS unsigned char* lds = F.lds; const int lane = F.lane, wave = F.wave, r32 = lane & 31, hh = lane >> 5;
    const int head = g * 4 + (wave >> 1);
    const int qloc = 32 * (wave & 1) + r32;
    const int t = 64 * qc + qloc;
    const size_t row = (size_t)b * SEQ + t;
    const bf16* QKV = (const bf16*)(F.ws + WS_QKV); const bf16* MISC = (const bf16*)(F.ws + WS_MISC);
    bf16x8 qr[4];
#pragma unroll
    for (int d0 = 0; d0 < 4; ++d0) qr[d0] = *(const bf16x8*)(QKV + row * 1280 + head * 64 + d0 * 16 + hh * 8);
    const float slope2 = exp2f(-(float)(head + 1)) * LOG2E;
    LAS unsigned* selw = (LAS unsigned*)(lds + OFF_SEL);
    if (F.tid < 80) selw[F.tid] = 0u;
    f32x16 ot0, ot1;
    {
        const bf16* KC = (const bf16*)(F.ws + WS_KC) + (size_t)(b * 2 + g) * 128 * 64; const bf16* VC = (const bf16*)(F.ws + WS_VC) + (size_t)(b * 2 + g) * 128 * 64;
        Flash f; flash_init(f);
        int nmax = (t >= 31) ? ((t - 31) >> 4) : -1; if (nmax > 126) nmax = 126;
        for (int ti = 0; ti < 2; ++ti) {
            issue_tile<8>(lds, ti, KC + (size_t)ti * 64 * 64, 64, nullptr, VC + (size_t)ti * 64 * 64, 64, wave, lane);
            LAS bf16* ov = (LAS bf16*)(lds + ti * BUF_BYTES + KB_BYTES + 2 * 4096);
#pragma unroll
            for (int e = 0; e < 4; ++e) { const int idx = F.tid * 4 + e, nl = idx >> 5, s = idx & 31, n = 64 * ti + nl;
                float v = 0.f; if (s == (n >> 2)) v = ((n & 3) == 3) ? 0.5f : 1.0f; else if (s == (n >> 2) + 1 && (n & 3) == 3) v = 0.5f;
                ov[(nl >> 4) * 512 + (nl & 15) * 32 + s] = (bf16)f2bf(v); }
        }
        __syncthreads();
#pragma unroll 1
        for (int ti = 0; ti < 2; ++ti) {
            const LAS unsigned char* kb = lds + ti * BUF_BYTES;
            tile_compute<4, 3, true>(f, kb, kb + KB_BYTES, qr, 16.f * slope2, 16.f * slope2 * (float)(64 * ti), 0, nmax - 64 * ti, true, r32, hh, lane);
        }
        flash_finish(f, 3);
        LAS float* imp = (LAS float*)(lds + OFF_IMP) + (wave * 32 + r32) * 32;
#pragma unroll
        for (int r = 0; r < 16; ++r) imp[crow(r, hh)] = f.o[2][r];
        const float gc = sigmoidf_(bf2f(MISC[row * 256 + 160 + head]));
        ot0 = f.o[0] * gc; ot1 = f.o[1] * gc;
    }
    __syncthreads();
    {
        LAS float* IMP = (LAS float*)(lds + OFF_IMP); LAS float* SC = (LAS float*)(lds + OFF_SC);
        const int q = F.tid >> 3, s4 = (F.tid & 7) * 4;
#pragma unroll
        for (int e = 0; e < 4; ++e) { const int s = s4 + e; float v = 0.f;
#pragma unroll
            for (int h4 = 0; h4 < 4; ++h4) v += IMP[((2 * h4 + (q >> 5)) * 32 + (q & 31)) * 32 + s];
            const bool causal = s <= qc, forced = causal && (s == 0 || s + 2 > qc);
            SC[q * 32 + s] = causal ? (v + (forced ? 1e4f : 0.f)) : -1e30f; }
        __syncthreads();
        float sc[32];
#pragma unroll
        for (int s = 0; s < 32; ++s) sc[s] = SC[q * 32 + s];
        unsigned bits = 0u;
#pragma unroll
        for (int e = 0; e < 4; ++e) { const int s = s4 + e; const float me = SC[q * 32 + s]; int rank = 0;
#pragma unroll
            for (int s2 = 0; s2 < 32; ++s2) rank += (sc[s2] > me || (sc[s2] == me && s2 < s)) ? 1 : 0;
            if (s <= qc && rank < 16) bits |= 1u << s; }
        atomicOr((unsigned*)&selw[q], bits); atomicOr((unsigned*)&selw[64], bits);
    }
    __syncthreads();
    const unsigned mymask = selw[qloc], anymask = selw[64];
    {
        const bf16* Kg = QKV + (size_t)b * SEQ * 1280 + 768 + g * 64; const bf16* Vg = QKV + (size_t)b * SEQ * 1280 + 896 + g * 64;
        Flash f; flash_init(f);
        unsigned rem = anymask; int buf = 0;
        { const int j0 = __builtin_ctz(rem); issue_tile<8>(lds, 0, Kg + (size_t)j0 * 64 * 1280, 1280, nullptr, Vg + (size_t)j0 * 64 * 1280, 1280, wave, lane); }
        while (rem) {
            const int j = __builtin_ctz(rem); rem &= rem - 1;
            __syncthreads();
            if (rem) { const int jn = __builtin_ctz(rem); issue_tile<8>(lds, buf ^ 1, Kg + (size_t)jn * 64 * 1280, 1280, nullptr, Vg + (size_t)jn * 64 * 1280, 1280, wave, lane); }
            const bool sel = (mymask >> j) & 1u;
            const int hi_ = sel ? ((j == qc) ? (t - 64 * j) : 63) : -1;
            const bool need = (j == qc) || !__all(sel);
            const LAS unsigned char* kb = lds + buf * BUF_BYTES;
            tile_compute<4, 2, true>(f, kb, kb + KB_BYTES, qr, slope2, slope2 * (float)(64 * j), 0, hi_, need, r32, hh, lane);
            buf ^= 1;
        }
        flash_finish(f, 2);
        const float gs = sigmoidf_(bf2f(MISC[row * 256 + 160 + 8 + head]));
        ot0 += f.o[0] * gs; ot1 += f.o[1] * gs;
        __syncthreads();
    }
    {
        const bf16* Kg = QKV + (size_t)b * SEQ * 1280 + 1024 + g * 64; const bf16* Vg = QKV + (size_t)b * SEQ * 1280 + 1152 + g * 64;
        Flash f; flash_init(f);
        const int j0 = qc >= 8 ? qc - 8 : 0; int buf = 0;
        issue_tile<8>(lds, 0, Kg + (size_t)j0 * 64 * 1280, 1280, nullptr, Vg + (size_t)j0 * 64 * 1280, 1280, wave, lane);
        for (int j = j0; j <= qc; ++j) {
            __syncthreads();
            if (j < qc) issue_tile<8>(lds, buf ^ 1, Kg + (size_t)(j + 1) * 64 * 1280, 1280, nullptr, Vg + (size_t)(j + 1) * 64 * 1280, 1280, wave, lane);
            int lo = t - 511 - 64 * j; if (lo < 0) lo = 0; int hi_ = t - 64 * j; if (hi_ > 63) hi_ = 63;
            const bool need = (j == qc) || (j + 8 == qc);
            const LAS unsigned char* kb = lds + buf * BUF_BYTES;
            tile_compute<4, 2, true>(f, kb, kb + KB_BYTES, qr, slope2, slope2 * (float)(64 * j), lo, hi_, need, r32, hh, lane);
            buf ^= 1;
        }
        flash_finish(f, 2);
        const float gw = sigmoidf_(bf2f(MISC[row * 256 + 160 + 16 + head]));
        ot0 += f.o[0] * gw; ot1 += f.o[1] * gw;
        __syncthreads();
    }
    { bf16* op = (bf16*)(F.ws + WS_OCAT) + row * 1024 + head * 64 + 4 * hh;
#pragma unroll
      for (int k = 0; k < 4; ++k) {
          *(v2u*)(op + 8 * k) = (v2u){cvtpk(ot0[4 * k], ot0[4 * k + 1]), cvtpk(ot0[4 * k + 2], ot0[4 * k + 3])};
          *(v2u*)(op + 32 + 8 * k) = (v2u){cvtpk(ot1[4 * k], ot1[4 * k + 1]), cvtpk(ot1[4 * k + 2], ot1[4 * k + 3])}; } }
}

__device__ __forceinline__ void mla_unit(Frame& F, int b, int h, int qb) {
    LAS unsigned char* lds = F.lds; const int lane = F.lane, wave = F.wave, r32 = lane & 31, hh = lane >> 5;
    const int t = 256 * qb + 32 * wave + r32;
    const size_t row = (size_t)b * SEQ + t;
    const bf16* MQ = (const bf16*)(F.ws + WS_MLAQ); const bf16* MKV = (const bf16*)(F.ws + WS_MLAKV); const bf16* KPE = (const bf16*)(F.ws + WS_KPE);
    bf16x8 qr[6];
#pragma unroll
    for (int d0 = 0; d0 < 6; ++d0) qr[d0] = *(const bf16x8*)(MQ + row * 768 + h * 96 + d0 * 16 + hh * 8);
    {
        const float pos = (float)F.pos[row];
        v4u a = __builtin_bit_cast(v4u, qr[4]), c = __builtin_bit_cast(v4u, qr[5]);
        float x1[8], x2[8];
        x1[0] = bf_lo(a.x); x1[1] = bf_hi(a.x); x1[2] = bf_lo(a.y); x1[3] = bf_hi(a.y); x1[4] = bf_lo(a.z); x1[5] = bf_hi(a.z); x1[6] = bf_lo(a.w); x1[7] = bf_hi(a.w);
        x2[0] = bf_lo(c.x); x2[1] = bf_hi(c.x); x2[2] = bf_lo(c.y); x2[3] = bf_hi(c.y); x2[4] = bf_lo(c.z); x2[5] = bf_hi(c.z); x2[6] = bf_lo(c.w); x2[7] = bf_hi(c.w);
        float y1[8], y2[8];
#pragma unroll
        for (int j = 0; j < 8; ++j) { const float inv = powf(10000.0f, -(float)(2 * (8 * hh + j)) / 32.0f); const float ang = pos * inv; const float cs = cosf(ang), sn = sinf(ang);
            y1[j] = x1[j] * cs - x2[j] * sn; y2[j] = x1[j] * sn + x2[j] * cs; }
        a = (v4u){cvtpk(y1[0], y1[1]), cvtpk(y1[2], y1[3]), cvtpk(y1[4], y1[5]), cvtpk(y1[6], y1[7])};
        c = (v4u){cvtpk(y2[0], y2[1]), cvtpk(y2[2], y2[3]), cvtpk(y2[4], y2[5]), cvtpk(y2[6], y2[7])};
        qr[4] = __builtin_bit_cast(bf16x8, a); qr[5] = __builtin_bit_cast(bf16x8, c);
    }
    const bf16* Kg = MKV + (size_t)b * SEQ * 1024 + h * 128; const bf16* Vg = Kg + 64; const bf16* Pg = KPE + (size_t)b * SEQ * 32;
    Flash f; flash_init(f);
    const int NT = 4 * qb + 4; int buf = 0;
    const int tmax_w = 256 * qb + 32 * wave + 31;
    issue_tile<12>(lds, 0, Kg, 1024, Pg, Vg, 1024, wave, lane);
    for (int j = 0; j < NT; ++j) {
        __syncthreads();
        if (j + 1 < NT) issue_tile<12>(lds, buf ^ 1, Kg + (size_t)(j + 1) * 64 * 1024, 1024, Pg + (size_t)(j + 1) * 64 * 32, Vg + (size_t)(j + 1) * 64 * 1024, 1024, wave, lane);
        if (64 * j <= tmax_w) {
            int hi_ = t - 64 * j; if (hi_ > 63) hi_ = 63;
            const bool need = (64 * j + 63 > 256 * qb + 32 * wave);
            const LAS unsigned char* kb = lds + buf * BUF_BYTES;
            tile_compute<6, 2, false>(f, kb, kb + KB_BYTES, qr, 0.f, 0.f, 0, hi_, need, r32, hh, lane);
        }
        buf ^= 1;
    }
    flash_finish(f, 2);
    __syncthreads();
    { bf16* op = (bf16*)(F.ws + WS_OCAT) + row * 1024 + 512 + h * 64 + 4 * hh;
#pragma unroll
      for (int k = 0; k < 4; ++k) {
          *(v2u*)(op + 8 * k) = (v2u){cvtpk(f.o[0][4 * k], f.o[0][4 * k + 1]), cvtpk(f.o[0][4 * k + 2], f.o[0][4 * k + 3])};
          *(v2u*)(op + 32 + 8 * k) = (v2u){cvtpk(f.o[1][4 * k], f.o[1][4 * k + 1]), cvtpk(f.o[1][4 * k + 2], f.o[1][4 * k + 3])}; } }
}

__device__ __forceinline__ void attn_phase(Frame& F) {
    const unsigned short* ord = (const unsigned short*)(F.ws + WS_ORDER);
#pragma unroll 1
    for (int i = F.bid; i < 1024; i += F.G) { const int u = ord[i]; if (u < 512) nsa_unit(F, u >> 6, (u >> 5) & 1, u & 31); }
#pragma unroll 1
    for (int i = F.bid; i < 1024; i += F.G) { const int u = ord[i]; if (u >= 512) { const int v = u - 512; mla_unit(F, v >> 6, (v >> 3) & 7, v & 7); } }
}
}
__device__ __forceinline__ void kpe_pass(Frame& F) {
    const bf16* MISC = (const bf16*)(F.ws + WS_MISC); bf16* KPE = (bf16*)(F.ws + WS_KPE);
    const int gt = F.bid * NTHREADS + F.tid, NGT = F.G * NTHREADS;
    for (int it = gt; it < MTOK * 16; it += NGT) { const int t = it >> 4, i = it & 15;
        const float x1 = bf2f(MISC[(size_t)t * 256 + 128 + i]), x2 = bf2f(MISC[(size_t)t * 256 + 144 + i]);
        const float inv = powf(10000.0f, -(float)(2 * i) / 32.0f); const float ang = (float)F.pos[t] * inv; const float cs = cosf(ang), sn = sinf(ang);
        KPE[(size_t)t * 32 + i] = (bf16)f2bf(x1 * cs - x2 * sn); KPE[(size_t)t * 32 + 16 + i] = (bf16)f2bf(x1 * sn + x2 * cs); }
}
__device__ __forceinline__ void cmp_finalize(Frame& F) {
    const int gw = F.bid * NWAVES + F.wave, NGW = F.G * NWAVES, lane = F.lane;
    LAS float* hid = (LAS float*)(F.lds + F.wave * 1024);
    for (int it = gw; it < 2 * 16 * 128; it += NGW) {
        const int kv = it >> 11, bg = (it >> 7) & 15, n = it & 127;
        bf16* dst = (bf16*)(F.ws + (kv ? WS_VC : WS_KC)) + ((size_t)bg * 128 + n) * 64;
        if (n == 127) { dst[lane] = 0; continue; }
        const float* U = (const float*)(F.ws + (kv ? WS_UV : WS_UK)) + (size_t)(bg * 128 + n) * 256; const float* c1 = (const float*)(F.ws + (kv ? WS_C1V : WS_C1K));
        const float* w2 = F.in[kv ? I_CW2V : I_CW2K];
        hid[lane] = gelu_tanh(U[lane] + U[256 + 128 + lane] + c1[lane]);
        hid[64 + lane] = gelu_tanh(U[64 + lane] + U[256 + 192 + lane] + c1[64 + lane]);
        asm volatile("s_waitcnt lgkmcnt(0)" ::: "memory");
        float s = 0.f;
#pragma unroll 8
        for (int i = 0; i < 128; ++i) s += hid[i] * w2[i * 64 + lane];
        dst[lane] = (bf16)f2bf(s);
        asm volatile("s_waitcnt lgkmcnt(0)" ::: "memory");
    }
}
__device__ __forceinline__ void cvt_table(Frame& F, const float* src, bf16* dst) {
    const size_t gt = (size_t)F.bid * NTHREADS + F.tid, NGT = (size_t)F.G * NTHREADS;
    for (size_t i = gt; i < (size_t)16384 * 1024 / 8; i += NGT) { const f32x4 a = ((const f32x4*)src)[2 * i], b = ((const f32x4*)src)[2 * i + 1];
        ((v4u*)dst)[i] = (v4u){pk2(a.x, a.y), pk2(a.z, a.w), pk2(b.x, b.y), pk2(b.z, b.w)}; }
}
__device__ __forceinline__ void xn2_pass(Frame& F) {
    const int gw = F.bid * NWAVES + F.wave, NGW = F.G * NWAVES; bf16* XN2 = (bf16*)(F.ws + WS_XN2);
    for (int m = gw; m < MTOK; m += NGW) rms_row_to_bf16(F.out + (size_t)m * DM, F.in[I_N2G], XN2 + (size_t)m * DM, F.lane);
}

namespace peer {
constexpr int TOK = 32;
constexpr int OFF_LIST = 0;
constexpr int OFF_ROUTE = 65536;
struct Ent { float v; unsigned k; };
__device__ __forceinline__ unsigned ordkey(float f) { const unsigned u = __float_as_uint(f); return u ^ ((u >> 31) ? 0xffffffffu : 0x80000000u); }
__device__ __forceinline__ float ordinv(unsigned k) { return __uint_as_float(k ^ ((k >> 31) ? 0x80000000u : 0xffffffffu)); }
__device__ __forceinline__ void swap2(int x, int& lo, int& hi) { auto rr = __builtin_amdgcn_permlane32_swap((unsigned)x, (unsigned)x, false, false); lo = (int)rr[0]; hi = (int)rr[1]; }

#define PEER_CANDS(X) X(0,0) X(0,1) X(0,2) X(0,3) X(0,4) X(0,5) X(0,6) X(0,7) X(0,8) X(0,9) X(0,10) X(0,11) X(0,12) X(0,13) X(0,14) X(0,15) \
    X(1,0) X(1,1) X(1,2) X(1,3) X(1,4) X(1,5) X(1,6) X(1,7) X(2,0) X(2,1) X(2,2) X(2,3) X(2,4) X(3,0) X(3,1) X(3,2) X(3,3) X(4,0) X(4,1) X(4,2) \
    X(5,0) X(5,1) X(6,0) X(6,1) X(7,0) X(7,1) X(8,0) X(9,0) X(10,0) X(11,0) X(12,0) X(13,0) X(14,0) X(15,0)

__device__ __forceinline__ void route_task(Frame& F, int tok0) {
    const int lane = F.lane, wave = F.wave, r32 = lane & 31, hh = lane >> 5;
    const bf16* QP = (const bf16*)(F.ws + WS_QP);
    const size_t row = (size_t)tok0 + r32;
    LAS Ent* LIST = (LAS Ent*)(F.lds + OFF_LIST) + (size_t)wave * 2 * TOK * 16;
#pragma unroll 1
    for (int half = 0; half < 2; ++half) {
        const bf16* SK = (const bf16*)(F.ws + (half ? WS_SK2 : WS_SK1));
        bf16x8 qf[8];
#pragma unroll
        for (int d0 = 0; d0 < 8; ++d0) qf[d0] = *(const bf16x8*)(QP + row * 2048 + wave * 256 + half * 128 + d0 * 16 + hh * 8);
        unsigned u[4][16];
#pragma unroll
        for (int kb = 0; kb < 4; ++kb) { f32x16 p = f32x16{};
#pragma unroll
            for (int d0 = 0; d0 < 8; ++d0) { const bf16x8 a = *(const bf16x8*)(SK + (size_t)(32 * kb + r32) * 128 + d0 * 16 + hh * 8);
                p = __builtin_amdgcn_mfma_f32_32x32x16_bf16(a, qf[d0], p, 0, 0, 0); }
#pragma unroll
            for (int r = 0; r < 16; ++r) u[kb][r] = ordkey(p[r]);
            asm volatile("" ::: "memory"); __builtin_amdgcn_sched_barrier(0); }
        unsigned prefix = 0u;
#pragma unroll 1
        for (int bit = 31; bit >= 0; --bit) { const unsigned trial = prefix | (1u << bit); int cnt = 0;
#pragma unroll
            for (int kb = 0; kb < 4; ++kb)
#pragma unroll
                for (int r = 0; r < 16; ++r) cnt += (u[kb][r] >= trial) ? 1 : 0;
            int c0, c1; swap2(cnt, c0, c1);
            if (c0 + c1 >= 16) prefix = trial; }
        int cgt = 0, ceq = 0;
#pragma unroll
        for (int kb = 0; kb < 4; ++kb)
#pragma unroll
            for (int r = 0; r < 16; ++r) { cgt += (u[kb][r] > prefix) ? 1 : 0; ceq += (u[kb][r] == prefix) ? 1 : 0; }
        int g0, g1, e0, e1; swap2(cgt, g0, g1); swap2(ceq, e0, e1);
        const int need = 16 - (g0 + g1);
        const int take0 = e0 < need ? e0 : need; const int take1 = (need - take0) < e1 ? (need - take0) : e1;
        int slot = hh ? (g0 + take0) : 0; int eq_left = hh ? take1 : take0;
        LAS Ent* L = LIST + ((size_t)half * TOK + r32) * 16;
#pragma unroll
        for (int kb = 0; kb < 4; ++kb)
#pragma unroll
            for (int r = 0; r < 16; ++r) { const unsigned uu = u[kb][r]; const int eq = ((uu == prefix) & (eq_left > 0)) ? 1 : 0; const int tk = (uu > prefix) ? 1 : eq;
                if (tk & (slot < 16)) { L[slot].v = ordinv(uu); L[slot].k = (unsigned)(32 * kb + (r & 3) + 8 * (r >> 2) + 4 * hh); }
                slot += tk; eq_left -= eq; }
    }
    asm volatile("s_waitcnt lgkmcnt(0)" ::: "memory");
    {
        LAS Ent* L = LIST + ((size_t)hh * TOK + r32) * 16;
        float v[16]; unsigned k[16];
#pragma unroll
        for (int a = 0; a < 16; ++a) { v[a] = L[a].v; k[a] = L[a].k; }
        asm volatile("s_waitcnt lgkmcnt(0)" ::: "memory");
#pragma unroll
        for (int a = 0; a < 16; ++a) { int rank = 0;
#pragma unroll
            for (int a2 = 0; a2 < 16; ++a2) rank += (v[a2] > v[a] || (v[a2] == v[a] && a2 < a)) ? 1 : 0;
            L[rank].v = v[a]; L[rank].k = k[a]; }
    }
    asm volatile("s_waitcnt lgkmcnt(0)" ::: "memory");
    {
        const LAS Ent* L1 = LIST + ((size_t)0 * TOK + r32) * 16; const LAS Ent* L2 = LIST + ((size_t)1 * TOK + r32) * 16;
        float v1[16], v2[16];
#pragma unroll
        for (int a = 0; a < 16; ++a) { v1[a] = L1[a].v; v2[a] = L2[a].v; }
        unsigned uc[50]; { int ci = 0;
#define X(a, b) uc[ci++] = ordkey(v1[a] + v2[b]);
        PEER_CANDS(X)
#undef X
        }
        const float cmax = v1[0] + v2[0];
        unsigned prefix = 0u;
#pragma unroll 1
        for (int bit = 31; bit >= 0; --bit) { const unsigned trial = prefix | (1u << bit); int cnt = 0;
#pragma unroll
            for (int i = 0; i < 50; ++i) cnt += (uc[i] >= trial) ? 1 : 0;
            if (cnt >= 16) prefix = trial; }
        int cgt = 0; float gsum = 0.f;
#pragma unroll
        for (int i = 0; i < 50; ++i) cgt += (uc[i] > prefix) ? 1 : 0;
        int eq_left = 16 - cgt;
        unsigned long long selm = 0ull;
#pragma unroll
        for (int i = 0; i < 50; ++i) { const int eq = ((uc[i] == prefix) & (eq_left > 0)) ? 1 : 0; const int sl = (uc[i] > prefix) ? 1 : eq; eq_left -= eq;
            selm |= (unsigned long long)sl << i; gsum += sl ? __expf(ordinv(uc[i]) - cmax) : 0.f; }
        const float ginv = 1.0f / gsum;
        LAS Ent* R = (LAS Ent*)(F.lds + OFF_ROUTE) + ((size_t)wave * TOK + r32) * 16;
        if (hh == 0) { int i = 0, slot = 0;
#define X(a, b) { const int sl = (int)((selm >> i) & 1ull); if (sl & (slot < 16)) { R[slot].k = L1[a].k * 128u + L2[b].k; R[slot].v = __expf(ordinv(uc[i]) - cmax) * ginv; } slot += sl; ++i; }
            PEER_CANDS(X)
#undef X
        }
    }
}

__device__ __forceinline__ void gather_token(Frame& F, int tl, size_t row) {
    const int lane = F.lane;
    const bf16* EXPD = (const bf16*)(F.ws + WS_EXPD); const bf16* EXPU = (const bf16*)(F.ws + WS_EXPU);
    float hv[16], xh[16], y[16];
    { const f32x4* hp = (const f32x4*)(F.out + row * DM); const f32x4* gp = (const f32x4*)F.in[I_N2G];
      float ss = 0.f;
#pragma unroll
      for (int c = 0; c < 4; ++c) { const int e4 = (c >> 1) * 128 + 2 * lane + (c & 1); const f32x4 v = hp[e4]; hv[4 * c] = v.x; hv[4 * c + 1] = v.y; hv[4 * c + 2] = v.z; hv[4 * c + 3] = v.w; ss += (v.x * v.x + v.y * v.y) + (v.z * v.z + v.w * v.w); }
      const float r = 1.0f / sqrtf(wave_sum(ss) * (1.f / DM) + EPS);
#pragma unroll
      for (int c = 0; c < 4; ++c) { const int e4 = (c >> 1) * 128 + 2 * lane + (c & 1); const f32x4 g = gp[e4]; xh[4 * c] = hv[4 * c] * r * g.x; xh[4 * c + 1] = hv[4 * c + 1] * r * g.y; xh[4 * c + 2] = hv[4 * c + 2] * r * g.z; xh[4 * c + 3] = hv[4 * c + 3] * r * g.w; }
    }
#pragma unroll
    for (int i = 0; i < 16; ++i) y[i] = 0.f;
    const LAS Ent* R = (const LAS Ent*)(F.lds + OFF_ROUTE);
#pragma unroll 1
    for (int grp = 0; grp < 32; ++grp) {
        const int head = grp >> 2, k0 = (grp & 3) * 4;
        unsigned ex[4]; float gt[4]; v4u dn[4][2], up[4][2];
#pragma unroll
        for (int k = 0; k < 4; ++k) { const LAS Ent* en = R + ((size_t)head * TOK + tl) * 16 + k0 + k; ex[k] = (unsigned)__builtin_amdgcn_readfirstlane((int)en->k); gt[k] = __uint_as_float((unsigned)__builtin_amdgcn_readfirstlane((int)__float_as_uint(en->v))); }
#pragma unroll
        for (int k = 0; k < 4; ++k) { const v4u* dp = (const v4u*)(EXPD + (size_t)ex[k] * 1024) + lane; const v4u* upp = (const v4u*)(EXPU + (size_t)ex[k] * 1024) + lane;
            dn[k][0] = dp[0]; dn[k][1] = dp[64]; up[k][0] = upp[0]; up[k][1] = upp[64]; }
        float dt[4];
#pragma unroll
        for (int k = 0; k < 4; ++k) { float s = 0.f;
#pragma unroll
            for (int c = 0; c < 2; ++c) { const v4u w = dn[k][c];
                s += bf_lo(w.x) * xh[8 * c] + bf_hi(w.x) * xh[8 * c + 1] + bf_lo(w.y) * xh[8 * c + 2] + bf_hi(w.y) * xh[8 * c + 3] + bf_lo(w.z) * xh[8 * c + 4] + bf_hi(w.z) * xh[8 * c + 5] + bf_lo(w.w) * xh[8 * c + 6] + bf_hi(w.w) * xh[8 * c + 7]; }
            dt[k] = s; }
        { const bool up32 = lane & 32; float keep0 = up32 ? dt[1] : dt[0], send0 = up32 ? dt[0] : dt[1]; keep0 += __shfl_xor(send0, 32);
          float keep1 = up32 ? dt[3] : dt[2], send1 = up32 ? dt[2] : dt[3]; keep1 += __shfl_xor(send1, 32);
          const bool up16 = lane & 16; float keep = up16 ? keep1 : keep0, send = up16 ? keep0 : keep1; keep += __shfl_xor(send, 16);
          keep += __shfl_xor(keep, 8); keep += __shfl_xor(keep, 4); keep += __shfl_xor(keep, 2); keep += __shfl_xor(keep, 1);
          dt[0] = __shfl(keep, 0); dt[2] = __shfl(keep, 16); dt[1] = __shfl(keep, 32); dt[3] = __shfl(keep, 48); }
#pragma unroll
        for (int k = 0; k < 4; ++k) { const float wk = gt[k] * gelu_tanh(dt[k]);
#pragma unroll
            for (int c = 0; c < 2; ++c) { const v4u w = up[k][c];
                y[8 * c] += wk * bf_lo(w.x); y[8 * c + 1] += wk * bf_hi(w.x); y[8 * c + 2] += wk * bf_lo(w.y); y[8 * c + 3] += wk * bf_hi(w.y);
                y[8 * c + 4] += wk * bf_lo(w.z); y[8 * c + 5] += wk * bf_hi(w.z); y[8 * c + 6] += wk * bf_lo(w.w); y[8 * c + 7] += wk * bf_hi(w.w); } }
    }
    { float ss = 0.f;
#pragma unroll
      for (int i = 0; i < 16; ++i) { hv[i] += y[i]; ss += hv[i] * hv[i]; }
      const float r = 1.0f / sqrtf(wave_sum(ss) * (1.f / DM) + EPS);
      f32x4* op = (f32x4*)(F.out + row * DM); const f32x4* gp = (const f32x4*)F.in[I_NFG];
#pragma unroll
      for (int c = 0; c < 4; ++c) { const int e4 = (c >> 1) * 128 + 2 * lane + (c & 1); const f32x4 g = gp[e4];
          op[e4] = (f32x4){hv[4 * c] * r * g.x, hv[4 * c + 1] * r * g.y, hv[4 * c + 2] * r * g.z, hv[4 * c + 3] * r * g.w}; } }
}

__device__ __forceinline__ void peer_phase(Frame& F) {
    for (int task = F.bid; task < MTOK / TOK; task += F.G) {
        const int tok0 = task * TOK;
#ifndef NO_ROUTE
        route_task(F, tok0);
#endif
        __syncthreads();
#ifndef NO_GATHER
        for (int i = 0; i < TOK / NWAVES; ++i) { const int tl = F.wave * (TOK / NWAVES) + i; gather_token(F, tl, (size_t)tok0 + tl); }
#endif
        __syncthreads();
    }
}
}
#ifndef MK_ONE_LAUNCH
#define MK_ONE_LAUNCH 1
#endif
constexpr int N_PHASES = 10;
struct Args { const void* in[N_IN]; float* out; unsigned char* ws; int ph_lo, ph_hi; };
__global__ void __launch_bounds__(NTHREADS, 2) fwd(Args a) {
    extern __shared__ __attribute__((aligned(16))) unsigned char lds_raw[];
    cg::grid_group grid = cg::this_grid();
    Frame F;
    F.lds = (LAS unsigned char*)lds_raw;
    F.tid = threadIdx.x; F.lane = F.tid & 63; F.wave = __builtin_amdgcn_readfirstlane(F.tid >> 6);
    F.G = gridDim.x; F.bid = blockIdx.x;
    F.in = (const float* const*)a.in;
    F.pos = (const int*)a.in[I_POS]; F.out = a.out; F.ws = a.ws;
    unsigned char* ws = a.ws;
    const int lo = a.ph_lo, hi = a.ph_hi;
#ifndef PHASE_MASK
#define PHASE_MASK 0x3ff
#endif
#define IN(k) (((PHASE_MASK >> (k)) & 1) && lo <= (k) && (k) < hi)
#define SEAM(k) do { if (IN(k) && IN((k) + 1)) grid.sync(); } while (0)
    pg8::StaticOrder S;

    if (IN(0)) { p0_prologue(F); }
    SEAM(0);
    if (IN(1)) {
        pg8::Gemm g = pg8::make_gemm((const bf16*)(ws + WS_XN), 1024, (const bf16*)(ws + WS_WIN), 1024, MTOK, NPROJ, 1024);
        S.init(MTOK, NPROJ, F.G, F.bid);
        EpiInProj E{(bf16*)(ws + WS_QKV), (bf16*)(ws + WS_CQ), (bf16*)(ws + WS_MISC), (bf16*)(ws + WS_GATES)};
        pg8::gemm_phase<EpiInProj, pg8::StaticOrder, true>(F.lds, g, S, E);
    }
    SEAM(1);
    if (IN(2)) {
        { pg8::Gemm g = pg8::make_gemm((const bf16*)(ws + WS_CQ), 256, (const bf16*)(ws + WS_WUQ), 256, MTOK, 768, 256);
          S.init(MTOK, 768, F.G, F.bid);
          EpiRowScale<256> E{(const bf16*)(ws + WS_CQ), (bf16*)(ws + WS_MLAQ), 768, QSCALE_MLA};
          pg8::gemm_phase<EpiRowScale<256>, pg8::StaticOrder, true>(F.lds, g, S, E); }
        { pg8::Gemm g = pg8::make_gemm((const bf16*)(ws + WS_MISC), 256, (const bf16*)(ws + WS_WUKV), 256, MTOK, 1024, 256);
          S.init(MTOK, 1024, F.G, F.bid);
          EpiRowScale<128> E{(const bf16*)(ws + WS_MISC), (bf16*)(ws + WS_MLAKV), 1024, 1.0f};
          pg8::gemm_phase<EpiRowScale<128>, pg8::StaticOrder, true>(F.lds, g, S, E); }
#pragma unroll 1
        for (int kv = 0; kv < 2; ++kv) {
            pg8::Gemm g; g.A = (const bf16*)(ws + WS_QKV) + 512 + 128 * kv; g.Bt = (const bf16*)(ws + (kv ? WS_WC1V : WS_WC1K)); g.M = 2048; g.N = 256; g.K = 1024;
            g.aRow = (size_t)16 * 1280 * 2; g.aHalf = 128; g.aTile = (size_t)SEQ * 1280 * 2; g.aK = (size_t)1280 * 2; g.bRow = 1024 * 2;
            S.init(2048, 256, F.G, F.bid);
            EpiF32 E{(float*)(ws + (kv ? WS_UV : WS_UK)), 256, nullptr};
            pg8::gemm_phase<EpiF32, pg8::StaticOrder, true>(F.lds, g, S, E);
        }
        kpe_pass(F);
    }
    SEAM(2);
    if (IN(3)) { cmp_finalize(F); }
    SEAM(3);
    if (IN(4)) { att::attn_phase(F); }
    SEAM(4);
    if (IN(5)) {
        S.init(MTOK, 1024, F.G, F.bid);
        { pg8::Gemm g = pg8::make_gemm((const bf16*)(ws + WS_OCAT), 1024, (const bf16*)(ws + WS_WBR), 1024, MTOK, 1024, 512);
          EpiGate<0> E{(const bf16*)(ws + WS_GATES), (bf16*)(ws + WS_MERGED), 0};
          pg8::gemm_phase<EpiGate<0>, pg8::StaticOrder, true>(F.lds, g, S, E); }
        { pg8::Gemm g = pg8::make_gemm((const bf16*)(ws + WS_OCAT) + 512, 1024, (const bf16*)(ws + WS_WBR) + 512, 1024, MTOK, 1024, 512);
          EpiGate<1> E{(const bf16*)(ws + WS_GATES), (bf16*)(ws + WS_MERGED), 1024};
          pg8::gemm_phase<EpiGate<1>, pg8::StaticOrder, true>(F.lds, g, S, E); }
        cvt_table(F, F.in[I_EDN], (bf16*)(ws + WS_EXPD));
    }
    SEAM(5);
    if (IN(6)) {
        pg8::Gemm g = pg8::make_gemm((const bf16*)(ws + WS_MERGED), 1024, (const bf16*)(ws + WS_WOUT), 1024, MTOK, 1024, 1024);
        S.init(MTOK, 1024, F.G, F.bid);
        EpiF32 E{F.out, 1024, F.in[I_X]};
        pg8::gemm_phase<EpiF32, pg8::StaticOrder, true>(F.lds, g, S, E);
        cvt_table(F, F.in[I_EUP], (bf16*)(ws + WS_EXPU));
    }
    SEAM(6);
    if (IN(7)) { xn2_pass(F); }
    SEAM(7);
    if (IN(8)) {
        pg8::Gemm g = pg8::make_gemm((const bf16*)(ws + WS_XN2), 1024, (const bf16*)(ws + WS_WPQ), 1024, MTOK, 2048, 1024);
        S.init(MTOK, 2048, F.G, F.bid);
        EpiBf16 E{(bf16*)(ws + WS_QP), 2048};
        pg8::gemm_phase<EpiBf16, pg8::StaticOrder, true>(F.lds, g, S, E);
    }
    SEAM(8);
    if (IN(9)) { peer::peer_phase(F); }
#undef IN
#undef SEAM
}

extern "C" void kernel_launch(void* const* d_in, const int* in_sizes, int n_in, void* d_out, int out_size, void* d_ws, size_t ws_size, hipStream_t stream) {
    static int grid = 0;
    if (grid == 0) {
        if (n_in != N_IN || out_size != MTOK * DM || ws_size < WS_END) { fprintf(stderr, "kernel_launch: unexpected shapes (n_in %d, out %d, ws %zu)\n", n_in, out_size, ws_size); grid = -1; return; }
        int dev = 0, cus = 0, per_cu = 0;
        if (hipGetDevice(&dev) != hipSuccess || hipDeviceGetAttribute(&cus, hipDeviceAttributeMultiprocessorCount, dev) != hipSuccess) { grid = -1; return; }
        if (hipFuncSetAttribute((const void*)fwd, hipFuncAttributeMaxDynamicSharedMemorySize, LDS_BYTES) != hipSuccess) { fprintf(stderr, "kernel_launch: hipFuncSetAttribute failed\n"); grid = -1; return; }
        if (hipOccupancyMaxActiveBlocksPerMultiprocessor(&per_cu, (const void*)fwd, NTHREADS, LDS_BYTES) != hipSuccess || per_cu < 1) { fprintf(stderr, "kernel_launch: occupancy query says %d\n", per_cu); (void)hipGetLastError(); grid = -1; return; }
        grid = cus;
    }
    if (grid < 0) return;
    Args a{};
    for (int i = 0; i < N_IN; ++i) a.in[i] = d_in[i];
    a.out = (float*)d_out; a.ws = (unsigned char*)d_ws;
#if MK_ONE_LAUNCH
    a.ph_lo = 0; a.ph_hi = N_PHASES;
    void* args[] = {&a};
    hipError_t e = hipLaunchCooperativeKernel((const void*)fwd, dim3(grid), dim3(NTHREADS), args, LDS_BYTES, stream);
    if (e != hipSuccess) fprintf(stderr, "kernel_launch: cooperative launch failed: %s (grid %d)\n", hipGetErrorString(e), grid);
#else
    for (int p = 0; p < N_PHASES; ++p) { a.ph_lo = p; a.ph_hi = p + 1; hipLaunchKernelGGL(fwd, dim3(grid), dim3(NTHREADS), LDS_BYTES, stream, a); }
#endif
}
```

```cpp
#define DBL_MASK 0
#include <hip/hip_runtime.h>
#include <hip/hip_cooperative_groups.h>
#include <cstdio>
#include <cstdint>
#include <cmath>
namespace cg = cooperative_groups;
namespace pg8 {
#define PG8_LAS __attribute__((address_space(3)))
typedef unsigned short bf16_t;
typedef short bf16x8 __attribute__((ext_vector_type(8)));
typedef float f32x4 __attribute__((ext_vector_type(4)));
typedef unsigned u32x4 __attribute__((ext_vector_type(4)));
constexpr int BM = 256, BK = 64, HALF = 128, HTB = HALF * BK * 2  , STAGE_BYTES = 8 * HTB, NXCD = 8, WGM = 8;

__host__ __device__ __forceinline__ int lds_byte(int r, int c) { const int st = (r >> 4) * 2 + (c >> 5), rr = r & 15, cc = c & 31, ob = rr * 64 + cc * 2; return st * 1024 + (ob ^ (((ob >> 9) & 1) << 5)); }
__host__ __device__ __forceinline__ void stage_rc(int b, int& R, int& C) { const int st = b / 1024, sb = b % 1024, swz = sb ^ (((sb >> 9) & 1) << 5); R = (st >> 1) * 16 + swz / 64; C = (st & 1) * 32 + (swz % 64) / 2; }
__host__ __device__ __forceinline__ int perm32(int rho) { const int n = rho >> 4, i = rho & 15; return 8 * (i >> 2) + 4 * n + (i & 3); }

struct Unit { int pm, pn; };
struct Gemm { const bf16_t* A; const bf16_t* Bt; int M, N, K; size_t aRow, aHalf, aTile, aK, bRow; };
__host__ __device__ __forceinline__ Gemm make_gemm(const bf16_t* A, int lda, const bf16_t* Bt, int ldb, int M, int N, int K) {
    Gemm g; g.A = A; g.Bt = Bt; g.M = M; g.N = N; g.K = K; g.aRow = (size_t)lda * 2; g.aHalf = (size_t)HALF * lda * 2; g.aTile = (size_t)BM * lda * 2; g.aK = BK * 2; g.bRow = (size_t)ldb * 2; return g; }

struct StaticOrder {
    int nM, nN, nwg, G, c;
    __host__ __device__ void init(int M, int N, int G_, int c_) { nM = M / BM; nN = N / BM; nwg = nM * nN; G = G_; c = c_; }
    __host__ __device__ bool next(int i, Unit& u) const {
        const long L = (long)i * G + c; if (L >= nwg) return false;
        int wgid = (int)L; { const int q = nwg / NXCD, r = nwg % NXCD, xcd = wgid % NXCD, off = wgid / NXCD; wgid = (xcd < r ? xcd * (q + 1) : r * (q + 1) + (xcd - r) * q) + off; }
        const int nig = WGM * nN, gid = wgid / nig, fm = gid * WGM, gsz = (nM - fm) < WGM ? (nM - fm) : WGM;
        u.pm = fm + ((wgid % nig) % gsz); u.pn = (wgid % nig) / gsz; return true;
    }
};

__device__ __forceinline__ unsigned cvt_pk_bf16(float lo, float hi) { unsigned r; asm volatile("v_cvt_pk_bf16_f32 %0, %1, %2" : "=v"(r) : "v"(lo), "v"(hi)); return r; }

template <class Epi, class Sched, bool ALIGN_EPI>
__device__ __forceinline__ void gemm_phase(PG8_LAS unsigned char* lds, const Gemm g, const Sched& S, const Epi& E) {
    const int tid = threadIdx.x, wid = __builtin_amdgcn_readfirstlane(tid >> 6), lane = tid & 63, wr = wid >> 2, wc = wid & 3, fr = lane & 15, fq = lane >> 4;
    const int K = g.K, nt = K / BK;
    unsigned voffA[2], voffB[2];
#pragma unroll
    for (int i = 0; i < 2; ++i) { int R, C; stage_rc(tid * 16 + i * 8192, R, C); const int Rb = Epi::PERM ? ((R & ~31) + perm32(R & 31)) : R;
        voffA[i] = (unsigned)((size_t)R * g.aRow + (size_t)C * 2); voffB[i] = (unsigned)((size_t)Rb * g.bRow + (size_t)C * 2); }
    const size_t kstepA = g.aK, kstepB = (size_t)(BK * 2);
    const size_t hstepA = g.aHalf, hstepB = (size_t)HALF * g.bRow;
    const size_t tstepA = g.aTile, tstepB = (size_t)BM * g.bRow;
    const unsigned ldsw = (unsigned)wid * 1024u;
    const int aoff = lds_byte(wr * 64 + fr, fq * 8), boff = lds_byte(wc * 32 + fr, fq * 8);
#define PG8_SA(b, h) (((b) * 2 + (h)) * HTB)
#define PG8_SB(b, h) ((4 + (b) * 2 + (h)) * HTB)
#define PG8_STAGE(bufoff, gbase, voff) do { _Pragma("unroll") for (int _i = 0; _i < 2; ++_i) \
        __builtin_amdgcn_global_load_lds((const unsigned*)((const char*)(gbase) + (voff)[_i]), (PG8_LAS unsigned*)(lds + (bufoff) + ldsw + _i * 8192), 16, 0, 0); } while (0)
#define PG8_LDA(dst, b, h) do { _Pragma("unroll") for (int m = 0; m < 4; ++m) _Pragma("unroll") for (int k = 0; k < 2; ++k) dst[m][k] = *(const PG8_LAS bf16x8*)(lds + PG8_SA(b, h) + aoff + m * 2048 + k * 1024); } while (0)
#define PG8_LDB(dst, b, h) do { _Pragma("unroll") for (int n = 0; n < 2; ++n) _Pragma("unroll") for (int k = 0; k < 2; ++k) dst[n][k] = *(const PG8_LAS bf16x8*)(lds + PG8_SB(b, h) + boff + n * 2048 + k * 1024); } while (0)
#define PG8_MMA(ai, bj, At, Bt) do { __builtin_amdgcn_s_setprio(1); _Pragma("unroll") for (int m = 0; m < 4; ++m) _Pragma("unroll") for (int n = 0; n < 2; ++n) _Pragma("unroll") for (int k = 0; k < 2; ++k) \
        acc[ai][bj][m][n] = __builtin_amdgcn_mfma_f32_16x16x32_bf16(Bt[n][k], At[m][k], acc[ai][bj][m][n], 0, 0, 0); __builtin_amdgcn_s_setprio(0); } while (0)
#define PG8_WAIT_V(n) asm volatile("s_waitcnt vmcnt(" #n ")" ::: "memory")
#define PG8_WAIT_L(n) asm volatile("s_waitcnt lgkmcnt(" #n ")" ::: "memory")
#define PG8_BAR __builtin_amdgcn_s_barrier()
#define PG8_SCHED __builtin_amdgcn_sched_barrier(0)
    Unit cur, nxt; int ui = 0;
    if (!S.next(0, cur)) return;
    f32x4 acc[2][2][4][2];
#pragma unroll
    for (int a = 0; a < 2; ++a)
#pragma unroll
        for (int b = 0; b < 2; ++b)
#pragma unroll
            for (int m = 0; m < 4; ++m)
#pragma unroll
                for (int n = 0; n < 2; ++n) acc[a][b][m][n] = (f32x4){0.f, 0.f, 0.f, 0.f};
    bf16x8 At[4][2], B0[2][2], B1[2][2];
    const char* cA = (const char*)g.A + (size_t)cur.pm * tstepA; const char* cB = (const char*)g.Bt + (size_t)cur.pn * tstepB;
    PG8_STAGE(PG8_SB(0, 0), cB, voffB); PG8_STAGE(PG8_SB(0, 1), cB + hstepB, voffB); PG8_STAGE(PG8_SA(0, 0), cA, voffA); PG8_STAGE(PG8_SA(0, 1), cA + hstepA, voffA);
    if (wr == 1) PG8_BAR;
    PG8_WAIT_V(2); PG8_BAR;
    PG8_STAGE(PG8_SB(1, 0), cB + kstepB, voffB); PG8_STAGE(PG8_SA(1, 0), cA + kstepA, voffA); PG8_STAGE(PG8_SB(1, 1), cB + hstepB + kstepB, voffB);
    PG8_WAIT_V(6); PG8_BAR;
    for (;;) {
        const bool has_next = S.next(ui + 1, nxt);
        const char* nA = has_next ? (const char*)g.A + (size_t)nxt.pm * tstepA : cA; const char* nB = has_next ? (const char*)g.Bt + (size_t)nxt.pn * tstepB : cB;
        for (int t = 0; t < nt; t += 2) {
            const bool last = (t == nt - 2);
            const char* a1 = cA + (size_t)(t + 1) * kstepA;
            const char* a2 = last ? nA : cA + (size_t)(t + 2) * kstepA; const char* b2 = last ? nB : cB + (size_t)(t + 2) * kstepB;
            const char* a3 = a2 + kstepA; const char* b3 = b2 + kstepB;
            PG8_LDB(B0, 0, 0); PG8_LDB(B1, 0, 1); PG8_SCHED; PG8_LDA(At, 0, 0); PG8_STAGE(PG8_SA(1, 1), a1 + hstepA, voffA);
            PG8_WAIT_V(8); PG8_WAIT_L(0); PG8_BAR; PG8_MMA(0, 0, At, B0); PG8_MMA(0, 1, At, B1); PG8_BAR; PG8_SCHED;
            PG8_LDA(At, 0, 1); PG8_STAGE(PG8_SB(0, 0), b2, voffB); PG8_STAGE(PG8_SB(0, 1), b2 + hstepB, voffB); PG8_STAGE(PG8_SA(0, 0), a2, voffA);
            PG8_WAIT_V(8); PG8_WAIT_L(0); PG8_BAR; PG8_MMA(1, 0, At, B0); PG8_MMA(1, 1, At, B1); PG8_BAR; PG8_SCHED;
            PG8_LDB(B0, 1, 0); PG8_LDB(B1, 1, 1); PG8_SCHED; PG8_LDA(At, 1, 0); PG8_STAGE(PG8_SA(0, 1), a2 + hstepA, voffA);
            PG8_WAIT_V(8); PG8_WAIT_L(0); PG8_BAR; PG8_MMA(0, 0, At, B0); PG8_MMA(0, 1, At, B1); PG8_BAR; PG8_SCHED;
            PG8_LDA(At, 1, 1); PG8_STAGE(PG8_SB(1, 0), b3, voffB); PG8_STAGE(PG8_SB(1, 1), b3 + hstepB, voffB); PG8_STAGE(PG8_SA(1, 0), a3, voffA);
            PG8_WAIT_V(8); PG8_WAIT_L(0); PG8_BAR; PG8_MMA(1, 0, At, B0); PG8_MMA(1, 1, At, B1); PG8_BAR; PG8_SCHED;
        }
        if constexpr (ALIGN_EPI) { if (wr == 0) PG8_BAR; }
        E(acc, cur, wr, wc, fr, fq);
        if (!has_next) break;
#pragma unroll
        for (int a = 0; a < 2; ++a)
#pragma unroll
            for (int b = 0; b < 2; ++b)
#pragma unroll
                for (int m = 0; m < 4; ++m)
#pragma unroll
                    for (int n = 0; n < 2; ++n) acc[a][b][m][n] = (f32x4){0.f, 0.f, 0.f, 0.f};
        cur = nxt; cA = nA; cB = nB; ++ui;
        if constexpr (ALIGN_EPI) { if (wr == 1) PG8_BAR; }
    }
    PG8_WAIT_V(0);
    if constexpr (!ALIGN_EPI) { if (wr == 0) PG8_BAR; }
    PG8_BAR;
#undef PG8_SA
#undef PG8_SB
#undef PG8_STAGE
#undef PG8_LDA
#undef PG8_LDB
#undef PG8_MMA
#undef PG8_WAIT_V
#undef PG8_WAIT_L
#undef PG8_BAR
#undef PG8_SCHED
}
}
constexpr int NWAVES = 8, NTHREADS = 512;
constexpr int BATCH = 8, SEQ = 2048, DM = 1024, MTOK = BATCH * SEQ;
constexpr int NPROJ = 3840;
constexpr float EPS = 1e-6f, LOG2E = 1.4426950408889634f;
constexpr float QSCALE_NSA = 0.125f * LOG2E;
constexpr float QSCALE_MLA = 0.10206207261596575f * LOG2E;
constexpr size_t MiB = 1u << 20;
enum { I_X = 0, I_POS, I_N1G, I_WIN, I_CPK, I_CW1K, I_CW2K, I_CPV, I_CW1V, I_CW2V, I_QNG, I_KVNG, I_WUQ, I_WUKV, I_WBN, I_WBM, I_WOUT, I_N2G, I_WPQ, I_SK1, I_SK2, I_EDN, I_EUP, I_NFG, N_IN };
constexpr size_t WS_CTL = 0;
constexpr size_t WS_WIN = 1 * MiB;
constexpr size_t WS_WUQ = WS_WIN + (size_t)NPROJ * 1024 * 2;
constexpr size_t WS_WUKV = WS_WUQ + 768 * 256 * 2;
constexpr size_t WS_WBR = 10 * MiB;
constexpr size_t WS_WOUT = 12 * MiB;
constexpr size_t WS_WPQ = 14 * MiB;
constexpr size_t WS_WC1K = 18 * MiB;
constexpr size_t WS_WC1V = WS_WC1K + 256 * 1024 * 2;
constexpr size_t WS_SMALL = 19 * MiB;
constexpr size_t WS_C1K = WS_SMALL;
constexpr size_t WS_C1V = WS_SMALL + 512;
constexpr size_t WS_ORDER = WS_SMALL + 1024;
constexpr size_t WS_SK1 = WS_SMALL + 4096;
constexpr size_t WS_SK2 = WS_SK1 + 32768;
constexpr size_t WS_XN = 20 * MiB;
constexpr size_t WS_MLAQ = WS_XN, WS_EXPD = WS_XN;
constexpr size_t WS_EXPD_SC = WS_EXPD + (size_t)16384 * 1024;
constexpr size_t WS_QKV = 52 * MiB;
constexpr size_t WS_MERGED = WS_QKV;
constexpr size_t WS_CQ = 92 * MiB;
constexpr size_t WS_MISC = 100 * MiB;
constexpr size_t WS_ROUTE = 92 * MiB;
constexpr size_t WS_GATES = 108 * MiB;
constexpr size_t WS_QP = WS_GATES;
constexpr size_t WS_MLAKV = 172 * MiB;
constexpr size_t WS_XN2 = WS_MLAKV;
constexpr size_t WS_KPE = 204 * MiB;
constexpr size_t WS_KC = 205 * MiB;
constexpr size_t WS_VC = WS_KC + 16 * 128 * 64 * 2;
constexpr size_t WS_UK = 206 * MiB;
constexpr size_t WS_UV = 208 * MiB;
constexpr size_t WS_OCAT = 210 * MiB;
constexpr size_t WS_EXPU = WS_OCAT;
constexpr size_t WS_EXPU_SC = WS_EXPU + (size_t)16384 * 1024;
constexpr size_t WS_END = 242 * MiB;
constexpr int RING_BYTES = 131072;
constexpr int LDS_BYTES = 147456;

#define GAS __attribute__((address_space(1)))
#define LAS __attribute__((address_space(3)))
typedef unsigned short bf16;
typedef unsigned v4u __attribute__((ext_vector_type(4)));
typedef unsigned v2u __attribute__((ext_vector_type(2)));
typedef float f32x4 __attribute__((ext_vector_type(4)));
typedef float f32x16 __attribute__((ext_vector_type(16)));
typedef short bf16x8 __attribute__((ext_vector_type(8)));
typedef short s16x4 __attribute__((ext_vector_type(4)));

__device__ __forceinline__ unsigned f2bf(float f) { unsigned u = __builtin_bit_cast(unsigned, f); return (u + 0x7fffu + ((u >> 16) & 1u)) >> 16; }
__device__ __forceinline__ unsigned pk2(float lo, float hi) { return f2bf(lo) | (f2bf(hi) << 16); }
__device__ __forceinline__ float bf_lo(unsigned u) { return __builtin_bit_cast(float, u << 16); }
__device__ __forceinline__ float bf_hi(unsigned u) { return __builtin_bit_cast(float, u & 0xffff0000u); }
__device__ __forceinline__ float bf2f(bf16 h) { return __builtin_bit_cast(float, (unsigned)h << 16); }
__device__ __forceinline__ float sigmoidf_(float v) { return 1.0f / (1.0f + __expf(-v)); }
__device__ __forceinline__ float gelu_tanh(float v) { const float u = 0.7978845608028654f * (v + 0.044715f * v * v * v); const float e = __expf(2.0f * u); const float th = 1.0f - 2.0f / (e + 1.0f); return 0.5f * v * (1.0f + th); }
__device__ __forceinline__ float wave_sum(float v) {
#pragma unroll
    for (int o = 1; o < 64; o <<= 1) v += __shfl_xor(v, o);
    return v;
}

struct Frame {
    LAS unsigned char* lds;
    int tid, lane, wave, G, bid;
    const float* const* in; const int* pos; float* out; unsigned char* ws;
};

__device__ __forceinline__ int win_srccol(int n) {
    if (n < 1280) return n;
    if (n < 1536) return 1304 + (n - 1280);
    if (n < 1664) return 1560 + (n - 1536);
    if (n < 1696) return 1688 + (n - 1664);
    if (n < 1720) return 1280 + (n - 1696);
    if (n < 1792) return -1;
    return 1720 + (n - 1792);
}
template <bool WIN_PERM>
__device__ __forceinline__ void tr_item(const float* src, int ld_src, int ksrc0, const float* kscale, bf16* dst, int ld_dst, int drow0, int dcol0, int N, LAS float* scr, int item, int lane) {
    const int nblk = N / 32, kb = item / nblk, nb = item % nblk, k0 = 64 * kb, n0 = 32 * nb;
    const int nn = n0 + (lane & 31); const int sc = WIN_PERM ? win_srccol(nn) : nn;
#pragma unroll 8
    for (int i = 0; i < 32; ++i) { const int kk = 2 * i + (lane >> 5); float v = 0.f; if (sc >= 0) v = src[(size_t)(ksrc0 + k0 + kk) * ld_src + sc]; if (kscale) v *= kscale[k0 + kk]; scr[kk * 33 + (lane & 31)] = v; }
    asm volatile("s_waitcnt lgkmcnt(0)" ::: "memory");
    const int c = lane & 7;
#pragma unroll
    for (int j = 0; j < 4; ++j) { const int n = (lane >> 3) + 8 * j; const LAS float* s = scr + (8 * c) * 33 + n;
        v4u o; o.x = pk2(s[0 * 33], s[1 * 33]); o.y = pk2(s[2 * 33], s[3 * 33]); o.z = pk2(s[4 * 33], s[5 * 33]); o.w = pk2(s[6 * 33], s[7 * 33]);
        *(v4u*)(dst + (size_t)(drow0 + n0 + n) * ld_dst + dcol0 + k0 + 8 * c) = o; }
    asm volatile("s_waitcnt lgkmcnt(0)" ::: "memory");
}
__device__ __forceinline__ void rms_row_to_bf16(const float* xrow, const float* gain, bf16* orow, int lane) {
    const f32x4* xr = (const f32x4*)xrow + lane; const f32x4* gr = (const f32x4*)gain + lane;
    f32x4 v[4]; float s = 0.f;
#pragma unroll
    for (int j = 0; j < 4; ++j) { v[j] = xr[64 * j]; s += (v[j].x * v[j].x + v[j].y * v[j].y) + (v[j].z * v[j].z + v[j].w * v[j].w); }
    const float r = 1.0f / sqrtf(wave_sum(s) * (1.f / DM) + EPS);
    unsigned long long* o8 = (unsigned long long*)orow + lane;
#pragma unroll
    for (int j = 0; j < 4; ++j) { const f32x4 g = gr[64 * j]; o8[64 * j] = (unsigned long long)pk2(v[j].x * r * g.x, v[j].y * r * g.y) | ((unsigned long long)pk2(v[j].z * r * g.z, v[j].w * r * g.w) << 32); }
}
__device__ __forceinline__ void p0_prologue(Frame& F) {
    LAS float* scr = (LAS float*)(F.lds + F.wave * 16384);
    const int gw = F.bid * NWAVES + F.wave, NGW = F.G * NWAVES, lane = F.lane;
    bf16* const Win_t = (bf16*)(F.ws + WS_WIN); bf16* const Wuq_t = (bf16*)(F.ws + WS_WUQ); bf16* const Wukv_t = (bf16*)(F.ws + WS_WUKV);
    bf16* const Wbr_t = (bf16*)(F.ws + WS_WBR); bf16* const Wout_t = (bf16*)(F.ws + WS_WOUT); bf16* const Wpq_t = (bf16*)(F.ws + WS_WPQ);
    bf16* const Wc1k_t = (bf16*)(F.ws + WS_WC1K); bf16* const Wc1v_t = (bf16*)(F.ws + WS_WC1V);
    constexpr int I_IN = 16 * (NPROJ / 32), I_UQ = 4 * 24, I_UKV = 2 * 32, I_BR = 8 * 32, I_OUT = 16 * 32, I_PQ = 16 * 64, I_C1 = 16 * 4;
    constexpr int NITEMS = I_IN + I_UQ + I_UKV + 2 * I_BR + I_OUT + I_PQ + 4 * I_C1;
    for (int it = gw; it < NITEMS; it += NGW) {
        int r = it;
        if (r < I_IN) { tr_item<true>(F.in[I_WIN], 3768, 0, nullptr, Win_t, 1024, 0, 0, NPROJ, scr, r, lane); continue; } r -= I_IN;
        if (r < I_UQ) { tr_item<false>(F.in[I_WUQ], 768, 0, F.in[I_QNG], Wuq_t, 256, 0, 0, 768, scr, r, lane); continue; } r -= I_UQ;
        if (r < I_UKV) { tr_item<false>(F.in[I_WUKV], 1024, 0, F.in[I_KVNG], Wukv_t, 256, 0, 0, 1024, scr, r, lane); continue; } r -= I_UKV;
        if (r < I_BR) { tr_item<false>(F.in[I_WBN], 1024, 0, nullptr, Wbr_t, 1024, 0, 0, 1024, scr, r, lane); continue; } r -= I_BR;
        if (r < I_BR) { tr_item<false>(F.in[I_WBM], 1024, 0, nullptr, Wbr_t, 1024, 0, 512, 1024, scr, r, lane); continue; } r -= I_BR;
        if (r < I_OUT) { tr_item<false>(F.in[I_WOUT], 1024, 0, nullptr, Wout_t, 1024, 0, 0, 1024, scr, r, lane); continue; } r -= I_OUT;
        if (r < I_PQ) { tr_item<false>(F.in[I_WPQ], 2048, 0, nullptr, Wpq_t, 1024, 0, 0, 2048, scr, r, lane); continue; } r -= I_PQ;
        if (r < I_C1) { tr_item<false>(F.in[I_CW1K], 128, 0, nullptr, Wc1k_t, 1024, 0, 0, 128, scr, r, lane); continue; } r -= I_C1;
        if (r < I_C1) { tr_item<false>(F.in[I_CW1K], 128, 1024, nullptr, Wc1k_t, 1024, 128, 0, 128, scr, r, lane); continue; } r -= I_C1;
        if (r < I_C1) { tr_item<false>(F.in[I_CW1V], 128, 0, nullptr, Wc1v_t, 1024, 0, 0, 128, scr, r, lane); continue; } r -= I_C1;
        tr_item<false>(F.in[I_CW1V], 128, 1024, nullptr, Wc1v_t, 1024, 128, 0, 128, scr, r, lane);
    }
    { bf16* XN = (bf16*)(F.ws + WS_XN); for (int m = gw; m < MTOK; m += NGW) rms_row_to_bf16(F.in[I_X] + (size_t)m * DM, F.in[I_N1G], XN + (size_t)m * DM, lane); }
    const int gt = F.bid * NTHREADS + F.tid, NGT = F.G * NTHREADS;
    for (int i = gt; i < 1024 * 128; i += NGT) { const int n = i >> 7, k = 128 + (i & 127); Wukv_t[n * 256 + k] = 0; }
    { bf16* S1 = (bf16*)(F.ws + WS_SK1); bf16* S2 = (bf16*)(F.ws + WS_SK2);
      for (int i = gt; i < 128 * 128; i += NGT) { S1[i] = (bf16)f2bf(F.in[I_SK1][i]); S2[i] = (bf16)f2bf(F.in[I_SK2][i]); } }
    for (int o = gw; o < 256; o += NGW) {
        const int kv = o >> 7, j = o & 127; const float* pe = F.in[kv ? I_CPV : I_CPK]; const float* w1 = F.in[kv ? I_CW1V : I_CW1K];
        float s = 0.f;
        for (int k = lane; k < 2048; k += 64) s += pe[k] * w1[(size_t)k * 128 + j];
        s = wave_sum(s);
        if (lane == 0) ((float*)(F.ws + (kv ? WS_C1V : WS_C1K)))[j] = s;
    }
}

using pg8::Unit; using pg8::cvt_pk_bf16;
constexpr int PG_HALF = 128, PG_BM = 256;
struct EpiInProj {
    static constexpr bool PERM = true;
    bf16 *QKV, *CQ, *MISC, *GATES;
    __device__ __forceinline__ void operator()(const f32x4 (&acc)[2][2][4][2], const Unit& u, int wr, int wc, int fr, int fq) const {
        bf16* base; int ldc, colt; float sc = 1.f;
        if (u.pn < 5) { base = QKV; ldc = 1280; colt = u.pn * 256; if (u.pn < 2) sc = QSCALE_NSA; }
        else if (u.pn == 5) { base = CQ; ldc = 256; colt = 0; }
        else if (u.pn == 6) { base = MISC; ldc = 256; colt = 0; }
        else { base = GATES; ldc = 2048; colt = (u.pn - 7) * 256; }
        const int row0 = u.pm * PG_BM + wr * 64 + fr, col0 = colt + wc * 32 + 8 * fq;
#pragma unroll
        for (int ai = 0; ai < 2; ++ai)
#pragma unroll
            for (int m = 0; m < 4; ++m) { bf16* rowp = base + (size_t)(row0 + ai * PG_HALF + m * 16) * ldc + col0;
#pragma unroll
                for (int bj = 0; bj < 2; ++bj) { const f32x4 v0 = acc[ai][bj][m][0] * sc, v1 = acc[ai][bj][m][1] * sc;
                    v4u w; w.x = cvt_pk_bf16(v0[0], v0[1]); w.y = cvt_pk_bf16(v0[2], v0[3]); w.z = cvt_pk_bf16(v1[0], v1[1]); w.w = cvt_pk_bf16(v1[2], v1[3]);
                    *(v4u*)(rowp + bj * PG_HALF) = w; } }
    }
};
struct EpiBf16 {
    static constexpr bool PERM = true;
    bf16* O; int ldc;
    __device__ __forceinline__ void operator()(const f32x4 (&acc)[2][2][4][2], const Unit& u, int wr, int wc, int fr, int fq) const {
        const int row0 = u.pm * PG_BM + wr * 64 + fr, col0 = u.pn * PG_BM + wc * 32 + 8 * fq;
#pragma unroll
        for (int ai = 0; ai < 2; ++ai)
#pragma unroll
            for (int m = 0; m < 4; ++m) { bf16* rowp = O + (size_t)(row0 + ai * PG_HALF + m * 16) * ldc + col0;
#pragma unroll
                for (int bj = 0; bj < 2; ++bj) { const f32x4 v0 = acc[ai][bj][m][0], v1 = acc[ai][bj][m][1];
                    v4u w; w.x = cvt_pk_bf16(v0[0], v0[1]); w.y = cvt_pk_bf16(v0[2], v0[3]); w.z = cvt_pk_bf16(v1[0], v1[1]); w.w = cvt_pk_bf16(v1[2], v1[3]);
                    *(v4u*)(rowp + bj * PG_HALF) = w; } }
    }
};
template <int NSRC> struct EpiRowScale {
    static constexpr bool PERM = true;
    const bf16* SRC; bf16* O; int ldc; float cscale;
    __device__ __forceinline__ void operator()(const f32x4 (&acc)[2][2][4][2], const Unit& u, int wr, int wc, int fr, int fq) const {
        const int row0 = u.pm * PG_BM + wr * 64 + fr, col0 = u.pn * PG_BM + wc * 32 + 8 * fq;
#pragma unroll
        for (int ai = 0; ai < 2; ++ai)
#pragma unroll
            for (int m = 0; m < 4; ++m) { const int row = row0 + ai * PG_HALF + m * 16;
                const v4u* sp = (const v4u*)(SRC + (size_t)row * 256 + fq * (NSRC / 4)); float ss = 0.f;
#pragma unroll
                for (int i = 0; i < NSRC / 32; ++i) { const v4u w = sp[i];
                    ss += bf_lo(w.x) * bf_lo(w.x) + bf_hi(w.x) * bf_hi(w.x) + bf_lo(w.y) * bf_lo(w.y) + bf_hi(w.y) * bf_hi(w.y) + bf_lo(w.z) * bf_lo(w.z) + bf_hi(w.z) * bf_hi(w.z) + bf_lo(w.w) * bf_lo(w.w) + bf_hi(w.w) * bf_hi(w.w); }
                ss += __shfl_xor(ss, 16); ss += __shfl_xor(ss, 32);
                const float sc = cscale / sqrtf(ss * (1.0f / NSRC) + EPS);
                bf16* rowp = O + (size_t)row * ldc + col0;
#pragma unroll
                for (int bj = 0; bj < 2; ++bj) { const f32x4 v0 = acc[ai][bj][m][0] * sc, v1 = acc[ai][bj][m][1] * sc;
                    v4u w; w.x = cvt_pk_bf16(v0[0], v0[1]); w.y = cvt_pk_bf16(v0[2], v0[3]); w.z = cvt_pk_bf16(v1[0], v1[1]); w.w = cvt_pk_bf16(v1[2], v1[3]);
                    *(v4u*)(rowp + bj * PG_HALF) = w; } }
    }
};
struct EpiF32 {
    static constexpr bool PERM = false;
    float* C; int ldc; const float* resid;
    __device__ __forceinline__ void operator()(const f32x4 (&acc)[2][2][4][2], const Unit& u, int wr, int wc, int fr, int fq) const {
        const int row0 = u.pm * PG_BM + wr * 64 + fr, col0 = u.pn * PG_BM + wc * 32 + 4 * fq;
#pragma unroll
        for (int ai = 0; ai < 2; ++ai)
#pragma unroll
            for (int m = 0; m < 4; ++m) { const size_t off = (size_t)(row0 + ai * PG_HALF + m * 16) * ldc + col0;
#pragma unroll
                for (int bj = 0; bj < 2; ++bj)
#pragma unroll
                    for (int n = 0; n < 2; ++n) { f32x4 v = acc[ai][bj][m][n]; if (resid) v += *(const f32x4*)(resid + off + bj * PG_HALF + n * 16); *(f32x4*)(C + off + bj * PG_HALF + n * 16) = v; } }
    }
};
template <int PASS> struct EpiGate {
    static constexpr bool PERM = true;
    const bf16* G; bf16* MG; int gcol0;
    __device__ __forceinline__ void operator()(const f32x4 (&acc)[2][2][4][2], const Unit& u, int wr, int wc, int fr, int fq) const {
        const int row0 = u.pm * PG_BM + wr * 64 + fr, col0 = u.pn * PG_BM + wc * 32 + 8 * fq;
#pragma unroll
        for (int ai = 0; ai < 2; ++ai)
#pragma unroll
            for (int m = 0; m < 4; ++m) { const int row = row0 + ai * PG_HALF + m * 16;
#pragma unroll
                for (int bj = 0; bj < 2; ++bj) { const int col = col0 + bj * PG_HALF;
                    const v4u gw = *(const v4u*)(G + (size_t)row * 2048 + gcol0 + col);
                    float v[8]; const f32x4 a0 = acc[ai][bj][m][0], a1 = acc[ai][bj][m][1];
                    v[0] = sigmoidf_(bf_lo(gw.x)) * a0[0]; v[1] = sigmoidf_(bf_hi(gw.x)) * a0[1]; v[2] = sigmoidf_(bf_lo(gw.y)) * a0[2]; v[3] = sigmoidf_(bf_hi(gw.y)) * a0[3];
                    v[4] = sigmoidf_(bf_lo(gw.z)) * a1[0]; v[5] = sigmoidf_(bf_hi(gw.z)) * a1[1]; v[6] = sigmoidf_(bf_lo(gw.w)) * a1[2]; v[7] = sigmoidf_(bf_hi(gw.w)) * a1[3];
                    v4u* mp = (v4u*)(MG + (size_t)row * 1024 + col);
                    if (PASS == 1) { const v4u t = *mp; v[0] += bf_lo(t.x); v[1] += bf_hi(t.x); v[2] += bf_lo(t.y); v[3] += bf_hi(t.y); v[4] += bf_lo(t.z); v[5] += bf_hi(t.z); v[6] += bf_lo(t.w); v[7] += bf_hi(t.w); }
                    v4u w; w.x = cvt_pk_bf16(v[0], v[1]); w.y = cvt_pk_bf16(v[2], v[3]); w.z = cvt_pk_bf16(v[4], v[5]); w.w = cvt_pk_bf16(v[6], v[7]);
                    *mp = w; } }
    }
};
namespace att {
constexpr int KB_BYTES = 12288, VB_BYTES = 12288, BUF_BYTES = KB_BYTES + VB_BYTES;
constexpr int OFF_IMP = 2 * BUF_BYTES;
constexpr int OFF_SC = OFF_IMP + 32768;
constexpr int OFF_SEL = OFF_SC + 8192;
constexpr int OFF_END = OFF_SEL + 512;
static_assert(OFF_END <= RING_BYTES, "attention LDS map");

__device__ __forceinline__ int crow(int r, int hi) { return (r & 3) + 8 * (r >> 2) + 4 * hi; }
__device__ __forceinline__ s16x4 vtr(const LAS unsigned char* p) { typedef short v4i16_t __attribute__((ext_vector_type(4))); return __builtin_bit_cast(s16x4, __builtin_amdgcn_ds_read_tr16_b64_v4i16((LAS v4i16_t*)p)); }
__device__ __forceinline__ unsigned cvtpk(float lo, float hi) { typedef float f2 __attribute__((ext_vector_type(2))); typedef __bf16 b2 __attribute__((ext_vector_type(2))); f2 v = {lo, hi}; b2 b = __builtin_convertvector(v, b2); return __builtin_bit_cast(unsigned, b); }
__device__ __forceinline__ float swapmax(float m) { auto rr = __builtin_amdgcn_permlane32_swap(__float_as_uint(m), __float_as_uint(m), false, false); return fmaxf(__uint_as_float(rr[0]), __uint_as_float(rr[1])); }
__device__ __forceinline__ float swapsum(float m) { auto rr = __builtin_amdgcn_permlane32_swap(__float_as_uint(m), __float_as_uint(m), false, false); return __uint_as_float(rr[0]) + __uint_as_float(rr[1]); }

struct Flash { f32x16 o[3]; float m, l; };
__device__ __forceinline__ void flash_init(Flash& f) { f.o[0] = f32x16{}; f.o[1] = f32x16{}; f.o[2] = f32x16{}; f.m = -1e30f; f.l = 0.f; }

template <int NKC>
__device__ __forceinline__ void issue_tile(LAS unsigned char* lds, int buf, const bf16* Kg, int ldk, const bf16* Kpe, const bf16* Vg, int ldv, int wave, int lane) {
    LAS unsigned char* kb = lds + buf * BUF_BYTES; LAS unsigned char* vb = kb + KB_BYTES;
    __builtin_amdgcn_global_load_lds((const unsigned*)(Kg + (size_t)lane * ldk + wave * 8), (LAS unsigned*)(kb + wave * 1024), 16, 0, 0);
    if (NKC == 12) { if (wave < 4) __builtin_amdgcn_global_load_lds((const unsigned*)(Kpe + (size_t)lane * 32 + wave * 8), (LAS unsigned*)(kb + (8 + wave) * 1024), 16, 0, 0); }
    __builtin_amdgcn_global_load_lds((const unsigned*)(Vg + (size_t)(16 * (wave & 3) + (lane >> 2)) * ldv + (wave >> 2) * 32 + (lane & 3) * 8), (LAS unsigned*)(vb + wave * 1024), 16, 0, 0);
}

template <int NKS, int NVB, bool HAS_BIAS>
__device__ __forceinline__ void tile_compute(Flash& f, const LAS unsigned char* kb, const LAS unsigned char* vb, const bf16x8* qr, float slope, float cb,
                                             int lo, int hi_, bool need_mask, int r32, int hh, int lane) {
    f32x16 p0, p1;
    if (HAS_BIAS) {
        const float cb0 = cb + slope * (float)(4 * hh), cb1 = cb0 + slope * 32.f;
#pragma unroll
        for (int r = 0; r < 16; ++r) { const float cr = (float)((r & 3) + 8 * (r >> 2)); p0[r] = __builtin_fmaf(slope, cr, cb0); p1[r] = __builtin_fmaf(slope, cr, cb1); }
    } else { p0 = f32x16{}; p1 = f32x16{}; }
    const LAS unsigned char* kp = kb + hh * 1024 + r32 * 16;
#pragma unroll
    for (int d0 = 0; d0 < NKS; ++d0) {
        const bf16x8 b0 = *(const LAS bf16x8*)(kp + d0 * 2048);
        const bf16x8 b1 = *(const LAS bf16x8*)(kp + d0 * 2048 + 512);
        p0 = __builtin_amdgcn_mfma_f32_32x32x16_bf16(b0, qr[d0], p0, 0, 0, 0);
        p1 = __builtin_amdgcn_mfma_f32_32x32x16_bf16(b1, qr[d0], p1, 0, 0, 0);
    }
    if (need_mask) {
        const int l0 = lo - 4 * hh, h0 = hi_ - 4 * hh;
#pragma unroll
        for (int r = 0; r < 16; ++r) { const int c = (r & 3) + 8 * (r >> 2);
            if (c < l0 || c > h0) p0[r] = -INFINITY;
            if (c + 32 < l0 || c + 32 > h0) p1[r] = -INFINITY; }
    }
    float mt = fmaxf(p0[0], p1[0]);
#pragma unroll
    for (int r = 1; r < 16; ++r) mt = fmaxf(mt, fmaxf(p0[r], p1[r]));
    mt = swapmax(mt);
    const float mn = fmaxf(f.m, mt);
    const float alpha = __builtin_amdgcn_exp2f(f.m - mn);
    f.m = mn;
    float sum = 0.f;
#pragma unroll
    for (int r = 0; r < 16; ++r) { p0[r] = __builtin_amdgcn_exp2f(p0[r] - mn); p1[r] = __builtin_amdgcn_exp2f(p1[r] - mn); sum += p0[r] + p1[r]; }
    f.l = f.l * alpha + sum;
#pragma unroll
    for (int b = 0; b < NVB; ++b)
#pragma unroll
        for (int r = 0; r < 16; ++r) f.o[b][r] *= alpha;
    v4u pw[4];
    pw[0] = (v4u){cvtpk(p0[0], p0[1]), cvtpk(p0[2], p0[3]), cvtpk(p0[4], p0[5]), cvtpk(p0[6], p0[7])};
    pw[1] = (v4u){cvtpk(p0[8], p0[9]), cvtpk(p0[10], p0[11]), cvtpk(p0[12], p0[13]), cvtpk(p0[14], p0[15])};
    pw[2] = (v4u){cvtpk(p1[0], p1[1]), cvtpk(p1[2], p1[3]), cvtpk(p1[4], p1[5]), cvtpk(p1[6], p1[7])};
    pw[3] = (v4u){cvtpk(p1[8], p1[9]), cvtpk(p1[10], p1[11]), cvtpk(p1[12], p1[13]), cvtpk(p1[14], p1[15])};
    const LAS unsigned char* vp = vb + ((lane >> 4) & 1) * 32 + (lane & 3) * 8 + (4 * hh + ((lane & 15) >> 2)) * 64;
#pragma unroll
    for (int b = 0; b < NVB; ++b)
#pragma unroll
        for (int ks = 0; ks < 4; ++ks) {
            const s16x4 vl = vtr(vp + b * 4096 + ks * 1024), vh = vtr(vp + b * 4096 + ks * 1024 + 512);
            const bf16x8 va = (bf16x8){vl[0], vl[1], vl[2], vl[3], vh[0], vh[1], vh[2], vh[3]};
            f.o[b] = __builtin_amdgcn_mfma_f32_32x32x16_bf16(va, __builtin_bit_cast(bf16x8, pw[ks]), f.o[b], 0, 0, 0);
        }
}
__device__ __forceinline__ void flash_finish(Flash& f, int nvb) {
    const float lt = swapsum(f.l); const float inv = lt > 0.f ? 1.0f / lt : 0.f;
#pragma unroll
    for (int b = 0; b < 3; ++b) if (b < nvb) {
#pragma unroll
        for (int r = 0; r < 16; ++r) f.o[b][r] *= inv; }
}

__device__ __forceinline__ void nsa_unit(Frame& F, int b, int g, int qc) {
    int lane = F.lane; asm volatile("" : "+v"(lane));
    LAS unsigned char* lds = F.lds; const int wave = F.wave, r32 = lane & 31, hh = lane >> 5;
    const int head = g * 4 + (wave >> 1);
    const int qloc = 32 * (wave & 1) + r32;
    const int t = 64 * qc + qloc;
    const size_t row = (size_t)b * SEQ + t;
    const bf16* QKV = (const bf16*)(F.ws + WS_QKV); const bf16* MISC = (const bf16*)(F.ws + WS_MISC);
    bf16x8 qr[4];
#pragma unroll
    for (int d0 = 0; d0 < 4; ++d0) qr[d0] = *(const bf16x8*)(QKV + row * 1280 + head * 64 + d0 * 16 + hh * 8);
    const float slope2 = exp2f(-(float)(head + 1)) * LOG2E;
    LAS unsigned* selw = (LAS unsigned*)(lds + OFF_SEL);
    if (F.tid < 80) selw[F.tid] = 0u;
    f32x16 ot0, ot1;
    {
        const bf16* KC = (const bf16*)(F.ws + WS_KC) + (size_t)(b * 2 + g) * 128 * 64; const bf16* VC = (const bf16*)(F.ws + WS_VC) + (size_t)(b * 2 + g) * 128 * 64;
        Flash f; flash_init(f);
        int nmax = (t >= 31) ? ((t - 31) >> 4) : -1; if (nmax > 126) nmax = 126;
        for (int ti = 0; ti < 2; ++ti) {
            issue_tile<8>(lds, ti, KC + (size_t)ti * 64 * 64, 64, nullptr, VC + (size_t)ti * 64 * 64, 64, wave, lane);
            LAS bf16* ov = (LAS bf16*)(lds + ti * BUF_BYTES + KB_BYTES + 2 * 4096);
#pragma unroll
            for (int e = 0; e < 4; ++e) { const int idx = F.tid * 4 + e, nl = idx >> 5, s = idx & 31, n = 64 * ti + nl;
                float v = 0.f; if (s == (n >> 2)) v = ((n & 3) == 3) ? 0.5f : 1.0f; else if (s == (n >> 2) + 1 && (n & 3) == 3) v = 0.5f;
                ov[(nl >> 4) * 512 + (nl & 15) * 32 + s] = (bf16)f2bf(v); }
        }
        __syncthreads();
#pragma unroll 1
        for (int ti = 0; ti < 2; ++ti) {
            const LAS unsigned char* kb = lds + ti * BUF_BYTES;
            tile_compute<4, 3, true>(f, kb, kb + KB_BYTES, qr, 16.f * slope2, 16.f * slope2 * (float)(64 * ti), 0, nmax - 64 * ti, true, r32, hh, lane);
        }
        flash_finish(f, 3);
        LAS float* imp = (LAS float*)(lds + OFF_IMP) + (wave * 32 + r32) * 32;
#pragma unroll
        for (int r = 0; r < 16; ++r) imp[crow(r, hh)] = f.o[2][r];
        const float gc = sigmoidf_(bf2f(MISC[row * 256 + 160 + head]));
        ot0 = f.o[0] * gc; ot1 = f.o[1] * gc;
    }
    __syncthreads();
    {
        LAS float* IMP = (LAS float*)(lds + OFF_IMP); LAS float* SC = (LAS float*)(lds + OFF_SC);
        const int q = F.tid >> 3, s4 = (F.tid & 7) * 4;
#pragma unroll
        for (int e = 0; e < 4; ++e) { const int s = s4 + e; float v = 0.f;
#pragma unroll
            for (int h4 = 0; h4 < 4; ++h4) v += IMP[((2 * h4 + (q >> 5)) * 32 + (q & 31)) * 32 + s];
            const bool causal = s <= qc, forced = causal && (s == 0 || s + 2 > qc);
            SC[q * 32 + s] = causal ? (v + (forced ? 1e4f : 0.f)) : -1e30f; }
        __syncthreads();
        float sc[32];
#pragma unroll
        for (int s = 0; s < 32; ++s) sc[s] = SC[q * 32 + s];
        unsigned bits = 0u;
#pragma unroll
        for (int e = 0; e < 4; ++e) { const int s = s4 + e; const float me = SC[q * 32 + s]; int rank = 0;
#pragma unroll
            for (int s2 = 0; s2 < 32; ++s2) rank += (sc[s2] > me || (sc[s2] == me && s2 < s)) ? 1 : 0;
            if (s <= qc && rank < 16) bits |= 1u << s; }
        atomicOr((unsigned*)&selw[q], bits); atomicOr((unsigned*)&selw[64], bits);
    }
    __syncthreads();
    const unsigned mymask = selw[qloc], anymask = selw[64];
    {
        const bf16* Kg = QKV + (size_t)b * SEQ * 1280 + 768 + g * 64; const bf16* Vg = QKV + (size_t)b * SEQ * 1280 + 896 + g * 64;
        Flash f; flash_init(f);
        unsigned rem = anymask; int buf = 0;
        { const int j0 = __builtin_ctz(rem); issue_tile<8>(lds, 0, Kg + (size_t)j0 * 64 * 1280, 1280, nullptr, Vg + (size_t)j0 * 64 * 1280, 1280, wave, lane); }
        while (rem) {
            const int j = __builtin_ctz(rem); rem &= rem - 1;
            __syncthreads();
            if (rem) { const int jn = __builtin_ctz(rem); issue_tile<8>(lds, buf ^ 1, Kg + (size_t)jn * 64 * 1280, 1280, nullptr, Vg + (size_t)jn * 64 * 1280, 1280, wave, lane); }
            const bool sel = (mymask >> j) & 1u;
            const int hi_ = sel ? ((j == qc) ? (t - 64 * j) : 63) : -1;
            const bool need = (j == qc) || !__all(sel);
            const LAS unsigned char* kb = lds + buf * BUF_BYTES;
            tile_compute<4, 2, true>(f, kb, kb + KB_BYTES, qr, slope2, slope2 * (float)(64 * j), 0, hi_, need, r32, hh, lane);
            buf ^= 1;
        }
        flash_finish(f, 2);
        const float gs = sigmoidf_(bf2f(MISC[row * 256 + 160 + 8 + head]));
        ot0 += f.o[0] * gs; ot1 += f.o[1] * gs;
        __syncthreads();
    }
    {
        const bf16* Kg = QKV + (size_t)b * SEQ * 1280 + 1024 + g * 64; const bf16* Vg = QKV + (size_t)b * SEQ * 1280 + 1152 + g * 64;
        Flash f; flash_init(f);
        const int j0 = qc >= 8 ? qc - 8 : 0; int buf = 0;
        issue_tile<8>(lds, 0, Kg + (size_t)j0 * 64 * 1280, 1280, nullptr, Vg + (size_t)j0 * 64 * 1280, 1280, wave, lane);
        for (int j = j0; j <= qc; ++j) {
            __syncthreads();
            if (j < qc) issue_tile<8>(lds, buf ^ 1, Kg + (size_t)(j + 1) * 64 * 1280, 1280, nullptr, Vg + (size_t)(j + 1) * 64 * 1280, 1280, wave, lane);
            int lo = t - 511 - 64 * j; if (lo < 0) lo = 0; int hi_ = t - 64 * j; if (hi_ > 63) hi_ = 63;
            const bool need = (j == qc) || (j + 8 == qc);
            const LAS unsigned char* kb = lds + buf * BUF_BYTES;
            tile_compute<4, 2, true>(f, kb, kb + KB_BYTES, qr, slope2, slope2 * (float)(64 * j), lo, hi_, need, r32, hh, lane);
            buf ^= 1;
        }
        flash_finish(f, 2);
        const float gw = sigmoidf_(bf2f(MISC[row * 256 + 160 + 16 + head]));
        ot0 += f.o[0] * gw; ot1 += f.o[1] * gw;
        __syncthreads();
    }
    { bf16* op = (bf16*)(F.ws + WS_OCAT) + row * 1024 + head * 64 + 4 * hh;
#pragma unroll
      for (int k = 0; k < 4; ++k) {
          *(v2u*)(op + 8 * k) = (v2u){cvtpk(ot0[4 * k], ot0[4 * k + 1]), cvtpk(ot0[4 * k + 2], ot0[4 * k + 3])};
          *(v2u*)(op + 32 + 8 * k) = (v2u){cvtpk(ot1[4 * k], ot1[4 * k + 1]), cvtpk(ot1[4 * k + 2], ot1[4 * k + 3])}; } }
}

__device__ __forceinline__ void mla_unit(Frame& F, int b, int h, int qb) {
    int lane = F.lane; asm volatile("" : "+v"(lane));
    LAS unsigned char* lds = F.lds; const int wave = F.wave, r32 = lane & 31, hh = lane >> 5;
    const int t = 256 * qb + 32 * wave + r32;
    const size_t row = (size_t)b * SEQ + t;
    const bf16* MQ = (const bf16*)(F.ws + WS_MLAQ); const bf16* MKV = (const bf16*)(F.ws + WS_MLAKV); const bf16* KPE = (const bf16*)(F.ws + WS_KPE);
    bf16x8 qr[6];
#pragma unroll
    for (int d0 = 0; d0 < 6; ++d0) qr[d0] = *(const bf16x8*)(MQ + row * 768 + h * 96 + d0 * 16 + hh * 8);
    {
        const float pos = (float)F.pos[row];
        v4u a = __builtin_bit_cast(v4u, qr[4]), c = __builtin_bit_cast(v4u, qr[5]);
        float x1[8], x2[8];
        x1[0] = bf_lo(a.x); x1[1] = bf_hi(a.x); x1[2] = bf_lo(a.y); x1[3] = bf_hi(a.y); x1[4] = bf_lo(a.z); x1[5] = bf_hi(a.z); x1[6] = bf_lo(a.w); x1[7] = bf_hi(a.w);
        x2[0] = bf_lo(c.x); x2[1] = bf_hi(c.x); x2[2] = bf_lo(c.y); x2[3] = bf_hi(c.y); x2[4] = bf_lo(c.z); x2[5] = bf_hi(c.z); x2[6] = bf_lo(c.w); x2[7] = bf_hi(c.w);
        float y1[8], y2[8];
#pragma unroll
        for (int j = 0; j < 8; ++j) { const float inv = powf(10000.0f, -(float)(2 * (8 * hh + j)) / 32.0f); const float ang = pos * inv; const float cs = cosf(ang), sn = sinf(ang);
            y1[j] = x1[j] * cs - x2[j] * sn; y2[j] = x1[j] * sn + x2[j] * cs; }
        a = (v4u){cvtpk(y1[0], y1[1]), cvtpk(y1[2], y1[3]), cvtpk(y1[4], y1[5]), cvtpk(y1[6], y1[7])};
        c = (v4u){cvtpk(y2[0], y2[1]), cvtpk(y2[2], y2[3]), cvtpk(y2[4], y2[5]), cvtpk(y2[6], y2[7])};
        qr[4] = __builtin_bit_cast(bf16x8, a); qr[5] = __builtin_bit_cast(bf16x8, c);
    }
    const bf16* Kg = MKV + (size_t)b * SEQ * 1024 + h * 128; const bf16* Vg = Kg + 64; const bf16* Pg = KPE + (size_t)b * SEQ * 32;
    Flash f; flash_init(f);
    const int NT = 4 * qb + 4; int buf = 0;
    const int tmax_w = 256 * qb + 32 * wave + 31;
    issue_tile<12>(lds, 0, Kg, 1024, Pg, Vg, 1024, wave, lane);
    for (int j = 0; j < NT; ++j) {
        __syncthreads();
        if (j + 1 < NT) issue_tile<12>(lds, buf ^ 1, Kg + (size_t)(j + 1) * 64 * 1024, 1024, Pg + (size_t)(j + 1) * 64 * 32, Vg + (size_t)(j + 1) * 64 * 1024, 1024, wave, lane);
        if (64 * j <= tmax_w) {
            int hi_ = t - 64 * j; if (hi_ > 63) hi_ = 63;
            const bool need = (64 * j + 63 > 256 * qb + 32 * wave);
            const LAS unsigned char* kb = lds + buf * BUF_BYTES;
            tile_compute<6, 2, false>(f, kb, kb + KB_BYTES, qr, 0.f, 0.f, 0, hi_, need, r32, hh, lane);
        }
        buf ^= 1;
    }
    flash_finish(f, 2);
    __syncthreads();
    { bf16* op = (bf16*)(F.ws + WS_OCAT) + row * 1024 + 512 + h * 64 + 4 * hh;
#pragma unroll
      for (int k = 0; k < 4; ++k) {
          *(v2u*)(op + 8 * k) = (v2u){cvtpk(f.o[0][4 * k], f.o[0][4 * k + 1]), cvtpk(f.o[0][4 * k + 2], f.o[0][4 * k + 3])};
          *(v2u*)(op + 32 + 8 * k) = (v2u){cvtpk(f.o[1][4 * k], f.o[1][4 * k + 1]), cvtpk(f.o[1][4 * k + 2], f.o[1][4 * k + 3])}; } }
}

__device__ __forceinline__ void nsa_loop(Frame& F) {
#pragma unroll 1
    for (int c = F.bid; c < 256; c += F.G) { const int bg = c >> 4, p = c & 15;
#pragma unroll 1
        for (int i = 0; i < 2; ++i) nsa_unit(F, bg >> 1, bg & 1, i ? p : 31 - p); }
}
__device__ __forceinline__ void mla_loop(Frame& F) {
#pragma unroll 1
    for (int c = F.bid; c < 256; c += F.G) { const int bh = c >> 2, p = c & 3;
#pragma unroll 1
        for (int i = 0; i < 2; ++i) mla_unit(F, bh >> 3, bh & 7, i ? p : 7 - p); }
}
}
__device__ __forceinline__ void kpe_pass(Frame& F) {
    const bf16* MISC = (const bf16*)(F.ws + WS_MISC); bf16* KPE = (bf16*)(F.ws + WS_KPE);
    const int gt = F.bid * NTHREADS + F.tid, NGT = F.G * NTHREADS;
    for (int it = gt; it < MTOK * 16; it += NGT) { const int t = it >> 4, i = it & 15;
        const float x1 = bf2f(MISC[(size_t)t * 256 + 128 + i]), x2 = bf2f(MISC[(size_t)t * 256 + 144 + i]);
        const float inv = powf(10000.0f, -(float)(2 * i) / 32.0f); const float ang = (float)F.pos[t] * inv; const float cs = cosf(ang), sn = sinf(ang);
        KPE[(size_t)t * 32 + i] = (bf16)f2bf(x1 * cs - x2 * sn); KPE[(size_t)t * 32 + 16 + i] = (bf16)f2bf(x1 * sn + x2 * cs); }
}
__device__ __forceinline__ void cmp_finalize(Frame& F) {
    const int gw = F.bid * NWAVES + F.wave, NGW = F.G * NWAVES, lane = F.lane;
    LAS float* hid = (LAS float*)(F.lds + F.wave * 1024);
    for (int it = gw; it < 2 * 16 * 128; it += NGW) {
        const int kv = it >> 11, bg = (it >> 7) & 15, n = it & 127;
        bf16* dst = (bf16*)(F.ws + (kv ? WS_VC : WS_KC)) + ((size_t)bg * 128 + n) * 64;
        if (n == 127) { dst[lane] = 0; continue; }
        const float* U = (const float*)(F.ws + (kv ? WS_UV : WS_UK)) + (size_t)(bg * 128 + n) * 256; const float* c1 = (const float*)(F.ws + (kv ? WS_C1V : WS_C1K));
        const float* w2 = F.in[kv ? I_CW2V : I_CW2K];
        hid[lane] = gelu_tanh(U[lane] + U[256 + 128 + lane] + c1[lane]);
        hid[64 + lane] = gelu_tanh(U[64 + lane] + U[256 + 192 + lane] + c1[64 + lane]);
        asm volatile("s_waitcnt lgkmcnt(0)" ::: "memory");
        float s = 0.f;
#pragma unroll 8
        for (int i = 0; i < 128; ++i) s += hid[i] * w2[i * 64 + lane];
        dst[lane] = (bf16)f2bf(s);
        asm volatile("s_waitcnt lgkmcnt(0)" ::: "memory");
    }
}
__device__ __forceinline__ void quant_table(Frame& F, const float* src, unsigned char* dst, float* steps) {
    const int gw = F.bid * NWAVES + F.wave, NGW = F.G * NWAVES, lane = F.lane;
    for (int e = gw; e < 16384; e += NGW) {
        const f32x4* sp = (const f32x4*)(src + (size_t)e * 1024) + 4 * lane;
        f32x4 v[4]; float mx = 0.f;
#pragma unroll
        for (int j = 0; j < 4; ++j) { v[j] = sp[j]; mx = fmaxf(mx, fmaxf(fmaxf(fabsf(v[j].x), fabsf(v[j].y)), fmaxf(fabsf(v[j].z), fabsf(v[j].w)))); }
#pragma unroll
        for (int o = 1; o < 64; o <<= 1) mx = fmaxf(mx, __shfl_xor(mx, o));
        const float step = mx > 0.f ? mx * (1.0f / 127.0f) : 1.0f, inv = 1.0f / step;
        v4u w;
#pragma unroll
        for (int j = 0; j < 4; ++j) { const unsigned b0 = (unsigned)(int)(rintf(v[j].x * inv) + 128.f), b1 = (unsigned)(int)(rintf(v[j].y * inv) + 128.f), b2 = (unsigned)(int)(rintf(v[j].z * inv) + 128.f), b3 = (unsigned)(int)(rintf(v[j].w * inv) + 128.f);
            w[j] = b0 | (b1 << 8) | (b2 << 16) | (b3 << 24); }
        ((v4u*)(dst + (size_t)e * 1024))[lane] = w;
        if (lane == 0) steps[e] = step;
    }
}
__device__ __forceinline__ void xn2_pass(Frame& F) {
    const int gw = F.bid * NWAVES + F.wave, NGW = F.G * NWAVES; bf16* XN2 = (bf16*)(F.ws + WS_XN2);
    for (int m = gw; m < MTOK; m += NGW) rms_row_to_bf16(F.out + (size_t)m * DM, F.in[I_N2G], XN2 + (size_t)m * DM, F.lane);
}

namespace peer {
constexpr int TOK = 32;
constexpr int OFF_LIST = 0;
constexpr int OFF_ROUTE = 65536;
struct Ent { float v; unsigned k; };
__device__ __forceinline__ unsigned ordkey(float f) { const unsigned u = __float_as_uint(f); return u ^ ((u >> 31) ? 0xffffffffu : 0x80000000u); }
__device__ __forceinline__ float ordinv(unsigned k) { return __uint_as_float(k ^ ((k >> 31) ? 0x80000000u : 0xffffffffu)); }
__device__ __forceinline__ void swap2(int x, int& lo, int& hi) { auto rr = __builtin_amdgcn_permlane32_swap((unsigned)x, (unsigned)x, false, false); lo = (int)rr[0]; hi = (int)rr[1]; }

#define PEER_CANDS(X) X(0,0) X(0,1) X(0,2) X(0,3) X(0,4) X(0,5) X(0,6) X(0,7) X(0,8) X(0,9) X(0,10) X(0,11) X(0,12) X(0,13) X(0,14) X(0,15) \
    X(1,0) X(1,1) X(1,2) X(1,3) X(1,4) X(1,5) X(1,6) X(1,7) X(2,0) X(2,1) X(2,2) X(2,3) X(2,4) X(3,0) X(3,1) X(3,2) X(3,3) X(4,0) X(4,1) X(4,2) \
    X(5,0) X(5,1) X(6,0) X(6,1) X(7,0) X(7,1) X(8,0) X(9,0) X(10,0) X(11,0) X(12,0) X(13,0) X(14,0) X(15,0)

__device__ __forceinline__ void route_task(Frame& F, int tok0) {
    int lane = F.lane; asm volatile("" : "+v"(lane));
    const int wave = F.wave, r32 = lane & 31, hh = lane >> 5;
    const bf16* QP = (const bf16*)(F.ws + WS_QP);
    const size_t row = (size_t)tok0 + r32;
    LAS Ent* LIST = (LAS Ent*)(F.lds + OFF_LIST) + (size_t)wave * 2 * TOK * 16;
#pragma unroll 1
    for (int half = 0; half < 2; ++half) {
        const bf16* SK = (const bf16*)(F.ws + (half ? WS_SK2 : WS_SK1));
        bf16x8 qf[8];
#pragma unroll
        for (int d0 = 0; d0 < 8; ++d0) qf[d0] = *(const bf16x8*)(QP + row * 2048 + wave * 256 + half * 128 + d0 * 16 + hh * 8);
        unsigned u[4][16];
#pragma unroll
        for (int kb = 0; kb < 4; ++kb) { f32x16 p = f32x16{};
#pragma unroll
            for (int d0 = 0; d0 < 8; ++d0) { const bf16x8 a = *(const bf16x8*)(SK + (size_t)(32 * kb + r32) * 128 + d0 * 16 + hh * 8);
                p = __builtin_amdgcn_mfma_f32_32x32x16_bf16(a, qf[d0], p, 0, 0, 0); }
#pragma unroll
            for (int r = 0; r < 16; ++r) u[kb][r] = ordkey(p[r]);
            asm volatile("" ::: "memory"); __builtin_amdgcn_sched_barrier(0); }
        unsigned prefix = 0u;
#pragma unroll 1
        for (int bit = 31; bit >= 0; --bit) { const unsigned trial = prefix | (1u << bit); int cnt = 0;
#pragma unroll
            for (int kb = 0; kb < 4; ++kb)
#pragma unroll
                for (int r = 0; r < 16; ++r) cnt += (u[kb][r] >= trial) ? 1 : 0;
            int c0, c1; swap2(cnt, c0, c1);
            if (c0 + c1 >= 16) prefix = trial; }
        int cgt = 0, ceq = 0;
#pragma unroll
        for (int kb = 0; kb < 4; ++kb)
#pragma unroll
            for (int r = 0; r < 16; ++r) { cgt += (u[kb][r] > prefix) ? 1 : 0; ceq += (u[kb][r] == prefix) ? 1 : 0; }
        int g0, g1, e0, e1; swap2(cgt, g0, g1); swap2(ceq, e0, e1);
        const int need = 16 - (g0 + g1);
        const int take0 = e0 < need ? e0 : need; const int take1 = (need - take0) < e1 ? (need - take0) : e1;
        int slot = hh ? (g0 + take0) : 0; int eq_left = hh ? take1 : take0;
        LAS Ent* L = LIST + ((size_t)half * TOK + r32) * 16;
#pragma unroll
        for (int kb = 0; kb < 4; ++kb)
#pragma unroll
            for (int r = 0; r < 16; ++r) { const unsigned uu = u[kb][r]; const int eq = ((uu == prefix) & (eq_left > 0)) ? 1 : 0; const int tk = (uu > prefix) ? 1 : eq;
                if (tk & (slot < 16)) { L[slot].v = ordinv(uu); L[slot].k = (unsigned)(32 * kb + (r & 3) + 8 * (r >> 2) + 4 * hh); }
                slot += tk; eq_left -= eq; }
    }
    asm volatile("s_waitcnt lgkmcnt(0)" ::: "memory");
    {
        LAS Ent* L = LIST + ((size_t)hh * TOK + r32) * 16;
        float v[16]; unsigned k[16];
#pragma unroll
        for (int a = 0; a < 16; ++a) { v[a] = L[a].v; k[a] = L[a].k; }
        asm volatile("s_waitcnt lgkmcnt(0)" ::: "memory");
#pragma unroll
        for (int a = 0; a < 16; ++a) { int rank = 0;
#pragma unroll
            for (int a2 = 0; a2 < 16; ++a2) rank += (v[a2] > v[a] || (v[a2] == v[a] && a2 < a)) ? 1 : 0;
            L[rank].v = v[a]; L[rank].k = k[a]; }
    }
    asm volatile("s_waitcnt lgkmcnt(0)" ::: "memory");
    {
        const LAS Ent* L1 = LIST + ((size_t)0 * TOK + r32) * 16; const LAS Ent* L2 = LIST + ((size_t)1 * TOK + r32) * 16;
        float v1[16], v2[16];
#pragma unroll
        for (int a = 0; a < 16; ++a) { v1[a] = L1[a].v; v2[a] = L2[a].v; }
        unsigned uc[50]; { int ci = 0;
#define X(a, b) uc[ci++] = ordkey(v1[a] + v2[b]);
        PEER_CANDS(X)
#undef X
        }
        const float cmax = v1[0] + v2[0];
        unsigned prefix = 0u;
#pragma unroll 1
        for (int bit = 31; bit >= 0; --bit) { const unsigned trial = prefix | (1u << bit); int cnt = 0;
#pragma unroll
            for (int i = 0; i < 50; ++i) cnt += (uc[i] >= trial) ? 1 : 0;
            if (cnt >= 16) prefix = trial; }
        int cgt = 0; float gsum = 0.f;
#pragma unroll
        for (int i = 0; i < 50; ++i) cgt += (uc[i] > prefix) ? 1 : 0;
        int eq_left = 16 - cgt;
        unsigned long long selm = 0ull;
#pragma unroll
        for (int i = 0; i < 50; ++i) { const int eq = ((uc[i] == prefix) & (eq_left > 0)) ? 1 : 0; const int sl = (uc[i] > prefix) ? 1 : eq; eq_left -= eq;
            selm |= (unsigned long long)sl << i; gsum += sl ? __expf(ordinv(uc[i]) - cmax) : 0.f; }
        const float ginv = 1.0f / gsum;
        LAS Ent* R = (LAS Ent*)(F.lds + OFF_ROUTE) + ((size_t)wave * TOK + r32) * 16;
        if (hh == 0) { int i = 0, slot = 0;
#define X(a, b) { const int sl = (int)((selm >> i) & 1ull); if (sl & (slot < 16)) { R[slot].k = L1[a].k * 128u + L2[b].k; R[slot].v = __expf(ordinv(uc[i]) - cmax) * ginv; } slot += sl; ++i; }
            PEER_CANDS(X)
#undef X
        }
    }
}

__device__ __forceinline__ float ub0(unsigned w) { return (float)(w & 0xffu); }
__device__ __forceinline__ float ub1(unsigned w) { return (float)((w >> 8) & 0xffu); }
__device__ __forceinline__ float ub2(unsigned w) { return (float)((w >> 16) & 0xffu); }
__device__ __forceinline__ float ub3(unsigned w) { return (float)(w >> 24); }
__device__ __forceinline__ void gather_token(Frame& F, int tl, size_t row, bool wr) {
    int lane = F.lane; asm volatile("" : "+v"(lane));
    const unsigned char* EXPD = F.ws + WS_EXPD; const unsigned char* EXPU = F.ws + WS_EXPU;
    const float* SD = (const float*)(F.ws + WS_EXPD_SC); const float* SU = (const float*)(F.ws + WS_EXPU_SC);
    float hv[16], xh[16], y[16]; float sx;
    { const f32x4* hp = (const f32x4*)(F.out + row * DM) + 4 * lane; const f32x4* gp = (const f32x4*)F.in[I_N2G] + 4 * lane;
      float ss = 0.f;
#pragma unroll
      for (int c = 0; c < 4; ++c) { const f32x4 v = hp[c]; hv[4 * c] = v.x; hv[4 * c + 1] = v.y; hv[4 * c + 2] = v.z; hv[4 * c + 3] = v.w; ss += (v.x * v.x + v.y * v.y) + (v.z * v.z + v.w * v.w); }
      const float r = 1.0f / sqrtf(wave_sum(ss) * (1.f / DM) + EPS);
      float s1 = 0.f;
#pragma unroll
      for (int c = 0; c < 4; ++c) { const f32x4 g = gp[c]; xh[4 * c] = hv[4 * c] * r * g.x; xh[4 * c + 1] = hv[4 * c + 1] * r * g.y; xh[4 * c + 2] = hv[4 * c + 2] * r * g.z; xh[4 * c + 3] = hv[4 * c + 3] * r * g.w;
          s1 += (xh[4 * c] + xh[4 * c + 1]) + (xh[4 * c + 2] + xh[4 * c + 3]); }
      sx = 128.f * wave_sum(s1);
    }
#pragma unroll
    for (int i = 0; i < 16; ++i) y[i] = 0.f;
    float ysub = 0.f;
    const LAS Ent* R = (const LAS Ent*)(F.lds + OFF_ROUTE);
#pragma unroll 1
    for (int grp = 0; grp < 32; ++grp) {
        const int head = grp >> 2, k0 = (grp & 3) * 4;
        unsigned ex[4]; float gt[4]; v4u dn[4], up[4]; float sd[4], su[4];
#pragma unroll
        for (int k = 0; k < 4; ++k) { const LAS Ent* en = R + ((size_t)head * TOK + tl) * 16 + k0 + k; ex[k] = (unsigned)__builtin_amdgcn_readfirstlane((int)en->k); gt[k] = __uint_as_float((unsigned)__builtin_amdgcn_readfirstlane((int)__float_as_uint(en->v))); }
#pragma unroll
        for (int k = 0; k < 4; ++k) { dn[k] = ((const v4u*)(EXPD + (size_t)ex[k] * 1024))[lane]; up[k] = ((const v4u*)(EXPU + (size_t)ex[k] * 1024))[lane]; sd[k] = SD[ex[k]]; su[k] = SU[ex[k]]; }
        float dt[4];
#pragma unroll
        for (int k = 0; k < 4; ++k) { float s = 0.f;
#pragma unroll
            for (int c = 0; c < 4; ++c) { const unsigned w = dn[k][c]; s += ub0(w) * xh[4 * c] + ub1(w) * xh[4 * c + 1] + ub2(w) * xh[4 * c + 2] + ub3(w) * xh[4 * c + 3]; }
            dt[k] = s; }
        { const bool up32 = lane & 32; float keep0 = up32 ? dt[1] : dt[0], send0 = up32 ? dt[0] : dt[1]; keep0 += __shfl_xor(send0, 32);
          float keep1 = up32 ? dt[3] : dt[2], send1 = up32 ? dt[2] : dt[3]; keep1 += __shfl_xor(send1, 32);
          const bool up16 = lane & 16; float keep = up16 ? keep1 : keep0, send = up16 ? keep0 : keep1; keep += __shfl_xor(send, 16);
          keep += __shfl_xor(keep, 8); keep += __shfl_xor(keep, 4); keep += __shfl_xor(keep, 2); keep += __shfl_xor(keep, 1);
          dt[0] = __shfl(keep, 0); dt[2] = __shfl(keep, 16); dt[1] = __shfl(keep, 32); dt[3] = __shfl(keep, 48); }
#pragma unroll
        for (int k = 0; k < 4; ++k) { const float hk = sd[k] * (dt[k] - sx); const float wk = gt[k] * gelu_tanh(hk) * su[k]; ysub += wk;
#pragma unroll
            for (int c = 0; c < 4; ++c) { const unsigned w = up[k][c]; y[4 * c] += wk * ub0(w); y[4 * c + 1] += wk * ub1(w); y[4 * c + 2] += wk * ub2(w); y[4 * c + 3] += wk * ub3(w); } }
    }
    { float ss = 0.f; const float ys = 128.f * ysub;
#pragma unroll
      for (int i = 0; i < 16; ++i) { hv[i] += y[i] - ys; ss += hv[i] * hv[i]; }
      const float r = 1.0f / sqrtf(wave_sum(ss) * (1.f / DM) + EPS);
      f32x4* op = (f32x4*)(F.out + row * DM) + 4 * lane; const f32x4* gp = (const f32x4*)F.in[I_NFG] + 4 * lane;
#pragma unroll
      for (int c = 0; c < 4; ++c) { const f32x4 g = gp[c];
          if (wr) op[c] = (f32x4){hv[4 * c] * r * g.x, hv[4 * c + 1] * r * g.y, hv[4 * c + 2] * r * g.z, hv[4 * c + 3] * r * g.w}; } }
}

__device__ __forceinline__ void peer_phase(Frame& F, bool never) {
    for (int task = F.bid; task < MTOK / TOK; task += F.G) {
        const int tok0 = task * TOK;
#pragma unroll 1
        for (int rep_ = 0; rep_ < (((DBL_MASK >> 12) & 1) ? 2 : 1); ++rep_) { route_task(F, tok0); __syncthreads(); }
#pragma unroll 1
        for (int rep_ = (((DBL_MASK >> 13) & 1) ? 0 : 1); rep_ < 2; ++rep_)
            for (int i = 0; i < TOK / NWAVES; ++i) { const int tl = F.wave * (TOK / NWAVES) + i; gather_token(F, tl, (size_t)tok0 + tl, rep_ == 1 || never); }
        __syncthreads();
    }
}
}
#ifndef MK_ONE_LAUNCH
#define MK_ONE_LAUNCH 1
#endif
#ifndef DBL_MASK
#define DBL_MASK 0
#endif
constexpr int N_PHASES = 10;
struct Args { const void* in[N_IN]; float* out; unsigned char* ws; int ph_lo, ph_hi; };
#define PHASE_FN __device__ __forceinline__ void
#define PHASE_FRAME \
    Frame F; F.lds = (LAS unsigned char*)(uintptr_t)(unsigned)__builtin_amdgcn_readfirstlane((int)ldsaddr); F.tid = threadIdx.x; F.lane = F.tid & 63; F.wave = __builtin_amdgcn_readfirstlane(F.tid >> 6); \
    F.G = gridDim.x; F.bid = blockIdx.x; F.in = (const float* const*)ap->in; F.pos = (const int*)ap->in[I_POS]; F.out = ap->out; F.ws = ap->ws; unsigned char* ws = F.ws; (void)ws;
#define REP(k) for (int rep_ = 0; rep_ < (((DBL_MASK >> (k)) & 1) ? 2 : 1); ++rep_)

PHASE_FN ph_prologue(const Args* ap, unsigned ldsaddr) { PHASE_FRAME REP(0) p0_prologue(F); }
PHASE_FN ph_inproj(const Args* ap, unsigned ldsaddr) { PHASE_FRAME REP(1) {
    pg8::StaticOrder S;
    pg8::Gemm g = pg8::make_gemm((const bf16*)(ws + WS_XN), 1024, (const bf16*)(ws + WS_WIN), 1024, MTOK, NPROJ, 1024);
    S.init(MTOK, NPROJ, F.G, F.bid);
    EpiInProj E{(bf16*)(ws + WS_QKV), (bf16*)(ws + WS_CQ), (bf16*)(ws + WS_MISC), (bf16*)(ws + WS_GATES)};
    pg8::gemm_phase<EpiInProj, pg8::StaticOrder, true>(F.lds, g, S, E); } }
PHASE_FN ph_upq(const Args* ap, unsigned ldsaddr) { PHASE_FRAME REP(2) {
    pg8::StaticOrder S;
    pg8::Gemm g = pg8::make_gemm((const bf16*)(ws + WS_CQ), 256, (const bf16*)(ws + WS_WUQ), 256, MTOK, 768, 256);
    S.init(MTOK, 768, F.G, F.bid);
    EpiRowScale<256> E{(const bf16*)(ws + WS_CQ), (bf16*)(ws + WS_MLAQ), 768, QSCALE_MLA};
    pg8::gemm_phase<EpiRowScale<256>, pg8::StaticOrder, true>(F.lds, g, S, E); } }
PHASE_FN ph_upkv(const Args* ap, unsigned ldsaddr) { PHASE_FRAME REP(2) {
    pg8::StaticOrder S;
    pg8::Gemm g = pg8::make_gemm((const bf16*)(ws + WS_MISC), 256, (const bf16*)(ws + WS_WUKV), 256, MTOK, 1024, 256);
    S.init(MTOK, 1024, F.G, F.bid);
    EpiRowScale<128> E{(const bf16*)(ws + WS_MISC), (bf16*)(ws + WS_MLAKV), 1024, 1.0f};
    pg8::gemm_phase<EpiRowScale<128>, pg8::StaticOrder, true>(F.lds, g, S, E); } }
PHASE_FN ph_cmpu(const Args* ap, unsigned ldsaddr) { PHASE_FRAME REP(2) {
    pg8::StaticOrder S;
#pragma unroll 1
    for (int kv = 0; kv < 2; ++kv) {
        pg8::Gemm g; g.A = (const bf16*)(ws + WS_QKV) + 512 + 128 * kv; g.Bt = (const bf16*)(ws + (kv ? WS_WC1V : WS_WC1K)); g.M = 2048; g.N = 256; g.K = 1024;
        g.aRow = (size_t)16 * 1280 * 2; g.aHalf = 128; g.aTile = (size_t)SEQ * 1280 * 2; g.aK = (size_t)1280 * 2; g.bRow = 1024 * 2;
        S.init(2048, 256, F.G, F.bid);
        EpiF32 E{(float*)(ws + (kv ? WS_UV : WS_UK)), 256, nullptr};
        pg8::gemm_phase<EpiF32, pg8::StaticOrder, true>(F.lds, g, S, E);
    }
    kpe_pass(F); } }
PHASE_FN ph_cmpfin(const Args* ap, unsigned ldsaddr) { PHASE_FRAME REP(3) cmp_finalize(F); }
PHASE_FN ph_nsa(const Args* ap, unsigned ldsaddr) { PHASE_FRAME REP(10) att::nsa_loop(F); }
PHASE_FN ph_mla(const Args* ap, unsigned ldsaddr) { PHASE_FRAME REP(11) att::mla_loop(F); }
PHASE_FN ph_branch0(const Args* ap, unsigned ldsaddr) { PHASE_FRAME REP(5) {
    pg8::StaticOrder S; S.init(MTOK, 1024, F.G, F.bid);
    pg8::Gemm g = pg8::make_gemm((const bf16*)(ws + WS_OCAT), 1024, (const bf16*)(ws + WS_WBR), 1024, MTOK, 1024, 512);
    EpiGate<0> E{(const bf16*)(ws + WS_GATES), (bf16*)(ws + WS_MERGED), 0};
    pg8::gemm_phase<EpiGate<0>, pg8::StaticOrder, true>(F.lds, g, S, E); } }
PHASE_FN ph_branch1(const Args* ap, unsigned ldsaddr) { PHASE_FRAME REP(5) {
    pg8::StaticOrder S; S.init(MTOK, 1024, F.G, F.bid);
    pg8::Gemm g = pg8::make_gemm((const bf16*)(ws + WS_OCAT) + 512, 1024, (const bf16*)(ws + WS_WBR) + 512, 1024, MTOK, 1024, 512);
    EpiGate<1> E{(const bf16*)(ws + WS_GATES), (bf16*)(ws + WS_MERGED), 1024};
    pg8::gemm_phase<EpiGate<1>, pg8::StaticOrder, true>(F.lds, g, S, E);
    quant_table(F, F.in[I_EDN], ws + WS_EXPD, (float*)(ws + WS_EXPD_SC)); } }
PHASE_FN ph_outproj(const Args* ap, unsigned ldsaddr) { PHASE_FRAME REP(6) {
    pg8::StaticOrder S; S.init(MTOK, 1024, F.G, F.bid);
    pg8::Gemm g = pg8::make_gemm((const bf16*)(ws + WS_MERGED), 1024, (const bf16*)(ws + WS_WOUT), 1024, MTOK, 1024, 1024);
    EpiF32 E{F.out, 1024, F.in[I_X]};
    pg8::gemm_phase<EpiF32, pg8::StaticOrder, true>(F.lds, g, S, E);
    quant_table(F, F.in[I_EUP], ws + WS_EXPU, (float*)(ws + WS_EXPU_SC)); } }
PHASE_FN ph_xn2(const Args* ap, unsigned ldsaddr) { PHASE_FRAME REP(7) xn2_pass(F); }
PHASE_FN ph_peerq(const Args* ap, unsigned ldsaddr) { PHASE_FRAME REP(8) {
    pg8::StaticOrder S; S.init(MTOK, 2048, F.G, F.bid);
    pg8::Gemm g = pg8::make_gemm((const bf16*)(ws + WS_XN2), 1024, (const bf16*)(ws + WS_WPQ), 1024, MTOK, 2048, 1024);
    EpiBf16 E{(bf16*)(ws + WS_QP), 2048};
    pg8::gemm_phase<EpiBf16, pg8::StaticOrder, true>(F.lds, g, S, E); } }
PHASE_FN ph_peer(const Args* ap, unsigned ldsaddr) { PHASE_FRAME peer::peer_phase(F, ap->ph_lo < 0); }

__global__ void __launch_bounds__(NTHREADS, 2) fwd(Args a) {
    extern __shared__ __attribute__((aligned(16))) unsigned char lds_raw[];
    cg::grid_group grid = cg::this_grid();
    const unsigned ldsaddr = (unsigned)(uintptr_t)(LAS unsigned char*)lds_raw;
    const int lo = a.ph_lo, hi = a.ph_hi;
#define IN(k) (lo <= (k) && (k) < hi)
#define SEAM(k) do { if (IN(k) && IN((k) + 1)) grid.sync(); } while (0)
    if (IN(0)) ph_prologue(&a, ldsaddr);
    SEAM(0);
    if (IN(1)) ph_inproj(&a, ldsaddr);
    SEAM(1);
    if (IN(2)) { ph_upq(&a, ldsaddr); ph_upkv(&a, ldsaddr); ph_cmpu(&a, ldsaddr); }
    SEAM(2);
    if (IN(3)) ph_cmpfin(&a, ldsaddr);
    SEAM(3);
    if (IN(4)) { ph_nsa(&a, ldsaddr); ph_mla(&a, ldsaddr); }
    SEAM(4);
    if (IN(5)) { ph_branch0(&a, ldsaddr); ph_branch1(&a, ldsaddr); }
    SEAM(5);
    if (IN(6)) ph_outproj(&a, ldsaddr);
    SEAM(6);
    if (IN(7)) ph_xn2(&a, ldsaddr);
    SEAM(7);
    if (IN(8)) ph_peerq(&a, ldsaddr);
    SEAM(8);
    if (IN(9)) ph_peer(&a, ldsaddr);
#undef IN
#undef SEAM
}

extern "C" void kernel_launch(void* const* d_in, const int* in_sizes, int n_in, void* d_out, int out_size, void* d_ws, size_t ws_size, hipStream_t stream) {
    static int grid = 0;
    if (grid == 0) {
        if (n_in != N_IN || out_size != MTOK * DM || ws_size < WS_END) { fprintf(stderr, "kernel_launch: unexpected shapes (n_in %d, out %d, ws %zu)\n", n_in, out_size, ws_size); grid = -1; return; }
        int dev = 0, cus = 0, per_cu = 0;
        if (hipGetDevice(&dev) != hipSuccess || hipDeviceGetAttribute(&cus, hipDeviceAttributeMultiprocessorCount, dev) != hipSuccess) { grid = -1; return; }
        if (hipFuncSetAttribute((const void*)fwd, hipFuncAttributeMaxDynamicSharedMemorySize, LDS_BYTES) != hipSuccess) { fprintf(stderr, "kernel_launch: hipFuncSetAttribute failed\n"); grid = -1; return; }
        if (hipOccupancyMaxActiveBlocksPerMultiprocessor(&per_cu, (const void*)fwd, NTHREADS, LDS_BYTES) != hipSuccess || per_cu < 1) { fprintf(stderr, "kernel_launch: occupancy query says %d\n", per_cu); (void)hipGetLastError(); grid = -1; return; }
        grid = cus;
    }
    if (grid < 0) return;
    Args a{};
    for (int i = 0; i < N_IN; ++i) a.in[i] = d_in[i];
    a.out = (float*)d_out; a.ws = (unsigned char*)d_ws;
#if MK_ONE_LAUNCH
    a.ph_lo = 0; a.ph_hi = N_PHASES;
    void* args[] = {&a};
    hipError_t e = hipLaunchCooperativeKernel((const void*)fwd, dim3(grid), dim3(NTHREADS), args, LDS_BYTES, stream);
    if (e != hipSuccess) fprintf(stderr, "kernel_launch: cooperative launch failed: %s (grid %d)\n", hipGetErrorString(e), grid);
#else
    for (int p = 0; p < N_PHASES; ++p) { a.ph_lo = p; a.ph_hi = p + 1; hipLaunchKernelGGL(fwd, dim3(grid), dim3(NTHREADS), LDS_BYTES, stream, a); }
#endif
}
```

```cpp
#define DBL_MASK 0
#include <hip/hip_runtime.h>
#include <hip/hip_cooperative_groups.h>
#include <cstdio>
#include <cstdint>
#include <cmath>
namespace cg = cooperative_groups;
namespace pg8 {
#define PG8_LAS __attribute__((address_space(3)))
typedef unsigned short bf16_t;
typedef short bf16x8 __attribute__((ext_vector_type(8)));
typedef float f32x4 __attribute__((ext_vector_type(4)));
typedef unsigned u32x4 __attribute__((ext_vector_type(4)));
constexpr int BM = 256, BK = 64, HALF = 128, HTB = HALF * BK * 2  , STAGE_BYTES = 8 * HTB, NXCD = 8, WGM = 8;

__host__ __device__ __forceinline__ int lds_byte(int r, int c) { const int st = (r >> 4) * 2 + (c >> 5), rr = r & 15, cc = c & 31, ob = rr * 64 + cc * 2; return st * 1024 + (ob ^ (((ob >> 9) & 1) << 5)); }
__host__ __device__ __forceinline__ void stage_rc(int b, int& R, int& C) { const int st = b / 1024, sb = b % 1024, swz = sb ^ (((sb >> 9) & 1) << 5); R = (st >> 1) * 16 + swz / 64; C = (st & 1) * 32 + (swz % 64) / 2; }
__host__ __device__ __forceinline__ int perm32(int rho) { const int n = rho >> 4, i = rho & 15; return 8 * (i >> 2) + 4 * n + (i & 3); }

struct Unit { int pm, pn; };
struct Gemm { const bf16_t* A; const bf16_t* Bt; int M, N, K; size_t aRow, aHalf, aTile, aK, bRow; };
__host__ __device__ __forceinline__ Gemm make_gemm(const bf16_t* A, int lda, const bf16_t* Bt, int ldb, int M, int N, int K) {
    Gemm g; g.A = A; g.Bt = Bt; g.M = M; g.N = N; g.K = K; g.aRow = (size_t)lda * 2; g.aHalf = (size_t)HALF * lda * 2; g.aTile = (size_t)BM * lda * 2; g.aK = BK * 2; g.bRow = (size_t)ldb * 2; return g; }

struct StaticOrder {
    int nM, nN, nwg, G, c;
    __host__ __device__ void init(int M, int N, int G_, int c_) { nM = M / BM; nN = N / BM; nwg = nM * nN; G = G_; c = c_; }
    __host__ __device__ bool next(int i, Unit& u) const {
        const long L = (long)i * G + c; if (L >= nwg) return false;
        int wgid = (int)L; { const int q = nwg / NXCD, r = nwg % NXCD, xcd = wgid % NXCD, off = wgid / NXCD; wgid = (xcd < r ? xcd * (q + 1) : r * (q + 1) + (xcd - r) * q) + off; }
        const int nig = WGM * nN, gid = wgid / nig, fm = gid * WGM, gsz = (nM - fm) < WGM ? (nM - fm) : WGM;
        u.pm = fm + ((wgid % nig) % gsz); u.pn = (wgid % nig) / gsz; return true;
    }
};

__device__ __forceinline__ unsigned cvt_pk_bf16(float lo, float hi) { unsigned r; asm volatile("v_cvt_pk_bf16_f32 %0, %1, %2" : "=v"(r) : "v"(lo), "v"(hi)); return r; }

template <class Epi, class Sched, bool ALIGN_EPI>
__device__ __forceinline__ void gemm_phase(PG8_LAS unsigned char* lds, const Gemm g, const Sched& S, const Epi& E) {
    const int tid = threadIdx.x, wid = __builtin_amdgcn_readfirstlane(tid >> 6), lane = tid & 63, wr = wid >> 2, wc = wid & 3, fr = lane & 15, fq = lane >> 4;
    const int K = g.K, nt = K / BK;
    unsigned voffA[2], voffB[2];
#pragma unroll
    for (int i = 0; i < 2; ++i) { int R, C; stage_rc(tid * 16 + i * 8192, R, C); const int Rb = Epi::PERM ? ((R & ~31) + perm32(R & 31)) : R;
        voffA[i] = (unsigned)((size_t)R * g.aRow + (size_t)C * 2); voffB[i] = (unsigned)((size_t)Rb * g.bRow + (size_t)C * 2); }
    const size_t kstepA = g.aK, kstepB = (size_t)(BK * 2);
    const size_t hstepA = g.aHalf, hstepB = (size_t)HALF * g.bRow;
    const size_t tstepA = g.aTile, tstepB = (size_t)BM * g.bRow;
    const unsigned ldsw = (unsigned)wid * 1024u;
    const int aoff = lds_byte(wr * 64 + fr, fq * 8), boff = lds_byte(wc * 32 + fr, fq * 8);
#define PG8_SA(b, h) (((b) * 2 + (h)) * HTB)
#define PG8_SB(b, h) ((4 + (b) * 2 + (h)) * HTB)
#define PG8_STAGE(bufoff, gbase, voff) do { _Pragma("unroll") for (int _i = 0; _i < 2; ++_i) \
        __builtin_amdgcn_global_load_lds((const unsigned*)((const char*)(gbase) + (voff)[_i]), (PG8_LAS unsigned*)(lds + (bufoff) + ldsw + _i * 8192), 16, 0, 0); } while (0)
#define PG8_LDA(dst, b, h) do { _Pragma("unroll") for (int m = 0; m < 4; ++m) _Pragma("unroll") for (int k = 0; k < 2; ++k) dst[m][k] = *(const PG8_LAS bf16x8*)(lds + PG8_SA(b, h) + aoff + m * 2048 + k * 1024); } while (0)
#define PG8_LDB(dst, b, h) do { _Pragma("unroll") for (int n = 0; n < 2; ++n) _Pragma("unroll") for (int k = 0; k < 2; ++k) dst[n][k] = *(const PG8_LAS bf16x8*)(lds + PG8_SB(b, h) + boff + n * 2048 + k * 1024); } while (0)
#define PG8_MMA(ai, bj, At, Bt) do { __builtin_amdgcn_s_setprio(1); _Pragma("unroll") for (int m = 0; m < 4; ++m) _Pragma("unroll") for (int n = 0; n < 2; ++n) _Pragma("unroll") for (int k = 0; k < 2; ++k) \
        acc[ai][bj][m][n] = __builtin_amdgcn_mfma_f32_16x16x32_bf16(Bt[n][k], At[m][k], acc[ai][bj][m][n], 0, 0, 0); __builtin_amdgcn_s_setprio(0); } while (0)
#define PG8_WAIT_V(n) asm volatile("s_waitcnt vmcnt(" #n ")" ::: "memory")
#define PG8_WAIT_L(n) asm volatile("s_waitcnt lgkmcnt(" #n ")" ::: "memory")
#define PG8_BAR __builtin_amdgcn_s_barrier()
#define PG8_SCHED __builtin_amdgcn_sched_barrier(0)
    Unit cur, nxt; int ui = 0;
    if (!S.next(0, cur)) return;
    f32x4 acc[2][2][4][2];
#pragma unroll
    for (int a = 0; a < 2; ++a)
#pragma unroll
        for (int b = 0; b < 2; ++b)
#pragma unroll
            for (int m = 0; m < 4; ++m)
#pragma unroll
                for (int n = 0; n < 2; ++n) acc[a][b][m][n] = (f32x4){0.f, 0.f, 0.f, 0.f};
    bf16x8 At[4][2], B0[2][2], B1[2][2];
    const char* cA = (const char*)g.A + (size_t)cur.pm * tstepA; const char* cB = (const char*)g.Bt + (size_t)cur.pn * tstepB;
    PG8_STAGE(PG8_SB(0, 0), cB, voffB); PG8_STAGE(PG8_SB(0, 1), cB + hstepB, voffB); PG8_STAGE(PG8_SA(0, 0), cA, voffA); PG8_STAGE(PG8_SA(0, 1), cA + hstepA, voffA);
    if (wr == 1) PG8_BAR;
    PG8_WAIT_V(2); PG8_BAR;
    PG8_STAGE(PG8_SB(1, 0), cB + kstepB, voffB); PG8_STAGE(PG8_SA(1, 0), cA + kstepA, voffA); PG8_STAGE(PG8_SB(1, 1), cB + hstepB + kstepB, voffB);
    PG8_WAIT_V(6); PG8_BAR;
    for (;;) {
        const bool has_next = S.next(ui + 1, nxt);
        const char* nA = has_next ? (const char*)g.A + (size_t)nxt.pm * tstepA : cA; const char* nB = has_next ? (const char*)g.Bt + (size_t)nxt.pn * tstepB : cB;
        for (int t = 0; t < nt; t += 2) {
            const bool last = (t == nt - 2);
            const char* a1 = cA + (size_t)(t + 1) * kstepA;
            const char* a2 = last ? nA : cA + (size_t)(t + 2) * kstepA; const char* b2 = last ? nB : cB + (size_t)(t + 2) * kstepB;
            const char* a3 = a2 + kstepA; const char* b3 = b2 + kstepB;
            PG8_LDB(B0, 0, 0); PG8_LDB(B1, 0, 1); PG8_SCHED; PG8_LDA(At, 0, 0); PG8_STAGE(PG8_SA(1, 1), a1 + hstepA, voffA);
            PG8_WAIT_V(8); PG8_WAIT_L(0); PG8_BAR; PG8_MMA(0, 0, At, B0); PG8_MMA(0, 1, At, B1); PG8_BAR; PG8_SCHED;
            PG8_LDA(At, 0, 1); PG8_STAGE(PG8_SB(0, 0), b2, voffB); PG8_STAGE(PG8_SB(0, 1), b2 + hstepB, voffB); PG8_STAGE(PG8_SA(0, 0), a2, voffA);
            PG8_WAIT_V(8); PG8_WAIT_L(0); PG8_BAR; PG8_MMA(1, 0, At, B0); PG8_MMA(1, 1, At, B1); PG8_BAR; PG8_SCHED;
            PG8_LDB(B0, 1, 0); PG8_LDB(B1, 1, 1); PG8_SCHED; PG8_LDA(At, 1, 0); PG8_STAGE(PG8_SA(0, 1), a2 + hstepA, voffA);
            PG8_WAIT_V(8); PG8_WAIT_L(0); PG8_BAR; PG8_MMA(0, 0, At, B0); PG8_MMA(0, 1, At, B1); PG8_BAR; PG8_SCHED;
            PG8_LDA(At, 1, 1); PG8_STAGE(PG8_SB(1, 0), b3, voffB); PG8_STAGE(PG8_SB(1, 1), b3 + hstepB, voffB); PG8_STAGE(PG8_SA(1, 0), a3, voffA);
            PG8_WAIT_V(8); PG8_WAIT_L(0); PG8_BAR; PG8_MMA(1, 0, At, B0); PG8_MMA(1, 1, At, B1); PG8_BAR; PG8_SCHED;
        }
        if constexpr (ALIGN_EPI) { if (wr == 0) PG8_BAR; }
        E(acc, cur, wr, wc, fr, fq);
        if (!has_next) break;
#pragma unroll
        for (int a = 0; a < 2; ++a)
#pragma unroll
            for (int b = 0; b < 2; ++b)
#pragma unroll
                for (int m = 0; m < 4; ++m)
#pragma unroll
                    for (int n = 0; n < 2; ++n) acc[a][b][m][n] = (f32x4){0.f, 0.f, 0.f, 0.f};
        cur = nxt; cA = nA; cB = nB; ++ui;
        if constexpr (ALIGN_EPI) { if (wr == 1) PG8_BAR; }
    }
    PG8_WAIT_V(0);
    if constexpr (!ALIGN_EPI) { if (wr == 0) PG8_BAR; }
    PG8_BAR;
#undef PG8_SA
#undef PG8_SB
#undef PG8_STAGE
#undef PG8_LDA
#undef PG8_LDB
#undef PG8_MMA
#undef PG8_WAIT_V
#undef PG8_WAIT_L
#undef PG8_BAR
#undef PG8_SCHED
}
}
constexpr int NWAVES = 8, NTHREADS = 512;
constexpr int BATCH = 8, SEQ = 2048, DM = 1024, MTOK = BATCH * SEQ;
constexpr int NPROJ = 3840;
constexpr float EPS = 1e-6f, LOG2E = 1.4426950408889634f;
constexpr float QSCALE_NSA = 0.125f * LOG2E;
constexpr float QSCALE_MLA = 0.10206207261596575f * LOG2E;
constexpr size_t MiB = 1u << 20;
enum { I_X = 0, I_POS, I_N1G, I_WIN, I_CPK, I_CW1K, I_CW2K, I_CPV, I_CW1V, I_CW2V, I_QNG, I_KVNG, I_WUQ, I_WUKV, I_WBN, I_WBM, I_WOUT, I_N2G, I_WPQ, I_SK1, I_SK2, I_EDN, I_EUP, I_NFG, N_IN };
constexpr size_t WS_CTL = 0;
constexpr size_t WS_WIN = 1 * MiB;
constexpr size_t WS_WUQ = WS_WIN + (size_t)NPROJ * 1024 * 2;
constexpr size_t WS_WUKV = WS_WUQ + 768 * 256 * 2;
constexpr size_t WS_WBR = 10 * MiB;
constexpr size_t WS_WOUT = 12 * MiB;
constexpr size_t WS_WPQ = 14 * MiB;
constexpr size_t WS_WC1K = 18 * MiB;
constexpr size_t WS_WC1V = WS_WC1K + 256 * 1024 * 2;
constexpr size_t WS_SMALL = 19 * MiB;
constexpr size_t WS_C1K = WS_SMALL;
constexpr size_t WS_C1V = WS_SMALL + 512;
constexpr size_t WS_ORDER = WS_SMALL + 1024;
constexpr size_t WS_SK1 = WS_SMALL + 4096;
constexpr size_t WS_SK2 = WS_SK1 + 32768;
constexpr size_t WS_XN = 20 * MiB;
constexpr size_t WS_MLAQ = WS_XN, WS_EXPD = WS_XN;
constexpr size_t WS_EXPD_SC = WS_EXPD + (size_t)16384 * 1024;
constexpr size_t WS_QKV = 52 * MiB;
constexpr size_t WS_MERGED = WS_QKV;
constexpr size_t WS_CQ = 92 * MiB;
constexpr size_t WS_MISC = 100 * MiB;
constexpr size_t WS_ROUTE = 92 * MiB;
constexpr size_t WS_GATES = 108 * MiB;
constexpr size_t WS_QP = WS_GATES;
constexpr size_t WS_MLAKV = 172 * MiB;
constexpr size_t WS_XN2 = WS_MLAKV;
constexpr size_t WS_KPE = 204 * MiB;
constexpr size_t WS_KC = 205 * MiB;
constexpr size_t WS_VC = WS_KC + 16 * 128 * 64 * 2;
constexpr size_t WS_UK = 206 * MiB;
constexpr size_t WS_UV = 208 * MiB;
constexpr size_t WS_OCAT = 210 * MiB;
constexpr size_t WS_EXPU = WS_OCAT;
constexpr size_t WS_EXPU_SC = WS_EXPU + (size_t)16384 * 1024;
constexpr size_t WS_END = 242 * MiB;
constexpr int RING_BYTES = 131072;
constexpr int LDS_BYTES = 147456;

#define GAS __attribute__((address_space(1)))
#define LAS __attribute__((address_space(3)))
typedef unsigned short bf16;
typedef unsigned v4u __attribute__((ext_vector_type(4)));
typedef unsigned v2u __attribute__((ext_vector_type(2)));
typedef float f32x4 __attribute__((ext_vector_type(4)));
typedef float f32x16 __attribute__((ext_vector_type(16)));
typedef short bf16x8 __attribute__((ext_vector_type(8)));
typedef short s16x4 __attribute__((ext_vector_type(4)));

__device__ __forceinline__ unsigned f2bf(float f) { unsigned u = __builtin_bit_cast(unsigned, f); return (u + 0x7fffu + ((u >> 16) & 1u)) >> 16; }
__device__ __forceinline__ unsigned pk2(float lo, float hi) { return f2bf(lo) | (f2bf(hi) << 16); }
__device__ __forceinline__ float bf_lo(unsigned u) { return __builtin_bit_cast(float, u << 16); }
__device__ __forceinline__ float bf_hi(unsigned u) { return __builtin_bit_cast(float, u & 0xffff0000u); }
__device__ __forceinline__ float bf2f(bf16 h) { return __builtin_bit_cast(float, (unsigned)h << 16); }
__device__ __forceinline__ float sigmoidf_(float v) { return 1.0f / (1.0f + __expf(-v)); }
__device__ __forceinline__ float gelu_tanh(float v) { const float u = 0.7978845608028654f * (v + 0.044715f * v * v * v); const float e = __expf(2.0f * u); const float th = 1.0f - 2.0f / (e + 1.0f); return 0.5f * v * (1.0f + th); }
__device__ __forceinline__ float wave_sum(float v) {
#pragma unroll
    for (int o = 1; o < 64; o <<= 1) v += __shfl_xor(v, o);
    return v;
}

struct Frame {
    LAS unsigned char* lds;
    int tid, lane, wave, G, bid;
    const float* const* in; const int* pos; float* out; unsigned char* ws;
};

__device__ __forceinline__ int win_srccol(int n) {
    if (n < 1280) return n;
    if (n < 1536) return 1304 + (n - 1280);
    if (n < 1664) return 1560 + (n - 1536);
    if (n < 1696) return 1688 + (n - 1664);
    if (n < 1720) return 1280 + (n - 1696);
    if (n < 1792) return -1;
    return 1720 + (n - 1792);
}
template <bool WIN_PERM>
__device__ __forceinline__ void tr_item(const float* src, int ld_src, int ksrc0, const float* kscale, bf16* dst, int ld_dst, int drow0, int dcol0, int N, LAS float* scr, int item, int lane) {
    const int nblk = N / 32, kb = item / nblk, nb = item % nblk, k0 = 64 * kb, n0 = 32 * nb;
    const int nn = n0 + (lane & 31); const int sc = WIN_PERM ? win_srccol(nn) : nn;
#pragma unroll 8
    for (int i = 0; i < 32; ++i) { const int kk = 2 * i + (lane >> 5); float v = 0.f; if (sc >= 0) v = src[(size_t)(ksrc0 + k0 + kk) * ld_src + sc]; if (kscale) v *= kscale[k0 + kk]; scr[kk * 33 + (lane & 31)] = v; }
    asm volatile("s_waitcnt lgkmcnt(0)" ::: "memory");
    const int c = lane & 7;
#pragma unroll
    for (int j = 0; j < 4; ++j) { const int n = (lane >> 3) + 8 * j; const LAS float* s = scr + (8 * c) * 33 + n;
        v4u o; o.x = pk2(s[0 * 33], s[1 * 33]); o.y = pk2(s[2 * 33], s[3 * 33]); o.z = pk2(s[4 * 33], s[5 * 33]); o.w = pk2(s[6 * 33], s[7 * 33]);
        *(v4u*)(dst + (size_t)(drow0 + n0 + n) * ld_dst + dcol0 + k0 + 8 * c) = o; }
    asm volatile("s_waitcnt lgkmcnt(0)" ::: "memory");
}
__device__ __forceinline__ void rms_row_to_bf16(const float* xrow, const float* gain, bf16* orow, int lane) {
    const f32x4* xr = (const f32x4*)xrow + lane; const f32x4* gr = (const f32x4*)gain + lane;
    f32x4 v[4]; float s = 0.f;
#pragma unroll
    for (int j = 0; j < 4; ++j) { v[j] = xr[64 * j]; s += (v[j].x * v[j].x + v[j].y * v[j].y) + (v[j].z * v[j].z + v[j].w * v[j].w); }
    const float r = 1.0f / sqrtf(wave_sum(s) * (1.f / DM) + EPS);
    unsigned long long* o8 = (unsigned long long*)orow + lane;
#pragma unroll
    for (int j = 0; j < 4; ++j) { const f32x4 g = gr[64 * j]; o8[64 * j] = (unsigned long long)pk2(v[j].x * r * g.x, v[j].y * r * g.y) | ((unsigned long long)pk2(v[j].z * r * g.z, v[j].w * r * g.w) << 32); }
}
__device__ __forceinline__ void p0_prologue(Frame& F) {
    LAS float* scr = (LAS float*)(F.lds + F.wave * 16384);
    const int gw = F.bid * NWAVES + F.wave, NGW = F.G * NWAVES, lane = F.lane;
    bf16* const Win_t = (bf16*)(F.ws + WS_WIN); bf16* const Wuq_t = (bf16*)(F.ws + WS_WUQ); bf16* const Wukv_t = (bf16*)(F.ws + WS_WUKV);
    bf16* const Wbr_t = (bf16*)(F.ws + WS_WBR); bf16* const Wout_t = (bf16*)(F.ws + WS_WOUT); bf16* const Wpq_t = (bf16*)(F.ws + WS_WPQ);
    bf16* const Wc1k_t = (bf16*)(F.ws + WS_WC1K); bf16* const Wc1v_t = (bf16*)(F.ws + WS_WC1V);
    constexpr int I_IN = 16 * (NPROJ / 32), I_UQ = 4 * 24, I_UKV = 2 * 32, I_BR = 8 * 32, I_OUT = 16 * 32, I_PQ = 16 * 64, I_C1 = 16 * 4;
    constexpr int NITEMS = I_IN + I_UQ + I_UKV + 2 * I_BR + I_OUT + I_PQ + 4 * I_C1;
    for (int it = gw; it < NITEMS; it += NGW) {
        int r = it;
        if (r < I_IN) { tr_item<true>(F.in[I_WIN], 3768, 0, nullptr, Win_t, 1024, 0, 0, NPROJ, scr, r, lane); continue; } r -= I_IN;
        if (r < I_UQ) { tr_item<false>(F.in[I_WUQ], 768, 0, F.in[I_QNG], Wuq_t, 256, 0, 0, 768, scr, r, lane); continue; } r -= I_UQ;
        if (r < I_UKV) { tr_item<false>(F.in[I_WUKV], 1024, 0, F.in[I_KVNG], Wukv_t, 256, 0, 0, 1024, scr, r, lane); continue; } r -= I_UKV;
        if (r < I_BR) { tr_item<false>(F.in[I_WBN], 1024, 0, nullptr, Wbr_t, 1024, 0, 0, 1024, scr, r, lane); continue; } r -= I_BR;
        if (r < I_BR) { tr_item<false>(F.in[I_WBM], 1024, 0, nullptr, Wbr_t, 1024, 0, 512, 1024, scr, r, lane); continue; } r -= I_BR;
        if (r < I_OUT) { tr_item<false>(F.in[I_WOUT], 1024, 0, nullptr, Wout_t, 1024, 0, 0, 1024, scr, r, lane); continue; } r -= I_OUT;
        if (r < I_PQ) { tr_item<false>(F.in[I_WPQ], 2048, 0, nullptr, Wpq_t, 1024, 0, 0, 2048, scr, r, lane); continue; } r -= I_PQ;
        if (r < I_C1) { tr_item<false>(F.in[I_CW1K], 128, 0, nullptr, Wc1k_t, 1024, 0, 0, 128, scr, r, lane); continue; } r -= I_C1;
        if (r < I_C1) { tr_item<false>(F.in[I_CW1K], 128, 1024, nullptr, Wc1k_t, 1024, 128, 0, 128, scr, r, lane); continue; } r -= I_C1;
        if (r < I_C1) { tr_item<false>(F.in[I_CW1V], 128, 0, nullptr, Wc1v_t, 1024, 0, 0, 128, scr, r, lane); continue; } r -= I_C1;
        tr_item<false>(F.in[I_CW1V], 128, 1024, nullptr, Wc1v_t, 1024, 128, 0, 128, scr, r, lane);
    }
    { bf16* XN = (bf16*)(F.ws + WS_XN); for (int m = gw; m < MTOK; m += NGW) rms_row_to_bf16(F.in[I_X] + (size_t)m * DM, F.in[I_N1G], XN + (size_t)m * DM, lane); }
    const int gt = F.bid * NTHREADS + F.tid, NGT = F.G * NTHREADS;
    for (int i = gt; i < 1024 * 128; i += NGT) { const int n = i >> 7, k = 128 + (i & 127); Wukv_t[n * 256 + k] = 0; }
    { bf16* S1 = (bf16*)(F.ws + WS_SK1); bf16* S2 = (bf16*)(F.ws + WS_SK2);
      for (int i = gt; i < 128 * 128; i += NGT) { S1[i] = (bf16)f2bf(F.in[I_SK1][i]); S2[i] = (bf16)f2bf(F.in[I_SK2][i]); } }
    for (int o = gw; o < 256; o += NGW) {
        const int kv = o >> 7, j = o & 127; const float* pe = F.in[kv ? I_CPV : I_CPK]; const float* w1 = F.in[kv ? I_CW1V : I_CW1K];
        float s = 0.f;
        for (int k = lane; k < 2048; k += 64) s += pe[k] * w1[(size_t)k * 128 + j];
        s = wave_sum(s);
        if (lane == 0) ((float*)(F.ws + (kv ? WS_C1V : WS_C1K)))[j] = s;
    }
}

using pg8::Unit; using pg8::cvt_pk_bf16;
constexpr int PG_HALF = 128, PG_BM = 256;
struct EpiInProj {
    static constexpr bool PERM = true;
    bf16 *QKV, *CQ, *MISC, *GATES;
    __device__ __forceinline__ void operator()(const f32x4 (&acc)[2][2][4][2], const Unit& u, int wr, int wc, int fr, int fq) const {
        bf16* base; int ldc, colt; float sc = 1.f;
        if (u.pn < 5) { base = QKV; ldc = 1280; colt = u.pn * 256; if (u.pn < 2) sc = QSCALE_NSA; }
        else if (u.pn == 5) { base = CQ; ldc = 256; colt = 0; }
        else if (u.pn == 6) { base = MISC; ldc = 256; colt = 0; }
        else { base = GATES; ldc = 2048; colt = (u.pn - 7) * 256; }
        const int row0 = u.pm * PG_BM + wr * 64 + fr, col0 = colt + wc * 32 + 8 * fq;
#pragma unroll
        for (int ai = 0; ai < 2; ++ai)
#pragma unroll
            for (int m = 0; m < 4; ++m) { bf16* rowp = base + (size_t)(row0 + ai * PG_HALF + m * 16) * ldc + col0;
#pragma unroll
                for (int bj = 0; bj < 2; ++bj) { const f32x4 v0 = acc[ai][bj][m][0] * sc, v1 = acc[ai][bj][m][1] * sc;
                    v4u w; w.x = cvt_pk_bf16(v0[0], v0[1]); w.y = cvt_pk_bf16(v0[2], v0[3]); w.z = cvt_pk_bf16(v1[0], v1[1]); w.w = cvt_pk_bf16(v1[2], v1[3]);
                    *(v4u*)(rowp + bj * PG_HALF) = w; } }
    }
};
struct EpiBf16 {
    static constexpr bool PERM = true;
    bf16* O; int ldc;
    __device__ __forceinline__ void operator()(const f32x4 (&acc)[2][2][4][2], const Unit& u, int wr, int wc, int fr, int fq) const {
        const int row0 = u.pm * PG_BM + wr * 64 + fr, col0 = u.pn * PG_BM + wc * 32 + 8 * fq;
#pragma unroll
        for (int ai = 0; ai < 2; ++ai)
#pragma unroll
            for (int m = 0; m < 4; ++m) { bf16* rowp = O + (size_t)(row0 + ai * PG_HALF + m * 16) * ldc + col0;
#pragma unroll
                for (int bj = 0; bj < 2; ++bj) { const f32x4 v0 = acc[ai][bj][m][0], v1 = acc[ai][bj][m][1];
                    v4u w; w.x = cvt_pk_bf16(v0[0], v0[1]); w.y = cvt_pk_bf16(v0[2], v0[3]); w.z = cvt_pk_bf16(v1[0], v1[1]); w.w = cvt_pk_bf16(v1[2], v1[3]);
                    *(v4u*)(rowp + bj * PG_HALF) = w; } }
    }
};
template <int NSRC> struct EpiRowScale {
    static constexpr bool PERM = true;
    const bf16* SRC; bf16* O; int ldc; float cscale;
    __device__ __forceinline__ void operator()(const f32x4 (&acc)[2][2][4][2], const Unit& u, int wr, int wc, int fr, int fq) const {
        const int row0 = u.pm * PG_BM + wr * 64 + fr, col0 = u.pn * PG_BM + wc * 32 + 8 * fq;
#pragma unroll
        for (int ai = 0; ai < 2; ++ai)
#pragma unroll
            for (int m = 0; m < 4; ++m) { const int row = row0 + ai * PG_HALF + m * 16;
                const v4u* sp = (const v4u*)(SRC + (size_t)row * 256 + fq * (NSRC / 4)); float ss = 0.f;
#pragma unroll
                for (int i = 0; i < NSRC / 32; ++i) { const v4u w = sp[i];
                    ss += bf_lo(w.x) * bf_lo(w.x) + bf_hi(w.x) * bf_hi(w.x) + bf_lo(w.y) * bf_lo(w.y) + bf_hi(w.y) * bf_hi(w.y) + bf_lo(w.z) * bf_lo(w.z) + bf_hi(w.z) * bf_hi(w.z) + bf_lo(w.w) * bf_lo(w.w) + bf_hi(w.w) * bf_hi(w.w); }
                ss += __shfl_xor(ss, 16); ss += __shfl_xor(ss, 32);
                const float sc = cscale / sqrtf(ss * (1.0f / NSRC) + EPS);
                bf16* rowp = O + (size_t)row * ldc + col0;
#pragma unroll
                for (int bj = 0; bj < 2; ++bj) { const f32x4 v0 = acc[ai][bj][m][0] * sc, v1 = acc[ai][bj][m][1] * sc;
                    v4u w; w.x = cvt_pk_bf16(v0[0], v0[1]); w.y = cvt_pk_bf16(v0[2], v0[3]); w.z = cvt_pk_bf16(v1[0], v1[1]); w.w = cvt_pk_bf16(v1[2], v1[3]);
                    *(v4u*)(rowp + bj * PG_HALF) = w; } }
    }
};
struct EpiF32 {
    static constexpr bool PERM = false;
    float* C; int ldc; const float* resid;
    __device__ __forceinline__ void operator()(const f32x4 (&acc)[2][2][4][2], const Unit& u, int wr, int wc, int fr, int fq) const {
        const int row0 = u.pm * PG_BM + wr * 64 + fr, col0 = u.pn * PG_BM + wc * 32 + 4 * fq;
#pragma unroll
        for (int ai = 0; ai < 2; ++ai)
#pragma unroll
            for (int m = 0; m < 4; ++m) { const size_t off = (size_t)(row0 + ai * PG_HALF + m * 16) * ldc + col0;
#pragma unroll
                for (int bj = 0; bj < 2; ++bj)
#pragma unroll
                    for (int n = 0; n < 2; ++n) { f32x4 v = acc[ai][bj][m][n]; if (resid) v += *(const f32x4*)(resid + off + bj * PG_HALF + n * 16); *(f32x4*)(C + off + bj * PG_HALF + n * 16) = v; } }
    }
};
template <int PASS> struct EpiGate {
    static constexpr bool PERM = true;
    const bf16* G; bf16* MG; int gcol0;
    __device__ __forceinline__ void operator()(const f32x4 (&acc)[2][2][4][2], const Unit& u, int wr, int wc, int fr, int fq) const {
        const int row0 = u.pm * PG_BM + wr * 64 + fr, col0 = u.pn * PG_BM + wc * 32 + 8 * fq;
#pragma unroll
        for (int ai = 0; ai < 2; ++ai)
#pragma unroll
            for (int m = 0; m < 4; ++m) { const int row = row0 + ai * PG_HALF + m * 16;
#pragma unroll
                for (int bj = 0; bj < 2; ++bj) { const int col = col0 + bj * PG_HALF;
                    const v4u gw = *(const v4u*)(G + (size_t)row * 2048 + gcol0 + col);
                    float v[8]; const f32x4 a0 = acc[ai][bj][m][0], a1 = acc[ai][bj][m][1];
                    v[0] = sigmoidf_(bf_lo(gw.x)) * a0[0]; v[1] = sigmoidf_(bf_hi(gw.x)) * a0[1]; v[2] = sigmoidf_(bf_lo(gw.y)) * a0[2]; v[3] = sigmoidf_(bf_hi(gw.y)) * a0[3];
                    v[4] = sigmoidf_(bf_lo(gw.z)) * a1[0]; v[5] = sigmoidf_(bf_hi(gw.z)) * a1[1]; v[6] = sigmoidf_(bf_lo(gw.w)) * a1[2]; v[7] = sigmoidf_(bf_hi(gw.w)) * a1[3];
                    v4u* mp = (v4u*)(MG + (size_t)row * 1024 + col);
                    if (PASS == 1) { const v4u t = *mp; v[0] += bf_lo(t.x); v[1] += bf_hi(t.x); v[2] += bf_lo(t.y); v[3] += bf_hi(t.y); v[4] += bf_lo(t.z); v[5] += bf_hi(t.z); v[6] += bf_lo(t.w); v[7] += bf_hi(t.w); }
                    v4u w; w.x = cvt_pk_bf16(v[0], v[1]); w.y = cvt_pk_bf16(v[2], v[3]); w.z = cvt_pk_bf16(v[4], v[5]); w.w = cvt_pk_bf16(v[6], v[7]);
                    *mp = w; } }
    }
};
namespace att {
constexpr int KB_BYTES = 12288, VB_BYTES = 12288, BUF_BYTES = KB_BYTES + VB_BYTES;
constexpr int OFF_IMP = 2 * BUF_BYTES;
constexpr int OFF_SC = OFF_IMP + 32768;
constexpr int OFF_SEL = OFF_SC + 8192;
constexpr int OFF_END = OFF_SEL + 512;
static_assert(OFF_END <= RING_BYTES, "attention LDS map");

__device__ __forceinline__ int crow(int r, int hi) { return (r & 3) + 8 * (r >> 2) + 4 * hi; }
__device__ __forceinline__ s16x4 vtr(const LAS unsigned char* p) { typedef short v4i16_t __attribute__((ext_vector_type(4))); return __builtin_bit_cast(s16x4, __builtin_amdgcn_ds_read_tr16_b64_v4i16((LAS v4i16_t*)p)); }
__device__ __forceinline__ unsigned cvtpk(float lo, float hi) { typedef float f2 __attribute__((ext_vector_type(2))); typedef __bf16 b2 __attribute__((ext_vector_type(2))); f2 v = {lo, hi}; b2 b = __builtin_convertvector(v, b2); return __builtin_bit_cast(unsigned, b); }
__device__ __forceinline__ float swapmax(float m) { auto rr = __builtin_amdgcn_permlane32_swap(__float_as_uint(m), __float_as_uint(m), false, false); return fmaxf(__uint_as_float(rr[0]), __uint_as_float(rr[1])); }
__device__ __forceinline__ float swapsum(float m) { auto rr = __builtin_amdgcn_permlane32_swap(__float_as_uint(m), __float_as_uint(m), false, false); return __uint_as_float(rr[0]) + __uint_as_float(rr[1]); }

struct Flash { f32x16 o[3]; float m, l; };
__device__ __forceinline__ void flash_init(Flash& f) { f.o[0] = f32x16{}; f.o[1] = f32x16{}; f.o[2] = f32x16{}; f.m = -1e30f; f.l = 0.f; }

template <int NKC>
__device__ __forceinline__ void issue_tile(LAS unsigned char* lds, int buf, const bf16* Kg, int ldk, const bf16* Kpe, const bf16* Vg, int ldv, int wave, int lane) {
    LAS unsigned char* kb = lds + buf * BUF_BYTES; LAS unsigned char* vb = kb + KB_BYTES;
    __builtin_amdgcn_global_load_lds((const unsigned*)(Kg + (size_t)lane * ldk + wave * 8), (LAS unsigned*)(kb + wave * 1024), 16, 0, 0);
    if (NKC == 12) { if (wave < 4) __builtin_amdgcn_global_load_lds((const unsigned*)(Kpe + (size_t)lane * 32 + wave * 8), (LAS unsigned*)(kb + (8 + wave) * 1024), 16, 0, 0); }
    __builtin_amdgcn_global_load_lds((const unsigned*)(Vg + (size_t)(16 * (wave & 3) + (lane >> 2)) * ldv + (wave >> 2) * 32 + (lane & 3) * 8), (LAS unsigned*)(vb + wave * 1024), 16, 0, 0);
}

template <int NKS, int NVB, bool HAS_BIAS>
__device__ __forceinline__ void tile_compute(Flash& f, const LAS unsigned char* kb, const LAS unsigned char* vb, const bf16x8* qr, float slope, float cb,
                                             int lo, int hi_, bool need_mask, int r32, int hh, int lane) {
    f32x16 p0, p1;
    if (HAS_BIAS) {
        const float cb0 = cb + slope * (float)(4 * hh), cb1 = cb0 + slope * 32.f;
#pragma unroll
        for (int r = 0; r < 16; ++r) { const float cr = (float)((r & 3) + 8 * (r >> 2)); p0[r] = __builtin_fmaf(slope, cr, cb0); p1[r] = __builtin_fmaf(slope, cr, cb1); }
    } else { p0 = f32x16{}; p1 = f32x16{}; }
    const LAS unsigned char* kp = kb + hh * 1024 + r32 * 16;
#pragma unroll
    for (int d0 = 0; d0 < NKS; ++d0) {
        const bf16x8 b0 = *(const LAS bf16x8*)(kp + d0 * 2048);
        const bf16x8 b1 = *(const LAS bf16x8*)(kp + d0 * 2048 + 512);
        p0 = __builtin_amdgcn_mfma_f32_32x32x16_bf16(b0, qr[d0], p0, 0, 0, 0);
        p1 = __builtin_amdgcn_mfma_f32_32x32x16_bf16(b1, qr[d0], p1, 0, 0, 0);
    }
    if (need_mask) {
        const int l0 = lo - 4 * hh, h0 = hi_ - 4 * hh;
#pragma unroll
        for (int r = 0; r < 16; ++r) { const int c = (r & 3) + 8 * (r >> 2);
            if (c < l0 || c > h0) p0[r] = -INFINITY;
            if (c + 32 < l0 || c + 32 > h0) p1[r] = -INFINITY; }
    }
    float mt = fmaxf(p0[0], p1[0]);
#pragma unroll
    for (int r = 1; r < 16; ++r) mt = fmaxf(mt, fmaxf(p0[r], p1[r]));
    mt = swapmax(mt);
    const float mn = fmaxf(f.m, mt);
    const float alpha = __builtin_amdgcn_exp2f(f.m - mn);
    f.m = mn;
    float sum = 0.f;
#pragma unroll
    for (int r = 0; r < 16; ++r) { p0[r] = __builtin_amdgcn_exp2f(p0[r] - mn); p1[r] = __builtin_amdgcn_exp2f(p1[r] - mn); sum += p0[r] + p1[r]; }
    f.l = f.l * alpha + sum;
#pragma unroll
    for (int b = 0; b < NVB; ++b)
#pragma unroll
        for (int r = 0; r < 16; ++r) f.o[b][r] *= alpha;
    v4u pw[4];
    pw[0] = (v4u){cvtpk(p0[0], p0[1]), cvtpk(p0[2], p0[3]), cvtpk(p0[4], p0[5]), cvtpk(p0[6], p0[7])};
    pw[1] = (v4u){cvtpk(p0[8], p0[9]), cvtpk(p0[10], p0[11]), cvtpk(p0[12], p0[13]), cvtpk(p0[14], p0[15])};
    pw[2] = (v4u){cvtpk(p1[0], p1[1]), cvtpk(p1[2], p1[3]), cvtpk(p1[4], p1[5]), cvtpk(p1[6], p1[7])};
    pw[3] = (v4u){cvtpk(p1[8], p1[9]), cvtpk(p1[10], p1[11]), cvtpk(p1[12], p1[13]), cvtpk(p1[14], p1[15])};
    const LAS unsigned char* vp = vb + ((lane >> 4) & 1) * 32 + (lane & 3) * 8 + (4 * hh + ((lane & 15) >> 2)) * 64;
#pragma unroll
    for (int b = 0; b < NVB; ++b)
#pragma unroll
        for (int ks = 0; ks < 4; ++ks) {
            const s16x4 vl = vtr(vp + b * 4096 + ks * 1024), vh = vtr(vp + b * 4096 + ks * 1024 + 512);
            const bf16x8 va = (bf16x8){vl[0], vl[1], vl[2], vl[3], vh[0], vh[1], vh[2], vh[3]};
            f.o[b] = __builtin_amdgcn_mfma_f32_32x32x16_bf16(va, __builtin_bit_cast(bf16x8, pw[ks]), f.o[b], 0, 0, 0);
        }
}
__device__ __forceinline__ void flash_finish(Flash& f, int nvb) {
    const float lt = swapsum(f.l); const float inv = lt > 0.f ? 1.0f / lt : 0.f;
#pragma unroll
    for (int b = 0; b < 3; ++b) if (b < nvb) {
#pragma unroll
        for (int r = 0; r < 16; ++r) f.o[b][r] *= inv; }
}

__device__ __forceinline__ void nsa_unit(Frame& F, int b, int g, int qc) {
    int lane = F.lane; asm volatile("" : "+v"(lane));
    LAS unsigned char* lds = F.lds; const int wave = F.wave, r32 = lane & 31, hh = lane >> 5;
    const int head = g * 4 + (wave >> 1);
    const int qloc = 32 * (wave & 1) + r32;
    const int t = 64 * qc + qloc;
    const size_t row = (size_t)b * SEQ + t;
    const bf16* QKV = (const bf16*)(F.ws + WS_QKV); const bf16* MISC = (const bf16*)(F.ws + WS_MISC);
    bf16x8 qr[4];
#pragma unroll
    for (int d0 = 0; d0 < 4; ++d0) qr[d0] = *(const bf16x8*)(QKV + row * 1280 + head * 64 + d0 * 16 + hh * 8);
    const float slope2 = exp2f(-(float)(head + 1)) * LOG2E;
    LAS unsigned* selw = (LAS unsigned*)(lds + OFF_SEL);
    if (F.tid < 80) selw[F.tid] = 0u;
    f32x16 ot0, ot1;
    {
        const bf16* KC = (const bf16*)(F.ws + WS_KC) + (size_t)(b * 2 + g) * 128 * 64; const bf16* VC = (const bf16*)(F.ws + WS_VC) + (size_t)(b * 2 + g) * 128 * 64;
        Flash f; flash_init(f);
        int nmax = (t >= 31) ? ((t - 31) >> 4) : -1; if (nmax > 126) nmax = 126;
        for (int ti = 0; ti < 2; ++ti) {
            issue_tile<8>(lds, ti, KC + (size_t)ti * 64 * 64, 64, nullptr, VC + (size_t)ti * 64 * 64, 64, wave, lane);
            LAS bf16* ov = (LAS bf16*)(lds + ti * BUF_BYTES + KB_BYTES + 2 * 4096);
#pragma unroll
            for (int e = 0; e < 4; ++e) { const int idx = F.tid * 4 + e, nl = idx >> 5, s = idx & 31, n = 64 * ti + nl;
                float v = 0.f; if (s == (n >> 2)) v = ((n & 3) == 3) ? 0.5f : 1.0f; else if (s == (n >> 2) + 1 && (n & 3) == 3) v = 0.5f;
                ov[(nl >> 4) * 512 + (nl & 15) * 32 + s] = (bf16)f2bf(v); }
        }
        __syncthreads();
#pragma unroll 1
        for (int ti = 0; ti < 2; ++ti) {
            const LAS unsigned char* kb = lds + ti * BUF_BYTES;
            tile_compute<4, 3, true>(f, kb, kb + KB_BYTES, qr, 16.f * slope2, 16.f * slope2 * (float)(64 * ti), 0, nmax - 64 * ti, true, r32, hh, lane);
        }
        flash_finish(f, 3);
        LAS float* imp = (LAS float*)(lds + OFF_IMP) + (wave * 32 + r32) * 32;
#pragma unroll
        for (int r = 0; r < 16; ++r) imp[crow(r, hh)] = f.o[2][r];
        const float gc = sigmoidf_(bf2f(MISC[row * 256 + 160 + head]));
        ot0 = f.o[0] * gc; ot1 = f.o[1] * gc;
    }
    __syncthreads();
    {
        LAS float* IMP = (LAS float*)(lds + OFF_IMP); LAS float* SC = (LAS float*)(lds + OFF_SC);
        const int q = F.tid >> 3, s4 = (F.tid & 7) * 4;
#pragma unroll
        for (int e = 0; e < 4; ++e) { const int s = s4 + e; float v = 0.f;
#pragma unroll
            for (int h4 = 0; h4 < 4; ++h4) v += IMP[((2 * h4 + (q >> 5)) * 32 + (q & 31)) * 32 + s];
            const bool causal = s <= qc, forced = causal && (s == 0 || s + 2 > qc);
            SC[q * 32 + s] = causal ? (v + (forced ? 1e4f : 0.f)) : -1e30f; }
        __syncthreads();
        float sc[32];
#pragma unroll
        for (int s = 0; s < 32; ++s) sc[s] = SC[q * 32 + s];
        unsigned bits = 0u;
#pragma unroll
        for (int e = 0; e < 4; ++e) { const int s = s4 + e; const float me = SC[q * 32 + s]; int rank = 0;
#pragma unroll
            for (int s2 = 0; s2 < 32; ++s2) rank += (sc[s2] > me || (sc[s2] == me && s2 < s)) ? 1 : 0;
            if (s <= qc && rank < 16) bits |= 1u << s; }
        atomicOr((unsigned*)&selw[q], bits); atomicOr((unsigned*)&selw[64], bits);
    }
    __syncthreads();
    const unsigned mymask = selw[qloc], anymask = selw[64];
    {
        const bf16* Kg = QKV + (size_t)b * SEQ * 1280 + 768 + g * 64; const bf16* Vg = QKV + (size_t)b * SEQ * 1280 + 896 + g * 64;
        Flash f; flash_init(f);
        unsigned rem = anymask; int buf = 0;
        { const int j0 = __builtin_ctz(rem); issue_tile<8>(lds, 0, Kg + (size_t)j0 * 64 * 1280, 1280, nullptr, Vg + (size_t)j0 * 64 * 1280, 1280, wave, lane); }
        while (rem) {
            const int j = __builtin_ctz(rem); rem &= rem - 1;
            __syncthreads();
            if (rem) { const int jn = __builtin_ctz(rem); issue_tile<8>(lds, buf ^ 1, Kg + (size_t)jn * 64 * 1280, 1280, nullptr, Vg + (size_t)jn * 64 * 1280, 1280, wave, lane); }
            const bool sel = (mymask >> j) & 1u;
            const int hi_ = sel ? ((j == qc) ? (t - 64 * j) : 63) : -1;
            const bool need = (j == qc) || !__all(sel);
            const LAS unsigned char* kb = lds + buf * BUF_BYTES;
            tile_compute<4, 2, true>(f, kb, kb + KB_BYTES, qr, slope2, slope2 * (float)(64 * j), 0, hi_, need, r32, hh, lane);
            buf ^= 1;
        }
        flash_finish(f, 2);
        const float gs = sigmoidf_(bf2f(MISC[row * 256 + 160 + 8 + head]));
        ot0 += f.o[0] * gs; ot1 += f.o[1] * gs;
        __syncthreads();
    }
    {
        const bf16* Kg = QKV + (size_t)b * SEQ * 1280 + 1024 + g * 64; const bf16* Vg = QKV + (size_t)b * SEQ * 1280 + 1152 + g * 64;
        Flash f; flash_init(f);
        const int j0 = qc >= 8 ? qc - 8 : 0; int buf = 0;
        issue_tile<8>(lds, 0, Kg + (size_t)j0 * 64 * 1280, 1280, nullptr, Vg + (size_t)j0 * 64 * 1280, 1280, wave, lane);
        for (int j = j0; j <= qc; ++j) {
            __syncthreads();
            if (j < qc) issue_tile<8>(lds, buf ^ 1, Kg + (size_t)(j + 1) * 64 * 1280, 1280, nullptr, Vg + (size_t)(j + 1) * 64 * 1280, 1280, wave, lane);
            int lo = t - 511 - 64 * j; if (lo < 0) lo = 0; int hi_ = t - 64 * j; if (hi_ > 63) hi_ = 63;
            const bool need = (j == qc) || (j + 8 == qc);
            const LAS unsigned char* kb = lds + buf * BUF_BYTES;
            tile_compute<4, 2, true>(f, kb, kb + KB_BYTES, qr, slope2, slope2 * (float)(64 * j), lo, hi_, need, r32, hh, lane);
            buf ^= 1;
        }
        flash_finish(f, 2);
        const float gw = sigmoidf_(bf2f(MISC[row * 256 + 160 + 16 + head]));
        ot0 += f.o[0] * gw; ot1 += f.o[1] * gw;
        __syncthreads();
    }
    { bf16* op = (bf16*)(F.ws + WS_OCAT) + row * 1024 + head * 64 + 4 * hh;
#pragma unroll
      for (int k = 0; k < 4; ++k) {
          *(v2u*)(op + 8 * k) = (v2u){cvtpk(ot0[4 * k], ot0[4 * k + 1]), cvtpk(ot0[4 * k + 2], ot0[4 * k + 3])};
          *(v2u*)(op + 32 + 8 * k) = (v2u){cvtpk(ot1[4 * k], ot1[4 * k + 1]), cvtpk(ot1[4 * k + 2], ot1[4 * k + 3])}; } }
}

__device__ __forceinline__ void mla_unit(Frame& F, int b, int h, int qb) {
    int lane = F.lane; asm volatile("" : "+v"(lane));
    LAS unsigned char* lds = F.lds; const int wave = F.wave, r32 = lane & 31, hh = lane >> 5;
    const int t = 256 * qb + 32 * wave + r32;
    const size_t row = (size_t)b * SEQ + t;
    const bf16* MQ = (const bf16*)(F.ws + WS_MLAQ); const bf16* MKV = (const bf16*)(F.ws + WS_MLAKV); const bf16* KPE = (const bf16*)(F.ws + WS_KPE);
    bf16x8 qr[6];
#pragma unroll
    for (int d0 = 0; d0 < 6; ++d0) qr[d0] = *(const bf16x8*)(MQ + row * 768 + h * 96 + d0 * 16 + hh * 8);
    {
        const float pos = (float)F.pos[row];
        v4u a = __builtin_bit_cast(v4u, qr[4]), c = __builtin_bit_cast(v4u, qr[5]);
        float x1[8], x2[8];
        x1[0] = bf_lo(a.x); x1[1] = bf_hi(a.x); x1[2] = bf_lo(a.y); x1[3] = bf_hi(a.y); x1[4] = bf_lo(a.z); x1[5] = bf_hi(a.z); x1[6] = bf_lo(a.w); x1[7] = bf_hi(a.w);
        x2[0] = bf_lo(c.x); x2[1] = bf_hi(c.x); x2[2] = bf_lo(c.y); x2[3] = bf_hi(c.y); x2[4] = bf_lo(c.z); x2[5] = bf_hi(c.z); x2[6] = bf_lo(c.w); x2[7] = bf_hi(c.w);
        float y1[8], y2[8];
#pragma unroll
        for (int j = 0; j < 8; ++j) { const float inv = powf(10000.0f, -(float)(2 * (8 * hh + j)) / 32.0f); const float ang = pos * inv; const float cs = cosf(ang), sn = sinf(ang);
            y1[j] = x1[j] * cs - x2[j] * sn; y2[j] = x1[j] * sn + x2[j] * cs; }
        a = (v4u){cvtpk(y1[0], y1[1]), cvtpk(y1[2], y1[3]), cvtpk(y1[4], y1[5]), cvtpk(y1[6], y1[7])};
        c = (v4u){cvtpk(y2[0], y2[1]), cvtpk(y2[2], y2[3]), cvtpk(y2[4], y2[5]), cvtpk(y2[6], y2[7])};
        qr[4] = __builtin_bit_cast(bf16x8, a); qr[5] = __builtin_bit_cast(bf16x8, c);
    }
    const bf16* Kg = MKV + (size_t)b * SEQ * 1024 + h * 128; const bf16* Vg = Kg + 64; const bf16* Pg = KPE + (size_t)b * SEQ * 32;
    Flash f; flash_init(f);
    const int NT = 4 * qb + 4; int buf = 0;
    const int tmax_w = 256 * qb + 32 * wave + 31;
    issue_tile<12>(lds, 0, Kg, 1024, Pg, Vg, 1024, wave, lane);
    for (int j = 0; j < NT; ++j) {
        __syncthreads();
        if (j + 1 < NT) issue_tile<12>(lds, buf ^ 1, Kg + (size_t)(j + 1) * 64 * 1024, 1024, Pg + (size_t)(j + 1) * 64 * 32, Vg + (size_t)(j + 1) * 64 * 1024, 1024, wave, lane);
        if (64 * j <= tmax_w) {
            int hi_ = t - 64 * j; if (hi_ > 63) hi_ = 63;
            const bool need = (64 * j + 63 > 256 * qb + 32 * wave);
            const LAS unsigned char* kb = lds + buf * BUF_BYTES;
            tile_compute<6, 2, false>(f, kb, kb + KB_BYTES, qr, 0.f, 0.f, 0, hi_, need, r32, hh, lane);
        }
        buf ^= 1;
    }
    flash_finish(f, 2);
    __syncthreads();
    { bf16* op = (bf16*)(F.ws + WS_OCAT) + row * 1024 + 512 + h * 64 + 4 * hh;
#pragma unroll
      for (int k = 0; k < 4; ++k) {
          *(v2u*)(op + 8 * k) = (v2u){cvtpk(f.o[0][4 * k], f.o[0][4 * k + 1]), cvtpk(f.o[0][4 * k + 2], f.o[0][4 * k + 3])};
          *(v2u*)(op + 32 + 8 * k) = (v2u){cvtpk(f.o[1][4 * k], f.o[1][4 * k + 1]), cvtpk(f.o[1][4 * k + 2], f.o[1][4 * k + 3])}; } }
}

__device__ __forceinline__ void nsa_loop(Frame& F) {
#pragma unroll 1
    for (int c = F.bid; c < 256; c += F.G) { const int bg = c >> 4, p = c & 15;
#pragma unroll 1
        for (int i = 0; i < 2; ++i) nsa_unit(F, bg >> 1, bg & 1, i ? p : 31 - p); }
}
__device__ __forceinline__ void mla_loop(Frame& F) {
#pragma unroll 1
    for (int c = F.bid; c < 256; c += F.G) { const int bh = c >> 2, p = c & 3;
#pragma unroll 1
        for (int i = 0; i < 2; ++i) mla_unit(F, bh >> 3, bh & 7, i ? p : 7 - p); }
}
}
__device__ __forceinline__ void kpe_pass(Frame& F) {
    const bf16* MISC = (const bf16*)(F.ws + WS_MISC); bf16* KPE = (bf16*)(F.ws + WS_KPE);
    const int gt = F.bid * NTHREADS + F.tid, NGT = F.G * NTHREADS;
    for (int it = gt; it < MTOK * 16; it += NGT) { const int t = it >> 4, i = it & 15;
        const float x1 = bf2f(MISC[(size_t)t * 256 + 128 + i]), x2 = bf2f(MISC[(size_t)t * 256 + 144 + i]);
        const float inv = powf(10000.0f, -(float)(2 * i) / 32.0f); const float ang = (float)F.pos[t] * inv; const float cs = cosf(ang), sn = sinf(ang);
        KPE[(size_t)t * 32 + i] = (bf16)f2bf(x1 * cs - x2 * sn); KPE[(size_t)t * 32 + 16 + i] = (bf16)f2bf(x1 * sn + x2 * cs); }
}
__device__ __forceinline__ void cmp_finalize(Frame& F) {
    const int gw = F.bid * NWAVES + F.wave, NGW = F.G * NWAVES, lane = F.lane;
    LAS float* hid = (LAS float*)(F.lds + F.wave * 1024);
    for (int it = gw; it < 2 * 16 * 128; it += NGW) {
        const int kv = it >> 11, bg = (it >> 7) & 15, n = it & 127;
        bf16* dst = (bf16*)(F.ws + (kv ? WS_VC : WS_KC)) + ((size_t)bg * 128 + n) * 64;
        if (n == 127) { dst[lane] = 0; continue; }
        const float* U = (const float*)(F.ws + (kv ? WS_UV : WS_UK)) + (size_t)(bg * 128 + n) * 256; const float* c1 = (const float*)(F.ws + (kv ? WS_C1V : WS_C1K));
        const float* w2 = F.in[kv ? I_CW2V : I_CW2K];
        hid[lane] = gelu_tanh(U[lane] + U[256 + 128 + lane] + c1[lane]);
        hid[64 + lane] = gelu_tanh(U[64 + lane] + U[256 + 192 + lane] + c1[64 + lane]);
        asm volatile("s_waitcnt lgkmcnt(0)" ::: "memory");
        float s = 0.f;
#pragma unroll 8
        for (int i = 0; i < 128; ++i) s += hid[i] * w2[i * 64 + lane];
        dst[lane] = (bf16)f2bf(s);
        asm volatile("s_waitcnt lgkmcnt(0)" ::: "memory");
    }
}
__device__ __forceinline__ void quant_table(Frame& F, const float* src, unsigned char* dst, float* steps) {
    const int gw = F.bid * NWAVES + F.wave, NGW = F.G * NWAVES, lane = F.lane;
    for (int e = gw; e < 16384; e += NGW) {
        const f32x4* sp = (const f32x4*)(src + (size_t)e * 1024) + 4 * lane;
        f32x4 v[4]; float mx = 0.f;
#pragma unroll
        for (int j = 0; j < 4; ++j) { v[j] = sp[j]; mx = fmaxf(mx, fmaxf(fmaxf(fabsf(v[j].x), fabsf(v[j].y)), fmaxf(fabsf(v[j].z), fabsf(v[j].w)))); }
#pragma unroll
        for (int o = 1; o < 64; o <<= 1) mx = fmaxf(mx, __shfl_xor(mx, o));
        const float step = mx > 0.f ? mx * (1.0f / 127.0f) : 1.0f, inv = 1.0f / step;
        v4u w;
#pragma unroll
        for (int j = 0; j < 4; ++j) { const unsigned b0 = (unsigned)(int)(rintf(v[j].x * inv) + 128.f), b1 = (unsigned)(int)(rintf(v[j].y * inv) + 128.f), b2 = (unsigned)(int)(rintf(v[j].z * inv) + 128.f), b3 = (unsigned)(int)(rintf(v[j].w * inv) + 128.f);
            w[j] = b0 | (b1 << 8) | (b2 << 16) | (b3 << 24); }
        ((v4u*)(dst + (size_t)e * 1024))[lane] = w;
        if (lane == 0) steps[e] = step;
    }
}
__device__ __forceinline__ void xn2_pass(Frame& F) {
    const int gw = F.bid * NWAVES + F.wave, NGW = F.G * NWAVES; bf16* XN2 = (bf16*)(F.ws + WS_XN2);
    for (int m = gw; m < MTOK; m += NGW) rms_row_to_bf16(F.out + (size_t)m * DM, F.in[I_N2G], XN2 + (size_t)m * DM, F.lane);
}

namespace peer {
constexpr int TOK = 32;
constexpr int OFF_LIST = 0;
constexpr int OFF_ROUTE = 65536;
struct Ent { float v; unsigned k; };
__device__ __forceinline__ unsigned ordkey(float f) { const unsigned u = __float_as_uint(f); return u ^ ((u >> 31) ? 0xffffffffu : 0x80000000u); }
__device__ __forceinline__ float ordinv(unsigned k) { return __uint_as_float(k ^ ((k >> 31) ? 0x80000000u : 0xffffffffu)); }
__device__ __forceinline__ void swap2(int x, int& lo, int& hi) { auto rr = __builtin_amdgcn_permlane32_swap((unsigned)x, (unsigned)x, false, false); lo = (int)rr[0]; hi = (int)rr[1]; }

#define PEER_CANDS(X) X(0,0) X(0,1) X(0,2) X(0,3) X(0,4) X(0,5) X(0,6) X(0,7) X(0,8) X(0,9) X(0,10) X(0,11) X(0,12) X(0,13) X(0,14) X(0,15) \
    X(1,0) X(1,1) X(1,2) X(1,3) X(1,4) X(1,5) X(1,6) X(1,7) X(2,0) X(2,1) X(2,2) X(2,3) X(2,4) X(3,0) X(3,1) X(3,2) X(3,3) X(4,0) X(4,1) X(4,2) \
    X(5,0) X(5,1) X(6,0) X(6,1) X(7,0) X(7,1) X(8,0) X(9,0) X(10,0) X(11,0) X(12,0) X(13,0) X(14,0) X(15,0)

__device__ __forceinline__ void route_task(Frame& F, int tok0) {
    int lane = F.lane; asm volatile("" : "+v"(lane));
    const int wave = F.wave, r32 = lane & 31, hh = lane >> 5;
    const bf16* QP = (const bf16*)(F.ws + WS_QP);
    const size_t row = (size_t)tok0 + r32;
    LAS Ent* LIST = (LAS Ent*)(F.lds + OFF_LIST) + (size_t)wave * 2 * TOK * 16;
#pragma unroll 1
    for (int half = 0; half < 2; ++half) {
        const bf16* SK = (const bf16*)(F.ws + (half ? WS_SK2 : WS_SK1));
        bf16x8 qf[8];
#pragma unroll
        for (int d0 = 0; d0 < 8; ++d0) qf[d0] = *(const bf16x8*)(QP + row * 2048 + wave * 256 + half * 128 + d0 * 16 + hh * 8);
        unsigned u[4][16];
#pragma unroll
        for (int kb = 0; kb < 4; ++kb) { f32x16 p = f32x16{};
#pragma unroll
            for (int d0 = 0; d0 < 8; ++d0) { const bf16x8 a = *(const bf16x8*)(SK + (size_t)(32 * kb + r32) * 128 + d0 * 16 + hh * 8);
                p = __builtin_amdgcn_mfma_f32_32x32x16_bf16(a, qf[d0], p, 0, 0, 0); }
#pragma unroll
            for (int r = 0; r < 16; ++r) u[kb][r] = ordkey(p[r]);
            asm volatile("" ::: "memory"); __builtin_amdgcn_sched_barrier(0); }
        unsigned prefix = 0u;
#pragma unroll 1
        for (int bit = 31; bit >= 0; --bit) { const unsigned trial = prefix | (1u << bit); int cnt = 0;
#pragma unroll
            for (int kb = 0; kb < 4; ++kb)
#pragma unroll
                for (int r = 0; r < 16; ++r) cnt += (u[kb][r] >= trial) ? 1 : 0;
            int c0, c1; swap2(cnt, c0, c1);
            if (c0 + c1 >= 16) prefix = trial; }
        int cgt = 0, ceq = 0;
#pragma unroll
        for (int kb = 0; kb < 4; ++kb)
#pragma unroll
            for (int r = 0; r < 16; ++r) { cgt += (u[kb][r] > prefix) ? 1 : 0; ceq += (u[kb][r] == prefix) ? 1 : 0; }
        int g0, g1, e0, e1; swap2(cgt, g0, g1); swap2(ceq, e0, e1);
        const int need = 16 - (g0 + g1);
        const int take0 = e0 < need ? e0 : need; const int take1 = (need - take0) < e1 ? (need - take0) : e1;
        int slot = hh ? (g0 + take0) : 0; int eq_left = hh ? take1 : take0;
        LAS Ent* L = LIST + ((size_t)half * TOK + r32) * 16;
#pragma unroll
        for (int kb = 0; kb < 4; ++kb)
#pragma unroll
            for (int r = 0; r < 16; ++r) { const unsigned uu = u[kb][r]; const int eq = ((uu == prefix) & (eq_left > 0)) ? 1 : 0; const int tk = (uu > prefix) ? 1 : eq;
                if (tk & (slot < 16)) { L[slot].v = ordinv(uu); L[slot].k = (unsigned)(32 * kb + (r & 3) + 8 * (r >> 2) + 4 * hh); }
                slot += tk; eq_left -= eq; }
    }
    asm volatile("s_waitcnt lgkmcnt(0)" ::: "memory");
    {
        LAS Ent* L = LIST + ((size_t)hh * TOK + r32) * 16;
        float v[16]; unsigned k[16];
#pragma unroll
        for (int a = 0; a < 16; ++a) { v[a] = L[a].v; k[a] = L[a].k; }
        asm volatile("s_waitcnt lgkmcnt(0)" ::: "memory");
#pragma unroll
        for (int a = 0; a < 16; ++a) { int rank = 0;
#pragma unroll
            for (int a2 = 0; a2 < 16; ++a2) rank += (v[a2] > v[a] || (v[a2] == v[a] && a2 < a)) ? 1 : 0;
            L[rank].v = v[a]; L[rank].k = k[a]; }
    }
    asm volatile("s_waitcnt lgkmcnt(0)" ::: "memory");
    {
        const LAS Ent* L1 = LIST + ((size_t)0 * TOK + r32) * 16; const LAS Ent* L2 = LIST + ((size_t)1 * TOK + r32) * 16;
        float v1[16], v2[16];
#pragma unroll
        for (int a = 0; a < 16; ++a) { v1[a] = L1[a].v; v2[a] = L2[a].v; }
        unsigned uc[50]; { int ci = 0;
#define X(a, b) uc[ci++] = ordkey(v1[a] + v2[b]);
        PEER_CANDS(X)
#undef X
        }
        const float cmax = v1[0] + v2[0];
        unsigned prefix = 0u;
#pragma unroll 1
        for (int bit = 31; bit >= 0; --bit) { const unsigned trial = prefix | (1u << bit); int cnt = 0;
#pragma unroll
            for (int i = 0; i < 50; ++i) cnt += (uc[i] >= trial) ? 1 : 0;
            if (cnt >= 16) prefix = trial; }
        int cgt = 0; float gsum = 0.f;
#pragma unroll
        for (int i = 0; i < 50; ++i) cgt += (uc[i] > prefix) ? 1 : 0;
        int eq_left = 16 - cgt;
        unsigned long long selm = 0ull;
#pragma unroll
        for (int i = 0; i < 50; ++i) { const int eq = ((uc[i] == prefix) & (eq_left > 0)) ? 1 : 0; const int sl = (uc[i] > prefix) ? 1 : eq; eq_left -= eq;
            selm |= (unsigned long long)sl << i; gsum += sl ? __expf(ordinv(uc[i]) - cmax) : 0.f; }
        const float ginv = 1.0f / gsum;
        LAS Ent* R = (LAS Ent*)(F.lds + OFF_ROUTE) + ((size_t)wave * TOK + r32) * 16;
        if (hh == 0) { int i = 0, slot = 0;
#define X(a, b) { const int sl = (int)((selm >> i) & 1ull); if (sl & (slot < 16)) { R[slot].k = L1[a].k * 128u + L2[b].k; R[slot].v = __expf(ordinv(uc[i]) - cmax) * ginv; } slot += sl; ++i; }
            PEER_CANDS(X)
#undef X
        }
    }
}

__device__ __forceinline__ float ub0(unsigned w) { return (float)(w & 0xffu); }
__device__ __forceinline__ float ub1(unsigned w) { return (float)((w >> 8) & 0xffu); }
__device__ __forceinline__ float ub2(unsigned w) { return (float)((w >> 16) & 0xffu); }
__device__ __forceinline__ float ub3(unsigned w) { return (float)(w >> 24); }
__device__ __forceinline__ void gather_token(Frame& F, int tl, size_t row, bool wr) {
    int lane = F.lane; asm volatile("" : "+v"(lane));
    const unsigned char* EXPD = F.ws + WS_EXPD; const unsigned char* EXPU = F.ws + WS_EXPU;
    const float* SD = (const float*)(F.ws + WS_EXPD_SC); const float* SU = (const float*)(F.ws + WS_EXPU_SC);
    float hv[16], xh[16], y[16]; float sx;
    { const f32x4* hp = (const f32x4*)(F.out + row * DM) + 4 * lane; const f32x4* gp = (const f32x4*)F.in[I_N2G] + 4 * lane;
      float ss = 0.f;
#pragma unroll
      for (int c = 0; c < 4; ++c) { const f32x4 v = hp[c]; hv[4 * c] = v.x; hv[4 * c + 1] = v.y; hv[4 * c + 2] = v.z; hv[4 * c + 3] = v.w; ss += (v.x * v.x + v.y * v.y) + (v.z * v.z + v.w * v.w); }
      const float r = 1.0f / sqrtf(wave_sum(ss) * (1.f / DM) + EPS);
      float s1 = 0.f;
#pragma unroll
      for (int c = 0; c < 4; ++c) { const f32x4 g = gp[c]; xh[4 * c] = hv[4 * c] * r * g.x; xh[4 * c + 1] = hv[4 * c + 1] * r * g.y; xh[4 * c + 2] = hv[4 * c + 2] * r * g.z; xh[4 * c + 3] = hv[4 * c + 3] * r * g.w;
          s1 += (xh[4 * c] + xh[4 * c + 1]) + (xh[4 * c + 2] + xh[4 * c + 3]); }
      sx = 128.f * wave_sum(s1);
    }
#pragma unroll
    for (int i = 0; i < 16; ++i) y[i] = 0.f;
    float ysub = 0.f;
    const LAS Ent* R = (const LAS Ent*)(F.lds + OFF_ROUTE);
#pragma unroll 1
    for (int grp = 0; grp < 32; ++grp) {
        const int head = grp >> 2, k0 = (grp & 3) * 4;
        unsigned ex[4]; float gt[4]; v4u dn[4], up[4]; float sd[4], su[4];
#pragma unroll
        for (int k = 0; k < 4; ++k) { const LAS Ent* en = R + ((size_t)head * TOK + tl) * 16 + k0 + k; ex[k] = (unsigned)__builtin_amdgcn_readfirstlane((int)en->k); gt[k] = __uint_as_float((unsigned)__builtin_amdgcn_readfirstlane((int)__float_as_uint(en->v))); }
#pragma unroll
        for (int k = 0; k < 4; ++k) { dn[k] = ((const v4u*)(EXPD + (size_t)ex[k] * 1024))[lane]; up[k] = ((const v4u*)(EXPU + (size_t)ex[k] * 1024))[lane]; sd[k] = SD[ex[k]]; su[k] = SU[ex[k]]; }
        float dt[4];
#pragma unroll
        for (int k = 0; k < 4; ++k) { float s = 0.f;
#pragma unroll
            for (int c = 0; c < 4; ++c) { const unsigned w = dn[k][c]; s += ub0(w) * xh[4 * c] + ub1(w) * xh[4 * c + 1] + ub2(w) * xh[4 * c + 2] + ub3(w) * xh[4 * c + 3]; }
            dt[k] = s; }
        { const bool up32 = lane & 32; float keep0 = up32 ? dt[1] : dt[0], send0 = up32 ? dt[0] : dt[1]; keep0 += __shfl_xor(send0, 32);
          float keep1 = up32 ? dt[3] : dt[2], send1 = up32 ? dt[2] : dt[3]; keep1 += __shfl_xor(send1, 32);
          const bool up16 = lane & 16; float keep = up16 ? keep1 : keep0, send = up16 ? keep0 : keep1; keep += __shfl_xor(send, 16);
          keep += __shfl_xor(keep, 8); keep += __shfl_xor(keep, 4); keep += __shfl_xor(keep, 2); keep += __shfl_xor(keep, 1);
          dt[0] = __shfl(keep, 0); dt[2] = __shfl(keep, 16); dt[1] = __shfl(keep, 32); dt[3] = __shfl(keep, 48); }
#pragma unroll
        for (int k = 0; k < 4; ++k) { const float hk = sd[k] * (dt[k] - sx); const float wk = gt[k] * gelu_tanh(hk) * su[k]; ysub += wk;
#pragma unroll
            for (int c = 0; c < 4; ++c) { const unsigned w = up[k][c]; y[4 * c] += wk * ub0(w); y[4 * c + 1] += wk * ub1(w); y[4 * c + 2] += wk * ub2(w); y[4 * c + 3] += wk * ub3(w); } }
    }
    { float ss = 0.f; const float ys = 128.f * ysub;
#pragma unroll
      for (int i = 0; i < 16; ++i) { hv[i] += y[i] - ys; ss += hv[i] * hv[i]; }
      const float r = 1.0f / sqrtf(wave_sum(ss) * (1.f / DM) + EPS);
      f32x4* op = (f32x4*)(F.out + row * DM) + 4 * lane; const f32x4* gp = (const f32x4*)F.in[I_NFG] + 4 * lane;
#pragma unroll
      for (int c = 0; c < 4; ++c) { const f32x4 g = gp[c];
          if (wr) op[c] = (f32x4){hv[4 * c] * r * g.x, hv[4 * c + 1] * r * g.y, hv[4 * c + 2] * r * g.z, hv[4 * c + 3] * r * g.w}; } }
}

__device__ __forceinline__ void peer_phase(Frame& F, bool never) {
    for (int task = F.bid; task < MTOK / TOK; task += F.G) {
        const int tok0 = task * TOK;
#pragma unroll 1
        for (int rep_ = 0; rep_ < (((DBL_MASK >> 12) & 1) ? 2 : 1); ++rep_) { route_task(F, tok0); __syncthreads(); }
#pragma unroll 1
        for (int rep_ = (((DBL_MASK >> 13) & 1) ? 0 : 1); rep_ < 2; ++rep_)
            for (int i = 0; i < TOK / NWAVES; ++i) { const int tl = F.wave * (TOK / NWAVES) + i; gather_token(F, tl, (size_t)tok0 + tl, rep_ == 1 || never); }
        __syncthreads();
    }
}
}
#define XB_TMO      128
#define XB_XCNT(j)  (256  + 64 * (j))
#define XB_XSUB(j)  (1280 + 64 * (j))
#define XB_XGEN(j)  (2304 + 64 * (j))
#define XB_TOP      3328
#define XB_TOPGEN   3392
#define XCD_BAR_WORDS 3456
#define XB_SPIN_CAP (1u << 18)

__device__ __forceinline__ unsigned xb_ld(unsigned* p)              { return __hip_atomic_load(p, __ATOMIC_RELAXED, __HIP_MEMORY_SCOPE_AGENT); }
__device__ __forceinline__ unsigned xb_add(unsigned* p, unsigned v) { return __hip_atomic_fetch_add(p, v, __ATOMIC_RELAXED, __HIP_MEMORY_SCOPE_AGENT); }
__device__ __forceinline__ unsigned xb_xcc_id() { return (unsigned)__builtin_amdgcn_s_getreg((3 << 11) | 20) & 0xFu; }
#define XB_SPIN(cond, bar) do { unsigned _sp = 0; while (cond) { __builtin_amdgcn_s_sleep(1); \
    if ((++_sp & 255u) == 0u) { if (xb_ld(&(bar)[XB_TMO])) break; if (_sp > XB_SPIN_CAP) { atomicAdd(&(bar)[XB_TMO], 1u); break; } } } } while (0)

struct XcdBarrier {
    unsigned* bar; unsigned x;
    volatile LAS unsigned* st;
};

__device__ __forceinline__ XcdBarrier xcd_barrier_post(unsigned* bar, volatile LAS unsigned* st) {
    XcdBarrier b; b.bar = bar; b.x = xb_xcc_id(); b.st = st;
    if (threadIdx.x == 0) (void)xb_add(&bar[XB_XCNT(b.x)], 1u);
    return b;
}
__device__ __forceinline__ void xcd_barrier_complete(unsigned* bar, unsigned x, unsigned& nloc, unsigned& nx) {
    const unsigned G = gridDim.x * gridDim.y * gridDim.z;
    unsigned sum, cnt, mine, sp = 0u;
    for (;;) {
        sum = 0u; cnt = 0u; mine = 0u;
#pragma unroll
        for (unsigned j = 0; j < 16; ++j) { const unsigned c = xb_ld(&bar[XB_XCNT(j)]); sum += c; cnt += (c > 0u) ? 1u : 0u; mine = (j == x) ? c : mine; }
        if (sum == G) break;
        __builtin_amdgcn_s_sleep(1);
        if ((++sp & 255u) == 0u) { if (xb_ld(&bar[XB_TMO])) break; if (sp > XB_SPIN_CAP) { atomicAdd(&bar[XB_TMO], 1u); break; } }
    }
    nloc = mine > 0u ? mine : 1u; nx = cnt > 0u ? cnt : 1u;
}

__device__ __forceinline__ void xcd_barrier(const XcdBarrier& b) {
    asm volatile("s_waitcnt vmcnt(0)" ::: "memory");
    __syncthreads();
    if (threadIdx.x == 0) {
        unsigned* bar = b.bar;
        __builtin_amdgcn_s_waitcnt(0);
        unsigned nloc = b.st[0], nx = b.st[1];
        if (nloc == 0u) { xcd_barrier_complete(bar, b.x, nloc, nx); b.st[0] = nloc; b.st[1] = nx; }
        const unsigned old = xb_add(&bar[XB_XSUB(b.x)], 1u);
        const unsigned gen = old / nloc;
        if (old + 1u == (gen + 1u) * nloc) {
            __builtin_amdgcn_fence(__ATOMIC_RELEASE, "agent");
            asm volatile("s_waitcnt vmcnt(0)" ::: "memory");
            const unsigned og = xb_add(&bar[XB_TOP], 1u);
            const unsigned tg = og / nx;
            if (og + 1u == (tg + 1u) * nx) xb_add(&bar[XB_TOPGEN], 1u);
            else XB_SPIN(xb_ld(&bar[XB_TOPGEN]) == tg, bar);
            __builtin_amdgcn_fence(__ATOMIC_ACQUIRE, "agent");
            xb_add(&bar[XB_XGEN(b.x)], 1u);
            asm volatile("s_waitcnt vmcnt(0)" ::: "memory");
        } else {
            XB_SPIN(xb_ld(&bar[XB_XGEN(b.x)]) == gen, bar);
            __builtin_amdgcn_fence(__ATOMIC_ACQUIRE, "agent");
            asm volatile("s_waitcnt vmcnt(0)" ::: "memory");
        }
    }
    __syncthreads();
}

#ifndef MK_ONE_LAUNCH
#define MK_ONE_LAUNCH 1
#endif
#ifndef DBL_MASK
#define DBL_MASK 0
#endif
constexpr int N_PHASES = 10;
struct Args { const void* in[N_IN]; float* out; unsigned char* ws; int ph_lo, ph_hi; };
#define PHASE_FN __device__ __forceinline__ void
#define PHASE_FRAME \
    Frame F; F.lds = (LAS unsigned char*)(uintptr_t)(unsigned)__builtin_amdgcn_readfirstlane((int)ldsaddr); F.tid = threadIdx.x; F.lane = F.tid & 63; F.wave = __builtin_amdgcn_readfirstlane(F.tid >> 6); \
    F.G = gridDim.x; F.bid = blockIdx.x; F.in = (const float* const*)ap->in; F.pos = (const int*)ap->in[I_POS]; F.out = ap->out; F.ws = ap->ws; unsigned char* ws = F.ws; (void)ws;
#define REP(k) for (int rep_ = 0; rep_ < (((DBL_MASK >> (k)) & 1) ? 2 : 1); ++rep_)

PHASE_FN ph_prologue(const Args* ap, unsigned ldsaddr) { PHASE_FRAME REP(0) p0_prologue(F); }
PHASE_FN ph_inproj(const Args* ap, unsigned ldsaddr) { PHASE_FRAME REP(1) {
    pg8::StaticOrder S;
    pg8::Gemm g = pg8::make_gemm((const bf16*)(ws + WS_XN), 1024, (const bf16*)(ws + WS_WIN), 1024, MTOK, NPROJ, 1024);
    S.init(MTOK, NPROJ, F.G, F.bid);
    EpiInProj E{(bf16*)(ws + WS_QKV), (bf16*)(ws + WS_CQ), (bf16*)(ws + WS_MISC), (bf16*)(ws + WS_GATES)};
    pg8::gemm_phase<EpiInProj, pg8::StaticOrder, true>(F.lds, g, S, E); } }
PHASE_FN ph_upq(const Args* ap, unsigned ldsaddr) { PHASE_FRAME REP(2) {
    pg8::StaticOrder S;
    pg8::Gemm g = pg8::make_gemm((const bf16*)(ws + WS_CQ), 256, (const bf16*)(ws + WS_WUQ), 256, MTOK, 768, 256);
    S.init(MTOK, 768, F.G, F.bid);
    EpiRowScale<256> E{(const bf16*)(ws + WS_CQ), (bf16*)(ws + WS_MLAQ), 768, QSCALE_MLA};
    pg8::gemm_phase<EpiRowScale<256>, pg8::StaticOrder, true>(F.lds, g, S, E); } }
PHASE_FN ph_upkv(const Args* ap, unsigned ldsaddr) { PHASE_FRAME REP(2) {
    pg8::StaticOrder S;
    pg8::Gemm g = pg8::make_gemm((const bf16*)(ws + WS_MISC), 256, (const bf16*)(ws + WS_WUKV), 256, MTOK, 1024, 256);
    S.init(MTOK, 1024, F.G, F.bid);
    EpiRowScale<128> E{(const bf16*)(ws + WS_MISC), (bf16*)(ws + WS_MLAKV), 1024, 1.0f};
    pg8::gemm_phase<EpiRowScale<128>, pg8::StaticOrder, true>(F.lds, g, S, E); } }
PHASE_FN ph_cmpu(const Args* ap, unsigned ldsaddr) { PHASE_FRAME REP(2) {
    pg8::StaticOrder S;
#pragma unroll 1
    for (int kv = 0; kv < 2; ++kv) {
        pg8::Gemm g; g.A = (const bf16*)(ws + WS_QKV) + 512 + 128 * kv; g.Bt = (const bf16*)(ws + (kv ? WS_WC1V : WS_WC1K)); g.M = 2048; g.N = 256; g.K = 1024;
        g.aRow = (size_t)16 * 1280 * 2; g.aHalf = 128; g.aTile = (size_t)SEQ * 1280 * 2; g.aK = (size_t)1280 * 2; g.bRow = 1024 * 2;
        S.init(2048, 256, F.G, F.bid);
        EpiF32 E{(float*)(ws + (kv ? WS_UV : WS_UK)), 256, nullptr};
        pg8::gemm_phase<EpiF32, pg8::StaticOrder, true>(F.lds, g, S, E);
    }
    kpe_pass(F); } }
PHASE_FN ph_cmpfin(const Args* ap, unsigned ldsaddr) { PHASE_FRAME REP(3) cmp_finalize(F); }
PHASE_FN ph_nsa(const Args* ap, unsigned ldsaddr) { PHASE_FRAME REP(10) att::nsa_loop(F); }
PHASE_FN ph_mla(const Args* ap, unsigned ldsaddr) { PHASE_FRAME REP(11) att::mla_loop(F); }
PHASE_FN ph_branch0(const Args* ap, unsigned ldsaddr) { PHASE_FRAME REP(5) {
    pg8::StaticOrder S; S.init(MTOK, 1024, F.G, F.bid);
    pg8::Gemm g = pg8::make_gemm((const bf16*)(ws + WS_OCAT), 1024, (const bf16*)(ws + WS_WBR), 1024, MTOK, 1024, 512);
    EpiGate<0> E{(const bf16*)(ws + WS_GATES), (bf16*)(ws + WS_MERGED), 0};
    pg8::gemm_phase<EpiGate<0>, pg8::StaticOrder, true>(F.lds, g, S, E); } }
PHASE_FN ph_branch1(const Args* ap, unsigned ldsaddr) { PHASE_FRAME REP(5) {
    pg8::StaticOrder S; S.init(MTOK, 1024, F.G, F.bid);
    pg8::Gemm g = pg8::make_gemm((const bf16*)(ws + WS_OCAT) + 512, 1024, (const bf16*)(ws + WS_WBR) + 512, 1024, MTOK, 1024, 512);
    EpiGate<1> E{(const bf16*)(ws + WS_GATES), (bf16*)(ws + WS_MERGED), 1024};
    pg8::gemm_phase<EpiGate<1>, pg8::StaticOrder, true>(F.lds, g, S, E);
    quant_table(F, F.in[I_EDN], ws + WS_EXPD, (float*)(ws + WS_EXPD_SC)); } }
PHASE_FN ph_outproj(const Args* ap, unsigned ldsaddr) { PHASE_FRAME REP(6) {
    pg8::StaticOrder S; S.init(MTOK, 1024, F.G, F.bid);
    pg8::Gemm g = pg8::make_gemm((const bf16*)(ws + WS_MERGED), 1024, (const bf16*)(ws + WS_WOUT), 1024, MTOK, 1024, 1024);
    EpiF32 E{F.out, 1024, F.in[I_X]};
    pg8::gemm_phase<EpiF32, pg8::StaticOrder, true>(F.lds, g, S, E);
    quant_table(F, F.in[I_EUP], ws + WS_EXPU, (float*)(ws + WS_EXPU_SC)); } }
PHASE_FN ph_xn2(const Args* ap, unsigned ldsaddr) { PHASE_FRAME REP(7) xn2_pass(F); }
PHASE_FN ph_peerq(const Args* ap, unsigned ldsaddr) { PHASE_FRAME REP(8) {
    pg8::StaticOrder S; S.init(MTOK, 2048, F.G, F.bid);
    pg8::Gemm g = pg8::make_gemm((const bf16*)(ws + WS_XN2), 1024, (const bf16*)(ws + WS_WPQ), 1024, MTOK, 2048, 1024);
    EpiBf16 E{(bf16*)(ws + WS_QP), 2048};
    pg8::gemm_phase<EpiBf16, pg8::StaticOrder, true>(F.lds, g, S, E); } }
PHASE_FN ph_peer(const Args* ap, unsigned ldsaddr) { PHASE_FRAME peer::peer_phase(F, ap->ph_lo < 0); }

__global__ void __launch_bounds__(NTHREADS, 2) fwd(Args a) {
    extern __shared__ __attribute__((aligned(16))) unsigned char lds_raw[];
    cg::grid_group grid = cg::this_grid();
    const unsigned ldsaddr = (unsigned)(uintptr_t)(LAS unsigned char*)lds_raw;
    const int lo = a.ph_lo, hi = a.ph_hi;
#define IN(k) (lo <= (k) && (k) < hi)
    { LAS unsigned* misc = (LAS unsigned*)((LAS unsigned char*)lds_raw + RING_BYTES); if (threadIdx.x < 64) misc[threadIdx.x] = 0u; }
    __syncthreads();
    XcdBarrier bar = xcd_barrier_post((unsigned*)(a.ws + WS_CTL) + 4096, (volatile LAS unsigned*)((LAS unsigned char*)lds_raw + RING_BYTES) + 8);
#define SEAM(k) do { if (IN(k) && IN((k) + 1)) { if (MK_ONE_LAUNCH) xcd_barrier(bar); } } while (0)
    if (IN(0)) ph_prologue(&a, ldsaddr);
    if (IN(0) && IN(1)) grid.sync();
    if (IN(1)) ph_inproj(&a, ldsaddr);
    SEAM(1);
    if (IN(2)) { ph_upq(&a, ldsaddr); ph_upkv(&a, ldsaddr); ph_cmpu(&a, ldsaddr); }
    SEAM(2);
    if (IN(3)) ph_cmpfin(&a, ldsaddr);
    SEAM(3);
    if (IN(4)) { ph_nsa(&a, ldsaddr); ph_mla(&a, ldsaddr); }
    SEAM(4);
    if (IN(5)) { ph_branch0(&a, ldsaddr); ph_branch1(&a, ldsaddr); }
    SEAM(5);
    if (IN(6)) ph_outproj(&a, ldsaddr);
    SEAM(6);
    if (IN(7)) ph_xn2(&a, ldsaddr);
    SEAM(7);
    if (IN(8)) ph_peerq(&a, ldsaddr);
    SEAM(8);
    if (IN(9)) ph_peer(&a, ldsaddr);
#undef IN
#undef SEAM
}

extern "C" void kernel_launch(void* const* d_in, const int* in_sizes, int n_in, void* d_out, int out_size, void* d_ws, size_t ws_size, hipStream_t stream) {
    static int grid = 0;
    if (grid == 0) {
        if (n_in != N_IN || out_size != MTOK * DM || ws_size < WS_END) { fprintf(stderr, "kernel_launch: unexpected shapes (n_in %d, out %d, ws %zu)\n", n_in, out_size, ws_size); grid = -1; return; }
        int dev = 0, cus = 0, per_cu = 0;
        if (hipGetDevice(&dev) != hipSuccess || hipDeviceGetAttribute(&cus, hipDeviceAttributeMultiprocessorCount, dev) != hipSuccess) { grid = -1; return; }
        if (hipFuncSetAttribute((const void*)fwd, hipFuncAttributeMaxDynamicSharedMemorySize, LDS_BYTES) != hipSuccess) { fprintf(stderr, "kernel_launch: hipFuncSetAttribute failed\n"); grid = -1; return; }
        if (hipOccupancyMaxActiveBlocksPerMultiprocessor(&per_cu, (const void*)fwd, NTHREADS, LDS_BYTES) != hipSuccess || per_cu < 1) { fprintf(stderr, "kernel_launch: occupancy query says %d\n", per_cu); (void)hipGetLastError(); grid = -1; return; }
        grid = cus;
    }
    if (grid < 0) return;
    Args a{};
    for (int i = 0; i < N_IN; ++i) a.in[i] = d_in[i];
    a.out = (float*)d_out; a.ws = (unsigned char*)d_ws;
#if MK_ONE_LAUNCH
    if (hipMemsetAsync((char*)d_ws + WS_CTL, 0, 65536, stream) != hipSuccess) { fprintf(stderr, "kernel_launch: hipMemsetAsync failed\n"); return; }
    a.ph_lo = 0; a.ph_hi = N_PHASES;
    void* args[] = {&a};
    hipError_t e = hipLaunchCooperativeKernel((const void*)fwd, dim3(grid), dim3(NTHREADS), args, LDS_BYTES, stream);
    if (e != hipSuccess) fprintf(stderr, "kernel_launch: cooperative launch failed: %s (grid %d)\n", hipGetErrorString(e), grid);
#else
    for (int p = 0; p < N_PHASES; ++p) { a.ph_lo = p; a.ph_hi = p + 1; hipLaunchKernelGGL(fwd, dim3(grid), dim3(NTHREADS), LDS_BYTES, stream, a); }
#endif
}
```

```cpp
#define DBL_MASK 0
#include <hip/hip_runtime.h>
#include <hip/hip_cooperative_groups.h>
#include <cstdio>
#include <cstdint>
#include <cmath>
namespace cg = cooperative_groups;
namespace pg8 {
#define PG8_LAS __attribute__((address_space(3)))
typedef unsigned short bf16_t;
typedef short bf16x8 __attribute__((ext_vector_type(8)));
typedef float f32x4 __attribute__((ext_vector_type(4)));
typedef unsigned u32x4 __attribute__((ext_vector_type(4)));
constexpr int BM = 256, BK = 64, HALF = 128, HTB = HALF * BK * 2  , STAGE_BYTES = 8 * HTB, NXCD = 8, WGM = 8;

__host__ __device__ __forceinline__ int lds_byte(int r, int c) { const int st = (r >> 4) * 2 + (c >> 5), rr = r & 15, cc = c & 31, ob = rr * 64 + cc * 2; return st * 1024 + (ob ^ (((ob >> 9) & 1) << 5)); }
__host__ __device__ __forceinline__ void stage_rc(int b, int& R, int& C) { const int st = b / 1024, sb = b % 1024, swz = sb ^ (((sb >> 9) & 1) << 5); R = (st >> 1) * 16 + swz / 64; C = (st & 1) * 32 + (swz % 64) / 2; }
__host__ __device__ __forceinline__ int perm32(int rho) { const int n = rho >> 4, i = rho & 15; return 8 * (i >> 2) + 4 * n + (i & 3); }

struct Unit { int pm, pn; };
struct Gemm { const bf16_t* A; const bf16_t* Bt; int M, N, K; size_t aRow, aHalf, aTile, aK, bRow; };
__host__ __device__ __forceinline__ Gemm make_gemm(const bf16_t* A, int lda, const bf16_t* Bt, int ldb, int M, int N, int K) {
    Gemm g; g.A = A; g.Bt = Bt; g.M = M; g.N = N; g.K = K; g.aRow = (size_t)lda * 2; g.aHalf = (size_t)HALF * lda * 2; g.aTile = (size_t)BM * lda * 2; g.aK = BK * 2; g.bRow = (size_t)ldb * 2; return g; }

struct StaticOrder {
    int nM, nN, nwg, G, c;
    __host__ __device__ void init(int M, int N, int G_, int c_) { nM = M / BM; nN = N / BM; nwg = nM * nN; G = G_; c = c_; }
    __host__ __device__ bool next(int i, Unit& u) const {
        const long L = (long)i * G + c; if (L >= nwg) return false;
        int wgid = (int)L; { const int q = nwg / NXCD, r = nwg % NXCD, xcd = wgid % NXCD, off = wgid / NXCD; wgid = (xcd < r ? xcd * (q + 1) : r * (q + 1) + (xcd - r) * q) + off; }
        const int nig = WGM * nN, gid = wgid / nig, fm = gid * WGM, gsz = (nM - fm) < WGM ? (nM - fm) : WGM;
        u.pm = fm + ((wgid % nig) % gsz); u.pn = (wgid % nig) / gsz; return true;
    }
};

__device__ __forceinline__ unsigned cvt_pk_bf16(float lo, float hi) { unsigned r; asm volatile("v_cvt_pk_bf16_f32 %0, %1, %2" : "=v"(r) : "v"(lo), "v"(hi)); return r; }

template <class Epi, class Sched, bool ALIGN_EPI>
__device__ __forceinline__ void gemm_phase(PG8_LAS unsigned char* lds, const Gemm g, const Sched& S, const Epi& E) {
    const int tid = threadIdx.x, wid = __builtin_amdgcn_readfirstlane(tid >> 6), lane = tid & 63, wr = wid >> 2, wc = wid & 3, fr = lane & 15, fq = lane >> 4;
    const int K = g.K, nt = K / BK;
    unsigned voffA[2], voffB[2];
#pragma unroll
    for (int i = 0; i < 2; ++i) { int R, C; stage_rc(tid * 16 + i * 8192, R, C); const int Rb = Epi::PERM ? ((R & ~31) + perm32(R & 31)) : R;
        voffA[i] = (unsigned)((size_t)R * g.aRow + (size_t)C * 2); voffB[i] = (unsigned)((size_t)Rb * g.bRow + (size_t)C * 2); }
    const size_t kstepA = g.aK, kstepB = (size_t)(BK * 2);
    const size_t hstepA = g.aHalf, hstepB = (size_t)HALF * g.bRow;
    const size_t tstepA = g.aTile, tstepB = (size_t)BM * g.bRow;
    const unsigned ldsw = (unsigned)wid * 1024u;
    const int aoff = lds_byte(wr * 64 + fr, fq * 8), boff = lds_byte(wc * 32 + fr, fq * 8);
#define PG8_SA(b, h) (((b) * 2 + (h)) * HTB)
#define PG8_SB(b, h) ((4 + (b) * 2 + (h)) * HTB)
#define PG8_STAGE(bufoff, gbase, voff) do { _Pragma("unroll") for (int _i = 0; _i < 2; ++_i) \
        __builtin_amdgcn_global_load_lds((const unsigned*)((const char*)(gbase) + (voff)[_i]), (PG8_LAS unsigned*)(lds + (bufoff) + ldsw + _i * 8192), 16, 0, 0); } while (0)
#define PG8_LDA(dst, b, h) do { _Pragma("unroll") for (int m = 0; m < 4; ++m) _Pragma("unroll") for (int k = 0; k < 2; ++k) dst[m][k] = *(const PG8_LAS bf16x8*)(lds + PG8_SA(b, h) + aoff + m * 2048 + k * 1024); } while (0)
#define PG8_LDB(dst, b, h) do { _Pragma("unroll") for (int n = 0; n < 2; ++n) _Pragma("unroll") for (int k = 0; k < 2; ++k) dst[n][k] = *(const PG8_LAS bf16x8*)(lds + PG8_SB(b, h) + boff + n * 2048 + k * 1024); } while (0)
#define PG8_MMA(ai, bj, At, Bt) do { __builtin_amdgcn_s_setprio(1); _Pragma("unroll") for (int m = 0; m < 4; ++m) _Pragma("unroll") for (int n = 0; n < 2; ++n) _Pragma("unroll") for (int k = 0; k < 2; ++k) \
        acc[ai][bj][m][n] = __builtin_amdgcn_mfma_f32_16x16x32_bf16(Bt[n][k], At[m][k], acc[ai][bj][m][n], 0, 0, 0); __builtin_amdgcn_s_setprio(0); } while (0)
#define PG8_WAIT_V(n) asm volatile("s_waitcnt vmcnt(" #n ")" ::: "memory")
#define PG8_WAIT_L(n) asm volatile("s_waitcnt lgkmcnt(" #n ")" ::: "memory")
#define PG8_BAR __builtin_amdgcn_s_barrier()
#define PG8_SCHED __builtin_amdgcn_sched_barrier(0)
    Unit cur, nxt; int ui = 0;
    if (!S.next(0, cur)) return;
    f32x4 acc[2][2][4][2];
#pragma unroll
    for (int a = 0; a < 2; ++a)
#pragma unroll
        for (int b = 0; b < 2; ++b)
#pragma unroll
            for (int m = 0; m < 4; ++m)
#pragma unroll
                for (int n = 0; n < 2; ++n) acc[a][b][m][n] = (f32x4){0.f, 0.f, 0.f, 0.f};
    bf16x8 At[4][2], B0[2][2], B1[2][2];
    const char* cA = (const char*)g.A + (size_t)cur.pm * tstepA; const char* cB = (const char*)g.Bt + (size_t)cur.pn * tstepB;
    PG8_STAGE(PG8_SB(0, 0), cB, voffB); PG8_STAGE(PG8_SB(0, 1), cB + hstepB, voffB); PG8_STAGE(PG8_SA(0, 0), cA, voffA); PG8_STAGE(PG8_SA(0, 1), cA + hstepA, voffA);
    if (wr == 1) PG8_BAR;
    PG8_WAIT_V(2); PG8_BAR;
    PG8_STAGE(PG8_SB(1, 0), cB + kstepB, voffB); PG8_STAGE(PG8_SA(1, 0), cA + kstepA, voffA); PG8_STAGE(PG8_SB(1, 1), cB + hstepB + kstepB, voffB);
    PG8_WAIT_V(6); PG8_BAR;
    for (;;) {
        const bool has_next = S.next(ui + 1, nxt);
        const char* nA = has_next ? (const char*)g.A + (size_t)nxt.pm * tstepA : cA; const char* nB = has_next ? (const char*)g.Bt + (size_t)nxt.pn * tstepB : cB;
        for (int t = 0; t < nt; t += 2) {
            const bool last = (t == nt - 2);
            const char* a1 = cA + (size_t)(t + 1) * kstepA;
            const char* a2 = last ? nA : cA + (size_t)(t + 2) * kstepA; const char* b2 = last ? nB : cB + (size_t)(t + 2) * kstepB;
            const char* a3 = a2 + kstepA; const char* b3 = b2 + kstepB;
            PG8_LDB(B0, 0, 0); PG8_LDB(B1, 0, 1); PG8_SCHED; PG8_LDA(At, 0, 0); PG8_STAGE(PG8_SA(1, 1), a1 + hstepA, voffA);
            PG8_WAIT_V(8); PG8_WAIT_L(0); PG8_BAR; PG8_MMA(0, 0, At, B0); PG8_MMA(0, 1, At, B1); PG8_BAR; PG8_SCHED;
            PG8_LDA(At, 0, 1); PG8_STAGE(PG8_SB(0, 0), b2, voffB); PG8_STAGE(PG8_SB(0, 1), b2 + hstepB, voffB); PG8_STAGE(PG8_SA(0, 0), a2, voffA);
            PG8_WAIT_V(8); PG8_WAIT_L(0); PG8_BAR; PG8_MMA(1, 0, At, B0); PG8_MMA(1, 1, At, B1); PG8_BAR; PG8_SCHED;
            PG8_LDB(B0, 1, 0); PG8_LDB(B1, 1, 1); PG8_SCHED; PG8_LDA(At, 1, 0); PG8_STAGE(PG8_SA(0, 1), a2 + hstepA, voffA);
            PG8_WAIT_V(8); PG8_WAIT_L(0); PG8_BAR; PG8_MMA(0, 0, At, B0); PG8_MMA(0, 1, At, B1); PG8_BAR; PG8_SCHED;
            PG8_LDA(At, 1, 1); PG8_STAGE(PG8_SB(1, 0), b3, voffB); PG8_STAGE(PG8_SB(1, 1), b3 + hstepB, voffB); PG8_STAGE(PG8_SA(1, 0), a3, voffA);
            PG8_WAIT_V(8); PG8_WAIT_L(0); PG8_BAR; PG8_MMA(1, 0, At, B0); PG8_MMA(1, 1, At, B1); PG8_BAR; PG8_SCHED;
        }
        if constexpr (ALIGN_EPI) { if (wr == 0) PG8_BAR; }
        E(acc, cur, wr, wc, fr, fq);
        if (!has_next) break;
#pragma unroll
        for (int a = 0; a < 2; ++a)
#pragma unroll
            for (int b = 0; b < 2; ++b)
#pragma unroll
                for (int m = 0; m < 4; ++m)
#pragma unroll
                    for (int n = 0; n < 2; ++n) acc[a][b][m][n] = (f32x4){0.f, 0.f, 0.f, 0.f};
        cur = nxt; cA = nA; cB = nB; ++ui;
        if constexpr (ALIGN_EPI) { if (wr == 1) PG8_BAR; }
    }
    PG8_WAIT_V(0);
    if constexpr (!ALIGN_EPI) { if (wr == 0) PG8_BAR; }
    PG8_BAR;
#undef PG8_SA
#undef PG8_SB
#undef PG8_STAGE
#undef PG8_LDA
#undef PG8_LDB
#undef PG8_MMA
#undef PG8_WAIT_V
#undef PG8_WAIT_L
#undef PG8_BAR
#undef PG8_SCHED
}
}
constexpr int NWAVES = 8, NTHREADS = 512;
constexpr int BATCH = 8, SEQ = 2048, DM = 1024, MTOK = BATCH * SEQ;
constexpr int NPROJ = 3840;
constexpr float EPS = 1e-6f, LOG2E = 1.4426950408889634f;
constexpr float QSCALE_NSA = 0.125f * LOG2E;
constexpr float QSCALE_MLA = 0.10206207261596575f * LOG2E;
constexpr size_t MiB = 1u << 20;
enum { I_X = 0, I_POS, I_N1G, I_WIN, I_CPK, I_CW1K, I_CW2K, I_CPV, I_CW1V, I_CW2V, I_QNG, I_KVNG, I_WUQ, I_WUKV, I_WBN, I_WBM, I_WOUT, I_N2G, I_WPQ, I_SK1, I_SK2, I_EDN, I_EUP, I_NFG, N_IN };
constexpr size_t WS_CTL = 0;
constexpr size_t WS_WIN = 1 * MiB;
constexpr size_t WS_WUQ = WS_WIN + (size_t)NPROJ * 1024 * 2;
constexpr size_t WS_WUKV = WS_WUQ + 768 * 256 * 2;
constexpr size_t WS_WBR = 10 * MiB;
constexpr size_t WS_WOUT = 12 * MiB;
constexpr size_t WS_WPQ = 14 * MiB;
constexpr size_t WS_WC1K = 18 * MiB;
constexpr size_t WS_WC1V = WS_WC1K + 256 * 1024 * 2;
constexpr size_t WS_SMALL = 19 * MiB;
constexpr size_t WS_C1K = WS_SMALL;
constexpr size_t WS_C1V = WS_SMALL + 512;
constexpr size_t WS_ORDER = WS_SMALL + 1024;
constexpr size_t WS_SK1 = WS_SMALL + 4096;
constexpr size_t WS_SK2 = WS_SK1 + 32768;
constexpr size_t WS_XN = 20 * MiB;
constexpr size_t WS_MLAQ = WS_XN, WS_EXPD = WS_XN;
constexpr size_t WS_EXPD_SC = WS_EXPD + (size_t)16384 * 1024;
constexpr size_t WS_QKV = 52 * MiB;
constexpr size_t WS_MERGED = WS_QKV;
constexpr size_t WS_CQ = 92 * MiB;
constexpr size_t WS_MISC = 100 * MiB;
constexpr size_t WS_ROUTE = 92 * MiB;
constexpr size_t WS_GATES = 108 * MiB;
constexpr size_t WS_QP = WS_GATES;
constexpr size_t WS_MLAKV = 172 * MiB;
constexpr size_t WS_XN2 = WS_MLAKV;
constexpr size_t WS_KPE = 204 * MiB;
constexpr size_t WS_KC = 205 * MiB;
constexpr size_t WS_VC = WS_KC + 16 * 128 * 64 * 2;
constexpr size_t WS_UK = 206 * MiB;
constexpr size_t WS_UV = 208 * MiB;
constexpr size_t WS_OCAT = 210 * MiB;
constexpr size_t WS_EXPU = WS_OCAT;
constexpr size_t WS_EXPU_SC = WS_EXPU + (size_t)16384 * 1024;
constexpr size_t WS_END = 242 * MiB;
constexpr int RING_BYTES = 131072;
constexpr int LDS_BYTES = 147456;

#define GAS __attribute__((address_space(1)))
#define LAS __attribute__((address_space(3)))
typedef unsigned short bf16;
typedef unsigned v4u __attribute__((ext_vector_type(4)));
typedef unsigned v2u __attribute__((ext_vector_type(2)));
typedef float f32x4 __attribute__((ext_vector_type(4)));
typedef float f32x16 __attribute__((ext_vector_type(16)));
typedef short bf16x8 __attribute__((ext_vector_type(8)));
typedef short s16x4 __attribute__((ext_vector_type(4)));

__device__ __forceinline__ unsigned f2bf(float f) { unsigned u = __builtin_bit_cast(unsigned, f); return (u + 0x7fffu + ((u >> 16) & 1u)) >> 16; }
__device__ __forceinline__ unsigned pk2(float lo, float hi) { return f2bf(lo) | (f2bf(hi) << 16); }
__device__ __forceinline__ float bf_lo(unsigned u) { return __builtin_bit_cast(float, u << 16); }
__device__ __forceinline__ float bf_hi(unsigned u) { return __builtin_bit_cast(float, u & 0xffff0000u); }
__device__ __forceinline__ float bf2f(bf16 h) { return __builtin_bit_cast(float, (unsigned)h << 16); }
__device__ __forceinline__ float sigmoidf_(float v) { return 1.0f / (1.0f + __expf(-v)); }
__device__ __forceinline__ float gelu_tanh(float v) { const float u = 0.7978845608028654f * (v + 0.044715f * v * v * v); const float e = __expf(2.0f * u); const float th = 1.0f - 2.0f / (e + 1.0f); return 0.5f * v * (1.0f + th); }
__device__ __forceinline__ float wave_sum(float v) {
#pragma unroll
    for (int o = 1; o < 64; o <<= 1) v += __shfl_xor(v, o);
    return v;
}

struct Frame {
    LAS unsigned char* lds;
    int tid, lane, wave, G, bid;
    const float* const* in; const int* pos; float* out; unsigned char* ws;
};

__device__ __forceinline__ int win_srccol(int n) {
    if (n < 1280) return n;
    if (n < 1536) return 1304 + (n - 1280);
    if (n < 1664) return 1560 + (n - 1536);
    if (n < 1696) return 1688 + (n - 1664);
    if (n < 1720) return 1280 + (n - 1696);
    if (n < 1792) return -1;
    return 1720 + (n - 1792);
}
template <bool WIN_PERM>
__device__ __forceinline__ void tr_item(const float* src, int ld_src, int ksrc0, const float* kscale, bf16* dst, int ld_dst, int drow0, int dcol0, int N, LAS float* scr, int item, int lane) {
    const int nblk = N / 32, kb = item / nblk, nb = item % nblk, k0 = 64 * kb, n0 = 32 * nb;
    const int nn = n0 + (lane & 31); const int sc = WIN_PERM ? win_srccol(nn) : nn;
#pragma unroll 8
    for (int i = 0; i < 32; ++i) { const int kk = 2 * i + (lane >> 5); float v = 0.f; if (sc >= 0) v = src[(size_t)(ksrc0 + k0 + kk) * ld_src + sc]; if (kscale) v *= kscale[k0 + kk]; scr[kk * 33 + (lane & 31)] = v; }
    asm volatile("s_waitcnt lgkmcnt(0)" ::: "memory");
    const int c = lane & 7;
#pragma unroll
    for (int j = 0; j < 4; ++j) { const int n = (lane >> 3) + 8 * j; const LAS float* s = scr + (8 * c) * 33 + n;
        v4u o; o.x = pk2(s[0 * 33], s[1 * 33]); o.y = pk2(s[2 * 33], s[3 * 33]); o.z = pk2(s[4 * 33], s[5 * 33]); o.w = pk2(s[6 * 33], s[7 * 33]);
        *(v4u*)(dst + (size_t)(drow0 + n0 + n) * ld_dst + dcol0 + k0 + 8 * c) = o; }
    asm volatile("s_waitcnt lgkmcnt(0)" ::: "memory");
}
__device__ __forceinline__ void rms_row_to_bf16(const float* xrow, const float* gain, bf16* orow, int lane) {
    const f32x4* xr = (const f32x4*)xrow + lane; const f32x4* gr = (const f32x4*)gain + lane;
    f32x4 v[4]; float s = 0.f;
#pragma unroll
    for (int j = 0; j < 4; ++j) { v[j] = xr[64 * j]; s += (v[j].x * v[j].x + v[j].y * v[j].y) + (v[j].z * v[j].z + v[j].w * v[j].w); }
    const float r = 1.0f / sqrtf(wave_sum(s) * (1.f / DM) + EPS);
    unsigned long long* o8 = (unsigned long long*)orow + lane;
#pragma unroll
    for (int j = 0; j < 4; ++j) { const f32x4 g = gr[64 * j]; o8[64 * j] = (unsigned long long)pk2(v[j].x * r * g.x, v[j].y * r * g.y) | ((unsigned long long)pk2(v[j].z * r * g.z, v[j].w * r * g.w) << 32); }
}
__device__ __forceinline__ void p0_prologue(Frame& F) {
    LAS float* scr = (LAS float*)(F.lds + F.wave * 16384);
    const int gw = F.bid * NWAVES + F.wave, NGW = F.G * NWAVES, lane = F.lane;
    bf16* const Win_t = (bf16*)(F.ws + WS_WIN); bf16* const Wuq_t = (bf16*)(F.ws + WS_WUQ); bf16* const Wukv_t = (bf16*)(F.ws + WS_WUKV);
    bf16* const Wbr_t = (bf16*)(F.ws + WS_WBR); bf16* const Wout_t = (bf16*)(F.ws + WS_WOUT); bf16* const Wpq_t = (bf16*)(F.ws + WS_WPQ);
    bf16* const Wc1k_t = (bf16*)(F.ws + WS_WC1K); bf16* const Wc1v_t = (bf16*)(F.ws + WS_WC1V);
    constexpr int I_IN = 16 * (NPROJ / 32), I_UQ = 4 * 24, I_UKV = 2 * 32, I_BR = 8 * 32, I_OUT = 16 * 32, I_PQ = 16 * 64, I_C1 = 16 * 4;
    constexpr int NITEMS = I_IN + I_UQ + I_UKV + 2 * I_BR + I_OUT + I_PQ + 4 * I_C1;
    for (int it = gw; it < NITEMS; it += NGW) {
        int r = it;
        if (r < I_IN) { tr_item<true>(F.in[I_WIN], 3768, 0, nullptr, Win_t, 1024, 0, 0, NPROJ, scr, r, lane); continue; } r -= I_IN;
        if (r < I_UQ) { tr_item<false>(F.in[I_WUQ], 768, 0, F.in[I_QNG], Wuq_t, 256, 0, 0, 768, scr, r, lane); continue; } r -= I_UQ;
        if (r < I_UKV) { tr_item<false>(F.in[I_WUKV], 1024, 0, F.in[I_KVNG], Wukv_t, 256, 0, 0, 1024, scr, r, lane); continue; } r -= I_UKV;
        if (r < I_BR) { tr_item<false>(F.in[I_WBN], 1024, 0, nullptr, Wbr_t, 1024, 0, 0, 1024, scr, r, lane); continue; } r -= I_BR;
        if (r < I_BR) { tr_item<false>(F.in[I_WBM], 1024, 0, nullptr, Wbr_t, 1024, 0, 512, 1024, scr, r, lane); continue; } r -= I_BR;
        if (r < I_OUT) { tr_item<false>(F.in[I_WOUT], 1024, 0, nullptr, Wout_t, 1024, 0, 0, 1024, scr, r, lane); continue; } r -= I_OUT;
        if (r < I_PQ) { tr_item<false>(F.in[I_WPQ], 2048, 0, nullptr, Wpq_t, 1024, 0, 0, 2048, scr, r, lane); continue; } r -= I_PQ;
        if (r < I_C1) { tr_item<false>(F.in[I_CW1K], 128, 0, nullptr, Wc1k_t, 1024, 0, 0, 128, scr, r, lane); continue; } r -= I_C1;
        if (r < I_C1) { tr_item<false>(F.in[I_CW1K], 128, 1024, nullptr, Wc1k_t, 1024, 128, 0, 128, scr, r, lane); continue; } r -= I_C1;
        if (r < I_C1) { tr_item<false>(F.in[I_CW1V], 128, 0, nullptr, Wc1v_t, 1024, 0, 0, 128, scr, r, lane); continue; } r -= I_C1;
        tr_item<false>(F.in[I_CW1V], 128, 1024, nullptr, Wc1v_t, 1024, 128, 0, 128, scr, r, lane);
    }
    { bf16* XN = (bf16*)(F.ws + WS_XN); for (int m = gw; m < MTOK; m += NGW) rms_row_to_bf16(F.in[I_X] + (size_t)m * DM, F.in[I_N1G], XN + (size_t)m * DM, lane); }
    const int gt = F.bid * NTHREADS + F.tid, NGT = F.G * NTHREADS;
    for (int i = gt; i < 1024 * 128; i += NGT) { const int n = i >> 7, k = 128 + (i & 127); Wukv_t[n * 256 + k] = 0; }
    { bf16* S1 = (bf16*)(F.ws + WS_SK1); bf16* S2 = (bf16*)(F.ws + WS_SK2);
      for (int i = gt; i < 128 * 128; i += NGT) { S1[i] = (bf16)f2bf(F.in[I_SK1][i]); S2[i] = (bf16)f2bf(F.in[I_SK2][i]); } }
    for (int o = gw; o < 256; o += NGW) {
        const int kv = o >> 7, j = o & 127; const float* pe = F.in[kv ? I_CPV : I_CPK]; const float* w1 = F.in[kv ? I_CW1V : I_CW1K];
        float s = 0.f;
        for (int k = lane; k < 2048; k += 64) s += pe[k] * w1[(size_t)k * 128 + j];
        s = wave_sum(s);
        if (lane == 0) ((float*)(F.ws + (kv ? WS_C1V : WS_C1K)))[j] = s;
    }
}

using pg8::Unit; using pg8::cvt_pk_bf16;
constexpr int PG_HALF = 128, PG_BM = 256;
struct EpiInProj {
    static constexpr bool PERM = true;
    bf16 *QKV, *CQ, *MISC, *GATES;
    __device__ __forceinline__ void operator()(const f32x4 (&acc)[2][2][4][2], const Unit& u, int wr, int wc, int fr, int fq) const {
        bf16* base; int ldc, colt; float sc = 1.f;
        if (u.pn < 5) { base = QKV; ldc = 1280; colt = u.pn * 256; if (u.pn < 2) sc = QSCALE_NSA; }
        else if (u.pn == 5) { base = CQ; ldc = 256; colt = 0; }
        else if (u.pn == 6) { base = MISC; ldc = 256; colt = 0; }
        else { base = GATES; ldc = 2048; colt = (u.pn - 7) * 256; }
        const int row0 = u.pm * PG_BM + wr * 64 + fr, col0 = colt + wc * 32 + 8 * fq;
#pragma unroll
        for (int ai = 0; ai < 2; ++ai)
#pragma unroll
            for (int m = 0; m < 4; ++m) { bf16* rowp = base + (size_t)(row0 + ai * PG_HALF + m * 16) * ldc + col0;
#pragma unroll
                for (int bj = 0; bj < 2; ++bj) { const f32x4 v0 = acc[ai][bj][m][0] * sc, v1 = acc[ai][bj][m][1] * sc;
                    v4u w; w.x = cvt_pk_bf16(v0[0], v0[1]); w.y = cvt_pk_bf16(v0[2], v0[3]); w.z = cvt_pk_bf16(v1[0], v1[1]); w.w = cvt_pk_bf16(v1[2], v1[3]);
                    *(v4u*)(rowp + bj * PG_HALF) = w; } }
    }
};
struct EpiBf16 {
    static constexpr bool PERM = true;
    bf16* O; int ldc;
    __device__ __forceinline__ void operator()(const f32x4 (&acc)[2][2][4][2], const Unit& u, int wr, int wc, int fr, int fq) const {
        const int row0 = u.pm * PG_BM + wr * 64 + fr, col0 = u.pn * PG_BM + wc * 32 + 8 * fq;
#pragma unroll
        for (int ai = 0; ai < 2; ++ai)
#pragma unroll
            for (int m = 0; m < 4; ++m) { bf16* rowp = O + (size_t)(row0 + ai * PG_HALF + m * 16) * ldc + col0;
#pragma unroll
                for (int bj = 0; bj < 2; ++bj) { const f32x4 v0 = acc[ai][bj][m][0], v1 = acc[ai][bj][m][1];
                    v4u w; w.x = cvt_pk_bf16(v0[0], v0[1]); w.y = cvt_pk_bf16(v0[2], v0[3]); w.z = cvt_pk_bf16(v1[0], v1[1]); w.w = cvt_pk_bf16(v1[2], v1[3]);
                    *(v4u*)(rowp + bj * PG_HALF) = w; } }
    }
};
template <int NSRC> struct EpiRowScale {
    static constexpr bool PERM = true;
    const bf16* SRC; bf16* O; int ldc; float cscale;
    __device__ __forceinline__ void operator()(const f32x4 (&acc)[2][2][4][2], const Unit& u, int wr, int wc, int fr, int fq) const {
        const int row0 = u.pm * PG_BM + wr * 64 + fr, col0 = u.pn * PG_BM + wc * 32 + 8 * fq;
#pragma unroll
        for (int ai = 0; ai < 2; ++ai)
#pragma unroll
            for (int m = 0; m < 4; ++m) { const int row = row0 + ai * PG_HALF + m * 16;
                const v4u* sp = (const v4u*)(SRC + (size_t)row * 256 + fq * (NSRC / 4)); float ss = 0.f;
#pragma unroll
                for (int i = 0; i < NSRC / 32; ++i) { const v4u w = sp[i];
                    ss += bf_lo(w.x) * bf_lo(w.x) + bf_hi(w.x) * bf_hi(w.x) + bf_lo(w.y) * bf_lo(w.y) + bf_hi(w.y) * bf_hi(w.y) + bf_lo(w.z) * bf_lo(w.z) + bf_hi(w.z) * bf_hi(w.z) + bf_lo(w.w) * bf_lo(w.w) + bf_hi(w.w) * bf_hi(w.w); }
                ss += __shfl_xor(ss, 16); ss += __shfl_xor(ss, 32);
                const float sc = cscale / sqrtf(ss * (1.0f / NSRC) + EPS);
                bf16* rowp = O + (size_t)row * ldc + col0;
#pragma unroll
                for (int bj = 0; bj < 2; ++bj) { const f32x4 v0 = acc[ai][bj][m][0] * sc, v1 = acc[ai][bj][m][1] * sc;
                    v4u w; w.x = cvt_pk_bf16(v0[0], v0[1]); w.y = cvt_pk_bf16(v0[2], v0[3]); w.z = cvt_pk_bf16(v1[0], v1[1]); w.w = cvt_pk_bf16(v1[2], v1[3]);
                    *(v4u*)(rowp + bj * PG_HALF) = w; } }
    }
};
struct EpiF32 {
    static constexpr bool PERM = false;
    float* C; int ldc; const float* resid;
    __device__ __forceinline__ void operator()(const f32x4 (&acc)[2][2][4][2], const Unit& u, int wr, int wc, int fr, int fq) const {
        const int row0 = u.pm * PG_BM + wr * 64 + fr, col0 = u.pn * PG_BM + wc * 32 + 4 * fq;
#pragma unroll
        for (int ai = 0; ai < 2; ++ai)
#pragma unroll
            for (int m = 0; m < 4; ++m) { const size_t off = (size_t)(row0 + ai * PG_HALF + m * 16) * ldc + col0;
#pragma unroll
                for (int bj = 0; bj < 2; ++bj)
#pragma unroll
                    for (int n = 0; n < 2; ++n) { f32x4 v = acc[ai][bj][m][n]; if (resid) v += *(const f32x4*)(resid + off + bj * PG_HALF + n * 16); *(f32x4*)(C + off + bj * PG_HALF + n * 16) = v; } }
    }
};
template <int PASS> struct EpiGate {
    static constexpr bool PERM = true;
    const bf16* G; bf16* MG; int gcol0;
    __device__ __forceinline__ void operator()(const f32x4 (&acc)[2][2][4][2], const Unit& u, int wr, int wc, int fr, int fq) const {
        const int row0 = u.pm * PG_BM + wr * 64 + fr, col0 = u.pn * PG_BM + wc * 32 + 8 * fq;
#pragma unroll
        for (int ai = 0; ai < 2; ++ai)
#pragma unroll
            for (int m = 0; m < 4; ++m) { const int row = row0 + ai * PG_HALF + m * 16;
#pragma unroll
                for (int bj = 0; bj < 2; ++bj) { const int col = col0 + bj * PG_HALF;
                    const v4u gw = *(const v4u*)(G + (size_t)row * 2048 + gcol0 + col);
                    float v[8]; const f32x4 a0 = acc[ai][bj][m][0], a1 = acc[ai][bj][m][1];
                    v[0] = sigmoidf_(bf_lo(gw.x)) * a0[0]; v[1] = sigmoidf_(bf_hi(gw.x)) * a0[1]; v[2] = sigmoidf_(bf_lo(gw.y)) * a0[2]; v[3] = sigmoidf_(bf_hi(gw.y)) * a0[3];
                    v[4] = sigmoidf_(bf_lo(gw.z)) * a1[0]; v[5] = sigmoidf_(bf_hi(gw.z)) * a1[1]; v[6] = sigmoidf_(bf_lo(gw.w)) * a1[2]; v[7] = sigmoidf_(bf_hi(gw.w)) * a1[3];
                    v4u* mp = (v4u*)(MG + (size_t)row * 1024 + col);
                    if (PASS == 1) { const v4u t = *mp; v[0] += bf_lo(t.x); v[1] += bf_hi(t.x); v[2] += bf_lo(t.y); v[3] += bf_hi(t.y); v[4] += bf_lo(t.z); v[5] += bf_hi(t.z); v[6] += bf_lo(t.w); v[7] += bf_hi(t.w); }
                    v4u w; w.x = cvt_pk_bf16(v[0], v[1]); w.y = cvt_pk_bf16(v[2], v[3]); w.z = cvt_pk_bf16(v[4], v[5]); w.w = cvt_pk_bf16(v[6], v[7]);
                    *mp = w; } }
    }
};
namespace att {
constexpr int KB_BYTES = 12288, VB_BYTES = 12288, BUF_BYTES = KB_BYTES + VB_BYTES;
constexpr int OFF_IMP = 2 * BUF_BYTES;
constexpr int OFF_SC = OFF_IMP + 32768;
constexpr int OFF_SEL = OFF_SC + 8192;
constexpr int OFF_END = OFF_SEL + 512;
static_assert(OFF_END <= RING_BYTES, "attention LDS map");

__device__ __forceinline__ int crow(int r, int hi) { return (r & 3) + 8 * (r >> 2) + 4 * hi; }
__device__ __forceinline__ s16x4 vtr(const LAS unsigned char* p) { typedef short v4i16_t __attribute__((ext_vector_type(4))); return __builtin_bit_cast(s16x4, __builtin_amdgcn_ds_read_tr16_b64_v4i16((LAS v4i16_t*)p)); }
__device__ __forceinline__ unsigned cvtpk(float lo, float hi) { typedef float f2 __attribute__((ext_vector_type(2))); typedef __bf16 b2 __attribute__((ext_vector_type(2))); f2 v = {lo, hi}; b2 b = __builtin_convertvector(v, b2); return __builtin_bit_cast(unsigned, b); }
__device__ __forceinline__ float swapmax(float m) { auto rr = __builtin_amdgcn_permlane32_swap(__float_as_uint(m), __float_as_uint(m), false, false); return fmaxf(__uint_as_float(rr[0]), __uint_as_float(rr[1])); }
__device__ __forceinline__ float swapsum(float m) { auto rr = __builtin_amdgcn_permlane32_swap(__float_as_uint(m), __float_as_uint(m), false, false); return __uint_as_float(rr[0]) + __uint_as_float(rr[1]); }

struct Flash { f32x16 o[3]; float m, l; };
__device__ __forceinline__ void flash_init(Flash& f) { f.o[0] = f32x16{}; f.o[1] = f32x16{}; f.o[2] = f32x16{}; f.m = -1e30f; f.l = 0.f; }

template <int NKC>
__device__ __forceinline__ void issue_tile(LAS unsigned char* lds, int buf, const bf16* Kg, int ldk, const bf16* Kpe, const bf16* Vg, int ldv, int wave, int lane) {
    LAS unsigned char* kb = lds + buf * BUF_BYTES; LAS unsigned char* vb = kb + KB_BYTES;
    __builtin_amdgcn_global_load_lds((const unsigned*)(Kg + (size_t)lane * ldk + wave * 8), (LAS unsigned*)(kb + wave * 1024), 16, 0, 0);
    if (NKC == 12) { if (wave < 4) __builtin_amdgcn_global_load_lds((const unsigned*)(Kpe + (size_t)lane * 32 + wave * 8), (LAS unsigned*)(kb + (8 + wave) * 1024), 16, 0, 0); }
    __builtin_amdgcn_global_load_lds((const unsigned*)(Vg + (size_t)(16 * (wave & 3) + (lane >> 2)) * ldv + (wave >> 2) * 32 + (lane & 3) * 8), (LAS unsigned*)(vb + wave * 1024), 16, 0, 0);
}

template <int NKS, int NVB, bool HAS_BIAS>
__device__ __forceinline__ void tile_compute(Flash& f, const LAS unsigned char* kb, const LAS unsigned char* vb, const bf16x8* qr, float slope, float cb,
                                             int lo, int hi_, bool need_mask, int r32, int hh, int lane) {
    f32x16 p0, p1;
    if (HAS_BIAS) {
        const float cb0 = cb + slope * (float)(4 * hh), cb1 = cb0 + slope * 32.f;
#pragma unroll
        for (int r = 0; r < 16; ++r) { const float cr = (float)((r & 3) + 8 * (r >> 2)); p0[r] = __builtin_fmaf(slope, cr, cb0); p1[r] = __builtin_fmaf(slope, cr, cb1); }
    } else { p0 = f32x16{}; p1 = f32x16{}; }
    const LAS unsigned char* kp = kb + hh * 1024 + r32 * 16;
#pragma unroll
    for (int d0 = 0; d0 < NKS; ++d0) {
        const bf16x8 b0 = *(const LAS bf16x8*)(kp + d0 * 2048);
        const bf16x8 b1 = *(const LAS bf16x8*)(kp + d0 * 2048 + 512);
        p0 = __builtin_amdgcn_mfma_f32_32x32x16_bf16(b0, qr[d0], p0, 0, 0, 0);
        p1 = __builtin_amdgcn_mfma_f32_32x32x16_bf16(b1, qr[d0], p1, 0, 0, 0);
    }
    if (need_mask) {
        const int l0 = lo - 4 * hh, h0 = hi_ - 4 * hh;
#pragma unroll
        for (int r = 0; r < 16; ++r) { const int c = (r & 3) + 8 * (r >> 2);
            if (c < l0 || c > h0) p0[r] = -INFINITY;
            if (c + 32 < l0 || c + 32 > h0) p1[r] = -INFINITY; }
    }
    float mt = fmaxf(p0[0], p1[0]);
#pragma unroll
    for (int r = 1; r < 16; ++r) mt = fmaxf(mt, fmaxf(p0[r], p1[r]));
    mt = swapmax(mt);
    const float mn = fmaxf(f.m, mt);
    const float alpha = __builtin_amdgcn_exp2f(f.m - mn);
    f.m = mn;
    float sum = 0.f;
#pragma unroll
    for (int r = 0; r < 16; ++r) { p0[r] = __builtin_amdgcn_exp2f(p0[r] - mn); p1[r] = __builtin_amdgcn_exp2f(p1[r] - mn); sum += p0[r] + p1[r]; }
    f.l = f.l * alpha + sum;
#pragma unroll
    for (int b = 0; b < NVB; ++b)
#pragma unroll
        for (int r = 0; r < 16; ++r) f.o[b][r] *= alpha;
    v4u pw[4];
    pw[0] = (v4u){cvtpk(p0[0], p0[1]), cvtpk(p0[2], p0[3]), cvtpk(p0[4], p0[5]), cvtpk(p0[6], p0[7])};
    pw[1] = (v4u){cvtpk(p0[8], p0[9]), cvtpk(p0[10], p0[11]), cvtpk(p0[12], p0[13]), cvtpk(p0[14], p0[15])};
    pw[2] = (v4u){cvtpk(p1[0], p1[1]), cvtpk(p1[2], p1[3]), cvtpk(p1[4], p1[5]), cvtpk(p1[6], p1[7])};
    pw[3] = (v4u){cvtpk(p1[8], p1[9]), cvtpk(p1[10], p1[11]), cvtpk(p1[12], p1[13]), cvtpk(p1[14], p1[15])};
    const LAS unsigned char* vp = vb + ((lane >> 4) & 1) * 32 + (lane & 3) * 8 + (4 * hh + ((lane & 15) >> 2)) * 64;
#pragma unroll
    for (int b = 0; b < NVB; ++b)
#pragma unroll
        for (int ks = 0; ks < 4; ++ks) {
            const s16x4 vl = vtr(vp + b * 4096 + ks * 1024), vh = vtr(vp + b * 4096 + ks * 1024 + 512);
            const bf16x8 va = (bf16x8){vl[0], vl[1], vl[2], vl[3], vh[0], vh[1], vh[2], vh[3]};
            f.o[b] = __builtin_amdgcn_mfma_f32_32x32x16_bf16(va, __builtin_bit_cast(bf16x8, pw[ks]), f.o[b], 0, 0, 0);
        }
}
__device__ __forceinline__ void flash_finish(Flash& f, int nvb) {
    const float lt = swapsum(f.l); const float inv = lt > 0.f ? 1.0f / lt : 0.f;
#pragma unroll
    for (int b = 0; b < 3; ++b) if (b < nvb) {
#pragma unroll
        for (int r = 0; r < 16; ++r) f.o[b][r] *= inv; }
}

__device__ __forceinline__ void nsa_unit(Frame& F, int b, int g, int qc) {
    int lane = F.lane; asm volatile("" : "+v"(lane));
    LAS unsigned char* lds = F.lds; const int wave = F.wave, r32 = lane & 31, hh = lane >> 5;
    const int head = g * 4 + (wave >> 1);
    const int qloc = 32 * (wave & 1) + r32;
    const int t = 64 * qc + qloc;
    const size_t row = (size_t)b * SEQ + t;
    const bf16* QKV = (const bf16*)(F.ws + WS_QKV); const bf16* MISC = (const bf16*)(F.ws + WS_MISC);
    bf16x8 qr[4];
#pragma unroll
    for (int d0 = 0; d0 < 4; ++d0) qr[d0] = *(const bf16x8*)(QKV + row * 1280 + head * 64 + d0 * 16 + hh * 8);
    const float slope2 = exp2f(-(float)(head + 1)) * LOG2E;
    LAS unsigned* selw = (LAS unsigned*)(lds + OFF_SEL);
    if (F.tid < 80) selw[F.tid] = 0u;
    f32x16 ot0, ot1;
    {
        const bf16* KC = (const bf16*)(F.ws + WS_KC) + (size_t)(b * 2 + g) * 128 * 64; const bf16* VC = (const bf16*)(F.ws + WS_VC) + (size_t)(b * 2 + g) * 128 * 64;
        Flash f; flash_init(f);
        int nmax = (t >= 31) ? ((t - 31) >> 4) : -1; if (nmax > 126) nmax = 126;
        for (int ti = 0; ti < 2; ++ti) {
            issue_tile<8>(lds, ti, KC + (size_t)ti * 64 * 64, 64, nullptr, VC + (size_t)ti * 64 * 64, 64, wave, lane);
            LAS bf16* ov = (LAS bf16*)(lds + ti * BUF_BYTES + KB_BYTES + 2 * 4096);
#pragma unroll
            for (int e = 0; e < 4; ++e) { const int idx = F.tid * 4 + e, nl = idx >> 5, s = idx & 31, n = 64 * ti + nl;
                float v = 0.f; if (s == (n >> 2)) v = ((n & 3) == 3) ? 0.5f : 1.0f; else if (s == (n >> 2) + 1 && (n & 3) == 3) v = 0.5f;
                ov[(nl >> 4) * 512 + (nl & 15) * 32 + s] = (bf16)f2bf(v); }
        }
        __syncthreads();
#pragma unroll 1
        for (int ti = 0; ti < 2; ++ti) {
            const LAS unsigned char* kb = lds + ti * BUF_BYTES;
            tile_compute<4, 3, true>(f, kb, kb + KB_BYTES, qr, 16.f * slope2, 16.f * slope2 * (float)(64 * ti), 0, nmax - 64 * ti, true, r32, hh, lane);
        }
        flash_finish(f, 3);
        LAS float* imp = (LAS float*)(lds + OFF_IMP) + (wave * 32 + r32) * 32;
#pragma unroll
        for (int r = 0; r < 16; ++r) imp[crow(r, hh)] = f.o[2][r];
        const float gc = sigmoidf_(bf2f(MISC[row * 256 + 160 + head]));
        ot0 = f.o[0] * gc; ot1 = f.o[1] * gc;
    }
    __syncthreads();
    {
        LAS float* IMP = (LAS float*)(lds + OFF_IMP); LAS float* SC = (LAS float*)(lds + OFF_SC);
        const int q = F.tid >> 3, s4 = (F.tid & 7) * 4;
#pragma unroll
        for (int e = 0; e < 4; ++e) { const int s = s4 + e; float v = 0.f;
#pragma unroll
            for (int h4 = 0; h4 < 4; ++h4) v += IMP[((2 * h4 + (q >> 5)) * 32 + (q & 31)) * 32 + s];
            const bool causal = s <= qc, forced = causal && (s == 0 || s + 2 > qc);
            SC[q * 32 + s] = causal ? (v + (forced ? 1e4f : 0.f)) : -1e30f; }
        __syncthreads();
        float sc[32];
#pragma unroll
        for (int s = 0; s < 32; ++s) sc[s] = SC[q * 32 + s];
        unsigned bits = 0u;
#pragma unroll
        for (int e = 0; e < 4; ++e) { const int s = s4 + e; const float me = SC[q * 32 + s]; int rank = 0;
#pragma unroll
            for (int s2 = 0; s2 < 32; ++s2) rank += (sc[s2] > me || (sc[s2] == me && s2 < s)) ? 1 : 0;
            if (s <= qc && rank < 16) bits |= 1u << s; }
        atomicOr((unsigned*)&selw[q], bits); atomicOr((unsigned*)&selw[64], bits);
    }
    __syncthreads();
    const unsigned mymask = selw[qloc], anymask = selw[64];
    {
        const bf16* Kg = QKV + (size_t)b * SEQ * 1280 + 768 + g * 64; const bf16* Vg = QKV + (size_t)b * SEQ * 1280 + 896 + g * 64;
        Flash f; flash_init(f);
        unsigned rem = anymask; int buf = 0;
        { const int j0 = __builtin_ctz(rem); issue_tile<8>(lds, 0, Kg + (size_t)j0 * 64 * 1280, 1280, nullptr, Vg + (size_t)j0 * 64 * 1280, 1280, wave, lane); }
        while (rem) {
            const int j = __builtin_ctz(rem); rem &= rem - 1;
            __syncthreads();
            if (rem) { const int jn = __builtin_ctz(rem); issue_tile<8>(lds, buf ^ 1, Kg + (size_t)jn * 64 * 1280, 1280, nullptr, Vg + (size_t)jn * 64 * 1280, 1280, wave, lane); }
            const bool sel = (mymask >> j) & 1u;
            const int hi_ = sel ? ((j == qc) ? (t - 64 * j) : 63) : -1;
            const bool need = (j == qc) || !__all(sel);
            const LAS unsigned char* kb = lds + buf * BUF_BYTES;
            tile_compute<4, 2, true>(f, kb, kb + KB_BYTES, qr, slope2, slope2 * (float)(64 * j), 0, hi_, need, r32, hh, lane);
            buf ^= 1;
        }
        flash_finish(f, 2);
        const float gs = sigmoidf_(bf2f(MISC[row * 256 + 160 + 8 + head]));
        ot0 += f.o[0] * gs; ot1 += f.o[1] * gs;
        __syncthreads();
    }
    {
        const bf16* Kg = QKV + (size_t)b * SEQ * 1280 + 1024 + g * 64; const bf16* Vg = QKV + (size_t)b * SEQ * 1280 + 1152 + g * 64;
        Flash f; flash_init(f);
        const int j0 = qc >= 8 ? qc - 8 : 0; int buf = 0;
        issue_tile<8>(lds, 0, Kg + (size_t)j0 * 64 * 1280, 1280, nullptr, Vg + (size_t)j0 * 64 * 1280, 1280, wave, lane);
        for (int j = j0; j <= qc; ++j) {
            __syncthreads();
            if (j < qc) issue_tile<8>(lds, buf ^ 1, Kg + (size_t)(j + 1) * 64 * 1280, 1280, nullptr, Vg + (size_t)(j + 1) * 64 * 1280, 1280, wave, lane);
            int lo = t - 511 - 64 * j; if (lo < 0) lo = 0; int hi_ = t - 64 * j; if (hi_ > 63) hi_ = 63;
            const bool need = (j == qc) || (j + 8 == qc);
            const LAS unsigned char* kb = lds + buf * BUF_BYTES;
            tile_compute<4, 2, true>(f, kb, kb + KB_BYTES, qr, slope2, slope2 * (float)(64 * j), lo, hi_, need, r32, hh, lane);
            buf ^= 1;
        }
        flash_finish(f, 2);
        const float gw = sigmoidf_(bf2f(MISC[row * 256 + 160 + 16 + head]));
        ot0 += f.o[0] * gw; ot1 += f.o[1] * gw;
        __syncthreads();
    }
    { bf16* op = (bf16*)(F.ws + WS_OCAT) + row * 1024 + head * 64 + 4 * hh;
#pragma unroll
      for (int k = 0; k < 4; ++k) {
          *(v2u*)(op + 8 * k) = (v2u){cvtpk(ot0[4 * k], ot0[4 * k + 1]), cvtpk(ot0[4 * k + 2], ot0[4 * k + 3])};
          *(v2u*)(op + 32 + 8 * k) = (v2u){cvtpk(ot1[4 * k], ot1[4 * k + 1]), cvtpk(ot1[4 * k + 2], ot1[4 * k + 3])}; } }
}

__device__ __forceinline__ void mla_unit(Frame& F, int b, int h, int qb) {
    int lane = F.lane; asm volatile("" : "+v"(lane));
    LAS unsigned char* lds = F.lds; const int wave = F.wave, r32 = lane & 31, hh = lane >> 5;
    const int t = 256 * qb + 32 * wave + r32;
    const size_t row = (size_t)b * SEQ + t;
    const bf16* MQ = (const bf16*)(F.ws + WS_MLAQ); const bf16* MKV = (const bf16*)(F.ws + WS_MLAKV); const bf16* KPE = (const bf16*)(F.ws + WS_KPE);
    bf16x8 qr[6];
#pragma unroll
    for (int d0 = 0; d0 < 6; ++d0) qr[d0] = *(const bf16x8*)(MQ + row * 768 + h * 96 + d0 * 16 + hh * 8);
    {
        const float pos = (float)F.pos[row];
        v4u a = __builtin_bit_cast(v4u, qr[4]), c = __builtin_bit_cast(v4u, qr[5]);
        float x1[8], x2[8];
        x1[0] = bf_lo(a.x); x1[1] = bf_hi(a.x); x1[2] = bf_lo(a.y); x1[3] = bf_hi(a.y); x1[4] = bf_lo(a.z); x1[5] = bf_hi(a.z); x1[6] = bf_lo(a.w); x1[7] = bf_hi(a.w);
        x2[0] = bf_lo(c.x); x2[1] = bf_hi(c.x); x2[2] = bf_lo(c.y); x2[3] = bf_hi(c.y); x2[4] = bf_lo(c.z); x2[5] = bf_hi(c.z); x2[6] = bf_lo(c.w); x2[7] = bf_hi(c.w);
        float y1[8], y2[8];
#pragma unroll
        for (int j = 0; j < 8; ++j) { const float inv = powf(10000.0f, -(float)(2 * (8 * hh + j)) / 32.0f); const float ang = pos * inv; const float cs = cosf(ang), sn = sinf(ang);
            y1[j] = x1[j] * cs - x2[j] * sn; y2[j] = x1[j] * sn + x2[j] * cs; }
        a = (v4u){cvtpk(y1[0], y1[1]), cvtpk(y1[2], y1[3]), cvtpk(y1[4], y1[5]), cvtpk(y1[6], y1[7])};
        c = (v4u){cvtpk(y2[0], y2[1]), cvtpk(y2[2], y2[3]), cvtpk(y2[4], y2[5]), cvtpk(y2[6], y2[7])};
        qr[4] = __builtin_bit_cast(bf16x8, a); qr[5] = __builtin_bit_cast(bf16x8, c);
    }
    const bf16* Kg = MKV + (size_t)b * SEQ * 1024 + h * 128; const bf16* Vg = Kg + 64; const bf16* Pg = KPE + (size_t)b * SEQ * 32;
    Flash f; flash_init(f);
    const int NT = 4 * qb + 4; int buf = 0;
    const int tmax_w = 256 * qb + 32 * wave + 31;
    issue_tile<12>(lds, 0, Kg, 1024, Pg, Vg, 1024, wave, lane);
    for (int j = 0; j < NT; ++j) {
        __syncthreads();
        if (j + 1 < NT) issue_tile<12>(lds, buf ^ 1, Kg + (size_t)(j + 1) * 64 * 1024, 1024, Pg + (size_t)(j + 1) * 64 * 32, Vg + (size_t)(j + 1) * 64 * 1024, 1024, wave, lane);
        if (64 * j <= tmax_w) {
            int hi_ = t - 64 * j; if (hi_ > 63) hi_ = 63;
            const bool need = (64 * j + 63 > 256 * qb + 32 * wave);
            const LAS unsigned char* kb = lds + buf * BUF_BYTES;
            tile_compute<6, 2, false>(f, kb, kb + KB_BYTES, qr, 0.f, 0.f, 0, hi_, need, r32, hh, lane);
        }
        buf ^= 1;
    }
    flash_finish(f, 2);
    __syncthreads();
    { bf16* op = (bf16*)(F.ws + WS_OCAT) + row * 1024 + 512 + h * 64 + 4 * hh;
#pragma unroll
      for (int k = 0; k < 4; ++k) {
          *(v2u*)(op + 8 * k) = (v2u){cvtpk(f.o[0][4 * k], f.o[0][4 * k + 1]), cvtpk(f.o[0][4 * k + 2], f.o[0][4 * k + 3])};
          *(v2u*)(op + 32 + 8 * k) = (v2u){cvtpk(f.o[1][4 * k], f.o[1][4 * k + 1]), cvtpk(f.o[1][4 * k + 2], f.o[1][4 * k + 3])}; } }
}

__device__ __forceinline__ void nsa_loop(Frame& F) {
#pragma unroll 1
    for (int c = F.bid; c < 256; c += F.G) { const int bg = c >> 4, p = c & 15;
#pragma unroll 1
        for (int i = 0; i < 2; ++i) nsa_unit(F, bg >> 1, bg & 1, i ? p : 31 - p); }
}
__device__ __forceinline__ void mla_loop(Frame& F) {
#pragma unroll 1
    for (int c = F.bid; c < 256; c += F.G) { const int bh = c >> 2, p = c & 3;
#pragma unroll 1
        for (int i = 0; i < 2; ++i) mla_unit(F, bh >> 3, bh & 7, i ? p : 7 - p); }
}
}
#define NET_SORT16(K) do { CE(K[0], K[1]); CE(K[2], K[3]); CE(K[0], K[2]); CE(K[1], K[3]); CE(K[1], K[2]); CE(K[4], K[5]); CE(K[6], K[7]); CE(K[4], K[6]); CE(K[5], K[7]); CE(K[5], K[6]); CE(K[0], K[4]); CE(K[2], K[6]); CE(K[2], K[4]); CE(K[1], K[5]); CE(K[3], K[7]); CE(K[3], K[5]); CE(K[1], K[2]); CE(K[3], K[4]); CE(K[5], K[6]); CE(K[8], K[9]); CE(K[10], K[11]); CE(K[8], K[10]); CE(K[9], K[11]); CE(K[9], K[10]); CE(K[12], K[13]); CE(K[14], K[15]); CE(K[12], K[14]); CE(K[13], K[15]); CE(K[13], K[14]); CE(K[8], K[12]); CE(K[10], K[14]); CE(K[10], K[12]); CE(K[9], K[13]); CE(K[11], K[15]); CE(K[11], K[13]); CE(K[9], K[10]); CE(K[11], K[12]); CE(K[13], K[14]); CE(K[0], K[8]); CE(K[4], K[12]); CE(K[4], K[8]); CE(K[2], K[10]); CE(K[6], K[14]); CE(K[6], K[10]); CE(K[2], K[4]); CE(K[6], K[8]); CE(K[10], K[12]); CE(K[1], K[9]); CE(K[5], K[13]); CE(K[5], K[9]); CE(K[3], K[11]); CE(K[7], K[15]); CE(K[7], K[11]); CE(K[3], K[5]); CE(K[7], K[9]); CE(K[11], K[13]); CE(K[1], K[2]); CE(K[3], K[4]); CE(K[5], K[6]); CE(K[7], K[8]); CE(K[9], K[10]); CE(K[11], K[12]); CE(K[13], K[14]); } while (0)
#define NET_BMERGE16(K) do { CE(K[0], K[8]); CE(K[1], K[9]); CE(K[2], K[10]); CE(K[3], K[11]); CE(K[4], K[12]); CE(K[5], K[13]); CE(K[6], K[14]); CE(K[7], K[15]); CE(K[0], K[4]); CE(K[1], K[5]); CE(K[2], K[6]); CE(K[3], K[7]); CE(K[8], K[12]); CE(K[9], K[13]); CE(K[10], K[14]); CE(K[11], K[15]); CE(K[0], K[2]); CE(K[1], K[3]); CE(K[4], K[6]); CE(K[5], K[7]); CE(K[8], K[10]); CE(K[9], K[11]); CE(K[12], K[14]); CE(K[13], K[15]); CE(K[0], K[1]); CE(K[2], K[3]); CE(K[4], K[5]); CE(K[6], K[7]); CE(K[8], K[9]); CE(K[10], K[11]); CE(K[12], K[13]); CE(K[14], K[15]); } while (0)
__device__ __forceinline__ void kpe_pass(Frame& F) {
    const bf16* MISC = (const bf16*)(F.ws + WS_MISC); bf16* KPE = (bf16*)(F.ws + WS_KPE);
    const int gt = F.bid * NTHREADS + F.tid, NGT = F.G * NTHREADS;
    for (int it = gt; it < MTOK * 16; it += NGT) { const int t = it >> 4, i = it & 15;
        const float x1 = bf2f(MISC[(size_t)t * 256 + 128 + i]), x2 = bf2f(MISC[(size_t)t * 256 + 144 + i]);
        const float inv = powf(10000.0f, -(float)(2 * i) / 32.0f); const float ang = (float)F.pos[t] * inv; const float cs = cosf(ang), sn = sinf(ang);
        KPE[(size_t)t * 32 + i] = (bf16)f2bf(x1 * cs - x2 * sn); KPE[(size_t)t * 32 + 16 + i] = (bf16)f2bf(x1 * sn + x2 * cs); }
}
__device__ __forceinline__ void cmp_finalize(Frame& F) {
    const int gw = F.bid * NWAVES + F.wave, NGW = F.G * NWAVES, lane = F.lane;
    LAS float* hid = (LAS float*)(F.lds + F.wave * 1024);
    for (int it = gw; it < 2 * 16 * 128; it += NGW) {
        const int kv = it >> 11, bg = (it >> 7) & 15, n = it & 127;
        bf16* dst = (bf16*)(F.ws + (kv ? WS_VC : WS_KC)) + ((size_t)bg * 128 + n) * 64;
        if (n == 127) { dst[lane] = 0; continue; }
        const float* U = (const float*)(F.ws + (kv ? WS_UV : WS_UK)) + (size_t)(bg * 128 + n) * 256; const float* c1 = (const float*)(F.ws + (kv ? WS_C1V : WS_C1K));
        const float* w2 = F.in[kv ? I_CW2V : I_CW2K];
        hid[lane] = gelu_tanh(U[lane] + U[256 + 128 + lane] + c1[lane]);
        hid[64 + lane] = gelu_tanh(U[64 + lane] + U[256 + 192 + lane] + c1[64 + lane]);
        asm volatile("s_waitcnt lgkmcnt(0)" ::: "memory");
        float s = 0.f;
#pragma unroll 8
        for (int i = 0; i < 128; ++i) s += hid[i] * w2[i * 64 + lane];
        dst[lane] = (bf16)f2bf(s);
        asm volatile("s_waitcnt lgkmcnt(0)" ::: "memory");
    }
}
__device__ __forceinline__ void quant_table(Frame& F, const float* src, unsigned char* dst, float* steps) {
    const int gw = F.bid * NWAVES + F.wave, NGW = F.G * NWAVES, lane = F.lane;
    for (int e = gw; e < 16384; e += NGW) {
        const f32x4* sp = (const f32x4*)(src + (size_t)e * 1024) + 4 * lane;
        f32x4 v[4]; float mx = 0.f;
#pragma unroll
        for (int j = 0; j < 4; ++j) { v[j] = sp[j]; mx = fmaxf(mx, fmaxf(fmaxf(fabsf(v[j].x), fabsf(v[j].y)), fmaxf(fabsf(v[j].z), fabsf(v[j].w)))); }
#pragma unroll
        for (int o = 1; o < 64; o <<= 1) mx = fmaxf(mx, __shfl_xor(mx, o));
        const float step = mx > 0.f ? mx * (1.0f / 127.0f) : 1.0f, inv = 1.0f / step;
        v4u w;
#pragma unroll
        for (int j = 0; j < 4; ++j) { const unsigned b0 = (unsigned)(int)(rintf(v[j].x * inv) + 128.f), b1 = (unsigned)(int)(rintf(v[j].y * inv) + 128.f), b2 = (unsigned)(int)(rintf(v[j].z * inv) + 128.f), b3 = (unsigned)(int)(rintf(v[j].w * inv) + 128.f);
            w[j] = b0 | (b1 << 8) | (b2 << 16) | (b3 << 24); }
        ((v4u*)(dst + (size_t)e * 1024))[lane] = w;
        if (lane == 0) steps[e] = step;
    }
}
__device__ __forceinline__ void xn2_pass(Frame& F) {
    const int gw = F.bid * NWAVES + F.wave, NGW = F.G * NWAVES; bf16* XN2 = (bf16*)(F.ws + WS_XN2);
    for (int m = gw; m < MTOK; m += NGW) rms_row_to_bf16(F.out + (size_t)m * DM, F.in[I_N2G], XN2 + (size_t)m * DM, F.lane);
}

namespace peer {
constexpr int TOK = 32;
constexpr int OFF_LIST = 0;
constexpr int OFF_ROUTE = 65536;
struct Ent { float v; unsigned k; };
__device__ __forceinline__ unsigned ordkey(float f) { const unsigned u = __float_as_uint(f); return u ^ ((u >> 31) ? 0xffffffffu : 0x80000000u); }
__device__ __forceinline__ float ordinv(unsigned k) { return __uint_as_float(k ^ ((k >> 31) ? 0x80000000u : 0xffffffffu)); }
__device__ __forceinline__ void swap2(int x, int& lo, int& hi) { auto rr = __builtin_amdgcn_permlane32_swap((unsigned)x, (unsigned)x, false, false); lo = (int)rr[0]; hi = (int)rr[1]; }

#define CE(a, b) do { const unsigned x_ = (a) > (b) ? (a) : (b), y_ = (a) > (b) ? (b) : (a); (a) = x_; (b) = y_; } while (0)
__device__ __forceinline__ void merge_top16(unsigned (&a)[16], const unsigned (&b)[16]) {
#pragma unroll
    for (int i = 0; i < 16; ++i) a[i] = a[i] > b[15 - i] ? a[i] : b[15 - i];
    NET_BMERGE16(a);
}
__device__ __forceinline__ void top16_of64(unsigned (&w)[4][16]) {
    NET_SORT16(w[0]); NET_SORT16(w[1]); NET_SORT16(w[2]); NET_SORT16(w[3]);
    merge_top16(w[0], w[1]); merge_top16(w[2], w[3]); merge_top16(w[0], w[2]);
}

#define PEER_CANDS(X) X(0,0) X(0,1) X(0,2) X(0,3) X(0,4) X(0,5) X(0,6) X(0,7) X(0,8) X(0,9) X(0,10) X(0,11) X(0,12) X(0,13) X(0,14) X(0,15) \
    X(1,0) X(1,1) X(1,2) X(1,3) X(1,4) X(1,5) X(1,6) X(1,7) X(2,0) X(2,1) X(2,2) X(2,3) X(2,4) X(3,0) X(3,1) X(3,2) X(3,3) X(4,0) X(4,1) X(4,2) \
    X(5,0) X(5,1) X(6,0) X(6,1) X(7,0) X(7,1) X(8,0) X(9,0) X(10,0) X(11,0) X(12,0) X(13,0) X(14,0) X(15,0)

__device__ __forceinline__ void route_task(Frame& F, int tok0) {
    int lane = F.lane; asm volatile("" : "+v"(lane));
    const int wave = F.wave, r32 = lane & 31, hh = lane >> 5;
    const bf16* QP = (const bf16*)(F.ws + WS_QP);
    const size_t row = (size_t)tok0 + r32;
    LAS Ent* LIST = (LAS Ent*)(F.lds + OFF_LIST) + (size_t)wave * 2 * TOK * 16;
#pragma unroll 1
    for (int half = 0; half < 2; ++half) {
        const bf16* SK = (const bf16*)(F.ws + (half ? WS_SK2 : WS_SK1));
        bf16x8 qf[8];
#pragma unroll
        for (int d0 = 0; d0 < 8; ++d0) qf[d0] = *(const bf16x8*)(QP + row * 2048 + wave * 256 + half * 128 + d0 * 16 + hh * 8);
        unsigned u[4][16];
#pragma unroll
        for (int kb = 0; kb < 4; ++kb) { f32x16 p = f32x16{};
#pragma unroll
            for (int d0 = 0; d0 < 8; ++d0) { const bf16x8 a = *(const bf16x8*)(SK + (size_t)(32 * kb + r32) * 128 + d0 * 16 + hh * 8);
                p = __builtin_amdgcn_mfma_f32_32x32x16_bf16(a, qf[d0], p, 0, 0, 0); }
#pragma unroll
            for (int r = 0; r < 16; ++r) u[kb][r] = ordkey(p[r]);
            asm volatile("" ::: "memory"); __builtin_amdgcn_sched_barrier(0); }
        unsigned prefix;
        { unsigned w[4][16];
#pragma unroll
          for (int kb = 0; kb < 4; ++kb)
#pragma unroll
              for (int r = 0; r < 16; ++r) w[kb][r] = u[kb][r];
          top16_of64(w);
          unsigned lo16[16], hi16[16];
#pragma unroll
          for (int i = 0; i < 16; ++i) { auto rr = __builtin_amdgcn_permlane32_swap(w[0][i], w[0][i], false, false); lo16[i] = rr[0]; hi16[i] = rr[1]; }
          unsigned t = 0xffffffffu;
#pragma unroll
          for (int i = 0; i < 16; ++i) { const unsigned m = lo16[i] > hi16[15 - i] ? lo16[i] : hi16[15 - i]; t = m < t ? m : t; }
          prefix = t; }
        int cgt = 0, ceq = 0;
#pragma unroll
        for (int kb = 0; kb < 4; ++kb)
#pragma unroll
            for (int r = 0; r < 16; ++r) { cgt += (u[kb][r] > prefix) ? 1 : 0; ceq += (u[kb][r] == prefix) ? 1 : 0; }
        int g0, g1, e0, e1; swap2(cgt, g0, g1); swap2(ceq, e0, e1);
        const int need = 16 - (g0 + g1);
        const int take0 = e0 < need ? e0 : need; const int take1 = (need - take0) < e1 ? (need - take0) : e1;
        int slot = hh ? (g0 + take0) : 0; int eq_left = hh ? take1 : take0;
        LAS Ent* L = LIST + ((size_t)half * TOK + r32) * 16;
#pragma unroll
        for (int kb = 0; kb < 4; ++kb)
#pragma unroll
            for (int r = 0; r < 16; ++r) { const unsigned uu = u[kb][r]; const int eq = ((uu == prefix) & (eq_left > 0)) ? 1 : 0; const int tk = (uu > prefix) ? 1 : eq;
                if (tk & (slot < 16)) { L[slot].v = ordinv(uu); L[slot].k = (unsigned)(32 * kb + (r & 3) + 8 * (r >> 2) + 4 * hh); }
                slot += tk; eq_left -= eq; }
    }
    asm volatile("s_waitcnt lgkmcnt(0)" ::: "memory");
    {
        LAS Ent* L = LIST + ((size_t)hh * TOK + r32) * 16;
        float v[16]; unsigned k[16];
#pragma unroll
        for (int a = 0; a < 16; ++a) { v[a] = L[a].v; k[a] = L[a].k; }
        asm volatile("s_waitcnt lgkmcnt(0)" ::: "memory");
#pragma unroll
        for (int a = 0; a < 16; ++a) { int rank = 0;
#pragma unroll
            for (int a2 = 0; a2 < 16; ++a2) rank += (v[a2] > v[a] || (v[a2] == v[a] && a2 < a)) ? 1 : 0;
            L[rank].v = v[a]; L[rank].k = k[a]; }
    }
    asm volatile("s_waitcnt lgkmcnt(0)" ::: "memory");
    {
        const LAS Ent* L1 = LIST + ((size_t)0 * TOK + r32) * 16; const LAS Ent* L2 = LIST + ((size_t)1 * TOK + r32) * 16;
        float v1[16], v2[16];
#pragma unroll
        for (int a = 0; a < 16; ++a) { v1[a] = L1[a].v; v2[a] = L2[a].v; }
        unsigned uc[50]; { int ci = 0;
#define X(a, b) uc[ci++] = ordkey(v1[a] + v2[b]);
        PEER_CANDS(X)
#undef X
        }
        const float cmax = v1[0] + v2[0];
        unsigned prefix;
        { unsigned w[4][16];
#pragma unroll
          for (int i = 0; i < 64; ++i) w[i >> 4][i & 15] = i < 50 ? uc[i] : 0u;
          top16_of64(w);
          prefix = w[0][15]; }
        int cgt = 0; float gsum = 0.f;
#pragma unroll
        for (int i = 0; i < 50; ++i) cgt += (uc[i] > prefix) ? 1 : 0;
        int eq_left = 16 - cgt;
        unsigned long long selm = 0ull;
#pragma unroll
        for (int i = 0; i < 50; ++i) { const int eq = ((uc[i] == prefix) & (eq_left > 0)) ? 1 : 0; const int sl = (uc[i] > prefix) ? 1 : eq; eq_left -= eq;
            selm |= (unsigned long long)sl << i; gsum += sl ? __expf(ordinv(uc[i]) - cmax) : 0.f; }
        const float ginv = 1.0f / gsum;
        LAS Ent* R = (LAS Ent*)(F.lds + OFF_ROUTE) + ((size_t)wave * TOK + r32) * 16;
        if (hh == 0) { int i = 0, slot = 0;
#define X(a, b) { const int sl = (int)((selm >> i) & 1ull); if (sl & (slot < 16)) { R[slot].k = L1[a].k * 128u + L2[b].k; R[slot].v = __expf(ordinv(uc[i]) - cmax) * ginv; } slot += sl; ++i; }
            PEER_CANDS(X)
#undef X
        }
    }
}

__device__ __forceinline__ float ub0(unsigned w) { return (float)(w & 0xffu); }
__device__ __forceinline__ float ub1(unsigned w) { return (float)((w >> 8) & 0xffu); }
__device__ __forceinline__ float ub2(unsigned w) { return (float)((w >> 16) & 0xffu); }
__device__ __forceinline__ float ub3(unsigned w) { return (float)(w >> 24); }
__device__ __forceinline__ void gather_token(Frame& F, int tl, size_t row, bool wr) {
    int lane = F.lane; asm volatile("" : "+v"(lane));
    const unsigned char* EXPD = F.ws + WS_EXPD; const unsigned char* EXPU = F.ws + WS_EXPU;
    const float* SD = (const float*)(F.ws + WS_EXPD_SC); const float* SU = (const float*)(F.ws + WS_EXPU_SC);
    float hv[16], xh[16], y[16]; float sx;
    { const f32x4* hp = (const f32x4*)(F.out + row * DM) + 4 * lane; const f32x4* gp = (const f32x4*)F.in[I_N2G] + 4 * lane;
      float ss = 0.f;
#pragma unroll
      for (int c = 0; c < 4; ++c) { const f32x4 v = hp[c]; hv[4 * c] = v.x; hv[4 * c + 1] = v.y; hv[4 * c + 2] = v.z; hv[4 * c + 3] = v.w; ss += (v.x * v.x + v.y * v.y) + (v.z * v.z + v.w * v.w); }
      const float r = 1.0f / sqrtf(wave_sum(ss) * (1.f / DM) + EPS);
      float s1 = 0.f;
#pragma unroll
      for (int c = 0; c < 4; ++c) { const f32x4 g = gp[c]; xh[4 * c] = hv[4 * c] * r * g.x; xh[4 * c + 1] = hv[4 * c + 1] * r * g.y; xh[4 * c + 2] = hv[4 * c + 2] * r * g.z; xh[4 * c + 3] = hv[4 * c + 3] * r * g.w;
          s1 += (xh[4 * c] + xh[4 * c + 1]) + (xh[4 * c + 2] + xh[4 * c + 3]); }
      sx = 128.f * wave_sum(s1);
    }
#pragma unroll
    for (int i = 0; i < 16; ++i) y[i] = 0.f;
    float ysub = 0.f;
    const LAS Ent* R = (const LAS Ent*)(F.lds + OFF_ROUTE);
#pragma unroll 1
    for (int grp = 0; grp < 32; ++grp) {
        const int head = grp >> 2, k0 = (grp & 3) * 4;
        unsigned ex[4]; float gt[4]; v4u dn[4], up[4]; float sd[4], su[4];
#pragma unroll
        for (int k = 0; k < 4; ++k) { const LAS Ent* en = R + ((size_t)head * TOK + tl) * 16 + k0 + k; ex[k] = (unsigned)__builtin_amdgcn_readfirstlane((int)en->k); gt[k] = __uint_as_float((unsigned)__builtin_amdgcn_readfirstlane((int)__float_as_uint(en->v))); }
#pragma unroll
        for (int k = 0; k < 4; ++k) { dn[k] = ((const v4u*)(EXPD + (size_t)ex[k] * 1024))[lane]; up[k] = ((const v4u*)(EXPU + (size_t)ex[k] * 1024))[lane]; sd[k] = SD[ex[k]]; su[k] = SU[ex[k]]; }
        float dt[4];
#pragma unroll
        for (int k = 0; k < 4; ++k) { float s = 0.f;
#pragma unroll
            for (int c = 0; c < 4; ++c) { const unsigned w = dn[k][c]; s += ub0(w) * xh[4 * c] + ub1(w) * xh[4 * c + 1] + ub2(w) * xh[4 * c + 2] + ub3(w) * xh[4 * c + 3]; }
            dt[k] = s; }
        { const bool up32 = lane & 32; float keep0 = up32 ? dt[1] : dt[0], send0 = up32 ? dt[0] : dt[1]; keep0 += __shfl_xor(send0, 32);
          float keep1 = up32 ? dt[3] : dt[2], send1 = up32 ? dt[2] : dt[3]; keep1 += __shfl_xor(send1, 32);
          const bool up16 = lane & 16; float keep = up16 ? keep1 : keep0, send = up16 ? keep0 : keep1; keep += __shfl_xor(send, 16);
          keep += __shfl_xor(keep, 8); keep += __shfl_xor(keep, 4); keep += __shfl_xor(keep, 2); keep += __shfl_xor(keep, 1);
          dt[0] = __shfl(keep, 0); dt[2] = __shfl(keep, 16); dt[1] = __shfl(keep, 32); dt[3] = __shfl(keep, 48); }
#pragma unroll
        for (int k = 0; k < 4; ++k) { const float hk = sd[k] * (dt[k] - sx); const float wk = gt[k] * gelu_tanh(hk) * su[k]; ysub += wk;
#pragma unroll
            for (int c = 0; c < 4; ++c) { const unsigned w = up[k][c]; y[4 * c] += wk * ub0(w); y[4 * c + 1] += wk * ub1(w); y[4 * c + 2] += wk * ub2(w); y[4 * c + 3] += wk * ub3(w); } }
    }
    { float ss = 0.f; const float ys = 128.f * ysub;
#pragma unroll
      for (int i = 0; i < 16; ++i) { hv[i] += y[i] - ys; ss += hv[i] * hv[i]; }
      const float r = 1.0f / sqrtf(wave_sum(ss) * (1.f / DM) + EPS);
      f32x4* op = (f32x4*)(F.out + row * DM) + 4 * lane; const f32x4* gp = (const f32x4*)F.in[I_NFG] + 4 * lane;
#pragma unroll
      for (int c = 0; c < 4; ++c) { const f32x4 g = gp[c];
          if (wr) op[c] = (f32x4){hv[4 * c] * r * g.x, hv[4 * c + 1] * r * g.y, hv[4 * c + 2] * r * g.z, hv[4 * c + 3] * r * g.w}; } }
}

__device__ __forceinline__ void peer_phase(Frame& F, bool never) {
    for (int task = F.bid; task < MTOK / TOK; task += F.G) {
        const int tok0 = task * TOK;
#pragma unroll 1
        for (int rep_ = 0; rep_ < (((DBL_MASK >> 12) & 1) ? 2 : 1); ++rep_) { route_task(F, tok0); __syncthreads(); }
#pragma unroll 1
        for (int rep_ = (((DBL_MASK >> 13) & 1) ? 0 : 1); rep_ < 2; ++rep_)
            for (int i = 0; i < TOK / NWAVES; ++i) { const int tl = F.wave * (TOK / NWAVES) + i; gather_token(F, tl, (size_t)tok0 + tl, rep_ == 1 || never); }
        __syncthreads();
    }
}
}
#define XB_TMO      128
#define XB_XCNT(j)  (256  + 64 * (j))
#define XB_XSUB(j)  (1280 + 64 * (j))
#define XB_XGEN(j)  (2304 + 64 * (j))
#define XB_TOP      3328
#define XB_TOPGEN   3392
#define XCD_BAR_WORDS 3456
#define XB_SPIN_CAP (1u << 18)

__device__ __forceinline__ unsigned xb_ld(unsigned* p)              { return __hip_atomic_load(p, __ATOMIC_RELAXED, __HIP_MEMORY_SCOPE_AGENT); }
__device__ __forceinline__ unsigned xb_add(unsigned* p, unsigned v) { return __hip_atomic_fetch_add(p, v, __ATOMIC_RELAXED, __HIP_MEMORY_SCOPE_AGENT); }
__device__ __forceinline__ unsigned xb_xcc_id() { return (unsigned)__builtin_amdgcn_s_getreg((3 << 11) | 20) & 0xFu; }
#define XB_SPIN(cond, bar) do { unsigned _sp = 0; while (cond) { __builtin_amdgcn_s_sleep(1); \
    if ((++_sp & 255u) == 0u) { if (xb_ld(&(bar)[XB_TMO])) break; if (_sp > XB_SPIN_CAP) { atomicAdd(&(bar)[XB_TMO], 1u); break; } } } } while (0)

struct XcdBarrier {
    unsigned* bar; unsigned x;
    volatile LAS unsigned* st;
};

__device__ __forceinline__ XcdBarrier xcd_barrier_post(unsigned* bar, volatile LAS unsigned* st) {
    XcdBarrier b; b.bar = bar; b.x = xb_xcc_id(); b.st = st;
    if (threadIdx.x == 0) (void)xb_add(&bar[XB_XCNT(b.x)], 1u);
    return b;
}
__device__ __forceinline__ void xcd_barrier_complete(unsigned* bar, unsigned x, unsigned& nloc, unsigned& nx) {
    const unsigned G = gridDim.x * gridDim.y * gridDim.z;
    unsigned sum, cnt, mine, sp = 0u;
    for (;;) {
        sum = 0u; cnt = 0u; mine = 0u;
#pragma unroll
        for (unsigned j = 0; j < 16; ++j) { const unsigned c = xb_ld(&bar[XB_XCNT(j)]); sum += c; cnt += (c > 0u) ? 1u : 0u; mine = (j == x) ? c : mine; }
        if (sum == G) break;
        __builtin_amdgcn_s_sleep(1);
        if ((++sp & 255u) == 0u) { if (xb_ld(&bar[XB_TMO])) break; if (sp > XB_SPIN_CAP) { atomicAdd(&bar[XB_TMO], 1u); break; } }
    }
    nloc = mine > 0u ? mine : 1u; nx = cnt > 0u ? cnt : 1u;
}

__device__ __forceinline__ void xcd_barrier(const XcdBarrier& b) {
    asm volatile("s_waitcnt vmcnt(0)" ::: "memory");
    __syncthreads();
    if (threadIdx.x == 0) {
        unsigned* bar = b.bar;
        __builtin_amdgcn_s_waitcnt(0);
        unsigned nloc = b.st[0], nx = b.st[1];
        if (nloc == 0u) { xcd_barrier_complete(bar, b.x, nloc, nx); b.st[0] = nloc; b.st[1] = nx; }
        const unsigned old = xb_add(&bar[XB_XSUB(b.x)], 1u);
        const unsigned gen = old / nloc;
        if (old + 1u == (gen + 1u) * nloc) {
            __builtin_amdgcn_fence(__ATOMIC_RELEASE, "agent");
            asm volatile("s_waitcnt vmcnt(0)" ::: "memory");
            const unsigned og = xb_add(&bar[XB_TOP], 1u);
            const unsigned tg = og / nx;
            if (og + 1u == (tg + 1u) * nx) xb_add(&bar[XB_TOPGEN], 1u);
            else XB_SPIN(xb_ld(&bar[XB_TOPGEN]) == tg, bar);
            __builtin_amdgcn_fence(__ATOMIC_ACQUIRE, "agent");
            xb_add(&bar[XB_XGEN(b.x)], 1u);
            asm volatile("s_waitcnt vmcnt(0)" ::: "memory");
        } else {
            XB_SPIN(xb_ld(&bar[XB_XGEN(b.x)]) == gen, bar);
            __builtin_amdgcn_fence(__ATOMIC_ACQUIRE, "agent");
            asm volatile("s_waitcnt vmcnt(0)" ::: "memory");
        }
    }
    __syncthreads();
}

#ifndef MK_ONE_LAUNCH
#define MK_ONE_LAUNCH 1
#endif
#ifndef DBL_MASK
#define DBL_MASK 0
#endif
constexpr int N_PHASES = 10;
struct Args { const void* in[N_IN]; float* out; unsigned char* ws; int ph_lo, ph_hi; };
#define PHASE_FN __device__ __forceinline__ void
#define PHASE_FRAME \
    Frame F; F.lds = (LAS unsigned char*)(uintptr_t)(unsigned)__builtin_amdgcn_readfirstlane((int)ldsaddr); F.tid = threadIdx.x; F.lane = F.tid & 63; F.wave = __builtin_amdgcn_readfirstlane(F.tid >> 6); \
    F.G = gridDim.x; F.bid = blockIdx.x; F.in = (const float* const*)ap->in; F.pos = (const int*)ap->in[I_POS]; F.out = ap->out; F.ws = ap->ws; unsigned char* ws = F.ws; (void)ws;
#define REP(k) for (int rep_ = 0; rep_ < (((DBL_MASK >> (k)) & 1) ? 2 : 1); ++rep_)

PHASE_FN ph_prologue(const Args* ap, unsigned ldsaddr) { PHASE_FRAME REP(0) p0_prologue(F); }
PHASE_FN ph_inproj(const Args* ap, unsigned ldsaddr) { PHASE_FRAME REP(1) {
    pg8::StaticOrder S;
    pg8::Gemm g = pg8::make_gemm((const bf16*)(ws + WS_XN), 1024, (const bf16*)(ws + WS_WIN), 1024, MTOK, NPROJ, 1024);
    S.init(MTOK, NPROJ, F.G, F.bid);
    EpiInProj E{(bf16*)(ws + WS_QKV), (bf16*)(ws + WS_CQ), (bf16*)(ws + WS_MISC), (bf16*)(ws + WS_GATES)};
    pg8::gemm_phase<EpiInProj, pg8::StaticOrder, true>(F.lds, g, S, E); } }
PHASE_FN ph_upq(const Args* ap, unsigned ldsaddr) { PHASE_FRAME REP(2) {
    pg8::StaticOrder S;
    pg8::Gemm g = pg8::make_gemm((const bf16*)(ws + WS_CQ), 256, (const bf16*)(ws + WS_WUQ), 256, MTOK, 768, 256);
    S.init(MTOK, 768, F.G, F.bid);
    EpiRowScale<256> E{(const bf16*)(ws + WS_CQ), (bf16*)(ws + WS_MLAQ), 768, QSCALE_MLA};
    pg8::gemm_phase<EpiRowScale<256>, pg8::StaticOrder, true>(F.lds, g, S, E); } }
PHASE_FN ph_upkv(const Args* ap, unsigned ldsaddr) { PHASE_FRAME REP(2) {
    pg8::StaticOrder S;
    pg8::Gemm g = pg8::make_gemm((const bf16*)(ws + WS_MISC), 256, (const bf16*)(ws + WS_WUKV), 256, MTOK, 1024, 256);
    S.init(MTOK, 1024, F.G, F.bid);
    EpiRowScale<128> E{(const bf16*)(ws + WS_MISC), (bf16*)(ws + WS_MLAKV), 1024, 1.0f};
    pg8::gemm_phase<EpiRowScale<128>, pg8::StaticOrder, true>(F.lds, g, S, E); } }
PHASE_FN ph_cmpu(const Args* ap, unsigned ldsaddr) { PHASE_FRAME REP(2) {
    pg8::StaticOrder S;
#pragma unroll 1
    for (int kv = 0; kv < 2; ++kv) {
        pg8::Gemm g; g.A = (const bf16*)(ws + WS_QKV) + 512 + 128 * kv; g.Bt = (const bf16*)(ws + (kv ? WS_WC1V : WS_WC1K)); g.M = 2048; g.N = 256; g.K = 1024;
        g.aRow = (size_t)16 * 1280 * 2; g.aHalf = 128; g.aTile = (size_t)SEQ * 1280 * 2; g.aK = (size_t)1280 * 2; g.bRow = 1024 * 2;
        S.init(2048, 256, F.G, F.bid);
        EpiF32 E{(float*)(ws + (kv ? WS_UV : WS_UK)), 256, nullptr};
        pg8::gemm_phase<EpiF32, pg8::StaticOrder, true>(F.lds, g, S, E);
    }
    kpe_pass(F); } }
PHASE_FN ph_cmpfin(const Args* ap, unsigned ldsaddr) { PHASE_FRAME REP(3) cmp_finalize(F); }
PHASE_FN ph_nsa(const Args* ap, unsigned ldsaddr) { PHASE_FRAME REP(10) att::nsa_loop(F); }
PHASE_FN ph_mla(const Args* ap, unsigned ldsaddr) { PHASE_FRAME REP(11) att::mla_loop(F); }
PHASE_FN ph_branch0(const Args* ap, unsigned ldsaddr) { PHASE_FRAME REP(5) {
    pg8::StaticOrder S; S.init(MTOK, 1024, F.G, F.bid);
    pg8::Gemm g = pg8::make_gemm((const bf16*)(ws + WS_OCAT), 1024, (const bf16*)(ws + WS_WBR), 1024, MTOK, 1024, 512);
    EpiGate<0> E{(const bf16*)(ws + WS_GATES), (bf16*)(ws + WS_MERGED), 0};
    pg8::gemm_phase<EpiGate<0>, pg8::StaticOrder, true>(F.lds, g, S, E); } }
PHASE_FN ph_branch1(const Args* ap, unsigned ldsaddr) { PHASE_FRAME REP(5) {
    pg8::StaticOrder S; S.init(MTOK, 1024, F.G, F.bid);
    pg8::Gemm g = pg8::make_gemm((const bf16*)(ws + WS_OCAT) + 512, 1024, (const bf16*)(ws + WS_WBR) + 512, 1024, MTOK, 1024, 512);
    EpiGate<1> E{(const bf16*)(ws + WS_GATES), (bf16*)(ws + WS_MERGED), 1024};
    pg8::gemm_phase<EpiGate<1>, pg8::StaticOrder, true>(F.lds, g, S, E);
    quant_table(F, F.in[I_EDN], ws + WS_EXPD, (float*)(ws + WS_EXPD_SC)); } }
PHASE_FN ph_outproj(const Args* ap, unsigned ldsaddr) { PHASE_FRAME REP(6) {
    pg8::StaticOrder S; S.init(MTOK, 1024, F.G, F.bid);
    pg8::Gemm g = pg8::make_gemm((const bf16*)(ws + WS_MERGED), 1024, (const bf16*)(ws + WS_WOUT), 1024, MTOK, 1024, 1024);
    EpiF32 E{F.out, 1024, F.in[I_X]};
    pg8::gemm_phase<EpiF32, pg8::StaticOrder, true>(F.lds, g, S, E);
    quant_table(F, F.in[I_EUP], ws + WS_EXPU, (float*)(ws + WS_EXPU_SC)); } }
PHASE_FN ph_xn2(const Args* ap, unsigned ldsaddr) { PHASE_FRAME REP(7) xn2_pass(F); }
PHASE_FN ph_peerq(const Args* ap, unsigned ldsaddr) { PHASE_FRAME REP(8) {
    pg8::StaticOrder S; S.init(MTOK, 2048, F.G, F.bid);
    pg8::Gemm g = pg8::make_gemm((const bf16*)(ws + WS_XN2), 1024, (const bf16*)(ws + WS_WPQ), 1024, MTOK, 2048, 1024);
    EpiBf16 E{(bf16*)(ws + WS_QP), 2048};
    pg8::gemm_phase<EpiBf16, pg8::StaticOrder, true>(F.lds, g, S, E); } }
PHASE_FN ph_peer(const Args* ap, unsigned ldsaddr) { PHASE_FRAME peer::peer_phase(F, ap->ph_lo < 0); }

__global__ void __launch_bounds__(NTHREADS, 2) fwd(Args a) {
    extern __shared__ __attribute__((aligned(16))) unsigned char lds_raw[];
    cg::grid_group grid = cg::this_grid();
    const unsigned ldsaddr = (unsigned)(uintptr_t)(LAS unsigned char*)lds_raw;
    const int lo = a.ph_lo, hi = a.ph_hi;
#define IN(k) (lo <= (k) && (k) < hi)
    { LAS unsigned* misc = (LAS unsigned*)((LAS unsigned char*)lds_raw + RING_BYTES); if (threadIdx.x < 64) misc[threadIdx.x] = 0u; }
    __syncthreads();
    XcdBarrier bar = xcd_barrier_post((unsigned*)(a.ws + WS_CTL) + 4096, (volatile LAS unsigned*)((LAS unsigned char*)lds_raw + RING_BYTES) + 8);
#define SEAM(k) do { if (IN(k) && IN((k) + 1)) { if (MK_ONE_LAUNCH) xcd_barrier(bar); } } while (0)
    if (IN(0)) ph_prologue(&a, ldsaddr);
    if (IN(0) && IN(1)) grid.sync();
    if (IN(1)) ph_inproj(&a, ldsaddr);
    SEAM(1);
    if (IN(2)) { ph_upq(&a, ldsaddr); ph_upkv(&a, ldsaddr); ph_cmpu(&a, ldsaddr); }
    SEAM(2);
    if (IN(3)) ph_cmpfin(&a, ldsaddr);
    SEAM(3);
    if (IN(4)) { ph_nsa(&a, ldsaddr); ph_mla(&a, ldsaddr); }
    SEAM(4);
    if (IN(5)) { ph_branch0(&a, ldsaddr); ph_branch1(&a, ldsaddr); }
    SEAM(5);
    if (IN(6)) ph_outproj(&a, ldsaddr);
    SEAM(6);
    if (IN(7)) ph_xn2(&a, ldsaddr);
    SEAM(7);
    if (IN(8)) ph_peerq(&a, ldsaddr);
    SEAM(8);
    if (IN(9)) ph_peer(&a, ldsaddr);
#undef IN
#undef SEAM
}

extern "C" void kernel_launch(void* const* d_in, const int* in_sizes, int n_in, void* d_out, int out_size, void* d_ws, size_t ws_size, hipStream_t stream) {
    static int grid = 0;
    if (grid == 0) {
        if (n_in != N_IN || out_size != MTOK * DM || ws_size < WS_END) { fprintf(stderr, "kernel_launch: unexpected shapes (n_in %d, out %d, ws %zu)\n", n_in, out_size, ws_size); grid = -1; return; }
        int dev = 0, cus = 0, per_cu = 0;
        if (hipGetDevice(&dev) != hipSuccess || hipDeviceGetAttribute(&cus, hipDeviceAttributeMultiprocessorCount, dev) != hipSuccess) { grid = -1; return; }
        if (hipFuncSetAttribute((const void*)fwd, hipFuncAttributeMaxDynamicSharedMemorySize, LDS_BYTES) != hipSuccess) { fprintf(stderr, "kernel_launch: hipFuncSetAttribute failed\n"); grid = -1; return; }
        if (hipOccupancyMaxActiveBlocksPerMultiprocessor(&per_cu, (const void*)fwd, NTHREADS, LDS_BYTES) != hipSuccess || per_cu < 1) { fprintf(stderr, "kernel_launch: occupancy query says %d\n", per_cu); (void)hipGetLastError(); grid = -1; return; }
        grid = cus;
    }
    if (grid < 0) return;
    Args a{};
    for (int i = 0; i < N_IN; ++i) a.in[i] = d_in[i];
    a.out = (float*)d_out; a.ws = (unsigned char*)d_ws;
#if MK_ONE_LAUNCH
    if (hipMemsetAsync((char*)d_ws + WS_CTL, 0, 65536, stream) != hipSuccess) { fprintf(stderr, "kernel_launch: hipMemsetAsync failed\n"); return; }
    a.ph_lo = 0; a.ph_hi = N_PHASES;
    void* args[] = {&a};
    hipError_t e = hipLaunchCooperativeKernel((const void*)fwd, dim3(grid), dim3(NTHREADS), args, LDS_BYTES, stream);
    if (e != hipSuccess) fprintf(stderr, "kernel_launch: cooperative launch failed: %s (grid %d)\n", hipGetErrorString(e), grid);
#else
    for (int p = 0; p < N_PHASES; ++p) { a.ph_lo = p; a.ph_hi = p + 1; hipLaunchKernelGGL(fwd, dim3(grid), dim3(NTHREADS), LDS_BYTES, stream, a); }
#endif
}
```

```cpp
#define DBL_MASK 0
#include <hip/hip_runtime.h>
#include <hip/hip_cooperative_groups.h>
#include <cstdio>
#include <cstdint>
#include <cmath>
namespace cg = cooperative_groups;
namespace pg8 {
#define PG8_LAS __attribute__((address_space(3)))
typedef unsigned short bf16_t;
typedef short bf16x8 __attribute__((ext_vector_type(8)));
typedef float f32x4 __attribute__((ext_vector_type(4)));
typedef unsigned u32x4 __attribute__((ext_vector_type(4)));
constexpr int BM = 256, BK = 64, HALF = 128, HTB = HALF * BK * 2  , STAGE_BYTES = 8 * HTB, NXCD = 8, WGM = 8;

__host__ __device__ __forceinline__ int lds_byte(int r, int c) { const int st = (r >> 4) * 2 + (c >> 5), rr = r & 15, cc = c & 31, ob = rr * 64 + cc * 2; return st * 1024 + (ob ^ (((ob >> 9) & 1) << 5)); }
__host__ __device__ __forceinline__ void stage_rc(int b, int& R, int& C) { const int st = b / 1024, sb = b % 1024, swz = sb ^ (((sb >> 9) & 1) << 5); R = (st >> 1) * 16 + swz / 64; C = (st & 1) * 32 + (swz % 64) / 2; }
__host__ __device__ __forceinline__ int perm32(int rho) { const int n = rho >> 4, i = rho & 15; return 8 * (i >> 2) + 4 * n + (i & 3); }

struct Unit { int pm, pn; };
struct Gemm { const bf16_t* A; const bf16_t* Bt; int M, N, K; size_t aRow, aHalf, aTile, aK, bRow; };
__host__ __device__ __forceinline__ Gemm make_gemm(const bf16_t* A, int lda, const bf16_t* Bt, int ldb, int M, int N, int K) {
    Gemm g; g.A = A; g.Bt = Bt; g.M = M; g.N = N; g.K = K; g.aRow = (size_t)lda * 2; g.aHalf = (size_t)HALF * lda * 2; g.aTile = (size_t)BM * lda * 2; g.aK = BK * 2; g.bRow = (size_t)ldb * 2; return g; }

struct StaticOrder {
    int nM, nN, nwg, G, c;
    __host__ __device__ void init(int M, int N, int G_, int c_) { nM = M / BM; nN = N / BM; nwg = nM * nN; G = G_; c = c_; }
    __host__ __device__ bool next(int i, Unit& u) const {
        const long L = (long)i * G + c; if (L >= nwg) return false;
        int wgid = (int)L; { const int q = nwg / NXCD, r = nwg % NXCD, xcd = wgid % NXCD, off = wgid / NXCD; wgid = (xcd < r ? xcd * (q + 1) : r * (q + 1) + (xcd - r) * q) + off; }
        const int nig = WGM * nN, gid = wgid / nig, fm = gid * WGM, gsz = (nM - fm) < WGM ? (nM - fm) : WGM;
        u.pm = fm + ((wgid % nig) % gsz); u.pn = (wgid % nig) / gsz; return true;
    }
};

__device__ __forceinline__ unsigned cvt_pk_bf16(float lo, float hi) { unsigned r; asm volatile("v_cvt_pk_bf16_f32 %0, %1, %2" : "=v"(r) : "v"(lo), "v"(hi)); return r; }

template <class Epi, class Sched, bool ALIGN_EPI>
__device__ __forceinline__ void gemm_phase(PG8_LAS unsigned char* lds, const Gemm g, const Sched& S, const Epi& E) {
    const int tid = threadIdx.x, wid = __builtin_amdgcn_readfirstlane(tid >> 6), lane = tid & 63, wr = wid >> 2, wc = wid & 3, fr = lane & 15, fq = lane >> 4;
    const int K = g.K, nt = K / BK;
    unsigned voffA[2], voffB[2];
#pragma unroll
    for (int i = 0; i < 2; ++i) { int R, C; stage_rc(tid * 16 + i * 8192, R, C); const int Rb = Epi::PERM ? ((R & ~31) + perm32(R & 31)) : R;
        voffA[i] = (unsigned)((size_t)R * g.aRow + (size_t)C * 2); voffB[i] = (unsigned)((size_t)Rb * g.bRow + (size_t)C * 2); }
    const size_t kstepA = g.aK, kstepB = (size_t)(BK * 2);
    const size_t hstepA = g.aHalf, hstepB = (size_t)HALF * g.bRow;
    const size_t tstepA = g.aTile, tstepB = (size_t)BM * g.bRow;
    const unsigned ldsw = (unsigned)wid * 1024u;
    const int aoff = lds_byte(wr * 64 + fr, fq * 8), boff = lds_byte(wc * 32 + fr, fq * 8);
#define PG8_SA(b, h) (((b) * 2 + (h)) * HTB)
#define PG8_SB(b, h) ((4 + (b) * 2 + (h)) * HTB)
#define PG8_STAGE(bufoff, gbase, voff) do { _Pragma("unroll") for (int _i = 0; _i < 2; ++_i) \
        __builtin_amdgcn_global_load_lds((const unsigned*)((const char*)(gbase) + (voff)[_i]), (PG8_LAS unsigned*)(lds + (bufoff) + ldsw + _i * 8192), 16, 0, 0); } while (0)
#define PG8_LDA(dst, b, h) do { _Pragma("unroll") for (int m = 0; m < 4; ++m) _Pragma("unroll") for (int k = 0; k < 2; ++k) dst[m][k] = *(const PG8_LAS bf16x8*)(lds + PG8_SA(b, h) + aoff + m * 2048 + k * 1024); } while (0)
#define PG8_LDB(dst, b, h) do { _Pragma("unroll") for (int n = 0; n < 2; ++n) _Pragma("unroll") for (int k = 0; k < 2; ++k) dst[n][k] = *(const PG8_LAS bf16x8*)(lds + PG8_SB(b, h) + boff + n * 2048 + k * 1024); } while (0)
#define PG8_MMA(ai, bj, At, Bt) do { __builtin_amdgcn_s_setprio(1); _Pragma("unroll") for (int m = 0; m < 4; ++m) _Pragma("unroll") for (int n = 0; n < 2; ++n) _Pragma("unroll") for (int k = 0; k < 2; ++k) \
        acc[ai][bj][m][n] = __builtin_amdgcn_mfma_f32_16x16x32_bf16(Bt[n][k], At[m][k], acc[ai][bj][m][n], 0, 0, 0); __builtin_amdgcn_s_setprio(0); } while (0)
#define PG8_WAIT_V(n) asm volatile("s_waitcnt vmcnt(" #n ")" ::: "memory")
#define PG8_WAIT_L(n) asm volatile("s_waitcnt lgkmcnt(" #n ")" ::: "memory")
#define PG8_BAR __builtin_amdgcn_s_barrier()
#define PG8_SCHED __builtin_amdgcn_sched_barrier(0)
    Unit cur, nxt; int ui = 0;
    if (!S.next(0, cur)) return;
    f32x4 acc[2][2][4][2];
#pragma unroll
    for (int a = 0; a < 2; ++a)
#pragma unroll
        for (int b = 0; b < 2; ++b)
#pragma unroll
            for (int m = 0; m < 4; ++m)
#pragma unroll
                for (int n = 0; n < 2; ++n) acc[a][b][m][n] = (f32x4){0.f, 0.f, 0.f, 0.f};
    bf16x8 At[4][2], B0[2][2], B1[2][2];
    const char* cA = (const char*)g.A + (size_t)cur.pm * tstepA; const char* cB = (const char*)g.Bt + (size_t)cur.pn * tstepB;
    PG8_STAGE(PG8_SB(0, 0), cB, voffB); PG8_STAGE(PG8_SB(0, 1), cB + hstepB, voffB); PG8_STAGE(PG8_SA(0, 0), cA, voffA); PG8_STAGE(PG8_SA(0, 1), cA + hstepA, voffA);
    if (wr == 1) PG8_BAR;
    PG8_WAIT_V(2); PG8_BAR;
    PG8_STAGE(PG8_SB(1, 0), cB + kstepB, voffB); PG8_STAGE(PG8_SA(1, 0), cA + kstepA, voffA); PG8_STAGE(PG8_SB(1, 1), cB + hstepB + kstepB, voffB);
    PG8_WAIT_V(6); PG8_BAR;
    for (;;) {
        const bool has_next = S.next(ui + 1, nxt);
        const char* nA = has_next ? (const char*)g.A + (size_t)nxt.pm * tstepA : cA; const char* nB = has_next ? (const char*)g.Bt + (size_t)nxt.pn * tstepB : cB;
        for (int t = 0; t < nt; t += 2) {
            const bool last = (t == nt - 2);
            const char* a1 = cA + (size_t)(t + 1) * kstepA;
            const char* a2 = last ? nA : cA + (size_t)(t + 2) * kstepA; const char* b2 = last ? nB : cB + (size_t)(t + 2) * kstepB;
            const char* a3 = a2 + kstepA; const char* b3 = b2 + kstepB;
            PG8_LDB(B0, 0, 0); PG8_LDB(B1, 0, 1); PG8_SCHED; PG8_LDA(At, 0, 0); PG8_STAGE(PG8_SA(1, 1), a1 + hstepA, voffA);
            PG8_WAIT_V(8); PG8_WAIT_L(0); PG8_BAR; PG8_MMA(0, 0, At, B0); PG8_MMA(0, 1, At, B1); PG8_BAR; PG8_SCHED;
            PG8_LDA(At, 0, 1); PG8_STAGE(PG8_SB(0, 0), b2, voffB); PG8_STAGE(PG8_SB(0, 1), b2 + hstepB, voffB); PG8_STAGE(PG8_SA(0, 0), a2, voffA);
            PG8_WAIT_V(8); PG8_WAIT_L(0); PG8_BAR; PG8_MMA(1, 0, At, B0); PG8_MMA(1, 1, At, B1); PG8_BAR; PG8_SCHED;
            PG8_LDB(B0, 1, 0); PG8_LDB(B1, 1, 1); PG8_SCHED; PG8_LDA(At, 1, 0); PG8_STAGE(PG8_SA(0, 1), a2 + hstepA, voffA);
            PG8_WAIT_V(8); PG8_WAIT_L(0); PG8_BAR; PG8_MMA(0, 0, At, B0); PG8_MMA(0, 1, At, B1); PG8_BAR; PG8_SCHED;
            PG8_LDA(At, 1, 1); PG8_STAGE(PG8_SB(1, 0), b3, voffB); PG8_STAGE(PG8_SB(1, 1), b3 + hstepB, voffB); PG8_STAGE(PG8_SA(1, 0), a3, voffA);
            PG8_WAIT_V(8); PG8_WAIT_L(0); PG8_BAR; PG8_MMA(1, 0, At, B0); PG8_MMA(1, 1, At, B1); PG8_BAR; PG8_SCHED;
        }
        if constexpr (ALIGN_EPI) { if (wr == 0) PG8_BAR; }
        E(acc, cur, wr, wc, fr, fq);
        if (!has_next) break;
#pragma unroll
        for (int a = 0; a < 2; ++a)
#pragma unroll
            for (int b = 0; b < 2; ++b)
#pragma unroll
                for (int m = 0; m < 4; ++m)
#pragma unroll
                    for (int n = 0; n < 2; ++n) acc[a][b][m][n] = (f32x4){0.f, 0.f, 0.f, 0.f};
        cur = nxt; cA = nA; cB = nB; ++ui;
        if constexpr (ALIGN_EPI) { if (wr == 1) PG8_BAR; }
    }
    PG8_WAIT_V(0);
    if constexpr (!ALIGN_EPI) { if (wr == 0) PG8_BAR; }
    PG8_BAR;
#undef PG8_SA
#undef PG8_SB
#undef PG8_STAGE
#undef PG8_LDA
#undef PG8_LDB
#undef PG8_MMA
#undef PG8_WAIT_V
#undef PG8_WAIT_L
#undef PG8_BAR
#undef PG8_SCHED
}
}
constexpr int NWAVES = 8, NTHREADS = 512;
constexpr int BATCH = 8, SEQ = 2048, DM = 1024, MTOK = BATCH * SEQ;
constexpr int NPROJ = 3840;
constexpr float EPS = 1e-6f, LOG2E = 1.4426950408889634f;
constexpr float QSCALE_NSA = 0.125f * LOG2E;
constexpr float QSCALE_MLA = 0.10206207261596575f * LOG2E;
constexpr size_t MiB = 1u << 20;
enum { I_X = 0, I_POS, I_N1G, I_WIN, I_CPK, I_CW1K, I_CW2K, I_CPV, I_CW1V, I_CW2V, I_QNG, I_KVNG, I_WUQ, I_WUKV, I_WBN, I_WBM, I_WOUT, I_N2G, I_WPQ, I_SK1, I_SK2, I_EDN, I_EUP, I_NFG, N_IN };
constexpr size_t WS_CTL = 0;
constexpr size_t WS_WIN = 1 * MiB;
constexpr size_t WS_WUQ = WS_WIN + (size_t)NPROJ * 1024 * 2;
constexpr size_t WS_WUKV = WS_WUQ + 768 * 256 * 2;
constexpr size_t WS_WBR = 10 * MiB;
constexpr size_t WS_WOUT = 12 * MiB;
constexpr size_t WS_WPQ = 14 * MiB;
constexpr size_t WS_WC1K = 18 * MiB;
constexpr size_t WS_WC1V = WS_WC1K + 256 * 1024 * 2;
constexpr size_t WS_SMALL = 19 * MiB;
constexpr size_t WS_C1K = WS_SMALL;
constexpr size_t WS_C1V = WS_SMALL + 512;
constexpr size_t WS_ORDER = WS_SMALL + 1024;
constexpr size_t WS_SK1 = WS_SMALL + 4096;
constexpr size_t WS_SK2 = WS_SK1 + 32768;
constexpr size_t WS_XN = 20 * MiB;
constexpr size_t WS_MLAQ = WS_XN, WS_EXPD = WS_XN;
constexpr size_t WS_EXPD_SC = WS_EXPD + (size_t)16384 * 1024;
constexpr size_t WS_QKV = 52 * MiB;
constexpr size_t WS_MERGED = WS_QKV;
constexpr size_t WS_CQ = 92 * MiB;
constexpr size_t WS_MISC = 100 * MiB;
constexpr size_t WS_ROUTE = 92 * MiB;
constexpr size_t WS_GATES = 108 * MiB;
constexpr size_t WS_QP = WS_GATES;
constexpr size_t WS_MLAKV = 172 * MiB;
constexpr size_t WS_XN2 = WS_MLAKV;
constexpr size_t WS_KPE = 204 * MiB;
constexpr size_t WS_KC = 205 * MiB;
constexpr size_t WS_VC = WS_KC + 16 * 128 * 64 * 2;
constexpr size_t WS_SS = 206 * MiB;
constexpr size_t WS_OCAT = 210 * MiB;
constexpr size_t WS_USLAB = WS_OCAT;
constexpr size_t WS_EXPU = WS_OCAT;
constexpr size_t WS_EXPU_SC = WS_EXPU + (size_t)16384 * 1024;
constexpr size_t WS_END = 242 * MiB;
constexpr int RING_BYTES = 131072;
constexpr int LDS_BYTES = 147456;

#define GAS __attribute__((address_space(1)))
#define LAS __attribute__((address_space(3)))
typedef unsigned short bf16;
typedef unsigned v4u __attribute__((ext_vector_type(4)));
typedef unsigned v2u __attribute__((ext_vector_type(2)));
typedef float f32x4 __attribute__((ext_vector_type(4)));
typedef float f32x16 __attribute__((ext_vector_type(16)));
typedef short bf16x8 __attribute__((ext_vector_type(8)));
typedef short s16x4 __attribute__((ext_vector_type(4)));

__device__ __forceinline__ unsigned f2bf(float f) { unsigned u = __builtin_bit_cast(unsigned, f); return (u + 0x7fffu + ((u >> 16) & 1u)) >> 16; }
__device__ __forceinline__ unsigned pk2(float lo, float hi) { return f2bf(lo) | (f2bf(hi) << 16); }
__device__ __forceinline__ float bf_lo(unsigned u) { return __builtin_bit_cast(float, u << 16); }
__device__ __forceinline__ float bf_hi(unsigned u) { return __builtin_bit_cast(float, u & 0xffff0000u); }
__device__ __forceinline__ float bf2f(bf16 h) { return __builtin_bit_cast(float, (unsigned)h << 16); }
__device__ __forceinline__ float sigmoidf_(float v) { return 1.0f / (1.0f + __expf(-v)); }
__device__ __forceinline__ float gelu_tanh(float v) { const float u = 0.7978845608028654f * (v + 0.044715f * v * v * v); const float e = __expf(2.0f * u); const float th = 1.0f - 2.0f / (e + 1.0f); return 0.5f * v * (1.0f + th); }
__device__ __forceinline__ float wave_sum(float v) {
#pragma unroll
    for (int o = 1; o < 64; o <<= 1) v += __shfl_xor(v, o);
    return v;
}

struct Frame {
    LAS unsigned char* lds;
    int tid, lane, wave, G, bid;
    const float* const* in; const int* pos; float* out; unsigned char* ws;
};

__device__ __forceinline__ int win_srccol(int n) {
    if (n < 1280) return n;
    if (n < 1536) return 1304 + (n - 1280);
    if (n < 1664) return 1560 + (n - 1536);
    if (n < 1696) return 1688 + (n - 1664);
    if (n < 1720) return 1280 + (n - 1696);
    if (n < 1792) return -1;
    return 1720 + (n - 1792);
}
template <bool WIN_PERM>
__device__ __forceinline__ void tr_item(const float* src, int ld_src, int ksrc0, const float* kscale, bf16* dst, int ld_dst, int drow0, int dcol0, int N, LAS float* scr, int item, int lane) {
    const int nblk = N / 32, kb = item / nblk, nb = item % nblk, k0 = 64 * kb, n0 = 32 * nb;
    const int nn = n0 + (lane & 31); const int sc = WIN_PERM ? win_srccol(nn) : nn;
#pragma unroll 8
    for (int i = 0; i < 32; ++i) { const int kk = 2 * i + (lane >> 5); float v = 0.f; if (sc >= 0) v = src[(size_t)(ksrc0 + k0 + kk) * ld_src + sc]; if (kscale) v *= kscale[k0 + kk]; scr[kk * 33 + (lane & 31)] = v; }
    asm volatile("s_waitcnt lgkmcnt(0)" ::: "memory");
    const int c = lane & 7;
#pragma unroll
    for (int j = 0; j < 4; ++j) { const int n = (lane >> 3) + 8 * j; const LAS float* s = scr + (8 * c) * 33 + n;
        v4u o; o.x = pk2(s[0 * 33], s[1 * 33]); o.y = pk2(s[2 * 33], s[3 * 33]); o.z = pk2(s[4 * 33], s[5 * 33]); o.w = pk2(s[6 * 33], s[7 * 33]);
        *(v4u*)(dst + (size_t)(drow0 + n0 + n) * ld_dst + dcol0 + k0 + 8 * c) = o; }
    asm volatile("s_waitcnt lgkmcnt(0)" ::: "memory");
}
__device__ __forceinline__ void rms_row_to_bf16(const float* xrow, const float* gain, bf16* orow, int lane) {
    const f32x4* xr = (const f32x4*)xrow + lane; const f32x4* gr = (const f32x4*)gain + lane;
    f32x4 v[4]; float s = 0.f;
#pragma unroll
    for (int j = 0; j < 4; ++j) { v[j] = xr[64 * j]; s += (v[j].x * v[j].x + v[j].y * v[j].y) + (v[j].z * v[j].z + v[j].w * v[j].w); }
    const float r = 1.0f / sqrtf(wave_sum(s) * (1.f / DM) + EPS);
    unsigned long long* o8 = (unsigned long long*)orow + lane;
#pragma unroll
    for (int j = 0; j < 4; ++j) { const f32x4 g = gr[64 * j]; o8[64 * j] = (unsigned long long)pk2(v[j].x * r * g.x, v[j].y * r * g.y) | ((unsigned long long)pk2(v[j].z * r * g.z, v[j].w * r * g.w) << 32); }
}
__device__ __forceinline__ void p0_prologue(Frame& F) {
    LAS float* scr = (LAS float*)(F.lds + F.wave * 16384);
    const int gw = F.bid * NWAVES + F.wave, NGW = F.G * NWAVES, lane = F.lane;
    bf16* const Win_t = (bf16*)(F.ws + WS_WIN); bf16* const Wuq_t = (bf16*)(F.ws + WS_WUQ); bf16* const Wukv_t = (bf16*)(F.ws + WS_WUKV);
    bf16* const Wbr_t = (bf16*)(F.ws + WS_WBR); bf16* const Wout_t = (bf16*)(F.ws + WS_WOUT); bf16* const Wpq_t = (bf16*)(F.ws + WS_WPQ);
    bf16* const Wc1k_t = (bf16*)(F.ws + WS_WC1K); bf16* const Wc1v_t = (bf16*)(F.ws + WS_WC1V);
    constexpr int I_IN = 16 * (NPROJ / 32), I_UQ = 4 * 24, I_UKV = 2 * 32, I_BR = 8 * 32, I_OUT = 16 * 32, I_PQ = 16 * 64, I_C1 = 16 * 4;
    constexpr int NITEMS = I_IN + I_UQ + I_UKV + 2 * I_BR + I_OUT + I_PQ + 4 * I_C1;
    for (int it = gw; it < NITEMS; it += NGW) {
        int r = it;
        if (r < I_IN) { tr_item<true>(F.in[I_WIN], 3768, 0, nullptr, Win_t, 1024, 0, 0, NPROJ, scr, r, lane); continue; } r -= I_IN;
        if (r < I_UQ) { tr_item<false>(F.in[I_WUQ], 768, 0, F.in[I_QNG], Wuq_t, 256, 0, 0, 768, scr, r, lane); continue; } r -= I_UQ;
        if (r < I_UKV) { tr_item<false>(F.in[I_WUKV], 1024, 0, F.in[I_KVNG], Wukv_t, 256, 0, 0, 1024, scr, r, lane); continue; } r -= I_UKV;
        if (r < I_BR) { tr_item<false>(F.in[I_WBN], 1024, 0, nullptr, Wbr_t, 1024, 0, 0, 1024, scr, r, lane); continue; } r -= I_BR;
        if (r < I_BR) { tr_item<false>(F.in[I_WBM], 1024, 0, nullptr, Wbr_t, 1024, 0, 512, 1024, scr, r, lane); continue; } r -= I_BR;
        if (r < I_OUT) { tr_item<false>(F.in[I_WOUT], 1024, 0, nullptr, Wout_t, 1024, 0, 0, 1024, scr, r, lane); continue; } r -= I_OUT;
        if (r < I_PQ) { tr_item<false>(F.in[I_WPQ], 2048, 0, F.in[I_N2G], Wpq_t, 1024, 0, 0, 2048, scr, r, lane); continue; } r -= I_PQ;
        if (r < I_C1) { tr_item<false>(F.in[I_CW1K], 128, 0, nullptr, Wc1k_t, 1024, 0, 0, 128, scr, r, lane); continue; } r -= I_C1;
        if (r < I_C1) { tr_item<false>(F.in[I_CW1K], 128, 1024, nullptr, Wc1k_t, 1024, 128, 0, 128, scr, r, lane); continue; } r -= I_C1;
        if (r < I_C1) { tr_item<false>(F.in[I_CW1V], 128, 0, nullptr, Wc1v_t, 1024, 0, 0, 128, scr, r, lane); continue; } r -= I_C1;
        tr_item<false>(F.in[I_CW1V], 128, 1024, nullptr, Wc1v_t, 1024, 128, 0, 128, scr, r, lane);
    }
    { bf16* XN = (bf16*)(F.ws + WS_XN); for (int m = gw; m < MTOK; m += NGW) rms_row_to_bf16(F.in[I_X] + (size_t)m * DM, F.in[I_N1G], XN + (size_t)m * DM, lane); }
    const int gt = F.bid * NTHREADS + F.tid, NGT = F.G * NTHREADS;
    for (int i = gt; i < 1024 * 128; i += NGT) { const int n = i >> 7, k = 128 + (i & 127); Wukv_t[n * 256 + k] = 0; }
    { bf16* S1 = (bf16*)(F.ws + WS_SK1); bf16* S2 = (bf16*)(F.ws + WS_SK2);
      for (int i = gt; i < 128 * 128; i += NGT) { S1[i] = (bf16)f2bf(F.in[I_SK1][i]); S2[i] = (bf16)f2bf(F.in[I_SK2][i]); } }
    for (int o = gw; o < 256; o += NGW) {
        const int kv = o >> 7, j = o & 127; const float* pe = F.in[kv ? I_CPV : I_CPK]; const float* w1 = F.in[kv ? I_CW1V : I_CW1K];
        float s = 0.f;
        for (int k = lane; k < 2048; k += 64) s += pe[k] * w1[(size_t)k * 128 + j];
        s = wave_sum(s);
        if (lane == 0) ((float*)(F.ws + (kv ? WS_C1V : WS_C1K)))[j] = s;
    }
}

using pg8::Unit; using pg8::cvt_pk_bf16;
constexpr int PG_HALF = 128, PG_BM = 256;
struct EpiInProj {
    static constexpr bool PERM = true;
    bf16 *QKV, *CQ, *MISC, *GATES;
    __device__ __forceinline__ void operator()(const f32x4 (&acc)[2][2][4][2], const Unit& u, int wr, int wc, int fr, int fq) const {
        bf16* base; int ldc, colt; float sc = 1.f;
        if (u.pn < 5) { base = QKV; ldc = 1280; colt = u.pn * 256; if (u.pn < 2) sc = QSCALE_NSA; }
        else if (u.pn == 5) { base = CQ; ldc = 256; colt = 0; }
        else if (u.pn == 6) { base = MISC; ldc = 256; colt = 0; }
        else { base = GATES; ldc = 2048; colt = (u.pn - 7) * 256; }
        const int row0 = u.pm * PG_BM + wr * 64 + fr, col0 = colt + wc * 32 + 8 * fq;
#pragma unroll
        for (int ai = 0; ai < 2; ++ai)
#pragma unroll
            for (int m = 0; m < 4; ++m) { bf16* rowp = base + (size_t)(row0 + ai * PG_HALF + m * 16) * ldc + col0;
#pragma unroll
                for (int bj = 0; bj < 2; ++bj) { const f32x4 v0 = acc[ai][bj][m][0] * sc, v1 = acc[ai][bj][m][1] * sc;
                    v4u w; w.x = cvt_pk_bf16(v0[0], v0[1]); w.y = cvt_pk_bf16(v0[2], v0[3]); w.z = cvt_pk_bf16(v1[0], v1[1]); w.w = cvt_pk_bf16(v1[2], v1[3]);
                    *(v4u*)(rowp + bj * PG_HALF) = w; } }
    }
};
struct EpiBf16 {
    static constexpr bool PERM = true;
    bf16* O; int ldc;
    __device__ __forceinline__ void operator()(const f32x4 (&acc)[2][2][4][2], const Unit& u, int wr, int wc, int fr, int fq) const {
        const int row0 = u.pm * PG_BM + wr * 64 + fr, col0 = u.pn * PG_BM + wc * 32 + 8 * fq;
#pragma unroll
        for (int ai = 0; ai < 2; ++ai)
#pragma unroll
            for (int m = 0; m < 4; ++m) { bf16* rowp = O + (size_t)(row0 + ai * PG_HALF + m * 16) * ldc + col0;
#pragma unroll
                for (int bj = 0; bj < 2; ++bj) { const f32x4 v0 = acc[ai][bj][m][0], v1 = acc[ai][bj][m][1];
                    v4u w; w.x = cvt_pk_bf16(v0[0], v0[1]); w.y = cvt_pk_bf16(v0[2], v0[3]); w.z = cvt_pk_bf16(v1[0], v1[1]); w.w = cvt_pk_bf16(v1[2], v1[3]);
                    *(v4u*)(rowp + bj * PG_HALF) = w; } }
    }
};
template <int NSRC> struct EpiRowScale {
    static constexpr bool PERM = true;
    const bf16* SRC; bf16* O; int ldc; float cscale;
    __device__ __forceinline__ void operator()(const f32x4 (&acc)[2][2][4][2], const Unit& u, int wr, int wc, int fr, int fq) const {
        const int row0 = u.pm * PG_BM + wr * 64 + fr, col0 = u.pn * PG_BM + wc * 32 + 8 * fq;
#pragma unroll
        for (int ai = 0; ai < 2; ++ai)
#pragma unroll
            for (int m = 0; m < 4; ++m) { const int row = row0 + ai * PG_HALF + m * 16;
                const v4u* sp = (const v4u*)(SRC + (size_t)row * 256 + fq * (NSRC / 4)); float ss = 0.f;
#pragma unroll
                for (int i = 0; i < NSRC / 32; ++i) { const v4u w = sp[i];
                    ss += bf_lo(w.x) * bf_lo(w.x) + bf_hi(w.x) * bf_hi(w.x) + bf_lo(w.y) * bf_lo(w.y) + bf_hi(w.y) * bf_hi(w.y) + bf_lo(w.z) * bf_lo(w.z) + bf_hi(w.z) * bf_hi(w.z) + bf_lo(w.w) * bf_lo(w.w) + bf_hi(w.w) * bf_hi(w.w); }
                ss += __shfl_xor(ss, 16); ss += __shfl_xor(ss, 32);
                const float sc = cscale / sqrtf(ss * (1.0f / NSRC) + EPS);
                bf16* rowp = O + (size_t)row * ldc + col0;
#pragma unroll
                for (int bj = 0; bj < 2; ++bj) { const f32x4 v0 = acc[ai][bj][m][0] * sc, v1 = acc[ai][bj][m][1] * sc;
                    v4u w; w.x = cvt_pk_bf16(v0[0], v0[1]); w.y = cvt_pk_bf16(v0[2], v0[3]); w.z = cvt_pk_bf16(v1[0], v1[1]); w.w = cvt_pk_bf16(v1[2], v1[3]);
                    *(v4u*)(rowp + bj * PG_HALF) = w; } }
    }
};
struct EpiF32 {
    static constexpr bool PERM = false;
    float* C; int ldc; const float* resid;
    __device__ __forceinline__ void operator()(const f32x4 (&acc)[2][2][4][2], const Unit& u, int wr, int wc, int fr, int fq) const {
        const int row0 = u.pm * PG_BM + wr * 64 + fr, col0 = u.pn * PG_BM + wc * 32 + 4 * fq;
#pragma unroll
        for (int ai = 0; ai < 2; ++ai)
#pragma unroll
            for (int m = 0; m < 4; ++m) { const size_t off = (size_t)(row0 + ai * PG_HALF + m * 16) * ldc + col0;
#pragma unroll
                for (int bj = 0; bj < 2; ++bj)
#pragma unroll
                    for (int n = 0; n < 2; ++n) { f32x4 v = acc[ai][bj][m][n]; if (resid) v += *(const f32x4*)(resid + off + bj * PG_HALF + n * 16); *(f32x4*)(C + off + bj * PG_HALF + n * 16) = v; } }
    }
};
template <int PASS> struct EpiGate {
    static constexpr bool PERM = true;
    const bf16* G; bf16* MG; int gcol0;
    __device__ __forceinline__ void operator()(const f32x4 (&acc)[2][2][4][2], const Unit& u, int wr, int wc, int fr, int fq) const {
        const int row0 = u.pm * PG_BM + wr * 64 + fr, col0 = u.pn * PG_BM + wc * 32 + 8 * fq;
#pragma unroll
        for (int ai = 0; ai < 2; ++ai)
#pragma unroll
            for (int m = 0; m < 4; ++m) { const int row = row0 + ai * PG_HALF + m * 16;
#pragma unroll
                for (int bj = 0; bj < 2; ++bj) { const int col = col0 + bj * PG_HALF;
                    const v4u gw = *(const v4u*)(G + (size_t)row * 2048 + gcol0 + col);
                    float v[8]; const f32x4 a0 = acc[ai][bj][m][0], a1 = acc[ai][bj][m][1];
                    v[0] = sigmoidf_(bf_lo(gw.x)) * a0[0]; v[1] = sigmoidf_(bf_hi(gw.x)) * a0[1]; v[2] = sigmoidf_(bf_lo(gw.y)) * a0[2]; v[3] = sigmoidf_(bf_hi(gw.y)) * a0[3];
                    v[4] = sigmoidf_(bf_lo(gw.z)) * a1[0]; v[5] = sigmoidf_(bf_hi(gw.z)) * a1[1]; v[6] = sigmoidf_(bf_lo(gw.w)) * a1[2]; v[7] = sigmoidf_(bf_hi(gw.w)) * a1[3];
                    v4u* mp = (v4u*)(MG + (size_t)row * 1024 + col);
                    if (PASS == 1) { const v4u t = *mp; v[0] += bf_lo(t.x); v[1] += bf_hi(t.x); v[2] += bf_lo(t.y); v[3] += bf_hi(t.y); v[4] += bf_lo(t.z); v[5] += bf_hi(t.z); v[6] += bf_lo(t.w); v[7] += bf_hi(t.w); }
                    v4u w; w.x = cvt_pk_bf16(v[0], v[1]); w.y = cvt_pk_bf16(v[2], v[3]); w.z = cvt_pk_bf16(v[4], v[5]); w.w = cvt_pk_bf16(v[6], v[7]);
                    *mp = w; } }
    }
};

struct EpiResid {
    static constexpr bool PERM = false;
    const float* X; float* H; bf16* HB; float* SS;
    __device__ __forceinline__ void operator()(const f32x4 (&acc)[2][2][4][2], const Unit& u, int wr, int wc, int fr, int fq) const {
        const int row0 = u.pm * PG_BM + wr * 64 + fr, col0 = u.pn * PG_BM + wc * 32 + 4 * fq;
#pragma unroll
        for (int ai = 0; ai < 2; ++ai)
#pragma unroll
            for (int m = 0; m < 4; ++m) { const int row = row0 + ai * PG_HALF + m * 16; const size_t off = (size_t)row * 1024 + col0; float ss = 0.f;
#pragma unroll
                for (int bj = 0; bj < 2; ++bj)
#pragma unroll
                    for (int n = 0; n < 2; ++n) { f32x4 v = acc[ai][bj][m][n] + *(const f32x4*)(X + off + bj * PG_HALF + n * 16); *(f32x4*)(H + off + bj * PG_HALF + n * 16) = v;
                        *(v2u*)(HB + off + bj * PG_HALF + n * 16) = (v2u){cvt_pk_bf16(v[0], v[1]), cvt_pk_bf16(v[2], v[3])}; ss += (v[0] * v[0] + v[1] * v[1]) + (v[2] * v[2] + v[3] * v[3]); }
                ss += __shfl_xor(ss, 16); ss += __shfl_xor(ss, 32);
                if (fq == 0) SS[(size_t)row * 16 + u.pn * 4 + wc] = ss; }
    }
};
struct EpiRowSS {
    static constexpr bool PERM = true;
    const float* SS; bf16* O; int ldc;
    __device__ __forceinline__ void operator()(const f32x4 (&acc)[2][2][4][2], const Unit& u, int wr, int wc, int fr, int fq) const {
        const int row0 = u.pm * PG_BM + wr * 64 + fr, col0 = u.pn * PG_BM + wc * 32 + 8 * fq;
#pragma unroll
        for (int ai = 0; ai < 2; ++ai)
#pragma unroll
            for (int m = 0; m < 4; ++m) { const int row = row0 + ai * PG_HALF + m * 16;
                const f32x4* sp = (const f32x4*)(SS + (size_t)row * 16); const f32x4 s0 = sp[0], s1 = sp[1], s2 = sp[2], s3 = sp[3];
                const float ss = (((s0[0] + s0[1]) + (s0[2] + s0[3])) + ((s1[0] + s1[1]) + (s1[2] + s1[3]))) + (((s2[0] + s2[1]) + (s2[2] + s2[3])) + ((s3[0] + s3[1]) + (s3[2] + s3[3])));
                const float sc = 1.0f / sqrtf(ss * (1.0f / DM) + EPS);
                bf16* rowp = O + (size_t)row * ldc + col0;
#pragma unroll
                for (int bj = 0; bj < 2; ++bj) { const f32x4 v0 = acc[ai][bj][m][0] * sc, v1 = acc[ai][bj][m][1] * sc;
                    v4u w; w.x = cvt_pk_bf16(v0[0], v0[1]); w.y = cvt_pk_bf16(v0[2], v0[3]); w.z = cvt_pk_bf16(v1[0], v1[1]); w.w = cvt_pk_bf16(v1[2], v1[3]);
                    *(v4u*)(rowp + bj * PG_HALF) = w; } }
    }
};
namespace att {
constexpr int KB_BYTES = 12288, VB_BYTES = 12288, BUF_BYTES = KB_BYTES + VB_BYTES;
constexpr int OFF_IMP = 2 * BUF_BYTES;
constexpr int OFF_SC = OFF_IMP + 32768;
constexpr int OFF_SEL = OFF_SC + 8192;
constexpr int OFF_END = OFF_SEL + 512;
static_assert(OFF_END <= RING_BYTES, "attention LDS map");

__device__ __forceinline__ int crow(int r, int hi) { return (r & 3) + 8 * (r >> 2) + 4 * hi; }
__device__ __forceinline__ s16x4 vtr(const LAS unsigned char* p) { typedef short v4i16_t __attribute__((ext_vector_type(4))); return __builtin_bit_cast(s16x4, __builtin_amdgcn_ds_read_tr16_b64_v4i16((LAS v4i16_t*)p)); }
__device__ __forceinline__ unsigned cvtpk(float lo, float hi) { typedef float f2 __attribute__((ext_vector_type(2))); typedef __bf16 b2 __attribute__((ext_vector_type(2))); f2 v = {lo, hi}; b2 b = __builtin_convertvector(v, b2); return __builtin_bit_cast(unsigned, b); }
__device__ __forceinline__ float swapmax(float m) { auto rr = __builtin_amdgcn_permlane32_swap(__float_as_uint(m), __float_as_uint(m), false, false); return fmaxf(__uint_as_float(rr[0]), __uint_as_float(rr[1])); }
__device__ __forceinline__ float swapsum(float m) { auto rr = __builtin_amdgcn_permlane32_swap(__float_as_uint(m), __float_as_uint(m), false, false); return __uint_as_float(rr[0]) + __uint_as_float(rr[1]); }

struct Flash { f32x16 o[3]; float m, l; };
__device__ __forceinline__ void flash_init(Flash& f) { f.o[0] = f32x16{}; f.o[1] = f32x16{}; f.o[2] = f32x16{}; f.m = -1e30f; f.l = 0.f; }

template <int NKC>
__device__ __forceinline__ void issue_tile(LAS unsigned char* lds, int buf, const bf16* Kg, int ldk, const bf16* Kpe, const bf16* Vg, int ldv, int wave, int lane) {
    LAS unsigned char* kb = lds + buf * BUF_BYTES; LAS unsigned char* vb = kb + KB_BYTES;
    __builtin_amdgcn_global_load_lds((const unsigned*)(Kg + (size_t)lane * ldk + wave * 8), (LAS unsigned*)(kb + wave * 1024), 16, 0, 0);
    if (NKC == 12) { if (wave < 4) __builtin_amdgcn_global_load_lds((const unsigned*)(Kpe + (size_t)lane * 32 + wave * 8), (LAS unsigned*)(kb + (8 + wave) * 1024), 16, 0, 0); }
    __builtin_amdgcn_global_load_lds((const unsigned*)(Vg + (size_t)(16 * (wave & 3) + (lane >> 2)) * ldv + (wave >> 2) * 32 + (lane & 3) * 8), (LAS unsigned*)(vb + wave * 1024), 16, 0, 0);
}

template <int NKS, int NVB, bool HAS_BIAS>
__device__ __forceinline__ void tile_compute(Flash& f, const LAS unsigned char* kb, const LAS unsigned char* vb, const bf16x8* qr, float slope, float cb,
                                             int lo, int hi_, bool need_mask, int r32, int hh, int lane) {
    f32x16 p0, p1;
    if (HAS_BIAS) {
        const float cb0 = cb + slope * (float)(4 * hh), cb1 = cb0 + slope * 32.f;
#pragma unroll
        for (int r = 0; r < 16; ++r) { const float cr = (float)((r & 3) + 8 * (r >> 2)); p0[r] = __builtin_fmaf(slope, cr, cb0); p1[r] = __builtin_fmaf(slope, cr, cb1); }
    } else { p0 = f32x16{}; p1 = f32x16{}; }
    const LAS unsigned char* kp = kb + hh * 1024 + r32 * 16;
#pragma unroll
    for (int d0 = 0; d0 < NKS; ++d0) {
        const bf16x8 b0 = *(const LAS bf16x8*)(kp + d0 * 2048);
        const bf16x8 b1 = *(const LAS bf16x8*)(kp + d0 * 2048 + 512);
        p0 = __builtin_amdgcn_mfma_f32_32x32x16_bf16(b0, qr[d0], p0, 0, 0, 0);
        p1 = __builtin_amdgcn_mfma_f32_32x32x16_bf16(b1, qr[d0], p1, 0, 0, 0);
    }
    if (need_mask) {
        const int l0 = lo - 4 * hh, h0 = hi_ - 4 * hh;
#pragma unroll
        for (int r = 0; r < 16; ++r) { const int c = (r & 3) + 8 * (r >> 2);
            if (c < l0 || c > h0) p0[r] = -INFINITY;
            if (c + 32 < l0 || c + 32 > h0) p1[r] = -INFINITY; }
    }
    float mt = fmaxf(p0[0], p1[0]);
#pragma unroll
    for (int r = 1; r < 16; ++r) mt = fmaxf(mt, fmaxf(p0[r], p1[r]));
    mt = swapmax(mt);
    const float mn = fmaxf(f.m, mt);
    const float alpha = __builtin_amdgcn_exp2f(f.m - mn);
    f.m = mn;
    float sum = 0.f;
#pragma unroll
    for (int r = 0; r < 16; ++r) { p0[r] = __builtin_amdgcn_exp2f(p0[r] - mn); p1[r] = __builtin_amdgcn_exp2f(p1[r] - mn); sum += p0[r] + p1[r]; }
    f.l = f.l * alpha + sum;
#pragma unroll
    for (int b = 0; b < NVB; ++b)
#pragma unroll
        for (int r = 0; r < 16; ++r) f.o[b][r] *= alpha;
    v4u pw[4];
    pw[0] = (v4u){cvtpk(p0[0], p0[1]), cvtpk(p0[2], p0[3]), cvtpk(p0[4], p0[5]), cvtpk(p0[6], p0[7])};
    pw[1] = (v4u){cvtpk(p0[8], p0[9]), cvtpk(p0[10], p0[11]), cvtpk(p0[12], p0[13]), cvtpk(p0[14], p0[15])};
    pw[2] = (v4u){cvtpk(p1[0], p1[1]), cvtpk(p1[2], p1[3]), cvtpk(p1[4], p1[5]), cvtpk(p1[6], p1[7])};
    pw[3] = (v4u){cvtpk(p1[8], p1[9]), cvtpk(p1[10], p1[11]), cvtpk(p1[12], p1[13]), cvtpk(p1[14], p1[15])};
    const LAS unsigned char* vp = vb + ((lane >> 4) & 1) * 32 + (lane & 3) * 8 + (4 * hh + ((lane & 15) >> 2)) * 64;
#pragma unroll
    for (int b = 0; b < NVB; ++b)
#pragma unroll
        for (int ks = 0; ks < 4; ++ks) {
            const s16x4 vl = vtr(vp + b * 4096 + ks * 1024), vh = vtr(vp + b * 4096 + ks * 1024 + 512);
            const bf16x8 va = (bf16x8){vl[0], vl[1], vl[2], vl[3], vh[0], vh[1], vh[2], vh[3]};
            f.o[b] = __builtin_amdgcn_mfma_f32_32x32x16_bf16(va, __builtin_bit_cast(bf16x8, pw[ks]), f.o[b], 0, 0, 0);
        }
}
__device__ __forceinline__ void flash_finish(Flash& f, int nvb) {
    const float lt = swapsum(f.l); const float inv = lt > 0.f ? 1.0f / lt : 0.f;
#pragma unroll
    for (int b = 0; b < 3; ++b) if (b < nvb) {
#pragma unroll
        for (int r = 0; r < 16; ++r) f.o[b][r] *= inv; }
}

__device__ __forceinline__ void nsa_unit(Frame& F, int b, int g, int qc) {
    int lane = F.lane; asm volatile("" : "+v"(lane));
    LAS unsigned char* lds = F.lds; const int wave = F.wave, r32 = lane & 31, hh = lane >> 5;
    const int head = g * 4 + (wave >> 1);
    const int qloc = 32 * (wave & 1) + r32;
    const int t = 64 * qc + qloc;
    const size_t row = (size_t)b * SEQ + t;
    const bf16* QKV = (const bf16*)(F.ws + WS_QKV); const bf16* MISC = (const bf16*)(F.ws + WS_MISC);
    bf16x8 qr[4];
#pragma unroll
    for (int d0 = 0; d0 < 4; ++d0) qr[d0] = *(const bf16x8*)(QKV + row * 1280 + head * 64 + d0 * 16 + hh * 8);
    const float slope2 = exp2f(-(float)(head + 1)) * LOG2E;
    LAS unsigned* selw = (LAS unsigned*)(lds + OFF_SEL);
    if (F.tid < 80) selw[F.tid] = 0u;
    f32x16 ot0, ot1;
    {
        const bf16* KC = (const bf16*)(F.ws + WS_KC) + (size_t)(b * 2 + g) * 128 * 64; const bf16* VC = (const bf16*)(F.ws + WS_VC) + (size_t)(b * 2 + g) * 128 * 64;
        Flash f; flash_init(f);
        int nmax = (t >= 31) ? ((t - 31) >> 4) : -1; if (nmax > 126) nmax = 126;
        for (int ti = 0; ti < 2; ++ti) {
            issue_tile<8>(lds, ti, KC + (size_t)ti * 64 * 64, 64, nullptr, VC + (size_t)ti * 64 * 64, 64, wave, lane);
            LAS bf16* ov = (LAS bf16*)(lds + ti * BUF_BYTES + KB_BYTES + 2 * 4096);
#pragma unroll
            for (int e = 0; e < 4; ++e) { const int idx = F.tid * 4 + e, nl = idx >> 5, s = idx & 31, n = 64 * ti + nl;
                float v = 0.f; if (s == (n >> 2)) v = ((n & 3) == 3) ? 0.5f : 1.0f; else if (s == (n >> 2) + 1 && (n & 3) == 3) v = 0.5f;
                ov[(nl >> 4) * 512 + (nl & 15) * 32 + s] = (bf16)f2bf(v); }
        }
        __syncthreads();
#pragma unroll 1
        for (int ti = 0; ti < 2; ++ti) {
            const LAS unsigned char* kb = lds + ti * BUF_BYTES;
            tile_compute<4, 3, true>(f, kb, kb + KB_BYTES, qr, 16.f * slope2, 16.f * slope2 * (float)(64 * ti), 0, nmax - 64 * ti, true, r32, hh, lane);
        }
        flash_finish(f, 3);
        LAS float* imp = (LAS float*)(lds + OFF_IMP) + (wave * 32 + r32) * 32;
#pragma unroll
        for (int r = 0; r < 16; ++r) imp[crow(r, hh)] = f.o[2][r];
        const float gc = sigmoidf_(bf2f(MISC[row * 256 + 160 + head]));
        ot0 = f.o[0] * gc; ot1 = f.o[1] * gc;
    }
    __syncthreads();
    {
        LAS float* IMP = (LAS float*)(lds + OFF_IMP); LAS float* SC = (LAS float*)(lds + OFF_SC);
        const int q = F.tid >> 3, s4 = (F.tid & 7) * 4;
#pragma unroll
        for (int e = 0; e < 4; ++e) { const int s = s4 + e; float v = 0.f;
#pragma unroll
            for (int h4 = 0; h4 < 4; ++h4) v += IMP[((2 * h4 + (q >> 5)) * 32 + (q & 31)) * 32 + s];
            const bool causal = s <= qc, forced = causal && (s == 0 || s + 2 > qc);
            SC[q * 32 + s] = causal ? (v + (forced ? 1e4f : 0.f)) : -1e30f; }
        __syncthreads();
        float sc[32];
#pragma unroll
        for (int s = 0; s < 32; ++s) sc[s] = SC[q * 32 + s];
        unsigned bits = 0u;
#pragma unroll
        for (int e = 0; e < 4; ++e) { const int s = s4 + e; const float me = SC[q * 32 + s]; int rank = 0;
#pragma unroll
            for (int s2 = 0; s2 < 32; ++s2) rank += (sc[s2] > me || (sc[s2] == me && s2 < s)) ? 1 : 0;
            if (s <= qc && rank < 16) bits |= 1u << s; }
        atomicOr((unsigned*)&selw[q], bits); atomicOr((unsigned*)&selw[64], bits);
    }
    __syncthreads();
    const unsigned mymask = selw[qloc], anymask = selw[64];
    {
        const bf16* Kg = QKV + (size_t)b * SEQ * 1280 + 768 + g * 64; const bf16* Vg = QKV + (size_t)b * SEQ * 1280 + 896 + g * 64;
        Flash f; flash_init(f);
        unsigned rem = anymask; int buf = 0;
        { const int j0 = __builtin_ctz(rem); issue_tile<8>(lds, 0, Kg + (size_t)j0 * 64 * 1280, 1280, nullptr, Vg + (size_t)j0 * 64 * 1280, 1280, wave, lane); }
        while (rem) {
            const int j = __builtin_ctz(rem); rem &= rem - 1;
            __syncthreads();
            if (rem) { const int jn = __builtin_ctz(rem); issue_tile<8>(lds, buf ^ 1, Kg + (size_t)jn * 64 * 1280, 1280, nullptr, Vg + (size_t)jn * 64 * 1280, 1280, wave, lane); }
            const bool sel = (mymask >> j) & 1u;
            const int hi_ = sel ? ((j == qc) ? (t - 64 * j) : 63) : -1;
            const bool need = (j == qc) || !__all(sel);
            const LAS unsigned char* kb = lds + buf * BUF_BYTES;
            tile_compute<4, 2, true>(f, kb, kb + KB_BYTES, qr, slope2, slope2 * (float)(64 * j), 0, hi_, need, r32, hh, lane);
            buf ^= 1;
        }
        flash_finish(f, 2);
        const float gs = sigmoidf_(bf2f(MISC[row * 256 + 160 + 8 + head]));
        ot0 += f.o[0] * gs; ot1 += f.o[1] * gs;
        __syncthreads();
    }
    {
        const bf16* Kg = QKV + (size_t)b * SEQ * 1280 + 1024 + g * 64; const bf16* Vg = QKV + (size_t)b * SEQ * 1280 + 1152 + g * 64;
        Flash f; flash_init(f);
        const int j0 = qc >= 8 ? qc - 8 : 0; int buf = 0;
        issue_tile<8>(lds, 0, Kg + (size_t)j0 * 64 * 1280, 1280, nullptr, Vg + (size_t)j0 * 64 * 1280, 1280, wave, lane);
        for (int j = j0; j <= qc; ++j) {
            __syncthreads();
            if (j < qc) issue_tile<8>(lds, buf ^ 1, Kg + (size_t)(j + 1) * 64 * 1280, 1280, nullptr, Vg + (size_t)(j + 1) * 64 * 1280, 1280, wave, lane);
            int lo = t - 511 - 64 * j; if (lo < 0) lo = 0; int hi_ = t - 64 * j; if (hi_ > 63) hi_ = 63;
            const bool need = (j == qc) || (j + 8 == qc);
            const LAS unsigned char* kb = lds + buf * BUF_BYTES;
            tile_compute<4, 2, true>(f, kb, kb + KB_BYTES, qr, slope2, slope2 * (float)(64 * j), lo, hi_, need, r32, hh, lane);
            buf ^= 1;
        }
        flash_finish(f, 2);
        const float gw = sigmoidf_(bf2f(MISC[row * 256 + 160 + 16 + head]));
        ot0 += f.o[0] * gw; ot1 += f.o[1] * gw;
        __syncthreads();
    }
    { bf16* op = (bf16*)(F.ws + WS_OCAT) + row * 1024 + head * 64 + 4 * hh;
#pragma unroll
      for (int k = 0; k < 4; ++k) {
          *(v2u*)(op + 8 * k) = (v2u){cvtpk(ot0[4 * k], ot0[4 * k + 1]), cvtpk(ot0[4 * k + 2], ot0[4 * k + 3])};
          *(v2u*)(op + 32 + 8 * k) = (v2u){cvtpk(ot1[4 * k], ot1[4 * k + 1]), cvtpk(ot1[4 * k + 2], ot1[4 * k + 3])}; } }
}

__device__ __forceinline__ void mla_unit(Frame& F, int b, int h, int qb) {
    int lane = F.lane; asm volatile("" : "+v"(lane));
    LAS unsigned char* lds = F.lds; const int wave = F.wave, r32 = lane & 31, hh = lane >> 5;
    const int t = 256 * qb + 32 * wave + r32;
    const size_t row = (size_t)b * SEQ + t;
    const bf16* MQ = (const bf16*)(F.ws + WS_MLAQ); const bf16* MKV = (const bf16*)(F.ws + WS_MLAKV); const bf16* KPE = (const bf16*)(F.ws + WS_KPE);
    bf16x8 qr[6];
#pragma unroll
    for (int d0 = 0; d0 < 6; ++d0) qr[d0] = *(const bf16x8*)(MQ + row * 768 + h * 96 + d0 * 16 + hh * 8);
    {
        const float pos = (float)F.pos[row];
        v4u a = __builtin_bit_cast(v4u, qr[4]), c = __builtin_bit_cast(v4u, qr[5]);
        float x1[8], x2[8];
        x1[0] = bf_lo(a.x); x1[1] = bf_hi(a.x); x1[2] = bf_lo(a.y); x1[3] = bf_hi(a.y); x1[4] = bf_lo(a.z); x1[5] = bf_hi(a.z); x1[6] = bf_lo(a.w); x1[7] = bf_hi(a.w);
        x2[0] = bf_lo(c.x); x2[1] = bf_hi(c.x); x2[2] = bf_lo(c.y); x2[3] = bf_hi(c.y); x2[4] = bf_lo(c.z); x2[5] = bf_hi(c.z); x2[6] = bf_lo(c.w); x2[7] = bf_hi(c.w);
        float y1[8], y2[8];
#pragma unroll
        for (int j = 0; j < 8; ++j) { const float inv = powf(10000.0f, -(float)(2 * (8 * hh + j)) / 32.0f); const float ang = pos * inv; const float cs = cosf(ang), sn = sinf(ang);
            y1[j] = x1[j] * cs - x2[j] * sn; y2[j] = x1[j] * sn + x2[j] * cs; }
        a = (v4u){cvtpk(y1[0], y1[1]), cvtpk(y1[2], y1[3]), cvtpk(y1[4], y1[5]), cvtpk(y1[6], y1[7])};
        c = (v4u){cvtpk(y2[0], y2[1]), cvtpk(y2[2], y2[3]), cvtpk(y2[4], y2[5]), cvtpk(y2[6], y2[7])};
        qr[4] = __builtin_bit_cast(bf16x8, a); qr[5] = __builtin_bit_cast(bf16x8, c);
    }
    const bf16* Kg = MKV + (size_t)b * SEQ * 1024 + h * 128; const bf16* Vg = Kg + 64; const bf16* Pg = KPE + (size_t)b * SEQ * 32;
    Flash f; flash_init(f);
    const int NT = 4 * qb + 4; int buf = 0;
    const int tmax_w = 256 * qb + 32 * wave + 31;
    issue_tile<12>(lds, 0, Kg, 1024, Pg, Vg, 1024, wave, lane);
    for (int j = 0; j < NT; ++j) {
        __syncthreads();
        if (j + 1 < NT) issue_tile<12>(lds, buf ^ 1, Kg + (size_t)(j + 1) * 64 * 1024, 1024, Pg + (size_t)(j + 1) * 64 * 32, Vg + (size_t)(j + 1) * 64 * 1024, 1024, wave, lane);
        if (64 * j <= tmax_w) {
            int hi_ = t - 64 * j; if (hi_ > 63) hi_ = 63;
            const bool need = (64 * j + 63 > 256 * qb + 32 * wave);
            const LAS unsigned char* kb = lds + buf * BUF_BYTES;
            tile_compute<6, 2, false>(f, kb, kb + KB_BYTES, qr, 0.f, 0.f, 0, hi_, need, r32, hh, lane);
        }
        buf ^= 1;
    }
    flash_finish(f, 2);
    __syncthreads();
    { bf16* op = (bf16*)(F.ws + WS_OCAT) + row * 1024 + 512 + h * 64 + 4 * hh;
#pragma unroll
      for (int k = 0; k < 4; ++k) {
          *(v2u*)(op + 8 * k) = (v2u){cvtpk(f.o[0][4 * k], f.o[0][4 * k + 1]), cvtpk(f.o[0][4 * k + 2], f.o[0][4 * k + 3])};
          *(v2u*)(op + 32 + 8 * k) = (v2u){cvtpk(f.o[1][4 * k], f.o[1][4 * k + 1]), cvtpk(f.o[1][4 * k + 2], f.o[1][4 * k + 3])}; } }
}

__device__ __forceinline__ void nsa_loop(Frame& F) {
#pragma unroll 1
    for (int c = F.bid; c < 256; c += F.G) { const int bg = c >> 4, p = c & 15;
#pragma unroll 1
        for (int i = 0; i < 2; ++i) nsa_unit(F, bg >> 1, bg & 1, i ? p : 31 - p); }
}
__device__ __forceinline__ void mla_loop(Frame& F) {
#pragma unroll 1
    for (int c = F.bid; c < 256; c += F.G) { const int bh = c >> 2, p = c & 3;
#pragma unroll 1
        for (int i = 0; i < 2; ++i) mla_unit(F, bh >> 3, bh & 7, i ? p : 7 - p); }
}
}
#define NET_SORT16(K) do { CE(K[0], K[1]); CE(K[2], K[3]); CE(K[0], K[2]); CE(K[1], K[3]); CE(K[1], K[2]); CE(K[4], K[5]); CE(K[6], K[7]); CE(K[4], K[6]); CE(K[5], K[7]); CE(K[5], K[6]); CE(K[0], K[4]); CE(K[2], K[6]); CE(K[2], K[4]); CE(K[1], K[5]); CE(K[3], K[7]); CE(K[3], K[5]); CE(K[1], K[2]); CE(K[3], K[4]); CE(K[5], K[6]); CE(K[8], K[9]); CE(K[10], K[11]); CE(K[8], K[10]); CE(K[9], K[11]); CE(K[9], K[10]); CE(K[12], K[13]); CE(K[14], K[15]); CE(K[12], K[14]); CE(K[13], K[15]); CE(K[13], K[14]); CE(K[8], K[12]); CE(K[10], K[14]); CE(K[10], K[12]); CE(K[9], K[13]); CE(K[11], K[15]); CE(K[11], K[13]); CE(K[9], K[10]); CE(K[11], K[12]); CE(K[13], K[14]); CE(K[0], K[8]); CE(K[4], K[12]); CE(K[4], K[8]); CE(K[2], K[10]); CE(K[6], K[14]); CE(K[6], K[10]); CE(K[2], K[4]); CE(K[6], K[8]); CE(K[10], K[12]); CE(K[1], K[9]); CE(K[5], K[13]); CE(K[5], K[9]); CE(K[3], K[11]); CE(K[7], K[15]); CE(K[7], K[11]); CE(K[3], K[5]); CE(K[7], K[9]); CE(K[11], K[13]); CE(K[1], K[2]); CE(K[3], K[4]); CE(K[5], K[6]); CE(K[7], K[8]); CE(K[9], K[10]); CE(K[11], K[12]); CE(K[13], K[14]); } while (0)
#define NET_BMERGE16(K) do { CE(K[0], K[8]); CE(K[1], K[9]); CE(K[2], K[10]); CE(K[3], K[11]); CE(K[4], K[12]); CE(K[5], K[13]); CE(K[6], K[14]); CE(K[7], K[15]); CE(K[0], K[4]); CE(K[1], K[5]); CE(K[2], K[6]); CE(K[3], K[7]); CE(K[8], K[12]); CE(K[9], K[13]); CE(K[10], K[14]); CE(K[11], K[15]); CE(K[0], K[2]); CE(K[1], K[3]); CE(K[4], K[6]); CE(K[5], K[7]); CE(K[8], K[10]); CE(K[9], K[11]); CE(K[12], K[14]); CE(K[13], K[15]); CE(K[0], K[1]); CE(K[2], K[3]); CE(K[4], K[5]); CE(K[6], K[7]); CE(K[8], K[9]); CE(K[10], K[11]); CE(K[12], K[13]); CE(K[14], K[15]); } while (0)
__device__ __forceinline__ void kpe_pass(Frame& F) {
    const bf16* MISC = (const bf16*)(F.ws + WS_MISC); bf16* KPE = (bf16*)(F.ws + WS_KPE);
    const int gt = F.bid * NTHREADS + F.tid, NGT = F.G * NTHREADS;
    for (int it = gt; it < MTOK * 16; it += NGT) { const int t = it >> 4, i = it & 15;
        const float x1 = bf2f(MISC[(size_t)t * 256 + 128 + i]), x2 = bf2f(MISC[(size_t)t * 256 + 144 + i]);
        const float inv = powf(10000.0f, -(float)(2 * i) / 32.0f); const float ang = (float)F.pos[t] * inv; const float cs = cosf(ang), sn = sinf(ang);
        KPE[(size_t)t * 32 + i] = (bf16)f2bf(x1 * cs - x2 * sn); KPE[(size_t)t * 32 + 16 + i] = (bf16)f2bf(x1 * sn + x2 * cs); }
}
__device__ __forceinline__ void cmp_finalize(Frame& F) {
    const int gw = F.bid * NWAVES + F.wave, NGW = F.G * NWAVES, lane = F.lane;
    LAS float* hid = (LAS float*)(F.lds + F.wave * 1024);
    for (int it = gw; it < 2 * 16 * 128; it += NGW) {
        const int kv = it >> 11, bg = (it >> 7) & 15, n = it & 127;
        bf16* dst = (bf16*)(F.ws + (kv ? WS_VC : WS_KC)) + ((size_t)bg * 128 + n) * 64;
        if (n == 127) { dst[lane] = 0; continue; }
        const float* U = (const float*)(F.ws + WS_USLAB) + (size_t)kv * 4 * 2048 * 256 + (size_t)(bg * 128 + n) * 256; const float* c1 = (const float*)(F.ws + (kv ? WS_C1V : WS_C1K));
        const float* w2 = F.in[kv ? I_CW2V : I_CW2K];
        float a0 = c1[lane], a1 = c1[64 + lane];
#pragma unroll
        for (int s = 0; s < 4; ++s) { const float* Us = U + (size_t)s * 2048 * 256; a0 += Us[lane] + Us[256 + 128 + lane]; a1 += Us[64 + lane] + Us[256 + 192 + lane]; }
        hid[lane] = gelu_tanh(a0); hid[64 + lane] = gelu_tanh(a1);
        asm volatile("s_waitcnt lgkmcnt(0)" ::: "memory");
        float s = 0.f;
#pragma unroll 8
        for (int i = 0; i < 128; ++i) s += hid[i] * w2[i * 64 + lane];
        dst[lane] = (bf16)f2bf(s);
        asm volatile("s_waitcnt lgkmcnt(0)" ::: "memory");
    }
}
__device__ __forceinline__ void quant_table(Frame& F, const float* src, unsigned char* dst, float* steps) {
    const int gw = F.bid * NWAVES + F.wave, NGW = F.G * NWAVES, lane = F.lane;
    for (int e = gw; e < 16384; e += NGW) {
        const f32x4* sp = (const f32x4*)(src + (size_t)e * 1024) + 4 * lane;
        f32x4 v[4]; float mx = 0.f;
#pragma unroll
        for (int j = 0; j < 4; ++j) { v[j] = sp[j]; mx = fmaxf(mx, fmaxf(fmaxf(fabsf(v[j].x), fabsf(v[j].y)), fmaxf(fabsf(v[j].z), fabsf(v[j].w)))); }
#pragma unroll
        for (int o = 1; o < 64; o <<= 1) mx = fmaxf(mx, __shfl_xor(mx, o));
        const float step = mx > 0.f ? mx * (1.0f / 127.0f) : 1.0f, inv = 1.0f / step;
        v4u w;
#pragma unroll
        for (int j = 0; j < 4; ++j) { const unsigned b0 = (unsigned)(int)(rintf(v[j].x * inv) + 128.f), b1 = (unsigned)(int)(rintf(v[j].y * inv) + 128.f), b2 = (unsigned)(int)(rintf(v[j].z * inv) + 128.f), b3 = (unsigned)(int)(rintf(v[j].w * inv) + 128.f);
            w[j] = b0 | (b1 << 8) | (b2 << 16) | (b3 << 24); }
        ((v4u*)(dst + (size_t)e * 1024))[lane] = w;
        if (lane == 0) steps[e] = step;
    }
}
namespace peer {
constexpr int TOK = 32;
constexpr int OFF_LIST = 0;
constexpr int OFF_ROUTE = 65536;
struct Ent { float v; unsigned k; };
__device__ __forceinline__ unsigned ordkey(float f) { const unsigned u = __float_as_uint(f); return u ^ ((u >> 31) ? 0xffffffffu : 0x80000000u); }
__device__ __forceinline__ float ordinv(unsigned k) { return __uint_as_float(k ^ ((k >> 31) ? 0x80000000u : 0xffffffffu)); }
__device__ __forceinline__ void swap2(int x, int& lo, int& hi) { auto rr = __builtin_amdgcn_permlane32_swap((unsigned)x, (unsigned)x, false, false); lo = (int)rr[0]; hi = (int)rr[1]; }

#define CE(a, b) do { const unsigned x_ = (a) > (b) ? (a) : (b), y_ = (a) > (b) ? (b) : (a); (a) = x_; (b) = y_; } while (0)
__device__ __forceinline__ void merge_top16(unsigned (&a)[16], const unsigned (&b)[16]) {
#pragma unroll
    for (int i = 0; i < 16; ++i) a[i] = a[i] > b[15 - i] ? a[i] : b[15 - i];
    NET_BMERGE16(a);
}
__device__ __forceinline__ void top16_of64(unsigned (&w)[4][16]) {
    NET_SORT16(w[0]); NET_SORT16(w[1]); NET_SORT16(w[2]); NET_SORT16(w[3]);
    merge_top16(w[0], w[1]); merge_top16(w[2], w[3]); merge_top16(w[0], w[2]);
}

#define PEER_CANDS(X) X(0,0) X(0,1) X(0,2) X(0,3) X(0,4) X(0,5) X(0,6) X(0,7) X(0,8) X(0,9) X(0,10) X(0,11) X(0,12) X(0,13) X(0,14) X(0,15) \
    X(1,0) X(1,1) X(1,2) X(1,3) X(1,4) X(1,5) X(1,6) X(1,7) X(2,0) X(2,1) X(2,2) X(2,3) X(2,4) X(3,0) X(3,1) X(3,2) X(3,3) X(4,0) X(4,1) X(4,2) \
    X(5,0) X(5,1) X(6,0) X(6,1) X(7,0) X(7,1) X(8,0) X(9,0) X(10,0) X(11,0) X(12,0) X(13,0) X(14,0) X(15,0)

__device__ __forceinline__ void route_task(Frame& F, int tok0) {
    int lane = F.lane; asm volatile("" : "+v"(lane));
    const int wave = F.wave, r32 = lane & 31, hh = lane >> 5;
    const bf16* QP = (const bf16*)(F.ws + WS_QP);
    const size_t row = (size_t)tok0 + r32;
    LAS Ent* LIST = (LAS Ent*)(F.lds + OFF_LIST) + (size_t)wave * 2 * TOK * 16;
#pragma unroll 1
    for (int half = 0; half < 2; ++half) {
        const bf16* SK = (const bf16*)(F.ws + (half ? WS_SK2 : WS_SK1));
        bf16x8 qf[8];
#pragma unroll
        for (int d0 = 0; d0 < 8; ++d0) qf[d0] = *(const bf16x8*)(QP + row * 2048 + wave * 256 + half * 128 + d0 * 16 + hh * 8);
        unsigned u[4][16];
#pragma unroll
        for (int kb = 0; kb < 4; ++kb) { f32x16 p = f32x16{};
#pragma unroll
            for (int d0 = 0; d0 < 8; ++d0) { const bf16x8 a = *(const bf16x8*)(SK + (size_t)(32 * kb + r32) * 128 + d0 * 16 + hh * 8);
                p = __builtin_amdgcn_mfma_f32_32x32x16_bf16(a, qf[d0], p, 0, 0, 0); }
#pragma unroll
            for (int r = 0; r < 16; ++r) u[kb][r] = ordkey(p[r]);
            asm volatile("" ::: "memory"); __builtin_amdgcn_sched_barrier(0); }
        unsigned prefix;
        { unsigned w[4][16];
#pragma unroll
          for (int kb = 0; kb < 4; ++kb)
#pragma unroll
              for (int r = 0; r < 16; ++r) w[kb][r] = u[kb][r];
          top16_of64(w);
          unsigned lo16[16], hi16[16];
#pragma unroll
          for (int i = 0; i < 16; ++i) { auto rr = __builtin_amdgcn_permlane32_swap(w[0][i], w[0][i], false, false); lo16[i] = rr[0]; hi16[i] = rr[1]; }
          unsigned t = 0xffffffffu;
#pragma unroll
          for (int i = 0; i < 16; ++i) { const unsigned m = lo16[i] > hi16[15 - i] ? lo16[i] : hi16[15 - i]; t = m < t ? m : t; }
          prefix = t; }
        int cgt = 0, ceq = 0;
#pragma unroll
        for (int kb = 0; kb < 4; ++kb)
#pragma unroll
            for (int r = 0; r < 16; ++r) { cgt += (u[kb][r] > prefix) ? 1 : 0; ceq += (u[kb][r] == prefix) ? 1 : 0; }
        int g0, g1, e0, e1; swap2(cgt, g0, g1); swap2(ceq, e0, e1);
        const int need = 16 - (g0 + g1);
        const int take0 = e0 < need ? e0 : need; const int take1 = (need - take0) < e1 ? (need - take0) : e1;
        int slot = hh ? (g0 + take0) : 0; int eq_left = hh ? take1 : take0;
        LAS Ent* L = LIST + ((size_t)half * TOK + r32) * 16;
#pragma unroll
        for (int kb = 0; kb < 4; ++kb)
#pragma unroll
            for (int r = 0; r < 16; ++r) { const unsigned uu = u[kb][r]; const int eq = ((uu == prefix) & (eq_left > 0)) ? 1 : 0; const int tk = (uu > prefix) ? 1 : eq;
                if (tk & (slot < 16)) { L[slot].v = ordinv(uu); L[slot].k = (unsigned)(32 * kb + (r & 3) + 8 * (r >> 2) + 4 * hh); }
                slot += tk; eq_left -= eq; }
    }
    asm volatile("s_waitcnt lgkmcnt(0)" ::: "memory");
    {
        LAS Ent* L = LIST + ((size_t)hh * TOK + r32) * 16;
        float v[16]; unsigned k[16];
#pragma unroll
        for (int a = 0; a < 16; ++a) { v[a] = L[a].v; k[a] = L[a].k; }
        asm volatile("s_waitcnt lgkmcnt(0)" ::: "memory");
#pragma unroll
        for (int a = 0; a < 16; ++a) { int rank = 0;
#pragma unroll
            for (int a2 = 0; a2 < 16; ++a2) rank += (v[a2] > v[a] || (v[a2] == v[a] && a2 < a)) ? 1 : 0;
            L[rank].v = v[a]; L[rank].k = k[a]; }
    }
    asm volatile("s_waitcnt lgkmcnt(0)" ::: "memory");
    {
        const LAS Ent* L1 = LIST + ((size_t)0 * TOK + r32) * 16; const LAS Ent* L2 = LIST + ((size_t)1 * TOK + r32) * 16;
        float v1[16], v2[16];
#pragma unroll
        for (int a = 0; a < 16; ++a) { v1[a] = L1[a].v; v2[a] = L2[a].v; }
        unsigned uc[50]; { int ci = 0;
#define X(a, b) uc[ci++] = ordkey(v1[a] + v2[b]);
        PEER_CANDS(X)
#undef X
        }
        const float cmax = v1[0] + v2[0];
        unsigned prefix;
        { unsigned w[4][16];
#pragma unroll
          for (int i = 0; i < 64; ++i) w[i >> 4][i & 15] = i < 50 ? uc[i] : 0u;
          top16_of64(w);
          prefix = w[0][15]; }
        int cgt = 0; float gsum = 0.f;
#pragma unroll
        for (int i = 0; i < 50; ++i) cgt += (uc[i] > prefix) ? 1 : 0;
        int eq_left = 16 - cgt;
        unsigned long long selm = 0ull;
#pragma unroll
        for (int i = 0; i < 50; ++i) { const int eq = ((uc[i] == prefix) & (eq_left > 0)) ? 1 : 0; const int sl = (uc[i] > prefix) ? 1 : eq; eq_left -= eq;
            selm |= (unsigned long long)sl << i; gsum += sl ? __expf(ordinv(uc[i]) - cmax) : 0.f; }
        const float ginv = 1.0f / gsum;
        LAS Ent* R = (LAS Ent*)(F.lds + OFF_ROUTE) + ((size_t)wave * TOK + r32) * 16;
        if (hh == 0) { int i = 0, slot = 0;
#define X(a, b) { const int sl = (int)((selm >> i) & 1ull); if (sl & (slot < 16)) { R[slot].k = L1[a].k * 128u + L2[b].k; R[slot].v = __expf(ordinv(uc[i]) - cmax) * ginv; } slot += sl; ++i; }
            PEER_CANDS(X)
#undef X
        }
    }
}

__device__ __forceinline__ float ub0(unsigned w) { return (float)(w & 0xffu); }
__device__ __forceinline__ float ub1(unsigned w) { return (float)((w >> 8) & 0xffu); }
__device__ __forceinline__ float ub2(unsigned w) { return (float)((w >> 16) & 0xffu); }
__device__ __forceinline__ float ub3(unsigned w) { return (float)(w >> 24); }
__device__ __forceinline__ void gather_token(Frame& F, int tl, size_t row, bool wr) {
    int lane = F.lane; asm volatile("" : "+v"(lane));
    const unsigned char* EXPD = F.ws + WS_EXPD; const unsigned char* EXPU = F.ws + WS_EXPU;
    const float* SD = (const float*)(F.ws + WS_EXPD_SC); const float* SU = (const float*)(F.ws + WS_EXPU_SC);
    float hv[16], xh[16], y[16]; float sx;
    { const f32x4* hp = (const f32x4*)(F.out + row * DM) + 4 * lane; const f32x4* gp = (const f32x4*)F.in[I_N2G] + 4 * lane;
      float ss = 0.f;
#pragma unroll
      for (int c = 0; c < 4; ++c) { const f32x4 v = hp[c]; hv[4 * c] = v.x; hv[4 * c + 1] = v.y; hv[4 * c + 2] = v.z; hv[4 * c + 3] = v.w; ss += (v.x * v.x + v.y * v.y) + (v.z * v.z + v.w * v.w); }
      const float r = 1.0f / sqrtf(wave_sum(ss) * (1.f / DM) + EPS);
      float s1 = 0.f;
#pragma unroll
      for (int c = 0; c < 4; ++c) { const f32x4 g = gp[c]; xh[4 * c] = hv[4 * c] * r * g.x; xh[4 * c + 1] = hv[4 * c + 1] * r * g.y; xh[4 * c + 2] = hv[4 * c + 2] * r * g.z; xh[4 * c + 3] = hv[4 * c + 3] * r * g.w;
          s1 += (xh[4 * c] + xh[4 * c + 1]) + (xh[4 * c + 2] + xh[4 * c + 3]); }
      sx = 128.f * wave_sum(s1);
    }
#pragma unroll
    for (int i = 0; i < 16; ++i) y[i] = 0.f;
    float ysub = 0.f;
    const LAS Ent* R = (const LAS Ent*)(F.lds + OFF_ROUTE);
#pragma unroll 1
    for (int grp = 0; grp < 32; ++grp) {
        const int head = grp >> 2, k0 = (grp & 3) * 4;
        unsigned ex[4]; float gt[4]; v4u dn[4], up[4]; float sd[4], su[4];
#pragma unroll
        for (int k = 0; k < 4; ++k) { const LAS Ent* en = R + ((size_t)head * TOK + tl) * 16 + k0 + k; ex[k] = (unsigned)__builtin_amdgcn_readfirstlane((int)en->k); gt[k] = __uint_as_float((unsigned)__builtin_amdgcn_readfirstlane((int)__float_as_uint(en->v))); }
#pragma unroll
        for (int k = 0; k < 4; ++k) { dn[k] = ((const v4u*)(EXPD + (size_t)ex[k] * 1024))[lane]; up[k] = ((const v4u*)(EXPU + (size_t)ex[k] * 1024))[lane]; sd[k] = SD[ex[k]]; su[k] = SU[ex[k]]; }
        float dt[4];
#pragma unroll
        for (int k = 0; k < 4; ++k) { float s = 0.f;
#pragma unroll
            for (int c = 0; c < 4; ++c) { const unsigned w = dn[k][c]; s += ub0(w) * xh[4 * c] + ub1(w) * xh[4 * c + 1] + ub2(w) * xh[4 * c + 2] + ub3(w) * xh[4 * c + 3]; }
            dt[k] = s; }
        { const bool up32 = lane & 32; float keep0 = up32 ? dt[1] : dt[0], send0 = up32 ? dt[0] : dt[1]; keep0 += __shfl_xor(send0, 32);
          float keep1 = up32 ? dt[3] : dt[2], send1 = up32 ? dt[2] : dt[3]; keep1 += __shfl_xor(send1, 32);
          const bool up16 = lane & 16; float keep = up16 ? keep1 : keep0, send = up16 ? keep0 : keep1; keep += __shfl_xor(send, 16);
          keep += __shfl_xor(keep, 8); keep += __shfl_xor(keep, 4); keep += __shfl_xor(keep, 2); keep += __shfl_xor(keep, 1);
          dt[0] = __shfl(keep, 0); dt[2] = __shfl(keep, 16); dt[1] = __shfl(keep, 32); dt[3] = __shfl(keep, 48); }
#pragma unroll
        for (int k = 0; k < 4; ++k) { const float hk = sd[k] * (dt[k] - sx); const float wk = gt[k] * gelu_tanh(hk) * su[k]; ysub += wk;
#pragma unroll
            for (int c = 0; c < 4; ++c) { const unsigned w = up[k][c]; y[4 * c] += wk * ub0(w); y[4 * c + 1] += wk * ub1(w); y[4 * c + 2] += wk * ub2(w); y[4 * c + 3] += wk * ub3(w); } }
    }
    { float ss = 0.f; const float ys = 128.f * ysub;
#pragma unroll
      for (int i = 0; i < 16; ++i) { hv[i] += y[i] - ys; ss += hv[i] * hv[i]; }
      const float r = 1.0f / sqrtf(wave_sum(ss) * (1.f / DM) + EPS);
      f32x4* op = (f32x4*)(F.out + row * DM) + 4 * lane; const f32x4* gp = (const f32x4*)F.in[I_NFG] + 4 * lane;
#pragma unroll
      for (int c = 0; c < 4; ++c) { const f32x4 g = gp[c];
          if (wr) op[c] = (f32x4){hv[4 * c] * r * g.x, hv[4 * c + 1] * r * g.y, hv[4 * c + 2] * r * g.z, hv[4 * c + 3] * r * g.w}; } }
}

__device__ __forceinline__ void peer_phase(Frame& F, bool never) {
    for (int task = F.bid; task < MTOK / TOK; task += F.G) {
        const int tok0 = task * TOK;
#pragma unroll 1
        for (int rep_ = 0; rep_ < (((DBL_MASK >> 12) & 1) ? 2 : 1); ++rep_) { route_task(F, tok0); __syncthreads(); }
#pragma unroll 1
        for (int rep_ = (((DBL_MASK >> 13) & 1) ? 0 : 1); rep_ < 2; ++rep_)
            for (int i = 0; i < TOK / NWAVES; ++i) { const int tl = F.wave * (TOK / NWAVES) + i; gather_token(F, tl, (size_t)tok0 + tl, rep_ == 1 || never); }
        __syncthreads();
    }
}
}
#define XB_TMO      128
#define XB_XCNT(j)  (256  + 64 * (j))
#define XB_XSUB(j)  (1280 + 64 * (j))
#define XB_XGEN(j)  (2304 + 64 * (j))
#define XB_TOP      3328
#define XB_TOPGEN   3392
#define XCD_BAR_WORDS 3456
#define XB_SPIN_CAP (1u << 18)

__device__ __forceinline__ unsigned xb_ld(unsigned* p)              { return __hip_atomic_load(p, __ATOMIC_RELAXED, __HIP_MEMORY_SCOPE_AGENT); }
__device__ __forceinline__ unsigned xb_add(unsigned* p, unsigned v) { return __hip_atomic_fetch_add(p, v, __ATOMIC_RELAXED, __HIP_MEMORY_SCOPE_AGENT); }
__device__ __forceinline__ unsigned xb_xcc_id() { return (unsigned)__builtin_amdgcn_s_getreg((3 << 11) | 20) & 0xFu; }
#define XB_SPIN(cond, bar) do { unsigned _sp = 0; while (cond) { __builtin_amdgcn_s_sleep(1); \
    if ((++_sp & 255u) == 0u) { if (xb_ld(&(bar)[XB_TMO])) break; if (_sp > XB_SPIN_CAP) { atomicAdd(&(bar)[XB_TMO], 1u); break; } } } } while (0)

struct XcdBarrier {
    unsigned* bar; unsigned x;
    volatile LAS unsigned* st;
};

__device__ __forceinline__ XcdBarrier xcd_barrier_post(unsigned* bar, volatile LAS unsigned* st) {
    XcdBarrier b; b.bar = bar; b.x = xb_xcc_id(); b.st = st;
    if (threadIdx.x == 0) (void)xb_add(&bar[XB_XCNT(b.x)], 1u);
    return b;
}
__device__ __forceinline__ void xcd_barrier_complete(unsigned* bar, unsigned x, unsigned& nloc, unsigned& nx) {
    const unsigned G = gridDim.x * gridDim.y * gridDim.z;
    unsigned sum, cnt, mine, sp = 0u;
    for (;;) {
        sum = 0u; cnt = 0u; mine = 0u;
#pragma unroll
        for (unsigned j = 0; j < 16; ++j) { const unsigned c = xb_ld(&bar[XB_XCNT(j)]); sum += c; cnt += (c > 0u) ? 1u : 0u; mine = (j == x) ? c : mine; }
        if (sum == G) break;
        __builtin_amdgcn_s_sleep(1);
        if ((++sp & 255u) == 0u) { if (xb_ld(&bar[XB_TMO])) break; if (sp > XB_SPIN_CAP) { atomicAdd(&bar[XB_TMO], 1u); break; } }
    }
    nloc = mine > 0u ? mine : 1u; nx = cnt > 0u ? cnt : 1u;
}

__device__ __forceinline__ void xcd_barrier(const XcdBarrier& b) {
    asm volatile("s_waitcnt vmcnt(0)" ::: "memory");
    __syncthreads();
    if (threadIdx.x == 0) {
        unsigned* bar = b.bar;
        __builtin_amdgcn_s_waitcnt(0);
        unsigned nloc = b.st[0], nx = b.st[1];
        if (nloc == 0u) { xcd_barrier_complete(bar, b.x, nloc, nx); b.st[0] = nloc; b.st[1] = nx; }
        const unsigned old = xb_add(&bar[XB_XSUB(b.x)], 1u);
        const unsigned gen = old / nloc;
        if (old + 1u == (gen + 1u) * nloc) {
            __builtin_amdgcn_fence(__ATOMIC_RELEASE, "agent");
            asm volatile("s_waitcnt vmcnt(0)" ::: "memory");
            const unsigned og = xb_add(&bar[XB_TOP], 1u);
            const unsigned tg = og / nx;
            if (og + 1u == (tg + 1u) * nx) xb_add(&bar[XB_TOPGEN], 1u);
            else XB_SPIN(xb_ld(&bar[XB_TOPGEN]) == tg, bar);
            __builtin_amdgcn_fence(__ATOMIC_ACQUIRE, "agent");
            xb_add(&bar[XB_XGEN(b.x)], 1u);
            asm volatile("s_waitcnt vmcnt(0)" ::: "memory");
        } else {
            XB_SPIN(xb_ld(&bar[XB_XGEN(b.x)]) == gen, bar);
            __builtin_amdgcn_fence(__ATOMIC_ACQUIRE, "agent");
            asm volatile("s_waitcnt vmcnt(0)" ::: "memory");
        }
    }
    __syncthreads();
}

#ifndef MK_ONE_LAUNCH
#define MK_ONE_LAUNCH 1
#endif
#ifndef DBL_MASK
#define DBL_MASK 0
#endif
constexpr int N_PHASES = 9;
struct Args { const void* in[N_IN]; float* out; unsigned char* ws; int ph_lo, ph_hi; };
#define PHASE_FN __device__ __forceinline__ void
#define PHASE_FRAME \
    Frame F; F.lds = (LAS unsigned char*)(uintptr_t)(unsigned)__builtin_amdgcn_readfirstlane((int)ldsaddr); F.tid = threadIdx.x; F.lane = F.tid & 63; F.wave = __builtin_amdgcn_readfirstlane(F.tid >> 6); \
    F.G = gridDim.x; F.bid = blockIdx.x; F.in = (const float* const*)ap->in; F.pos = (const int*)ap->in[I_POS]; F.out = ap->out; F.ws = ap->ws; unsigned char* ws = F.ws; (void)ws;
#define REP(k) for (int rep_ = 0; rep_ < (((DBL_MASK >> (k)) & 1) ? 2 : 1); ++rep_)

PHASE_FN ph_prologue(const Args* ap, unsigned ldsaddr) { PHASE_FRAME REP(0) p0_prologue(F); }
PHASE_FN ph_inproj(const Args* ap, unsigned ldsaddr) { PHASE_FRAME REP(1) {
    pg8::StaticOrder S;
    pg8::Gemm g = pg8::make_gemm((const bf16*)(ws + WS_XN), 1024, (const bf16*)(ws + WS_WIN), 1024, MTOK, NPROJ, 1024);
    S.init(MTOK, NPROJ, F.G, F.bid);
    EpiInProj E{(bf16*)(ws + WS_QKV), (bf16*)(ws + WS_CQ), (bf16*)(ws + WS_MISC), (bf16*)(ws + WS_GATES)};
    pg8::gemm_phase<EpiInProj, pg8::StaticOrder, true>(F.lds, g, S, E); } }
PHASE_FN ph_upq(const Args* ap, unsigned ldsaddr) { PHASE_FRAME REP(2) {
    pg8::StaticOrder S;
    pg8::Gemm g = pg8::make_gemm((const bf16*)(ws + WS_CQ), 256, (const bf16*)(ws + WS_WUQ), 256, MTOK, 768, 256);
    S.init(MTOK, 768, F.G, F.bid);
    EpiRowScale<256> E{(const bf16*)(ws + WS_CQ), (bf16*)(ws + WS_MLAQ), 768, QSCALE_MLA};
    pg8::gemm_phase<EpiRowScale<256>, pg8::StaticOrder, true>(F.lds, g, S, E); } }
PHASE_FN ph_upkv(const Args* ap, unsigned ldsaddr) { PHASE_FRAME REP(2) {
    pg8::StaticOrder S;
    pg8::Gemm g = pg8::make_gemm((const bf16*)(ws + WS_MISC), 256, (const bf16*)(ws + WS_WUKV), 256, MTOK, 1024, 256);
    S.init(MTOK, 1024, F.G, F.bid);
    EpiRowScale<128> E{(const bf16*)(ws + WS_MISC), (bf16*)(ws + WS_MLAKV), 1024, 1.0f};
    pg8::gemm_phase<EpiRowScale<128>, pg8::StaticOrder, true>(F.lds, g, S, E); } }
PHASE_FN ph_cmpu(const Args* ap, unsigned ldsaddr) { PHASE_FRAME REP(2) {
    pg8::StaticOrder S;
#pragma unroll 1
    for (int ks = 0; ks < 8; ++ks) { const int kv = ks >> 2, s = ks & 3;
        pg8::Gemm g; g.A = (const bf16*)(ws + WS_QKV) + 512 + 128 * kv + (size_t)s * 4 * 1280; g.Bt = (const bf16*)(ws + (kv ? WS_WC1V : WS_WC1K)) + s * 256; g.M = 2048; g.N = 256; g.K = 256;
        g.aRow = (size_t)16 * 1280 * 2; g.aHalf = 128; g.aTile = (size_t)SEQ * 1280 * 2; g.aK = (size_t)1280 * 2; g.bRow = 1024 * 2;
        S.init(2048, 256, F.G, (F.bid + F.G - (192 + 8 * ks) % F.G) % F.G);
        EpiF32 E{(float*)(ws + WS_USLAB) + (size_t)ks * 2048 * 256, 256, nullptr};
        pg8::gemm_phase<EpiF32, pg8::StaticOrder, true>(F.lds, g, S, E);
    }
    kpe_pass(F); } }
PHASE_FN ph_cmpfin(const Args* ap, unsigned ldsaddr) { PHASE_FRAME REP(3) cmp_finalize(F); }
PHASE_FN ph_nsa(const Args* ap, unsigned ldsaddr) { PHASE_FRAME REP(10) att::nsa_loop(F); }
PHASE_FN ph_mla(const Args* ap, unsigned ldsaddr) { PHASE_FRAME REP(11) att::mla_loop(F); }
PHASE_FN ph_branch0(const Args* ap, unsigned ldsaddr) { PHASE_FRAME REP(5) {
    pg8::StaticOrder S; S.init(MTOK, 1024, F.G, F.bid);
    pg8::Gemm g = pg8::make_gemm((const bf16*)(ws + WS_OCAT), 1024, (const bf16*)(ws + WS_WBR), 1024, MTOK, 1024, 512);
    EpiGate<0> E{(const bf16*)(ws + WS_GATES), (bf16*)(ws + WS_MERGED), 0};
    pg8::gemm_phase<EpiGate<0>, pg8::StaticOrder, true>(F.lds, g, S, E); } }
PHASE_FN ph_branch1(const Args* ap, unsigned ldsaddr) { PHASE_FRAME REP(5) {
    pg8::StaticOrder S; S.init(MTOK, 1024, F.G, F.bid);
    pg8::Gemm g = pg8::make_gemm((const bf16*)(ws + WS_OCAT) + 512, 1024, (const bf16*)(ws + WS_WBR) + 512, 1024, MTOK, 1024, 512);
    EpiGate<1> E{(const bf16*)(ws + WS_GATES), (bf16*)(ws + WS_MERGED), 1024};
    pg8::gemm_phase<EpiGate<1>, pg8::StaticOrder, true>(F.lds, g, S, E);
    quant_table(F, F.in[I_EDN], ws + WS_EXPD, (float*)(ws + WS_EXPD_SC)); } }
PHASE_FN ph_outproj(const Args* ap, unsigned ldsaddr) { PHASE_FRAME REP(6) {
    pg8::StaticOrder S; S.init(MTOK, 1024, F.G, F.bid);
    pg8::Gemm g = pg8::make_gemm((const bf16*)(ws + WS_MERGED), 1024, (const bf16*)(ws + WS_WOUT), 1024, MTOK, 1024, 1024);
    EpiResid E{F.in[I_X], F.out, (bf16*)(ws + WS_XN2), (float*)(ws + WS_SS)};
    pg8::gemm_phase<EpiResid, pg8::StaticOrder, true>(F.lds, g, S, E);
    quant_table(F, F.in[I_EUP], ws + WS_EXPU, (float*)(ws + WS_EXPU_SC)); } }
PHASE_FN ph_peerq(const Args* ap, unsigned ldsaddr) { PHASE_FRAME REP(8) {
    pg8::StaticOrder S; S.init(MTOK, 2048, F.G, F.bid);
    pg8::Gemm g = pg8::make_gemm((const bf16*)(ws + WS_XN2), 1024, (const bf16*)(ws + WS_WPQ), 1024, MTOK, 2048, 1024);
    EpiRowSS E{(const float*)(ws + WS_SS), (bf16*)(ws + WS_QP), 2048};
    pg8::gemm_phase<EpiRowSS, pg8::StaticOrder, true>(F.lds, g, S, E); } }
PHASE_FN ph_peer(const Args* ap, unsigned ldsaddr) { PHASE_FRAME peer::peer_phase(F, ap->ph_lo < 0); }

__global__ void __launch_bounds__(NTHREADS, 2) fwd(Args a) {
    extern __shared__ __attribute__((aligned(16))) unsigned char lds_raw[];
    cg::grid_group grid = cg::this_grid();
    const unsigned ldsaddr = (unsigned)(uintptr_t)(LAS unsigned char*)lds_raw;
    const int lo = a.ph_lo, hi = a.ph_hi;
#define IN(k) (lo <= (k) && (k) < hi)
    { LAS unsigned* misc = (LAS unsigned*)((LAS unsigned char*)lds_raw + RING_BYTES); if (threadIdx.x < 64) misc[threadIdx.x] = 0u; }
    __syncthreads();
    XcdBarrier bar = xcd_barrier_post((unsigned*)(a.ws + WS_CTL) + 4096, (volatile LAS unsigned*)((LAS unsigned char*)lds_raw + RING_BYTES) + 8);
#define SEAM(k) do { if (IN(k) && IN((k) + 1)) { if (MK_ONE_LAUNCH) xcd_barrier(bar); } } while (0)
    if (IN(0)) ph_prologue(&a, ldsaddr);
    if (IN(0) && IN(1)) grid.sync();
    if (IN(1)) ph_inproj(&a, ldsaddr);
    SEAM(1);
    if (IN(2)) { ph_upq(&a, ldsaddr); ph_upkv(&a, ldsaddr); ph_cmpu(&a, ldsaddr); }
    SEAM(2);
    if (IN(3)) ph_cmpfin(&a, ldsaddr);
    SEAM(3);
    if (IN(4)) { ph_nsa(&a, ldsaddr); ph_mla(&a, ldsaddr); }
    SEAM(4);
    if (IN(5)) { ph_branch0(&a, ldsaddr); ph_branch1(&a, ldsaddr); }
    SEAM(5);
    if (IN(6)) ph_outproj(&a, ldsaddr);
    SEAM(6);
    if (IN(7)) ph_peerq(&a, ldsaddr);
    SEAM(7);
    if (IN(8)) ph_peer(&a, ldsaddr);
#undef IN
#undef SEAM
}

extern "C" void kernel_launch(void* const* d_in, const int* in_sizes, int n_in, void* d_out, int out_size, void* d_ws, size_t ws_size, hipStream_t stream) {
    static int grid = 0;
    if (grid == 0) {
        if (n_in != N_IN || out_size != MTOK * DM || ws_size < WS_END) { fprintf(stderr, "kernel_launch: unexpected shapes (n_in %d, out %d, ws %zu)\n", n_in, out_size, ws_size); grid = -1; return; }
        int dev = 0, cus = 0, per_cu = 0;
        if (hipGetDevice(&dev) != hipSuccess || hipDeviceGetAttribute(&cus, hipDeviceAttributeMultiprocessorCount, dev) != hipSuccess) { grid = -1; return; }
        if (hipFuncSetAttribute((const void*)fwd, hipFuncAttributeMaxDynamicSharedMemorySize, LDS_BYTES) != hipSuccess) { fprintf(stderr, "kernel_launch: hipFuncSetAttribute failed\n"); grid = -1; return; }
        if (hipOccupancyMaxActiveBlocksPerMultiprocessor(&per_cu, (const void*)fwd, NTHREADS, LDS_BYTES) != hipSuccess || per_cu < 1) { fprintf(stderr, "kernel_launch: occupancy query says %d\n", per_cu); (void)hipGetLastError(); grid = -1; return; }
        grid = cus;
    }
    if (grid < 0) return;
    Args a{};
    for (int i = 0; i < N_IN; ++i) a.in[i] = d_in[i];
    a.out = (float*)d_out; a.ws = (unsigned char*)d_ws;
#if MK_ONE_LAUNCH
    if (hipMemsetAsync((char*)d_ws + WS_CTL, 0, 65536, stream) != hipSuccess) { fprintf(stderr, "kernel_launch: hipMemsetAsync failed\n"); return; }
    a.ph_lo = 0; a.ph_hi = N_PHASES;
    void* args[] = {&a};
    hipError_t e = hipLaunchCooperativeKernel((const void*)fwd, dim3(grid), dim3(NTHREADS), args, LDS_BYTES, stream);
    if (e != hipSuccess) fprintf(stderr, "kernel_launch: cooperative launch failed: %s (grid %d)\n", hipGetErrorString(e), grid);
#else
    for (int p = 0; p < N_PHASES; ++p) { a.ph_lo = p; a.ph_hi = p + 1; hipLaunchKernelGGL(fwd, dim3(grid), dim3(NTHREADS), LDS_BYTES, stream, a); }
#endif
}
```

```cpp
#define DBL_MASK 0
#include <hip/hip_runtime.h>
#include <cstdio>
#include <cstdint>
#include <cmath>
namespace pg8 {
#define PG8_LAS __attribute__((address_space(3)))
typedef unsigned short bf16_t;
typedef short bf16x8 __attribute__((ext_vector_type(8)));
typedef float f32x4 __attribute__((ext_vector_type(4)));
typedef unsigned u32x4 __attribute__((ext_vector_type(4)));
constexpr int BM = 256, BK = 64, HALF = 128, HTB = HALF * BK * 2  , STAGE_BYTES = 8 * HTB, NXCD = 8, WGM = 8;

__host__ __device__ __forceinline__ int lds_byte(int r, int c) { const int st = (r >> 4) * 2 + (c >> 5), rr = r & 15, cc = c & 31, ob = rr * 64 + cc * 2; return st * 1024 + (ob ^ (((ob >> 9) & 1) << 5)); }
__host__ __device__ __forceinline__ void stage_rc(int b, int& R, int& C) { const int st = b / 1024, sb = b % 1024, swz = sb ^ (((sb >> 9) & 1) << 5); R = (st >> 1) * 16 + swz / 64; C = (st & 1) * 32 + (swz % 64) / 2; }
__host__ __device__ __forceinline__ int perm32(int rho) { const int n = rho >> 4, i = rho & 15; return 8 * (i >> 2) + 4 * n + (i & 3); }

struct Unit { int pm, pn, seg; };
struct Gemm { const bf16_t* A; const bf16_t* Bt; int M, N, K; size_t aRow, aHalf, aTile, aK, bRow, aSeg, bSeg; };
__host__ __device__ __forceinline__ Gemm make_gemm(const bf16_t* A, int lda, const bf16_t* Bt, int ldb, int M, int N, int K) {
    Gemm g; g.A = A; g.Bt = Bt; g.M = M; g.N = N; g.K = K; g.aRow = (size_t)lda * 2; g.aHalf = (size_t)HALF * lda * 2; g.aTile = (size_t)BM * lda * 2; g.aK = BK * 2; g.bRow = (size_t)ldb * 2; g.aSeg = 0; g.bSeg = 0; return g; }

struct StaticOrder {
    int nM, nN, nwg, G, c;
    __host__ __device__ void init(int M, int N, int G_, int c_) { nM = M / BM; nN = N / BM; nwg = nM * nN; G = G_; c = c_; }
    __host__ __device__ bool next(int i, Unit& u) const {
        const long L = (long)i * G + c; if (L >= nwg) return false;
        int wgid = (int)L; { const int q = nwg / NXCD, r = nwg % NXCD, xcd = wgid % NXCD, off = wgid / NXCD; wgid = (xcd < r ? xcd * (q + 1) : r * (q + 1) + (xcd - r) * q) + off; }
        const int nig = WGM * nN, gid = wgid / nig, fm = gid * WGM, gsz = (nM - fm) < WGM ? (nM - fm) : WGM;
        u.pm = fm + ((wgid % nig) % gsz); u.pn = (wgid % nig) / gsz; u.seg = 0; return true;
    }
};
struct ChainOrder : StaticOrder {
    __host__ __device__ bool next(int i, Unit& u) const { if (!StaticOrder::next(i >> 1, u)) return false; u.seg = i & 1; return true; }
};

__device__ __forceinline__ unsigned cvt_pk_bf16(float lo, float hi) { unsigned r; asm volatile("v_cvt_pk_bf16_f32 %0, %1, %2" : "=v"(r) : "v"(lo), "v"(hi)); return r; }

template <class Epi, class Sched, bool ALIGN_EPI, bool CHAIN = false>
__device__ __forceinline__ void gemm_phase(PG8_LAS unsigned char* lds, const Gemm g, const Sched& S, const Epi& E) {
    const int tid = threadIdx.x, wid = __builtin_amdgcn_readfirstlane(tid >> 6), lane = tid & 63, wr = wid >> 2, wc = wid & 3, fr = lane & 15, fq = lane >> 4;
    const int K = g.K, nt = K / BK;
    unsigned voffA[2], voffB[2];
#pragma unroll
    for (int i = 0; i < 2; ++i) { int R, C; stage_rc(tid * 16 + i * 8192, R, C); const int Rb = Epi::PERM ? ((R & ~31) + perm32(R & 31)) : R;
        voffA[i] = (unsigned)((size_t)R * g.aRow + (size_t)C * 2); voffB[i] = (unsigned)((size_t)Rb * g.bRow + (size_t)C * 2); }
    const size_t kstepA = g.aK, kstepB = (size_t)(BK * 2);
    const size_t hstepA = g.aHalf, hstepB = (size_t)HALF * g.bRow;
    const size_t tstepA = g.aTile, tstepB = (size_t)BM * g.bRow;
    const unsigned ldsw = (unsigned)wid * 1024u;
    const int aoff = lds_byte(wr * 64 + fr, fq * 8), boff = lds_byte(wc * 32 + fr, fq * 8);
#define PG8_SA(b, h) (((b) * 2 + (h)) * HTB)
#define PG8_SB(b, h) ((4 + (b) * 2 + (h)) * HTB)
#define PG8_STAGE(bufoff, gbase, voff) do { _Pragma("unroll") for (int _i = 0; _i < 2; ++_i) \
        __builtin_amdgcn_global_load_lds((const unsigned*)((const char*)(gbase) + (voff)[_i]), (PG8_LAS unsigned*)(lds + (bufoff) + ldsw + _i * 8192), 16, 0, 0); } while (0)
#define PG8_LDA(dst, b, h) do { _Pragma("unroll") for (int m = 0; m < 4; ++m) _Pragma("unroll") for (int k = 0; k < 2; ++k) dst[m][k] = *(const PG8_LAS bf16x8*)(lds + PG8_SA(b, h) + aoff + m * 2048 + k * 1024); } while (0)
#define PG8_LDB(dst, b, h) do { _Pragma("unroll") for (int n = 0; n < 2; ++n) _Pragma("unroll") for (int k = 0; k < 2; ++k) dst[n][k] = *(const PG8_LAS bf16x8*)(lds + PG8_SB(b, h) + boff + n * 2048 + k * 1024); } while (0)
#define PG8_MMA(ai, bj, At, Bt) do { __builtin_amdgcn_s_setprio(1); _Pragma("unroll") for (int m = 0; m < 4; ++m) _Pragma("unroll") for (int n = 0; n < 2; ++n) _Pragma("unroll") for (int k = 0; k < 2; ++k) \
        acc[ai][bj][m][n] = __builtin_amdgcn_mfma_f32_16x16x32_bf16(Bt[n][k], At[m][k], acc[ai][bj][m][n], 0, 0, 0); __builtin_amdgcn_s_setprio(0); } while (0)
#define PG8_WAIT_V(n) asm volatile("s_waitcnt vmcnt(" #n ")" ::: "memory")
#define PG8_WAIT_L(n) asm volatile("s_waitcnt lgkmcnt(" #n ")" ::: "memory")
#define PG8_BAR __builtin_amdgcn_s_barrier()
#define PG8_SCHED __builtin_amdgcn_sched_barrier(0)
    Unit cur, nxt; int ui = 0;
    if (!S.next(0, cur)) return;
    f32x4 acc[2][2][4][2];
#pragma unroll
    for (int a = 0; a < 2; ++a)
#pragma unroll
        for (int b = 0; b < 2; ++b)
#pragma unroll
            for (int m = 0; m < 4; ++m)
#pragma unroll
                for (int n = 0; n < 2; ++n) acc[a][b][m][n] = (f32x4){0.f, 0.f, 0.f, 0.f};
    bf16x8 At[4][2], B0[2][2], B1[2][2];
    const char* cA = (const char*)g.A + (size_t)cur.pm * tstepA + ((CHAIN && cur.seg) ? g.aSeg : 0); const char* cB = (const char*)g.Bt + (size_t)cur.pn * tstepB + ((CHAIN && cur.seg) ? g.bSeg : 0);
    PG8_STAGE(PG8_SB(0, 0), cB, voffB); PG8_STAGE(PG8_SB(0, 1), cB + hstepB, voffB); PG8_STAGE(PG8_SA(0, 0), cA, voffA); PG8_STAGE(PG8_SA(0, 1), cA + hstepA, voffA);
    if (wr == 1) PG8_BAR;
    PG8_WAIT_V(2); PG8_BAR;
    PG8_STAGE(PG8_SB(1, 0), cB + kstepB, voffB); PG8_STAGE(PG8_SA(1, 0), cA + kstepA, voffA); PG8_STAGE(PG8_SB(1, 1), cB + hstepB + kstepB, voffB);
    PG8_WAIT_V(6); PG8_BAR;
    for (;;) {
        const bool has_next = S.next(ui + 1, nxt);
        const char* nA = has_next ? (const char*)g.A + (size_t)nxt.pm * tstepA + ((CHAIN && nxt.seg) ? g.aSeg : 0) : cA; const char* nB = has_next ? (const char*)g.Bt + (size_t)nxt.pn * tstepB + ((CHAIN && nxt.seg) ? g.bSeg : 0) : cB;
        for (int t = 0; t < nt; t += 2) {
            const bool last = (t == nt - 2);
            const char* a1 = cA + (size_t)(t + 1) * kstepA;
            const char* a2 = last ? nA : cA + (size_t)(t + 2) * kstepA; const char* b2 = last ? nB : cB + (size_t)(t + 2) * kstepB;
            const char* a3 = a2 + kstepA; const char* b3 = b2 + kstepB;
            PG8_LDB(B0, 0, 0); PG8_LDB(B1, 0, 1); PG8_SCHED; PG8_LDA(At, 0, 0); PG8_STAGE(PG8_SA(1, 1), a1 + hstepA, voffA);
            PG8_WAIT_V(8); PG8_WAIT_L(0); PG8_BAR; PG8_MMA(0, 0, At, B0); PG8_MMA(0, 1, At, B1); PG8_BAR; PG8_SCHED;
            PG8_LDA(At, 0, 1); PG8_STAGE(PG8_SB(0, 0), b2, voffB); PG8_STAGE(PG8_SB(0, 1), b2 + hstepB, voffB); PG8_STAGE(PG8_SA(0, 0), a2, voffA);
            PG8_WAIT_V(8); PG8_WAIT_L(0); PG8_BAR; PG8_MMA(1, 0, At, B0); PG8_MMA(1, 1, At, B1); PG8_BAR; PG8_SCHED;
            PG8_LDB(B0, 1, 0); PG8_LDB(B1, 1, 1); PG8_SCHED; PG8_LDA(At, 1, 0); PG8_STAGE(PG8_SA(0, 1), a2 + hstepA, voffA);
            PG8_WAIT_V(8); PG8_WAIT_L(0); PG8_BAR; PG8_MMA(0, 0, At, B0); PG8_MMA(0, 1, At, B1); PG8_BAR; PG8_SCHED;
            PG8_LDA(At, 1, 1); PG8_STAGE(PG8_SB(1, 0), b3, voffB); PG8_STAGE(PG8_SB(1, 1), b3 + hstepB, voffB); PG8_STAGE(PG8_SA(1, 0), a3, voffA);
            PG8_WAIT_V(8); PG8_WAIT_L(0); PG8_BAR; PG8_MMA(1, 0, At, B0); PG8_MMA(1, 1, At, B1); PG8_BAR; PG8_SCHED;
        }
        if constexpr (ALIGN_EPI) { if (wr == 0) PG8_BAR; }
        bool keep = false;
        if constexpr (CHAIN) { if (cur.seg == 0) { E.mid(acc, cur, wr, wc, fr, fq); keep = true; } else E(acc, cur, wr, wc, fr, fq); }
        else E(acc, cur, wr, wc, fr, fq);
        if (!has_next) break;
        if (!keep) {
#pragma unroll
        for (int a = 0; a < 2; ++a)
#pragma unroll
            for (int b = 0; b < 2; ++b)
#pragma unroll
                for (int m = 0; m < 4; ++m)
#pragma unroll
                    for (int n = 0; n < 2; ++n) acc[a][b][m][n] = (f32x4){0.f, 0.f, 0.f, 0.f};
        }
        cur = nxt; cA = nA; cB = nB; ++ui;
        if constexpr (ALIGN_EPI) { if (wr == 1) PG8_BAR; }
    }
    PG8_WAIT_V(0);
    if constexpr (!ALIGN_EPI) { if (wr == 0) PG8_BAR; }
    PG8_BAR;
#undef PG8_SA
#undef PG8_SB
#undef PG8_STAGE
#undef PG8_LDA
#undef PG8_LDB
#undef PG8_MMA
#undef PG8_WAIT_V
#undef PG8_WAIT_L
#undef PG8_BAR
#undef PG8_SCHED
}
}
constexpr int NWAVES = 8, NTHREADS = 512;
constexpr int BATCH = 8, SEQ = 2048, DM = 1024, MTOK = BATCH * SEQ;
constexpr int NPROJ = 3840;
constexpr float EPS = 1e-6f, LOG2E = 1.4426950408889634f;
constexpr float QSCALE_NSA = 0.125f * LOG2E;
constexpr float QSCALE_MLA = 0.10206207261596575f * LOG2E;
constexpr size_t MiB = 1u << 20;
enum { I_X = 0, I_POS, I_N1G, I_WIN, I_CPK, I_CW1K, I_CW2K, I_CPV, I_CW1V, I_CW2V, I_QNG, I_KVNG, I_WUQ, I_WUKV, I_WBN, I_WBM, I_WOUT, I_N2G, I_WPQ, I_SK1, I_SK2, I_EDN, I_EUP, I_NFG, N_IN };
constexpr size_t WS_CTL = 0;
constexpr size_t WS_WIN = 1 * MiB;
constexpr size_t WS_WUQ = WS_WIN + (size_t)NPROJ * 1024 * 2;
constexpr size_t WS_WUKV = WS_WUQ + 768 * 256 * 2;
constexpr size_t WS_WBR = 10 * MiB;
constexpr size_t WS_WOUT = 12 * MiB;
constexpr size_t WS_WPQ = 14 * MiB;
constexpr size_t WS_WC1K = 18 * MiB;
constexpr size_t WS_WC1V = WS_WC1K + 256 * 1024 * 2;
constexpr size_t WS_SMALL = 19 * MiB;
constexpr size_t WS_C1K = WS_SMALL;
constexpr size_t WS_C1V = WS_SMALL + 512;
constexpr size_t WS_ORDER = WS_SMALL + 1024;
constexpr size_t WS_SK1 = WS_SMALL + 4096;
constexpr size_t WS_SK2 = WS_SK1 + 32768;
constexpr size_t WS_XN = 20 * MiB;
constexpr size_t WS_MLAQ = WS_XN, WS_EXPD = WS_XN;
constexpr size_t WS_EXPD_SC = WS_EXPD + (size_t)16384 * 1024;
constexpr size_t WS_QKV = 52 * MiB;
constexpr size_t WS_MERGED = WS_QKV;
constexpr size_t WS_CQ = 92 * MiB;
constexpr size_t WS_MISC = 100 * MiB;
constexpr size_t WS_ROUTE = 92 * MiB;
constexpr size_t WS_GATES = 108 * MiB;
constexpr size_t WS_QP = WS_GATES;
constexpr size_t WS_MLAKV = 172 * MiB;
constexpr size_t WS_XN2 = WS_MLAKV;
constexpr size_t WS_KPE = 204 * MiB;
constexpr size_t WS_KC = 205 * MiB;
constexpr size_t WS_VC = WS_KC + 16 * 128 * 64 * 2;
constexpr size_t WS_SSQ = 207 * MiB, WS_SSKV = 207 * MiB + 262144;
constexpr size_t WS_SS = 206 * MiB;
constexpr size_t WS_OCAT = 210 * MiB;
constexpr size_t WS_USLAB = WS_OCAT;
constexpr size_t WS_EXPU = WS_OCAT;
constexpr size_t WS_EXPU_SC = WS_EXPU + (size_t)16384 * 1024;
constexpr size_t WS_END = 242 * MiB;
constexpr int RING_BYTES = 131072;
constexpr int LDS_BYTES = 147456;

#define GAS __attribute__((address_space(1)))
#define LAS __attribute__((address_space(3)))
typedef unsigned short bf16;
typedef unsigned v4u __attribute__((ext_vector_type(4)));
typedef unsigned v2u __attribute__((ext_vector_type(2)));
typedef float f32x4 __attribute__((ext_vector_type(4)));
typedef float f32x16 __attribute__((ext_vector_type(16)));
typedef short bf16x8 __attribute__((ext_vector_type(8)));
typedef short s16x4 __attribute__((ext_vector_type(4)));

__device__ __forceinline__ unsigned f2bf(float f) { unsigned u = __builtin_bit_cast(unsigned, f); return (u + 0x7fffu + ((u >> 16) & 1u)) >> 16; }
__device__ __forceinline__ unsigned pk2(float lo, float hi) { return f2bf(lo) | (f2bf(hi) << 16); }
__device__ __forceinline__ float bf_lo(unsigned u) { return __builtin_bit_cast(float, u << 16); }
__device__ __forceinline__ float bf_hi(unsigned u) { return __builtin_bit_cast(float, u & 0xffff0000u); }
__device__ __forceinline__ float bf2f(bf16 h) { return __builtin_bit_cast(float, (unsigned)h << 16); }
__device__ __forceinline__ float sigmoidf_(float v) { return __builtin_amdgcn_rcpf(1.0f + __expf(-v)); }
__device__ __forceinline__ float gelu_tanh(float v) { const float u = 0.7978845608028654f * (v + 0.044715f * v * v * v); const float e = __expf(2.0f * u); const float th = 1.0f - 2.0f * __builtin_amdgcn_rcpf(e + 1.0f); return 0.5f * v * (1.0f + th); }
__device__ __forceinline__ float rope_inv(int i) { return exp2f(-(float)i * (13.287712379549449f / 16.0f)); }
__device__ __forceinline__ void rope_sincos(float ang, float& sn, float& cs) { float t = ang * 0.15915494309189535f; t -= floorf(t); sn = __builtin_amdgcn_sinf(t); cs = __builtin_amdgcn_cosf(t); }
__device__ __forceinline__ float wave_sum(float v) {
#pragma unroll
    for (int o = 1; o < 64; o <<= 1) v += __shfl_xor(v, o);
    return v;
}

#ifdef TIMER_PHASE
#define TMS_BEGIN(id) unsigned long long tms_t0_ = ((id) == TIMER_PHASE) ? __builtin_amdgcn_s_memrealtime() : 0ull
#define TMS_DECL unsigned long long tms_m0_ = 0ull
#define TMS_MARK(id) do { if ((id) == TIMER_PHASE) tms_m0_ = __builtin_amdgcn_s_memrealtime(); } while (0)
#define TMS_MARKEND(id) do { if ((id) == TIMER_PHASE && threadIdx.x == 448) { *(LAS unsigned long long*)(F.lds + RING_BYTES + 512) += __builtin_amdgcn_s_memrealtime() - tms_m0_; } } while (0)
#define TMS_COUNT(id) do { if ((id) == TIMER_PHASE && threadIdx.x == 448) { *(LAS unsigned long long*)(F.lds + RING_BYTES + 512) += 100ull; } } while (0)
#define TMS_END(id) do { if ((id) == TIMER_PHASE && threadIdx.x == (((id) >= 41 && (id) <= 49) ? 448 : 0)) { *(LAS unsigned long long*)(F.lds + RING_BYTES + 512) += __builtin_amdgcn_s_memrealtime() - tms_t0_; } } while (0)
#else
#define TMS_BEGIN(id) do {} while (0)
#define TMS_COUNT(id) do {} while (0)
#define TMS_DECL do {} while (0)
#define TMS_MARK(id) do {} while (0)
#define TMS_MARKEND(id) do {} while (0)
#define TMS_END(id) do {} while (0)
#endif
struct Frame {
    LAS unsigned char* lds;
    int tid, lane, wave, G, bid;
    const float* const* in; const int* pos; float* out; unsigned char* ws;
};

__device__ __forceinline__ int win_srccol(int n) {
    if (n < 1280) return n;
    if (n < 1536) return 1304 + (n - 1280);
    if (n < 1664) return 1560 + (n - 1536);
    if (n < 1696) return 1688 + (n - 1664);
    if (n < 1720) return 1280 + (n - 1696);
    if (n < 1792) return -1;
    return 1720 + (n - 1792);
}
template <bool WIN_PERM>
__device__ __forceinline__ void tr_item(const float* src, int ld_src, int ksrc0, const float* kscale, bf16* dst, int ld_dst, int drow0, int dcol0, int N, LAS float* scr, int item, int lane) {
    const int nblk = N / 32, kb = item / nblk, nb = item % nblk, k0 = 64 * kb, n0 = 32 * nb;
    const int nn = n0 + 4 * (lane & 7); const int sc = WIN_PERM ? win_srccol(nn) : nn;
    f32x4 v[8];
#pragma unroll
    for (int i = 0; i < 8; ++i) { const int kk = 8 * i + (lane >> 3); v[i] = (f32x4){0.f, 0.f, 0.f, 0.f}; if (sc >= 0) v[i] = *(const f32x4*)(src + (size_t)(ksrc0 + k0 + kk) * ld_src + sc); }
#pragma unroll
    for (int i = 0; i < 8; ++i) { const int kk = 8 * i + (lane >> 3); const float ks = kscale ? kscale[k0 + kk] : 1.0f; LAS float* d = scr + kk * 33 + 4 * (lane & 7);
        d[0] = v[i].x * ks; d[1] = v[i].y * ks; d[2] = v[i].z * ks; d[3] = v[i].w * ks; }
    asm volatile("s_waitcnt lgkmcnt(0)" ::: "memory");
    const int c = lane & 7;
#pragma unroll
    for (int j = 0; j < 4; ++j) { const int n = (lane >> 3) + 8 * j; const LAS float* s = scr + (8 * c) * 33 + n;
        v4u o; o.x = pk2(s[0 * 33], s[1 * 33]); o.y = pk2(s[2 * 33], s[3 * 33]); o.z = pk2(s[4 * 33], s[5 * 33]); o.w = pk2(s[6 * 33], s[7 * 33]);
        *(v4u*)(dst + (size_t)(drow0 + n0 + n) * ld_dst + dcol0 + k0 + 8 * c) = o; }
    asm volatile("s_waitcnt lgkmcnt(0)" ::: "memory");
}
__device__ __forceinline__ void rms_row_to_bf16(const float* xrow, const float* gain, bf16* orow, int lane) {
    const f32x4* xr = (const f32x4*)xrow + lane; const f32x4* gr = (const f32x4*)gain + lane;
    f32x4 v[4]; float s = 0.f;
#pragma unroll
    for (int j = 0; j < 4; ++j) { v[j] = xr[64 * j]; s += (v[j].x * v[j].x + v[j].y * v[j].y) + (v[j].z * v[j].z + v[j].w * v[j].w); }
    const float r = 1.0f / sqrtf(wave_sum(s) * (1.f / DM) + EPS);
    unsigned long long* o8 = (unsigned long long*)orow + lane;
#pragma unroll
    for (int j = 0; j < 4; ++j) { const f32x4 g = gr[64 * j]; o8[64 * j] = (unsigned long long)pk2(v[j].x * r * g.x, v[j].y * r * g.y) | ((unsigned long long)pk2(v[j].z * r * g.z, v[j].w * r * g.w) << 32); }
}
__device__ __forceinline__ void p0_prologue(Frame& F) {
    LAS float* scr = (LAS float*)(F.lds + F.wave * 16384);
    const int gw = F.bid * NWAVES + F.wave, NGW = F.G * NWAVES, lane = F.lane;
    bf16* const Win_t = (bf16*)(F.ws + WS_WIN); bf16* const Wuq_t = (bf16*)(F.ws + WS_WUQ); bf16* const Wukv_t = (bf16*)(F.ws + WS_WUKV);
    bf16* const Wbr_t = (bf16*)(F.ws + WS_WBR); bf16* const Wout_t = (bf16*)(F.ws + WS_WOUT); bf16* const Wpq_t = (bf16*)(F.ws + WS_WPQ);
    bf16* const Wc1k_t = (bf16*)(F.ws + WS_WC1K); bf16* const Wc1v_t = (bf16*)(F.ws + WS_WC1V);
    constexpr int I_IN = 16 * (NPROJ / 32), I_UQ = 4 * 24, I_UKV = 2 * 32, I_BR = 8 * 32, I_OUT = 16 * 32, I_PQ = 16 * 64, I_C1 = 16 * 4;
    constexpr int NITEMS = I_IN + I_UQ + I_UKV + 2 * I_BR + I_OUT + I_PQ + 4 * I_C1;
    for (int it = gw; it < NITEMS; it += NGW) {
        int r = it;
        if (r < I_IN) { tr_item<true>(F.in[I_WIN], 3768, 0, nullptr, Win_t, 1024, 0, 0, NPROJ, scr, r, lane); continue; } r -= I_IN;
        if (r < I_UQ) { tr_item<false>(F.in[I_WUQ], 768, 0, F.in[I_QNG], Wuq_t, 256, 0, 0, 768, scr, r, lane); continue; } r -= I_UQ;
        if (r < I_UKV) { tr_item<false>(F.in[I_WUKV], 1024, 0, F.in[I_KVNG], Wukv_t, 256, 0, 0, 1024, scr, r, lane); continue; } r -= I_UKV;
        if (r < I_BR) { tr_item<false>(F.in[I_WBN], 1024, 0, nullptr, Wbr_t, 1024, 0, 0, 1024, scr, r, lane); continue; } r -= I_BR;
        if (r < I_BR) { tr_item<false>(F.in[I_WBM], 1024, 0, nullptr, Wbr_t, 1024, 0, 512, 1024, scr, r, lane); continue; } r -= I_BR;
        if (r < I_OUT) { tr_item<false>(F.in[I_WOUT], 1024, 0, nullptr, Wout_t, 1024, 0, 0, 1024, scr, r, lane); continue; } r -= I_OUT;
        if (r < I_PQ) { tr_item<false>(F.in[I_WPQ], 2048, 0, F.in[I_N2G], Wpq_t, 1024, 0, 0, 2048, scr, r, lane); continue; } r -= I_PQ;
        if (r < I_C1) { tr_item<false>(F.in[I_CW1K], 128, 0, nullptr, Wc1k_t, 1024, 0, 0, 128, scr, r, lane); continue; } r -= I_C1;
        if (r < I_C1) { tr_item<false>(F.in[I_CW1K], 128, 1024, nullptr, Wc1k_t, 1024, 128, 0, 128, scr, r, lane); continue; } r -= I_C1;
        if (r < I_C1) { tr_item<false>(F.in[I_CW1V], 128, 0, nullptr, Wc1v_t, 1024, 0, 0, 128, scr, r, lane); continue; } r -= I_C1;
        tr_item<false>(F.in[I_CW1V], 128, 1024, nullptr, Wc1v_t, 1024, 128, 0, 128, scr, r, lane);
    }
    { bf16* XN = (bf16*)(F.ws + WS_XN); const float* X = F.in[I_X]; const f32x4* gr = (const f32x4*)F.in[I_N1G] + lane;
      for (int m = gw; m < MTOK; m += 2 * NGW) {
          const int m2 = (m + NGW < MTOK) ? m + NGW : m;
          const f32x4* xa = (const f32x4*)(X + (size_t)m * DM) + lane; const f32x4* xb = (const f32x4*)(X + (size_t)m2 * DM) + lane;
          f32x4 va[4], vb[4]; float sa = 0.f, sb = 0.f;
#pragma unroll
          for (int j = 0; j < 4; ++j) { va[j] = xa[64 * j]; vb[j] = xb[64 * j]; }
#pragma unroll
          for (int j = 0; j < 4; ++j) { sa += (va[j].x * va[j].x + va[j].y * va[j].y) + (va[j].z * va[j].z + va[j].w * va[j].w); sb += (vb[j].x * vb[j].x + vb[j].y * vb[j].y) + (vb[j].z * vb[j].z + vb[j].w * vb[j].w); }
#pragma unroll
          for (int o = 1; o < 64; o <<= 1) { sa += __shfl_xor(sa, o); sb += __shfl_xor(sb, o); }
          const float ra = 1.0f / sqrtf(sa * (1.f / DM) + EPS), rb = 1.0f / sqrtf(sb * (1.f / DM) + EPS);
          unsigned long long* oa = (unsigned long long*)(XN + (size_t)m * DM) + lane; unsigned long long* ob = (unsigned long long*)(XN + (size_t)m2 * DM) + lane;
#pragma unroll
          for (int j = 0; j < 4; ++j) { const f32x4 g = gr[64 * j];
              oa[64 * j] = (unsigned long long)pk2(va[j].x * ra * g.x, va[j].y * ra * g.y) | ((unsigned long long)pk2(va[j].z * ra * g.z, va[j].w * ra * g.w) << 32);
              ob[64 * j] = (unsigned long long)pk2(vb[j].x * rb * g.x, vb[j].y * rb * g.y) | ((unsigned long long)pk2(vb[j].z * rb * g.z, vb[j].w * rb * g.w) << 32); }
      } }
    const int gt = F.bid * NTHREADS + F.tid, NGT = F.G * NTHREADS;
    for (int i = gt; i < 1024 * 128; i += NGT) { const int n = i >> 7, k = 128 + (i & 127); Wukv_t[n * 256 + k] = 0; }
    { bf16* S1 = (bf16*)(F.ws + WS_SK1); bf16* S2 = (bf16*)(F.ws + WS_SK2);
      for (int i = gt; i < 128 * 128; i += NGT) { S1[i] = (bf16)f2bf(F.in[I_SK1][i]); S2[i] = (bf16)f2bf(F.in[I_SK2][i]); } }
    for (int o = gw; o < 256; o += NGW) {
        const int kv = o >> 7, j = o & 127; const float* pe = F.in[kv ? I_CPV : I_CPK]; const float* w1 = F.in[kv ? I_CW1V : I_CW1K];
        float s = 0.f;
        for (int k = lane; k < 2048; k += 64) s += pe[k] * w1[(size_t)k * 128 + j];
        s = wave_sum(s);
        if (lane == 0) ((float*)(F.ws + (kv ? WS_C1V : WS_C1K)))[j] = s;
    }
}

using pg8::Unit; using pg8::cvt_pk_bf16;
constexpr int PG_HALF = 128, PG_BM = 256;
struct EpiInProj {
    static constexpr bool PERM = true;
    bf16 *QKV, *CQ, *MISC, *GATES; float *SSQ, *SSKV;
    __device__ __forceinline__ void operator()(const f32x4 (&acc)[2][2][4][2], const Unit& u, int wr, int wc, int fr, int fq) const {
        bf16* base; int ldc, colt; float sc = 1.f;
        if (u.pn < 5) { base = QKV; ldc = 1280; colt = u.pn * 256; if (u.pn < 2) sc = QSCALE_NSA; }
        else if (u.pn == 5) { base = CQ; ldc = 256; colt = 0; }
        else if (u.pn == 6) { base = MISC; ldc = 256; colt = 0; }
        else { base = GATES; ldc = 2048; colt = (u.pn - 7) * 256; }
        const int row0 = u.pm * PG_BM + wr * 64 + fr, col0 = colt + wc * 32 + 8 * fq;
#pragma unroll
        for (int ai = 0; ai < 2; ++ai)
#pragma unroll
            for (int m = 0; m < 4; ++m) { bf16* rowp = base + (size_t)(row0 + ai * PG_HALF + m * 16) * ldc + col0;
#pragma unroll
                for (int bj = 0; bj < 2; ++bj) { const f32x4 v0 = acc[ai][bj][m][0] * sc, v1 = acc[ai][bj][m][1] * sc;
                    v4u w; w.x = cvt_pk_bf16(v0[0], v0[1]); w.y = cvt_pk_bf16(v0[2], v0[3]); w.z = cvt_pk_bf16(v1[0], v1[1]); w.w = cvt_pk_bf16(v1[2], v1[3]);
                    *(v4u*)(rowp + bj * PG_HALF) = w; }
                if (u.pn == 5 || u.pn == 6) {
                    float ss = 0.f;
#pragma unroll
                    for (int bj = 0; bj < 2; ++bj) if (u.pn == 5 || bj == 0) {
#pragma unroll
                        for (int n = 0; n < 2; ++n) { const f32x4 v = acc[ai][bj][m][n]; ss += (v[0] * v[0] + v[1] * v[1]) + (v[2] * v[2] + v[3] * v[3]); } }
                    ss += __shfl_xor(ss, 16); ss += __shfl_xor(ss, 32);
                    if (fq == 0) (u.pn == 5 ? SSQ : SSKV)[(size_t)(row0 + ai * PG_HALF + m * 16) * 4 + wc] = ss; } }
    }
};
struct EpiBf16 {
    static constexpr bool PERM = true;
    bf16* O; int ldc;
    __device__ __forceinline__ void operator()(const f32x4 (&acc)[2][2][4][2], const Unit& u, int wr, int wc, int fr, int fq) const {
        const int row0 = u.pm * PG_BM + wr * 64 + fr, col0 = u.pn * PG_BM + wc * 32 + 8 * fq;
#pragma unroll
        for (int ai = 0; ai < 2; ++ai)
#pragma unroll
            for (int m = 0; m < 4; ++m) { bf16* rowp = O + (size_t)(row0 + ai * PG_HALF + m * 16) * ldc + col0;
#pragma unroll
                for (int bj = 0; bj < 2; ++bj) { const f32x4 v0 = acc[ai][bj][m][0], v1 = acc[ai][bj][m][1];
                    v4u w; w.x = cvt_pk_bf16(v0[0], v0[1]); w.y = cvt_pk_bf16(v0[2], v0[3]); w.z = cvt_pk_bf16(v1[0], v1[1]); w.w = cvt_pk_bf16(v1[2], v1[3]);
                    *(v4u*)(rowp + bj * PG_HALF) = w; } }
    }
};
template <int NSRC> struct EpiRowScale {
    static constexpr bool PERM = true;
    const float* SS; bf16* O; int ldc; float cscale;
    __device__ __forceinline__ void operator()(const f32x4 (&acc)[2][2][4][2], const Unit& u, int wr, int wc, int fr, int fq) const {
        const int row0 = u.pm * PG_BM + wr * 64 + fr, col0 = u.pn * PG_BM + wc * 32 + 8 * fq;
#pragma unroll
        for (int ai = 0; ai < 2; ++ai)
#pragma unroll
            for (int m = 0; m < 4; ++m) { const int row = row0 + ai * PG_HALF + m * 16;
                const f32x4 s4 = *(const f32x4*)(SS + (size_t)row * 4); const float ss = (s4[0] + s4[1]) + (s4[2] + s4[3]);
                const float sc = cscale * __builtin_amdgcn_rsqf(ss * (1.0f / NSRC) + EPS);
                bf16* rowp = O + (size_t)row * ldc + col0;
#pragma unroll
                for (int bj = 0; bj < 2; ++bj) { const f32x4 v0 = acc[ai][bj][m][0] * sc, v1 = acc[ai][bj][m][1] * sc;
                    v4u w; w.x = cvt_pk_bf16(v0[0], v0[1]); w.y = cvt_pk_bf16(v0[2], v0[3]); w.z = cvt_pk_bf16(v1[0], v1[1]); w.w = cvt_pk_bf16(v1[2], v1[3]);
                    *(v4u*)(rowp + bj * PG_HALF) = w; } }
    }
};
struct EpiF32 {
    static constexpr bool PERM = false;
    float* C; int ldc; const float* resid;
    __device__ __forceinline__ void operator()(const f32x4 (&acc)[2][2][4][2], const Unit& u, int wr, int wc, int fr, int fq) const {
        const int row0 = u.pm * PG_BM + wr * 64 + fr, col0 = u.pn * PG_BM + wc * 32 + 4 * fq;
#pragma unroll
        for (int ai = 0; ai < 2; ++ai)
#pragma unroll
            for (int m = 0; m < 4; ++m) { const size_t off = (size_t)(row0 + ai * PG_HALF + m * 16) * ldc + col0;
#pragma unroll
                for (int bj = 0; bj < 2; ++bj)
#pragma unroll
                    for (int n = 0; n < 2; ++n) { f32x4 v = acc[ai][bj][m][n]; if (resid) v += *(const f32x4*)(resid + off + bj * PG_HALF + n * 16); *(f32x4*)(C + off + bj * PG_HALF + n * 16) = v; } }
    }
};
struct EpiGateChain {
    static constexpr bool PERM = true;
    const bf16* G; bf16* MG;
    __device__ __forceinline__ void mid(f32x4 (&acc)[2][2][4][2], const Unit& u, int wr, int wc, int fr, int fq) const {
        const int row0 = u.pm * PG_BM + wr * 64 + fr, col0 = u.pn * PG_BM + wc * 32 + 8 * fq;
#pragma unroll
        for (int ai = 0; ai < 2; ++ai)
#pragma unroll
            for (int m = 0; m < 4; ++m) { const int row = row0 + ai * PG_HALF + m * 16;
#pragma unroll
                for (int bj = 0; bj < 2; ++bj) { const int col = col0 + bj * PG_HALF;
                    const v4u gn = *(const v4u*)(G + (size_t)row * 2048 + col), gm = *(const v4u*)(G + (size_t)row * 2048 + 1024 + col);
#define RATIO(a, b) ((1.0f + __expf(-(b))) * __builtin_amdgcn_rcpf(1.0f + __expf(-(a))))
                    acc[ai][bj][m][0][0] *= RATIO(bf_lo(gn.x), bf_lo(gm.x)); acc[ai][bj][m][0][1] *= RATIO(bf_hi(gn.x), bf_hi(gm.x)); acc[ai][bj][m][0][2] *= RATIO(bf_lo(gn.y), bf_lo(gm.y)); acc[ai][bj][m][0][3] *= RATIO(bf_hi(gn.y), bf_hi(gm.y));
                    acc[ai][bj][m][1][0] *= RATIO(bf_lo(gn.z), bf_lo(gm.z)); acc[ai][bj][m][1][1] *= RATIO(bf_hi(gn.z), bf_hi(gm.z)); acc[ai][bj][m][1][2] *= RATIO(bf_lo(gn.w), bf_lo(gm.w)); acc[ai][bj][m][1][3] *= RATIO(bf_hi(gn.w), bf_hi(gm.w));
#undef RATIO
                } }
    }
    __device__ __forceinline__ void operator()(const f32x4 (&acc)[2][2][4][2], const Unit& u, int wr, int wc, int fr, int fq) const {
        const int row0 = u.pm * PG_BM + wr * 64 + fr, col0 = u.pn * PG_BM + wc * 32 + 8 * fq;
#pragma unroll
        for (int ai = 0; ai < 2; ++ai)
#pragma unroll
            for (int m = 0; m < 4; ++m) { const int row = row0 + ai * PG_HALF + m * 16;
#pragma unroll
                for (int bj = 0; bj < 2; ++bj) { const int col = col0 + bj * PG_HALF;
                    const v4u gm = *(const v4u*)(G + (size_t)row * 2048 + 1024 + col); const f32x4 a0 = acc[ai][bj][m][0], a1 = acc[ai][bj][m][1];
                    v4u w; w.x = cvt_pk_bf16(sigmoidf_(bf_lo(gm.x)) * a0[0], sigmoidf_(bf_hi(gm.x)) * a0[1]); w.y = cvt_pk_bf16(sigmoidf_(bf_lo(gm.y)) * a0[2], sigmoidf_(bf_hi(gm.y)) * a0[3]);
                    w.z = cvt_pk_bf16(sigmoidf_(bf_lo(gm.z)) * a1[0], sigmoidf_(bf_hi(gm.z)) * a1[1]); w.w = cvt_pk_bf16(sigmoidf_(bf_lo(gm.w)) * a1[2], sigmoidf_(bf_hi(gm.w)) * a1[3]);
                    *(v4u*)(MG + (size_t)row * 1024 + col) = w; } }
    }
};
struct EpiResid {
    static constexpr bool PERM = false;
    const float* X; bf16* HB; float* SS;
    __device__ __forceinline__ void operator()(const f32x4 (&acc)[2][2][4][2], const Unit& u, int wr, int wc, int fr, int fq) const {
        const int row0 = u.pm * PG_BM + wr * 64 + fr, col0 = u.pn * PG_BM + wc * 32 + 4 * fq;
#pragma unroll
        for (int ai = 0; ai < 2; ++ai)
#pragma unroll
            for (int m = 0; m < 4; ++m) { const int row = row0 + ai * PG_HALF + m * 16; const size_t off = (size_t)row * 1024 + col0; float ss = 0.f;
#pragma unroll
                for (int bj = 0; bj < 2; ++bj)
#pragma unroll
                    for (int n = 0; n < 2; ++n) { const f32x4 v = acc[ai][bj][m][n] + *(const f32x4*)(X + off + bj * PG_HALF + n * 16);
                        const unsigned w0 = cvt_pk_bf16(v[0], v[1]), w1 = cvt_pk_bf16(v[2], v[3]); *(v2u*)(HB + off + bj * PG_HALF + n * 16) = (v2u){w0, w1};
                        const float r0 = bf_lo(w0), r1 = bf_hi(w0), r2 = bf_lo(w1), r3 = bf_hi(w1); ss += (r0 * r0 + r1 * r1) + (r2 * r2 + r3 * r3); }
                ss += __shfl_xor(ss, 16); ss += __shfl_xor(ss, 32);
                if (fq == 0) SS[(size_t)row * 16 + u.pn * 4 + wc] = ss; }
    }
};
struct EpiRowSS {
    static constexpr bool PERM = true;
    const float* SS; bf16* O; int ldc;
    __device__ __forceinline__ void operator()(const f32x4 (&acc)[2][2][4][2], const Unit& u, int wr, int wc, int fr, int fq) const {
        const int row0 = u.pm * PG_BM + wr * 64 + fr, col0 = u.pn * PG_BM + wc * 32 + 8 * fq;
#pragma unroll
        for (int ai = 0; ai < 2; ++ai)
#pragma unroll
            for (int m = 0; m < 4; ++m) { const int row = row0 + ai * PG_HALF + m * 16;
                const f32x4* sp = (const f32x4*)(SS + (size_t)row * 16); const f32x4 s0 = sp[0], s1 = sp[1], s2 = sp[2], s3 = sp[3];
                const float ss = (((s0[0] + s0[1]) + (s0[2] + s0[3])) + ((s1[0] + s1[1]) + (s1[2] + s1[3]))) + (((s2[0] + s2[1]) + (s2[2] + s2[3])) + ((s3[0] + s3[1]) + (s3[2] + s3[3])));
                const float sc = __builtin_amdgcn_rsqf(ss * (1.0f / DM) + EPS);
                bf16* rowp = O + (size_t)row * ldc + col0;
#pragma unroll
                for (int bj = 0; bj < 2; ++bj) { const f32x4 v0 = acc[ai][bj][m][0] * sc, v1 = acc[ai][bj][m][1] * sc;
                    v4u w; w.x = cvt_pk_bf16(v0[0], v0[1]); w.y = cvt_pk_bf16(v0[2], v0[3]); w.z = cvt_pk_bf16(v1[0], v1[1]); w.w = cvt_pk_bf16(v1[2], v1[3]);
                    *(v4u*)(rowp + bj * PG_HALF) = w; } }
    }
};
namespace att {
constexpr int KB_BYTES = 12288, VB_BYTES = 12288, BUF_BYTES = KB_BYTES + VB_BYTES;
constexpr int NBUF = 4;
constexpr int OFF_IMP = 2 * BUF_BYTES;
constexpr int OFF_SC = OFF_IMP + 32768;
constexpr int OFF_IMP2 = 0, OFF_SC2 = 32768;
constexpr int OFF_SEL = NBUF * BUF_BYTES;
constexpr int OFF_END = OFF_SEL + 512;
static_assert(OFF_SC + 8192 <= NBUF * BUF_BYTES, "selection scratch must stay inside the aliased buffers");
static_assert(OFF_END <= RING_BYTES, "attention LDS map");

__device__ __forceinline__ int crow(int r, int hi) { return (r & 3) + 8 * (r >> 2) + 4 * hi; }
__device__ __forceinline__ s16x4 vtr(const LAS unsigned char* p) { typedef short v4i16_t __attribute__((ext_vector_type(4))); return __builtin_bit_cast(s16x4, __builtin_amdgcn_ds_read_tr16_b64_v4i16((LAS v4i16_t*)p)); }
__device__ __forceinline__ unsigned cvtpk(float lo, float hi) { typedef float f2 __attribute__((ext_vector_type(2))); typedef __bf16 b2 __attribute__((ext_vector_type(2))); f2 v = {lo, hi}; b2 b = __builtin_convertvector(v, b2); return __builtin_bit_cast(unsigned, b); }
__device__ __forceinline__ float swapmax(float m) { auto rr = __builtin_amdgcn_permlane32_swap(__float_as_uint(m), __float_as_uint(m), false, false); return fmaxf(__uint_as_float(rr[0]), __uint_as_float(rr[1])); }
__device__ __forceinline__ float swapsum(float m) { auto rr = __builtin_amdgcn_permlane32_swap(__float_as_uint(m), __float_as_uint(m), false, false); return __uint_as_float(rr[0]) + __uint_as_float(rr[1]); }

__device__ __forceinline__ float max3f(float a, float b, float c) { float r; asm("v_max3_f32 %0, %1, %2, %3" : "=v"(r) : "v"(a), "v"(b), "v"(c)); return r; }
__device__ __forceinline__ float max2f(float a, float b) { float r; asm("v_max_f32_e32 %0, %1, %2" : "=v"(r) : "v"(a), "v"(b)); return r; }
struct Flash { f32x16 o[3]; float m, l; };
constexpr float FLASH_THR = 8.0f;
__device__ __forceinline__ void flash_init(Flash& f) { f.o[0] = f32x16{}; f.o[1] = f32x16{}; f.o[2] = f32x16{}; f.m = 0.f; f.l = 0.f; }

template <int NKC>
__device__ __forceinline__ void issue_tile(LAS unsigned char* lds, int buf, const bf16* Kg, int ldk, const bf16* Kpe, const bf16* Vg, int ldv, int wave, int lane) {
    LAS unsigned char* kb = lds + buf * BUF_BYTES; LAS unsigned char* vb = kb + KB_BYTES;
    { const int row = 8 * wave + (lane >> 3), chunk = (lane & 7) ^ ((row >> 1) & 7);
      __builtin_amdgcn_global_load_lds((const unsigned*)(Kg + (size_t)row * ldk + chunk * 8), (LAS unsigned*)(kb + wave * 1024), 16, 0, 0); }
    if (NKC == 12) { if (wave < 4) { const int row = 16 * wave + (lane >> 2), chunk = (lane & 3) ^ ((row >> 2) & 3);
      __builtin_amdgcn_global_load_lds((const unsigned*)(Kpe + (size_t)row * 32 + chunk * 8), (LAS unsigned*)(kb + 8192 + wave * 1024), 16, 0, 0); } }
    __builtin_amdgcn_global_load_lds((const unsigned*)(Vg + (size_t)(16 * (wave & 3) + (lane >> 2)) * ldv + (wave >> 2) * 32 + (lane & 3) * 8), (LAS unsigned*)(vb + wave * 1024), 16, 0, 0);
}

template <int NKS, int NVB, bool HAS_BIAS>
__device__ __forceinline__ void tile_compute(Flash& f, const LAS unsigned char* kb, const LAS unsigned char* vb, const bf16x8* qr, float slope, float cb,
                                             int lo, int hi_, bool need_mask, bool set_ref, int r32, int hh, int lane) {
    const LAS unsigned char* vp = vb + ((lane >> 4) & 1) * 32 + (lane & 3) * 8 + (4 * hh + ((lane & 15) >> 2)) * 64;
    s16x4 vl[NVB][4], vh[NVB][4];
    f32x16 p0, p1;
    if (HAS_BIAS) {
        const float cb0 = (cb - f.m) + slope * (float)(4 * hh), cb1 = cb0 + slope * 32.f;
#pragma unroll
        for (int r = 0; r < 16; ++r) { const float cr = (float)((r & 3) + 8 * (r >> 2)); p0[r] = __builtin_fmaf(slope, cr, cb0); p1[r] = __builtin_fmaf(slope, cr, cb1); }
    } else {
        const float nm = -f.m;
#pragma unroll
        for (int r = 0; r < 16; ++r) { p0[r] = nm; p1[r] = nm; }
    }
    const LAS unsigned char* kp = kb + r32 * 128; const int sw = (r32 >> 1) & 7;
    const LAS unsigned char* kpe = kb + 8192 + r32 * 64; const int swe = (r32 >> 2) & 3;
    bf16x8 kf0[NKS], kf1[NKS];
    auto kload = [&](int d0) {
        const LAS unsigned char* a0 = (d0 < 4) ? kp + (((2 * d0 + hh) ^ sw) << 4) : kpe + (((2 * (d0 - 4) + hh) ^ swe) << 4);
        kf0[d0] = *(const LAS bf16x8*)(a0); kf1[d0] = *(const LAS bf16x8*)(a0 + ((d0 < 4) ? 4096 : 2048)); };
#pragma unroll
    for (int d0 = 0; d0 < 4; ++d0) kload(d0);
    __builtin_amdgcn_sched_barrier(0);
#pragma unroll
    for (int d0 = 0; d0 < NKS; ++d0) {
        p0 = __builtin_amdgcn_mfma_f32_32x32x16_bf16(kf0[d0], qr[d0], p0, 0, 0, 0);
        p1 = __builtin_amdgcn_mfma_f32_32x32x16_bf16(kf1[d0], qr[d0], p1, 0, 0, 0);
        if (d0 + 4 < NKS) { kload(d0 + 4); __builtin_amdgcn_sched_barrier(0); }
    }
#pragma unroll
    for (int b = 0; b < NVB; ++b)
#pragma unroll
        for (int ks = 0; ks < 4; ++ks) {
            asm volatile("ds_read_b64_tr_b16 %0, %1 offset:%c2" : "=&v"(vl[b][ks]) : "v"(vp), "i"(b * 4096 + ks * 1024) : "memory");
            asm volatile("ds_read_b64_tr_b16 %0, %1 offset:%c2" : "=&v"(vh[b][ks]) : "v"(vp), "i"(b * 4096 + ks * 1024 + 512) : "memory"); }
    if (need_mask) {
        asm volatile("" ::: "memory");
        const int l0 = lo - 4 * hh, h0 = hi_ - 4 * hh;
#pragma unroll
        for (int r = 0; r < 16; ++r) { const int c = (r & 3) + 8 * (r >> 2);
            if (c < l0 || c > h0) p0[r] = -INFINITY;
            if (c + 32 < l0 || c + 32 > h0) p1[r] = -INFINITY; }
    }
    if (set_ref) {
        asm volatile("s_nop 15\n\ts_nop 7" : "+v"(p0), "+v"(p1));
        float mt;
        { float a = max3f(p0[0], p0[1], p1[0]), b = max3f(p0[2], p0[3], p1[1]); a = max3f(a, p1[2], p1[3]);
#pragma unroll
          for (int r = 4; r < 16; r += 4) { a = max3f(a, p0[r], p0[r + 1]); b = max3f(b, p0[r + 2], p0[r + 3]); a = max3f(a, p1[r], p1[r + 1]); b = max3f(b, p1[r + 2], p1[r + 3]); }
          mt = max2f(a, b); }
        { auto rr = __builtin_amdgcn_permlane32_swap(__float_as_uint(mt), __float_as_uint(mt), false, false); mt = max2f(__uint_as_float(rr[0]), __uint_as_float(rr[1])); }
        if (__any(mt > FLASH_THR)) {
            const float delta = fmaxf(mt, 0.f), alpha = __builtin_amdgcn_exp2f(-delta);
            f.m += delta; f.l *= alpha;
#pragma unroll
            for (int r = 0; r < 16; ++r) { p0[r] -= delta; p1[r] -= delta; }
#pragma unroll
            for (int b = 0; b < NVB; ++b)
#pragma unroll
                for (int r = 0; r < 16; ++r) f.o[b][r] *= alpha;
        }
    }
    float sum = 0.f;
#pragma unroll
    for (int r = 0; r < 16; ++r) { p0[r] = __builtin_amdgcn_exp2f(p0[r]); p1[r] = __builtin_amdgcn_exp2f(p1[r]); sum += p0[r] + p1[r]; }
    f.l += sum;
    if (__any(f.l > 0x1p60f)) {
        asm volatile("" ::: "memory");
        f.m += 60.f; f.l *= 0x1p-60f;
#pragma unroll
        for (int b = 0; b < NVB; ++b)
#pragma unroll
            for (int r = 0; r < 16; ++r) f.o[b][r] *= 0x1p-60f;
    }
    v4u pw[4];
    pw[0] = (v4u){cvtpk(p0[0], p0[1]), cvtpk(p0[2], p0[3]), cvtpk(p0[4], p0[5]), cvtpk(p0[6], p0[7])};
    pw[1] = (v4u){cvtpk(p0[8], p0[9]), cvtpk(p0[10], p0[11]), cvtpk(p0[12], p0[13]), cvtpk(p0[14], p0[15])};
    pw[2] = (v4u){cvtpk(p1[0], p1[1]), cvtpk(p1[2], p1[3]), cvtpk(p1[4], p1[5]), cvtpk(p1[6], p1[7])};
    pw[3] = (v4u){cvtpk(p1[8], p1[9]), cvtpk(p1[10], p1[11]), cvtpk(p1[12], p1[13]), cvtpk(p1[14], p1[15])};
    if (NVB == 3) asm volatile("s_waitcnt lgkmcnt(0)" : "+v"(vl[0][0]), "+v"(vl[0][1]), "+v"(vl[0][2]), "+v"(vl[0][3]), "+v"(vh[0][0]), "+v"(vh[0][1]), "+v"(vh[0][2]), "+v"(vh[0][3]),
                                                         "+v"(vl[1][0]), "+v"(vl[1][1]), "+v"(vl[1][2]), "+v"(vl[1][3]), "+v"(vh[1][0]), "+v"(vh[1][1]), "+v"(vh[1][2]), "+v"(vh[1][3]),
                                                         "+v"(vl[NVB - 1][0]), "+v"(vl[NVB - 1][1]), "+v"(vl[NVB - 1][2]), "+v"(vl[NVB - 1][3]), "+v"(vh[NVB - 1][0]), "+v"(vh[NVB - 1][1]), "+v"(vh[NVB - 1][2]), "+v"(vh[NVB - 1][3]) :: "memory");
    else          asm volatile("s_waitcnt lgkmcnt(0)" : "+v"(vl[0][0]), "+v"(vl[0][1]), "+v"(vl[0][2]), "+v"(vl[0][3]), "+v"(vh[0][0]), "+v"(vh[0][1]), "+v"(vh[0][2]), "+v"(vh[0][3]),
                                                         "+v"(vl[1][0]), "+v"(vl[1][1]), "+v"(vl[1][2]), "+v"(vl[1][3]), "+v"(vh[1][0]), "+v"(vh[1][1]), "+v"(vh[1][2]), "+v"(vh[1][3]) :: "memory");
    __builtin_amdgcn_sched_barrier(0);
#pragma unroll
    for (int b = 0; b < NVB; ++b)
#pragma unroll
        for (int ks = 0; ks < 4; ++ks) {
            const bf16x8 va = (bf16x8){vl[b][ks][0], vl[b][ks][1], vl[b][ks][2], vl[b][ks][3], vh[b][ks][0], vh[b][ks][1], vh[b][ks][2], vh[b][ks][3]};
            f.o[b] = __builtin_amdgcn_mfma_f32_32x32x16_bf16(va, __builtin_bit_cast(bf16x8, pw[ks]), f.o[b], 0, 0, 0);
        }
}
__device__ __forceinline__ void dma_wait_bar(int outstanding) {
    if (outstanding == 3) asm volatile("s_waitcnt vmcnt(3) lgkmcnt(0)\n\ts_barrier" ::: "memory");
    else if (outstanding == 2) asm volatile("s_waitcnt vmcnt(2) lgkmcnt(0)\n\ts_barrier" ::: "memory");
    else asm volatile("s_waitcnt vmcnt(0) lgkmcnt(0)\n\ts_barrier" ::: "memory");
}
template <bool DESC> __device__ __forceinline__ int pick_tile(unsigned m) { return DESC ? 31 - __builtin_clz(m) : __builtin_ctz(m); }
struct NoNext { __device__ __forceinline__ void operator()(int, int) const {} };
template <int NKS, int NVB, bool HAS_BIAS, bool DESC, bool NDESC, bool MAXALL, class Src, class Par, class NSrc>
__device__ __forceinline__ int flash_run(Flash& f, LAS unsigned char* lds, unsigned tm, const bf16x8* qr, float slope, const Src& src, const Par& par, bool pre, int slot0, unsigned ntm, const NSrc& nsrc, int r32, int hh, int lane) {
#ifdef TIMER_PHASE
    struct { LAS unsigned char* lds; } F{lds};
#endif
    unsigned rem = tm, ahead = tm;
    int islot = slot0, cslot = slot0, nslot = -1;
    bool first = true;
    auto issue_pair = [&]() {
        if (ahead) { const int j = pick_tile<DESC>(ahead); src(j, 2 * islot); ahead &= ~(1u << j);
            if (ahead) { const int j2 = pick_tile<DESC>(ahead); src(j2, 2 * islot + 1); ahead &= ~(1u << j2); } }
        else if (ntm && nslot < 0) { unsigned nm = ntm; const int j = pick_tile<NDESC>(nm); nsrc(j, 2 * islot); nm &= ~(1u << j);
            if (nm) { const int j2 = pick_tile<NDESC>(nm); nsrc(j2, 2 * islot + 1); } nslot = islot; }
        islot ^= 1; };
    if (pre) { int n = 0; unsigned a2 = ahead; while (a2 && n < 2) { const int j = pick_tile<DESC>(a2); a2 &= ~(1u << j); ++n; } ahead = a2; islot ^= 1; }
    else { TMS_BEGIN(44); issue_pair(); TMS_END(44); }
#pragma unroll 1
    while (rem) {
        const int ja = pick_tile<DESC>(rem); rem &= ~(1u << ja);
        int jb = -1; if (rem) { jb = pick_tile<DESC>(rem); rem &= ~(1u << jb); }
#ifdef TIMER_PHASE
        const unsigned long long tb0_ = (TIMER_PHASE == 40 || TIMER_PHASE == 41) ? __builtin_amdgcn_s_memrealtime() : 0ull;
#endif
        asm volatile("s_waitcnt vmcnt(0) lgkmcnt(0)\n\ts_barrier" ::: "memory");
#ifdef TIMER_PHASE
        if ((TIMER_PHASE == 40 && threadIdx.x == 0) || (TIMER_PHASE == 41 && threadIdx.x == 448)) *(LAS unsigned long long*)(lds + RING_BYTES + 512) += __builtin_amdgcn_s_memrealtime() - tb0_;
#endif
        { TMS_BEGIN(44); issue_pair(); TMS_END(44); }
        int lo, hi_; bool need; float cb;
        if (par(ja, lo, hi_, need, cb)) { const LAS unsigned char* kb = lds + (2 * cslot) * BUF_BYTES;
            TMS_BEGIN(43); tile_compute<NKS, NVB, HAS_BIAS>(f, kb, kb + KB_BYTES, qr, slope, cb, lo, hi_, need, MAXALL || first, r32, hh, lane); first = false; TMS_END(43); TMS_COUNT(42); }
        if (jb >= 0 && par(jb, lo, hi_, need, cb)) { const LAS unsigned char* kb = lds + (2 * cslot + 1) * BUF_BYTES;
            TMS_BEGIN(43); tile_compute<NKS, NVB, HAS_BIAS>(f, kb, kb + KB_BYTES, qr, slope, cb, lo, hi_, need, MAXALL || first, r32, hh, lane); first = false; TMS_END(43); TMS_COUNT(42); }
        cslot ^= 1;
    }
    if (nslot < 0) asm volatile("s_waitcnt lgkmcnt(0)\n\ts_barrier" ::: "memory");
    return nslot;
}

__device__ __forceinline__ void flash_finish(Flash& f, int nvb) {
    const float lt = swapsum(f.l); const float inv = lt > 0.f ? 1.0f / lt : 0.f;
#pragma unroll
    for (int b = 0; b < 3; ++b) if (b < nvb) {
#pragma unroll
        for (int r = 0; r < 16; ++r) f.o[b][r] *= inv; }
}

__device__ __forceinline__ void nsa_unit(Frame& F, int b, int g, int qc) {
    int lane; asm volatile("v_and_b32_e32 %0, 63, %1" : "=v"(lane) : "v"(F.tid));
    LAS unsigned char* lds = F.lds; const int wave = F.wave, r32 = lane & 31, hh = lane >> 5;
    const int head = g * 4 + (wave >> 1);
    const int qloc = 32 * (wave & 1) + r32;
    const int t = 64 * qc + qloc;
    const size_t row = (size_t)b * SEQ + t;
    const bf16* QKV = (const bf16*)(F.ws + WS_QKV); const bf16* MISC = (const bf16*)(F.ws + WS_MISC);
    bf16x8 qr[4];
#pragma unroll
    for (int d0 = 0; d0 < 4; ++d0) qr[d0] = *(const bf16x8*)(QKV + row * 1280 + head * 64 + d0 * 16 + hh * 8);
    float graw_c = bf2f(MISC[row * 256 + 160 + head]), graw_s = bf2f(MISC[row * 256 + 160 + 8 + head]), graw_w = bf2f(MISC[row * 256 + 160 + 16 + head]);
    asm volatile("" : "+v"(graw_c), "+v"(graw_s), "+v"(graw_w) : "v"(qr[0]), "v"(qr[1]), "v"(qr[2]), "v"(qr[3]));
    const float slope2 = exp2f(-(float)(head + 1)) * LOG2E;
    LAS unsigned* selw = (LAS unsigned*)(lds + OFF_SEL);
    if (F.tid < 80) selw[F.tid] = 0u;
    f32x16 ot0, ot1;
    const bf16* Kw = QKV + (size_t)b * SEQ * 1280 + 1024 + g * 64; const bf16* Vw = QKV + (size_t)b * SEQ * 1280 + 1152 + g * 64;
    const bf16* Ks = QKV + (size_t)b * SEQ * 1280 + 768 + g * 64; const bf16* Vs = QKV + (size_t)b * SEQ * 1280 + 896 + g * 64;
    auto src_win = [&](int j, int buf) { issue_tile<8>(lds, buf, Kw + (size_t)j * 64 * 1280, 1280, nullptr, Vw + (size_t)j * 64 * 1280, 1280, wave, lane); };
    auto src_sel = [&](int j, int buf) { issue_tile<8>(lds, buf, Ks + (size_t)j * 64 * 1280, 1280, nullptr, Vs + (size_t)j * 64 * 1280, 1280, wave, lane); };
    const int j0w = qc >= 8 ? qc - 8 : 0;
    const unsigned tm_win = (qc == 31 ? 0xffffffffu : ((2u << qc) - 1u)) & ~((1u << j0w) - 1u);
    TMS_DECL; TMS_MARK(47);
    int hand;
    {
        const bf16* KC = (const bf16*)(F.ws + WS_KC) + (size_t)(b * 2 + g) * 128 * 64; const bf16* VC = (const bf16*)(F.ws + WS_VC) + (size_t)(b * 2 + g) * 128 * 64;
        Flash f; flash_init(f);
        int nmax = (t >= 31) ? ((t - 31) >> 4) : -1; if (nmax > 126) nmax = 126;
        const int tid = F.tid;
        auto src = [&](int ti, int buf) {
            issue_tile<8>(lds, buf, KC + (size_t)ti * 64 * 64, 64, nullptr, VC + (size_t)ti * 64 * 64, 64, wave, lane);
            LAS bf16* ov = (LAS bf16*)(lds + buf * BUF_BYTES + KB_BYTES + 2 * 4096);
#pragma unroll
            for (int e = 0; e < 4; ++e) { const int idx = tid * 4 + e, nl = idx >> 5, s_ = idx & 31, n = 64 * ti + nl;
                float v = 0.f; if (s_ == (n >> 2)) v = ((n & 3) == 3) ? 0.5f : 1.0f; else if (s_ == (n >> 2) + 1 && (n & 3) == 3) v = 0.5f;
                ov[(nl >> 4) * 512 + (nl & 15) * 32 + s_] = (bf16)f2bf(v); } };
        auto par = [&](int ti, int& lo, int& hi_, bool& need, float& cb) { lo = 0; hi_ = nmax - 64 * ti; need = true; cb = 16.f * slope2 * (float)(64 * ti); return true; };
        TMS_MARKEND(47);
        hand = flash_run<4, 3, true, true, true, true>(f, lds, 3u, qr, 16.f * slope2, src, par, false, 0, tm_win, src_win, r32, hh, lane);
        flash_finish(f, 3);
        TMS_MARK(45);
        asm volatile("s_waitcnt lgkmcnt(0)\n\ts_barrier" ::: "memory");
        LAS float* imp = (LAS float*)(lds + OFF_IMP2) + (wave * 32 + r32) * 32;
#pragma unroll
        for (int r = 0; r < 16; ++r) imp[crow(r, hh)] = f.o[2][r];
        const float gc = sigmoidf_(graw_c);
        ot0 = f.o[0] * gc; ot1 = f.o[1] * gc;
    }
    asm volatile("s_waitcnt lgkmcnt(0)\n\ts_barrier" ::: "memory");
    if (qc < 16) { if (F.tid <= 64) selw[F.tid] = (2u << qc) - 1u; }
    else {
        LAS float* IMP = (LAS float*)(lds + OFF_IMP2); LAS float* SC = (LAS float*)(lds + OFF_SC2);
        const int q = F.tid >> 3, s4 = (F.tid & 7) * 4;
#pragma unroll
        for (int e = 0; e < 4; ++e) { const int s_ = s4 + e; float v = 0.f;
#pragma unroll
            for (int h4 = 0; h4 < 4; ++h4) v += IMP[((2 * h4 + (q >> 5)) * 32 + (q & 31)) * 32 + s_];
            const bool causal = s_ <= qc, forced = causal && (s_ == 0 || s_ + 2 > qc);
            SC[q * 32 + s_] = causal ? (v + (forced ? 1e4f : 0.f)) : -1e30f; }
        asm volatile("s_waitcnt lgkmcnt(0)\n\ts_barrier" ::: "memory");
        float sc[32];
#pragma unroll
        for (int s_ = 0; s_ < 32; ++s_) sc[s_] = SC[q * 32 + s_];
        unsigned bits = 0u;
#pragma unroll
        for (int e = 0; e < 4; ++e) { const int s_ = s4 + e; const float me = SC[q * 32 + s_]; int rank = 0;
#pragma unroll
            for (int s2 = 0; s2 < 32; ++s2) rank += (sc[s2] > me || (sc[s2] == me && s2 < s_)) ? 1 : 0;
            if (s_ <= qc && rank < 16) bits |= 1u << s_; }
        atomicOr((unsigned*)&selw[q], bits); atomicOr((unsigned*)&selw[64], bits);
    }
    asm volatile("s_waitcnt lgkmcnt(0)\n\ts_barrier" ::: "memory");
    const unsigned mymask = selw[qloc], anymask = selw[64];
    TMS_MARKEND(45);
    {
        Flash f; flash_init(f);
        auto par = [&](int j, int& lo, int& hi_, bool& need, float& cb) { lo = t - 511 - 64 * j; if (lo < 0) lo = 0; hi_ = t - 64 * j; if (hi_ > 63) hi_ = 63;
            need = (j == qc) || (j + 8 == qc); cb = slope2 * (float)(64 * j); return slope2 * (float)(64 * qc + 32 * (wave & 1) - (64 * j + 63)) < 256.f; };
        hand = flash_run<4, 2, true, true, true, false>(f, lds, tm_win, qr, slope2, src_win, par, true, hand, anymask, src_sel, r32, hh, lane);
        flash_finish(f, 2);
        const float gw = sigmoidf_(graw_w);
        ot0 += f.o[0] * gw; ot1 += f.o[1] * gw;
    }
    {
        Flash f; flash_init(f);
        const int tmin_w = 64 * qc + 32 * (wave & 1);
        auto par = [&](int j, int& lo, int& hi_, bool& need, float& cb) { const bool sel = (mymask >> j) & 1u; lo = 0; hi_ = (j == qc) ? (t - 64 * j) : 63;
            need = (j == qc); cb = sel ? slope2 * (float)(64 * j) : -INFINITY;
            return __any(sel) && slope2 * (float)(tmin_w - (64 * j + 63)) < 256.f; };
        (void)flash_run<4, 2, true, true, true, false>(f, lds, anymask, qr, slope2, src_sel, par, true, hand, 0u, NoNext(), r32, hh, lane);
        TMS_MARK(48);
        flash_finish(f, 2);
        const float gs = sigmoidf_(graw_s);
        ot0 += f.o[0] * gs; ot1 += f.o[1] * gs;
    }
    { bf16* op = (bf16*)(F.ws + WS_OCAT) + row * 1024 + head * 64 + 4 * hh;
#pragma unroll
      for (int k = 0; k < 4; ++k) {
          *(v2u*)(op + 8 * k) = (v2u){cvtpk(ot0[4 * k], ot0[4 * k + 1]), cvtpk(ot0[4 * k + 2], ot0[4 * k + 3])};
          *(v2u*)(op + 32 + 8 * k) = (v2u){cvtpk(ot1[4 * k], ot1[4 * k + 1]), cvtpk(ot1[4 * k + 2], ot1[4 * k + 3])}; } }
    TMS_MARKEND(48);
}

__device__ __forceinline__ void mla_unit(Frame& F, int b, int h, int qb) {
    int lane; asm volatile("v_and_b32_e32 %0, 63, %1" : "=v"(lane) : "v"(F.tid));
    LAS unsigned char* lds = F.lds; const int wave = F.wave, r32 = lane & 31, hh = lane >> 5;
    const int t = 256 * qb + 32 * wave + r32;
    const size_t row = (size_t)b * SEQ + t;
    const bf16* MQ = (const bf16*)(F.ws + WS_MLAQ); const bf16* MKV = (const bf16*)(F.ws + WS_MLAKV); const bf16* KPE = (const bf16*)(F.ws + WS_KPE);
    bf16x8 qr[6];
#pragma unroll
    for (int d0 = 0; d0 < 6; ++d0) qr[d0] = *(const bf16x8*)(MQ + row * 768 + h * 96 + d0 * 16 + hh * 8);
    {
        const float pos = (float)F.pos[row];
        v4u a = __builtin_bit_cast(v4u, qr[4]), c = __builtin_bit_cast(v4u, qr[5]);
        float x1[8], x2[8];
        x1[0] = bf_lo(a.x); x1[1] = bf_hi(a.x); x1[2] = bf_lo(a.y); x1[3] = bf_hi(a.y); x1[4] = bf_lo(a.z); x1[5] = bf_hi(a.z); x1[6] = bf_lo(a.w); x1[7] = bf_hi(a.w);
        x2[0] = bf_lo(c.x); x2[1] = bf_hi(c.x); x2[2] = bf_lo(c.y); x2[3] = bf_hi(c.y); x2[4] = bf_lo(c.z); x2[5] = bf_hi(c.z); x2[6] = bf_lo(c.w); x2[7] = bf_hi(c.w);
        float y1[8], y2[8];
#pragma unroll
        for (int j = 0; j < 8; ++j) { const float ang = pos * rope_inv(8 * hh + j); float sn, cs; rope_sincos(ang, sn, cs);
            y1[j] = x1[j] * cs - x2[j] * sn; y2[j] = x1[j] * sn + x2[j] * cs; }
        a = (v4u){cvtpk(y1[0], y1[1]), cvtpk(y1[2], y1[3]), cvtpk(y1[4], y1[5]), cvtpk(y1[6], y1[7])};
        c = (v4u){cvtpk(y2[0], y2[1]), cvtpk(y2[2], y2[3]), cvtpk(y2[4], y2[5]), cvtpk(y2[6], y2[7])};
        qr[4] = __builtin_bit_cast(bf16x8, a); qr[5] = __builtin_bit_cast(bf16x8, c);
    }
    asm volatile("" :: "v"(qr[0]), "v"(qr[1]), "v"(qr[2]), "v"(qr[3]), "v"(qr[4]), "v"(qr[5]));
    const bf16* Kg = MKV + (size_t)b * SEQ * 1024 + h * 128; const bf16* Vg = Kg + 64; const bf16* Pg = KPE + (size_t)b * SEQ * 32;
    Flash f; flash_init(f);
    const int NT = 4 * qb + 4;
    const int tmin_w = 256 * qb + 32 * wave, tmax_w = tmin_w + 31;
    auto src = [&](int j, int buf) { issue_tile<12>(lds, buf, Kg + (size_t)j * 64 * 1024, 1024, Pg + (size_t)j * 64 * 32, Vg + (size_t)j * 64 * 1024, 1024, wave, lane); };
    auto par = [&](int j, int& lo, int& hi_, bool& need, float& cb) { lo = 0; hi_ = t - 64 * j; if (hi_ > 63) hi_ = 63; need = (64 * j + 63 > tmin_w); cb = 0.f; return 64 * j <= tmax_w; };
    (void)flash_run<6, 2, false, false, false, false>(f, lds, NT == 32 ? 0xffffffffu : ((1u << NT) - 1u), qr, 0.f, src, par, false, 0, 0u, NoNext(), r32, hh, lane);
    flash_finish(f, 2);
    { bf16* op = (bf16*)(F.ws + WS_OCAT) + row * 1024 + 512 + h * 64 + 4 * hh;
#pragma unroll
      for (int k = 0; k < 4; ++k) {
          *(v2u*)(op + 8 * k) = (v2u){cvtpk(f.o[0][4 * k], f.o[0][4 * k + 1]), cvtpk(f.o[0][4 * k + 2], f.o[0][4 * k + 3])};
          *(v2u*)(op + 32 + 8 * k) = (v2u){cvtpk(f.o[1][4 * k], f.o[1][4 * k + 1]), cvtpk(f.o[1][4 * k + 2], f.o[1][4 * k + 3])}; } }
}

__device__ __forceinline__ int draw_unit(Frame& F, unsigned* ctr) {
    TMS_BEGIN(46);
    LAS int* slot = (LAS int*)(F.lds + OFF_SEL + 384);
    if (F.tid == 0) *slot = (int)__hip_atomic_fetch_add(ctr, 1u, __ATOMIC_RELAXED, __HIP_MEMORY_SCOPE_AGENT);
    __syncthreads();
    const int v = *slot;
    __syncthreads();
    TMS_END(46);
    return __builtin_amdgcn_readfirstlane(v);
}
__device__ __forceinline__ void nsa_loop(Frame& F) {
    unsigned* ctr = (unsigned*)(F.ws + WS_CTL) + 8192;
#pragma unroll 1
    for (int first = 1;; first = 0) { const int idx = (first && F.bid < 256) ? F.bid : 256 + draw_unit(F, ctr); if (idx >= 512) break; const int qc = 31 - (idx >> 4), bg = idx & 15; nsa_unit(F, bg >> 1, bg & 1, qc); }
}
__device__ __forceinline__ void mla_loop(Frame& F) {
    unsigned* ctr = (unsigned*)(F.ws + WS_CTL) + 8192 + 64;
#pragma unroll 1
    for (int first = 1;; first = 0) { const int idx = (first && F.bid < 256) ? F.bid : 256 + draw_unit(F, ctr); if (idx >= 512) break; const int qb = 7 - (idx >> 6), bh = idx & 63; mla_unit(F, bh >> 3, bh & 7, qb); }
}
}
#define NET_SORT16(K) do { CE(K[0], K[1]); CE(K[2], K[3]); CE(K[0], K[2]); CE(K[1], K[3]); CE(K[1], K[2]); CE(K[4], K[5]); CE(K[6], K[7]); CE(K[4], K[6]); CE(K[5], K[7]); CE(K[5], K[6]); CE(K[0], K[4]); CE(K[2], K[6]); CE(K[2], K[4]); CE(K[1], K[5]); CE(K[3], K[7]); CE(K[3], K[5]); CE(K[1], K[2]); CE(K[3], K[4]); CE(K[5], K[6]); CE(K[8], K[9]); CE(K[10], K[11]); CE(K[8], K[10]); CE(K[9], K[11]); CE(K[9], K[10]); CE(K[12], K[13]); CE(K[14], K[15]); CE(K[12], K[14]); CE(K[13], K[15]); CE(K[13], K[14]); CE(K[8], K[12]); CE(K[10], K[14]); CE(K[10], K[12]); CE(K[9], K[13]); CE(K[11], K[15]); CE(K[11], K[13]); CE(K[9], K[10]); CE(K[11], K[12]); CE(K[13], K[14]); CE(K[0], K[8]); CE(K[4], K[12]); CE(K[4], K[8]); CE(K[2], K[10]); CE(K[6], K[14]); CE(K[6], K[10]); CE(K[2], K[4]); CE(K[6], K[8]); CE(K[10], K[12]); CE(K[1], K[9]); CE(K[5], K[13]); CE(K[5], K[9]); CE(K[3], K[11]); CE(K[7], K[15]); CE(K[7], K[11]); CE(K[3], K[5]); CE(K[7], K[9]); CE(K[11], K[13]); CE(K[1], K[2]); CE(K[3], K[4]); CE(K[5], K[6]); CE(K[7], K[8]); CE(K[9], K[10]); CE(K[11], K[12]); CE(K[13], K[14]); } while (0)
#define NET_BMERGE16(K) do { CE(K[0], K[8]); CE(K[1], K[9]); CE(K[2], K[10]); CE(K[3], K[11]); CE(K[4], K[12]); CE(K[5], K[13]); CE(K[6], K[14]); CE(K[7], K[15]); CE(K[0], K[4]); CE(K[1], K[5]); CE(K[2], K[6]); CE(K[3], K[7]); CE(K[8], K[12]); CE(K[9], K[13]); CE(K[10], K[14]); CE(K[11], K[15]); CE(K[0], K[2]); CE(K[1], K[3]); CE(K[4], K[6]); CE(K[5], K[7]); CE(K[8], K[10]); CE(K[9], K[11]); CE(K[12], K[14]); CE(K[13], K[15]); CE(K[0], K[1]); CE(K[2], K[3]); CE(K[4], K[5]); CE(K[6], K[7]); CE(K[8], K[9]); CE(K[10], K[11]); CE(K[12], K[13]); CE(K[14], K[15]); } while (0)
__device__ __forceinline__ void kpe_pass(Frame& F) {
    const bf16* MISC = (const bf16*)(F.ws + WS_MISC); bf16* KPE = (bf16*)(F.ws + WS_KPE);
    const int gt = F.bid * NTHREADS + F.tid, NGT = F.G * NTHREADS;
    for (int it = gt; it < MTOK * 16; it += NGT) { const int t = it >> 4, i = it & 15;
        const float x1 = bf2f(MISC[(size_t)t * 256 + 128 + i]), x2 = bf2f(MISC[(size_t)t * 256 + 144 + i]);
        const float ang = (float)F.pos[t] * rope_inv(i); float sn, cs; rope_sincos(ang, sn, cs);
        KPE[(size_t)t * 32 + i] = (bf16)f2bf(x1 * cs - x2 * sn); KPE[(size_t)t * 32 + 16 + i] = (bf16)f2bf(x1 * sn + x2 * cs); }
}
__device__ __forceinline__ void cmp_finalize(Frame& F) {
    const int gw = F.bid * NWAVES + F.wave, NGW = F.G * NWAVES, lane = F.lane;
    LAS float* W2S = (LAS float*)(F.lds + 16384);
    LAS float* hid = (LAS float*)(F.lds + F.wave * 1024);
    for (int i = F.tid; i < 2 * 128 * 64 / 4; i += NTHREADS) { const int kv = i >> 11, j = i & 2047; ((LAS f32x4*)W2S)[i] = ((const f32x4*)F.in[kv ? I_CW2V : I_CW2K])[j]; }
    __syncthreads();
    for (int it = gw; it < 2 * 16 * 128; it += NGW) {
        const int kv = it >> 11, bg = (it >> 7) & 15, n = it & 127;
        bf16* dst = (bf16*)(F.ws + (kv ? WS_VC : WS_KC)) + ((size_t)bg * 128 + n) * 64;
        if (n == 127) { dst[lane] = 0; continue; }
        const float* U = (const float*)(F.ws + WS_USLAB) + (size_t)kv * 4 * 2048 * 256 + (size_t)(bg * 128 + n) * 256; const float* c1 = (const float*)(F.ws + (kv ? WS_C1V : WS_C1K));
        float a0 = c1[lane], a1 = c1[64 + lane];
#pragma unroll
        for (int s = 0; s < 4; ++s) { const float* Us = U + (size_t)s * 2048 * 256; a0 += Us[lane] + Us[256 + 128 + lane]; a1 += Us[64 + lane] + Us[256 + 192 + lane]; }
        hid[lane] = gelu_tanh(a0); hid[64 + lane] = gelu_tanh(a1);
        asm volatile("s_waitcnt lgkmcnt(0)" ::: "memory");
        const LAS float* w2 = W2S + kv * 8192 + lane;
        float s0 = 0.f, s1 = 0.f, s2 = 0.f, s3 = 0.f;
#pragma unroll 8
        for (int i = 0; i < 128; i += 4) { s0 += hid[i] * w2[i * 64]; s1 += hid[i + 1] * w2[(i + 1) * 64]; s2 += hid[i + 2] * w2[(i + 2) * 64]; s3 += hid[i + 3] * w2[(i + 3) * 64]; }
        dst[lane] = (bf16)f2bf((s0 + s1) + (s2 + s3));
        asm volatile("s_waitcnt lgkmcnt(0)" ::: "memory");
    }
}
template <bool SIGNED>
__device__ __forceinline__ void quant_table(Frame& F, const float* src, unsigned char* dst, float* steps) {
    const int gw = F.bid * NWAVES + F.wave, NGW = F.G * NWAVES, lane = F.lane;
    for (int e0 = gw; e0 < 16384; e0 += 2 * NGW) {
        const int e1 = (e0 + NGW < 16384) ? e0 + NGW : e0;
        const f32x4* spa = (const f32x4*)(src + (size_t)e0 * 1024) + 4 * lane; const f32x4* spb = (const f32x4*)(src + (size_t)e1 * 1024) + 4 * lane;
        f32x4 va[4], vb[4];
#pragma unroll
        for (int j = 0; j < 4; ++j) { va[j] = spa[j]; vb[j] = spb[j]; }
        float ma = 0.f, mb = 0.f;
#pragma unroll
        for (int j = 0; j < 4; ++j) { ma = fmaxf(ma, fmaxf(fmaxf(fabsf(va[j].x), fabsf(va[j].y)), fmaxf(fabsf(va[j].z), fabsf(va[j].w)))); mb = fmaxf(mb, fmaxf(fmaxf(fabsf(vb[j].x), fabsf(vb[j].y)), fmaxf(fabsf(vb[j].z), fabsf(vb[j].w)))); }
#pragma unroll
        for (int o = 1; o < 64; o <<= 1) { ma = fmaxf(ma, __shfl_xor(ma, o)); mb = fmaxf(mb, __shfl_xor(mb, o)); }
        const float offs = SIGNED ? 0.f : 128.f;
        const float sta = ma > 0.f ? ma * (1.0f / 127.0f) : 1.0f, ia = 1.0f / sta, stb = mb > 0.f ? mb * (1.0f / 127.0f) : 1.0f, ib = 1.0f / stb;
        v4u wa, wb;
#pragma unroll
        for (int j = 0; j < 4; ++j) {
            wa[j] = ((unsigned)(int)(rintf(va[j].x * ia) + offs) & 0xffu) | (((unsigned)(int)(rintf(va[j].y * ia) + offs) & 0xffu) << 8) | (((unsigned)(int)(rintf(va[j].z * ia) + offs) & 0xffu) << 16) | (((unsigned)(int)(rintf(va[j].w * ia) + offs) & 0xffu) << 24);
            wb[j] = ((unsigned)(int)(rintf(vb[j].x * ib) + offs) & 0xffu) | (((unsigned)(int)(rintf(vb[j].y * ib) + offs) & 0xffu) << 8) | (((unsigned)(int)(rintf(vb[j].z * ib) + offs) & 0xffu) << 16) | (((unsigned)(int)(rintf(vb[j].w * ib) + offs) & 0xffu) << 24); }
        ((v4u*)(dst + (size_t)e0 * 1024))[lane] = wa; ((v4u*)(dst + (size_t)e1 * 1024))[lane] = wb;
        if (lane == 0) { steps[e0] = sta; steps[e1] = stb; }
    }
}

namespace peer {
constexpr int TOK = 32;
constexpr int LSTR = 17;
constexpr int OFF_LISTV = 0, OFF_LISTK = 34816;
constexpr int OFF_ROUTE = 45056;
constexpr int OFF_SKB = 77824;
struct Ent { float v; unsigned k; };
__device__ __forceinline__ unsigned ordkey(float f) { const unsigned u = __float_as_uint(f); return u ^ ((u >> 31) ? 0xffffffffu : 0x80000000u); }
__device__ __forceinline__ float ordinv(unsigned k) { return __uint_as_float(k ^ ((k >> 31) ? 0x80000000u : 0xffffffffu)); }
__device__ __forceinline__ void swap2(int x, int& lo, int& hi) { auto rr = __builtin_amdgcn_permlane32_swap((unsigned)x, (unsigned)x, false, false); lo = (int)rr[0]; hi = (int)rr[1]; }

#define CE(a, b) do { const unsigned x_ = (a) > (b) ? (a) : (b), y_ = (a) > (b) ? (b) : (a); (a) = x_; (b) = y_; } while (0)
__device__ __forceinline__ void merge_top16(unsigned (&a)[16], const unsigned (&b)[16]) {
#pragma unroll
    for (int i = 0; i < 16; ++i) a[i] = a[i] > b[15 - i] ? a[i] : b[15 - i];
    NET_BMERGE16(a);
}
__device__ __forceinline__ void top16_of64(unsigned (&w)[4][16]) {
    NET_SORT16(w[0]); NET_SORT16(w[1]); NET_SORT16(w[2]); NET_SORT16(w[3]);
    merge_top16(w[0], w[1]); merge_top16(w[2], w[3]); merge_top16(w[0], w[2]);
}

#define PEER_CANDS(X) X(0,0) X(0,1) X(0,2) X(0,3) X(0,4) X(0,5) X(0,6) X(0,7) X(0,8) X(0,9) X(0,10) X(0,11) X(0,12) X(0,13) X(0,14) X(0,15) \
    X(1,0) X(1,1) X(1,2) X(1,3) X(1,4) X(1,5) X(1,6) X(1,7) X(2,0) X(2,1) X(2,2) X(2,3) X(2,4) X(3,0) X(3,1) X(3,2) X(3,3) X(4,0) X(4,1) X(4,2) \
    X(5,0) X(5,1) X(6,0) X(6,1) X(7,0) X(7,1) X(8,0) X(9,0) X(10,0) X(11,0) X(12,0) X(13,0) X(14,0) X(15,0)

__device__ __forceinline__ void route_task(Frame& F, int tok0) {
    int lane; asm volatile("v_and_b32_e32 %0, 63, %1" : "=v"(lane) : "v"(F.tid));
    const int wave = F.wave, r32 = lane & 31, hh = lane >> 5;
    const bf16* QP = (const bf16*)(F.ws + WS_QP);
    const size_t row = (size_t)tok0 + r32;
    LAS float* LV = (LAS float*)(F.lds + OFF_LISTV) + (size_t)wave * 2 * TOK * LSTR;
    LAS unsigned char* LK = F.lds + OFF_LISTK + (size_t)wave * 2 * TOK * LSTR;
    LAS unsigned char* SKB = F.lds + OFF_SKB;
#pragma unroll 1
    for (int half = 0; half < 2; ++half) {
        const bf16* SK = (const bf16*)(F.ws + (half ? WS_SK2 : WS_SK1));
        if (half) __syncthreads();
#pragma unroll
        for (int i = 0; i < 4; ++i) { const int pc = 4 * wave + i, c = pc >> 1, kbk = pc & 1;
            __builtin_amdgcn_global_load_lds((const unsigned*)(SK + (size_t)(64 * kbk + lane) * 128 + c * 8), (LAS unsigned*)(SKB + c * 2048 + kbk * 1024), 16, 0, 0); }
        bf16x8 qf[8];
#pragma unroll
        for (int d0 = 0; d0 < 8; ++d0) qf[d0] = *(const bf16x8*)(QP + row * 2048 + wave * 256 + half * 128 + d0 * 16 + hh * 8);
        __syncthreads();
        unsigned u[4][16];
#pragma unroll
        for (int kb = 0; kb < 4; ++kb) { f32x16 pacc = f32x16{};
#pragma unroll
            for (int d0 = 0; d0 < 8; ++d0) { const bf16x8 a = *(const LAS bf16x8*)(SKB + (2 * d0 + hh) * 2048 + (32 * kb + r32) * 16);
                pacc = __builtin_amdgcn_mfma_f32_32x32x16_bf16(a, qf[d0], pacc, 0, 0, 0); }
#pragma unroll
            for (int r = 0; r < 16; ++r) u[kb][r] = ordkey(pacc[r]); }
        unsigned prefix;
        { unsigned w[4][16];
#pragma unroll
          for (int kb = 0; kb < 4; ++kb)
#pragma unroll
              for (int r = 0; r < 16; ++r) w[kb][r] = u[kb][r];
          top16_of64(w);
          unsigned t = 0xffffffffu;
#pragma unroll
          for (int i = 0; i < 8; ++i) { auto ra = __builtin_amdgcn_permlane32_swap(w[0][i], w[0][i], false, false); auto rb = __builtin_amdgcn_permlane32_swap(w[0][15 - i], w[0][15 - i], false, false);
              const unsigned m1 = ra[0] > rb[1] ? ra[0] : rb[1], m2 = rb[0] > ra[1] ? rb[0] : ra[1]; t = m1 < t ? m1 : t; t = m2 < t ? m2 : t; }
          prefix = t; }
        int cgt = 0, ceq = 0;
#pragma unroll
        for (int kb = 0; kb < 4; ++kb)
#pragma unroll
            for (int r = 0; r < 16; ++r) { cgt += (u[kb][r] > prefix) ? 1 : 0; ceq += (u[kb][r] == prefix) ? 1 : 0; }
        int g0, g1, e0, e1; swap2(cgt, g0, g1); swap2(ceq, e0, e1);
        const int need = 16 - (g0 + g1);
        const int take0 = e0 < need ? e0 : need; const int take1 = (need - take0) < e1 ? (need - take0) : e1;
        int slot = hh ? (g0 + take0) : 0; int eq_left = hh ? take1 : take0;
        LAS float* Lv = LV + ((size_t)half * TOK + r32) * LSTR; LAS unsigned char* Lk = LK + ((size_t)half * TOK + r32) * LSTR;
#pragma unroll
        for (int kb = 0; kb < 4; ++kb)
#pragma unroll
            for (int r = 0; r < 16; ++r) { const unsigned uu = u[kb][r]; const int eq = ((uu == prefix) & (eq_left > 0)) ? 1 : 0; const int tk = (uu > prefix) ? 1 : eq;
                if (tk & (slot < 16)) { Lv[slot] = ordinv(uu); Lk[slot] = (unsigned char)(32 * kb + (r & 3) + 8 * (r >> 2) + 4 * hh); }
                slot += tk; eq_left -= eq; }
    }
    asm volatile("s_waitcnt lgkmcnt(0)" ::: "memory");
    {
        LAS float* Lv = LV + ((size_t)hh * TOK + r32) * LSTR; LAS unsigned char* Lk = LK + ((size_t)hh * TOK + r32) * LSTR;
        float v[16]; unsigned k[16];
#pragma unroll
        for (int a = 0; a < 16; ++a) { v[a] = Lv[a]; k[a] = Lk[a]; }
        asm volatile("s_waitcnt lgkmcnt(0)" ::: "memory");
#pragma unroll
        for (int a = 0; a < 16; ++a) { int rank = 0;
#pragma unroll
            for (int a2 = 0; a2 < 16; ++a2) rank += (v[a2] > v[a] || (v[a2] == v[a] && a2 < a)) ? 1 : 0;
            Lv[rank] = v[a]; Lk[rank] = (unsigned char)k[a]; }
    }
    asm volatile("s_waitcnt lgkmcnt(0)" ::: "memory");
    {
        const LAS float* L1v = LV + ((size_t)0 * TOK + r32) * LSTR; const LAS float* L2v = LV + ((size_t)1 * TOK + r32) * LSTR;
        const LAS unsigned char* L1k = LK + ((size_t)0 * TOK + r32) * LSTR; const LAS unsigned char* L2k = LK + ((size_t)1 * TOK + r32) * LSTR;
        float v1[16], v2[16];
#pragma unroll
        for (int a = 0; a < 16; ++a) { v1[a] = L1v[a]; v2[a] = L2v[a]; }
        unsigned uc[50]; { int ci = 0;
#define X(a, b) uc[ci++] = ordkey(v1[a] + v2[b]);
        PEER_CANDS(X)
#undef X
        }
        const float cmax = v1[0] + v2[0];
        unsigned prefix;
        { unsigned w[4][16];
#pragma unroll
          for (int i = 0; i < 64; ++i) w[i >> 4][i & 15] = i < 50 ? uc[i] : 0u;
          top16_of64(w);
          prefix = w[0][15]; }
        int cgt = 0; float gsum = 0.f;
#pragma unroll
        for (int i = 0; i < 50; ++i) cgt += (uc[i] > prefix) ? 1 : 0;
        int eq_left = 16 - cgt;
        unsigned long long selm = 0ull;
#pragma unroll
        for (int i = 0; i < 50; ++i) { const int eq = ((uc[i] == prefix) & (eq_left > 0)) ? 1 : 0; const int sl = (uc[i] > prefix) ? 1 : eq; eq_left -= eq;
            selm |= (unsigned long long)sl << i; gsum += sl ? __expf(ordinv(uc[i]) - cmax) : 0.f; }
        const float ginv = 1.0f / gsum;
        LAS Ent* R = (LAS Ent*)(F.lds + OFF_ROUTE) + ((size_t)wave * TOK + r32) * 16;
        if (hh == 0) { int i = 0, slot = 0;
#define X(a, b) { const int sl = (int)((selm >> i) & 1ull); if (sl & (slot < 16)) { R[slot].k = (unsigned)L1k[a] * 128u + (unsigned)L2k[b]; R[slot].v = __expf(ordinv(uc[i]) - cmax) * ginv; } slot += sl; ++i; }
            PEER_CANDS(X)
#undef X
        }
    }
}

constexpr int OFF_SORT = 77824;
constexpr int OFF_OFFS = 20480;
constexpr int NRANGE = 16, RSHIFT = 10;
__device__ __forceinline__ float ub0(unsigned w) { return (float)(w & 0xffu); }
__device__ __forceinline__ float ub1(unsigned w) { return (float)((w >> 8) & 0xffu); }
__device__ __forceinline__ float ub2(unsigned w) { return (float)((w >> 16) & 0xffu); }
__device__ __forceinline__ float ub3(unsigned w) { return (float)(w >> 24); }
__device__ __forceinline__ int mbcnt64(unsigned long long m) { return (int)__builtin_amdgcn_mbcnt_hi((unsigned)(m >> 32), __builtin_amdgcn_mbcnt_lo((unsigned)m, 0u)); }

constexpr int OFF_SDN = 0;
__device__ __forceinline__ void sort_token(Frame& F, int tl, int lane) {
    const LAS Ent* R = (const LAS Ent*)(F.lds + OFF_ROUTE); LAS Ent* SO = (LAS Ent*)(F.lds + OFF_SORT) + (size_t)tl * 128; LAS int* OF = (LAS int*)(F.lds + OFF_OFFS) + tl * 17;
    LAS float* SDN = (LAS float*)(F.lds + OFF_SDN) + tl * 128;
    const float* SD = (const float*)(F.ws + WS_EXPD_SC); const float* SU = (const float*)(F.ws + WS_EXPU_SC);
    const LAS Ent* p0 = R + ((size_t)(lane >> 4) * TOK + tl) * 16 + (lane & 15); const LAS Ent* p1 = R + ((size_t)(4 + (lane >> 4)) * TOK + tl) * 16 + (lane & 15);
    const unsigned e0 = p0->k, e1 = p1->k; const float g0 = p0->v * SU[e0], g1 = p1->v * SU[e1]; const float d0 = SD[e0], d1 = SD[e1];
    const int r0 = (int)(e0 >> RSHIFT), r1 = (int)(e1 >> RSHIFT);
    int base = 0, pos0 = 0, pos1 = 0;
#pragma unroll
    for (int r = 0; r < NRANGE; ++r) {
        const unsigned long long m0 = __ballot(r0 == r), m1 = __ballot(r1 == r);
        const int n0 = __popcll(m0), n1 = __popcll(m1);
        if (r0 == r) pos0 = base + mbcnt64(m0);
        if (r1 == r) pos1 = base + n0 + mbcnt64(m1);
        if (lane == 0) OF[r] = base;
        base += n0 + n1;
    }
    if (lane == 0) OF[NRANGE] = base;
    SO[pos0].k = e0; SO[pos0].v = g0; SO[pos1].k = e1; SO[pos1].v = g1; SDN[pos0] = d0; SDN[pos1] = d1;
}

struct Rows4 { v4u r[4]; };
__device__ __forceinline__ void fetch_rows(const unsigned char* tab, const LAS Ent* SO, Rows4& q, int lane) {
    unsigned ex[4];
#pragma unroll
    for (int k = 0; k < 4; ++k) ex[k] = (unsigned)__builtin_amdgcn_readfirstlane((int)SO[k].k);
#pragma unroll
    for (int k = 0; k < 4; ++k) q.r[k] = ((const v4u*)(tab + (size_t)ex[k] * 1024))[lane];
}
__device__ __forceinline__ void down_chunk(const Rows4& q, const int (&xq)[4], float sx, LAS Ent* SO, const LAS float* SDN, int lane) {
    int s[4];
#pragma unroll
    for (int k = 0; k < 4; ++k) { s[k] = 0;
#pragma unroll
        for (int c = 0; c < 4; ++c) s[k] = __builtin_amdgcn_sdot4((int)q.r[k][c], xq[c], s[k], false); }
#pragma unroll
    for (int k = 0; k < 4; ++k) s[k] += __builtin_amdgcn_update_dpp(0, s[k], 0xB1, 0xF, 0xF, true);
#pragma unroll
    for (int k = 0; k < 4; ++k) s[k] += __builtin_amdgcn_update_dpp(0, s[k], 0x4E, 0xF, 0xF, true);
#pragma unroll
    for (int k = 0; k < 4; ++k) s[k] += __builtin_amdgcn_update_dpp(0, s[k], 0x141, 0xF, 0xF, true);
#pragma unroll
    for (int k = 0; k < 4; ++k) s[k] += __builtin_amdgcn_update_dpp(0, s[k], 0x140, 0xF, 0xF, true);
    int dv = 0;
#pragma unroll
    for (int k = 0; k < 4; ++k) { const int dt = (__builtin_amdgcn_readlane(s[k], 0) + __builtin_amdgcn_readlane(s[k], 16)) + (__builtin_amdgcn_readlane(s[k], 32) + __builtin_amdgcn_readlane(s[k], 48)); dv = (lane == k) ? dt : dv; }
    if (lane < 4) { const float hk = SDN[lane] * sx * (float)dv; SO[lane].v = SO[lane].v * gelu_tanh(hk); }
}
__device__ __forceinline__ void up_chunk(const Rows4& q, unsigned wq4, int (&yi)[16]) {
#pragma unroll
    for (int c = 0; c < 4; ++c) {
        const unsigned r0 = q.r[0][c], r1 = q.r[1][c], r2 = q.r[2][c], r3 = q.r[3][c];
        const unsigned a_lo = __builtin_amdgcn_perm(r1, r0, 0x05010400u), a_hi = __builtin_amdgcn_perm(r1, r0, 0x07030602u);
        const unsigned b_lo = __builtin_amdgcn_perm(r3, r2, 0x05010400u), b_hi = __builtin_amdgcn_perm(r3, r2, 0x07030602u);
        yi[4 * c + 0] = __builtin_amdgcn_sdot4((int)__builtin_amdgcn_perm(b_lo, a_lo, 0x05040100u), (int)wq4, yi[4 * c + 0], false);
        yi[4 * c + 1] = __builtin_amdgcn_sdot4((int)__builtin_amdgcn_perm(b_lo, a_lo, 0x07060302u), (int)wq4, yi[4 * c + 1], false);
        yi[4 * c + 2] = __builtin_amdgcn_sdot4((int)__builtin_amdgcn_perm(b_hi, a_hi, 0x05040100u), (int)wq4, yi[4 * c + 2], false);
        yi[4 * c + 3] = __builtin_amdgcn_sdot4((int)__builtin_amdgcn_perm(b_hi, a_hi, 0x07060302u), (int)wq4, yi[4 * c + 3], false);
    }
}

__device__ __forceinline__ void gather_sweep(Frame& F, int tok0) {
    int lane; asm volatile("v_and_b32_e32 %0, 63, %1" : "=v"(lane) : "v"(F.tid));
    const int wave = F.wave;
#pragma unroll 1
    for (int i = 0; i < 4; ++i) sort_token(F, 4 * wave + i, lane);
    const unsigned char* EXPD = F.ws + WS_EXPD; const unsigned char* EXPU = F.ws + WS_EXPU;
    LAS Ent* SOW = (LAS Ent*)(F.lds + OFF_SORT) + (size_t)(4 * wave) * 128; const LAS float* SDW = (const LAS float*)(F.lds + OFF_SDN) + (4 * wave) * 128;
    {
        int xq[4][4]; float sxs[4];
#pragma unroll
        for (int tk = 0; tk < 4; ++tk) {
            const size_t row = (size_t)tok0 + 4 * wave + tk;
            const v4u* hp = (const v4u*)((const bf16*)(F.ws + WS_XN2) + row * DM) + 2 * lane; const f32x4* gp = (const f32x4*)F.in[I_N2G] + 4 * lane;
            float xh[16]; float ss = 0.f;
#pragma unroll
            for (int c = 0; c < 2; ++c) { const v4u w = hp[c]; xh[8 * c] = bf_lo(w.x); xh[8 * c + 1] = bf_hi(w.x); xh[8 * c + 2] = bf_lo(w.y); xh[8 * c + 3] = bf_hi(w.y); xh[8 * c + 4] = bf_lo(w.z); xh[8 * c + 5] = bf_hi(w.z); xh[8 * c + 6] = bf_lo(w.w); xh[8 * c + 7] = bf_hi(w.w); }
#pragma unroll
            for (int e = 0; e < 16; ++e) ss += xh[e] * xh[e];
            const float r = __builtin_amdgcn_rsqf(wave_sum(ss) * (1.f / DM) + EPS);
            float mx = 0.f;
#pragma unroll
            for (int c = 0; c < 4; ++c) { const f32x4 g = gp[c]; xh[4 * c] *= r * g.x; xh[4 * c + 1] *= r * g.y; xh[4 * c + 2] *= r * g.z; xh[4 * c + 3] *= r * g.w;
                mx = fmaxf(mx, fmaxf(fmaxf(fabsf(xh[4 * c]), fabsf(xh[4 * c + 1])), fmaxf(fabsf(xh[4 * c + 2]), fabsf(xh[4 * c + 3])))); }
#pragma unroll
            for (int o = 1; o < 64; o <<= 1) mx = fmaxf(mx, __shfl_xor(mx, o));
            mx = __uint_as_float((unsigned)__builtin_amdgcn_readfirstlane((int)__float_as_uint(mx)));
            const float step = mx > 0.f ? mx * (1.0f / 127.0f) : 1.0f, inv = 1.0f / step;
            sxs[tk] = step;
#pragma unroll
            for (int c = 0; c < 4; ++c) { const unsigned b0 = (unsigned)(int)rintf(xh[4 * c] * inv) & 0xffu, b1 = (unsigned)(int)rintf(xh[4 * c + 1] * inv) & 0xffu, b2 = (unsigned)(int)rintf(xh[4 * c + 2] * inv) & 0xffu, b3 = (unsigned)(int)rintf(xh[4 * c + 3] * inv) & 0xffu;
                xq[tk][c] = (int)(b0 | (b1 << 8) | (b2 << 16) | (b3 << 24)); }
        }
        asm volatile("s_waitcnt lgkmcnt(0)" ::: "memory");
        Rows4 b0, b1, b2, b3, b4, b5, b6, b7;
#define P1_FETCH(buf, u, j) fetch_rows(EXPD, SOW + ((u) & 3) * 128 + 4 * (2 * (j) + ((u) >> 2)), buf, lane)
#define P1_STEP(buf, u) do { down_chunk(buf, xq[(u) & 3], sxs[(u) & 3], SOW + ((u) & 3) * 128 + 4 * (2 * j + ((u) >> 2)), SDW + ((u) & 3) * 128 + 4 * (2 * j + ((u) >> 2)), lane); \
        if (j < 15) P1_FETCH(buf, u, j + 1); } while (0)
        P1_FETCH(b0, 0, 0); P1_FETCH(b1, 1, 0); P1_FETCH(b2, 2, 0); P1_FETCH(b3, 3, 0); P1_FETCH(b4, 4, 0); P1_FETCH(b5, 5, 0); P1_FETCH(b6, 6, 0); P1_FETCH(b7, 7, 0);
#pragma unroll 1
        for (int j = 0; j < 16; ++j) { P1_STEP(b0, 0); P1_STEP(b1, 1); P1_STEP(b2, 2); P1_STEP(b3, 3); P1_STEP(b4, 4); P1_STEP(b5, 5); P1_STEP(b6, 6); P1_STEP(b7, 7); }
#undef P1_FETCH
#undef P1_STEP
    }
    asm volatile("s_waitcnt lgkmcnt(0)" ::: "memory");
    constexpr int OFF_W8 = 16384;
    float wsc[4];
#pragma unroll
    for (int tk = 0; tk < 4; ++tk) {
        const float w0 = SOW[tk * 128 + lane].v, w1 = SOW[tk * 128 + 64 + lane].v;
        float mx = fmaxf(fabsf(w0), fabsf(w1));
#pragma unroll
        for (int o = 1; o < 64; o <<= 1) mx = fmaxf(mx, __shfl_xor(mx, o));
        mx = __uint_as_float((unsigned)__builtin_amdgcn_readfirstlane((int)__float_as_uint(mx)));
        const float step = mx > 0.f ? mx * (1.0f / 127.0f) : 1.0f, inv = 1.0f / step; wsc[tk] = step;
        LAS unsigned char* W8 = F.lds + OFF_W8 + (4 * wave + tk) * 128;
        W8[lane] = (unsigned char)((int)rintf(w0 * inv) & 0xff); W8[64 + lane] = (unsigned char)((int)rintf(w1 * inv) & 0xff);
    }
    asm volatile("s_waitcnt lgkmcnt(0)" ::: "memory");
    { TMS_BEGIN(14);
        int yi[4][16];
#pragma unroll
        for (int tk = 0; tk < 4; ++tk)
#pragma unroll
            for (int e = 0; e < 16; ++e) yi[tk][e] = 0;
        const LAS unsigned* W8W = (const LAS unsigned*)(F.lds + OFF_W8 + (4 * wave) * 128);
        Rows4 b0, b1, b2, b3;
#define P2_FETCH(buf, u, c) fetch_rows(EXPU, SOW + (u) * 128 + 4 * (c), buf, lane)
#define P2_STEP(buf, u) do { up_chunk(buf, (unsigned)__builtin_amdgcn_readfirstlane((int)W8W[(u) * 32 + c]), yi[u]); if (c < 31) P2_FETCH(buf, u, c + 1); } while (0)
        P2_FETCH(b0, 0, 0); P2_FETCH(b1, 1, 0); P2_FETCH(b2, 2, 0); P2_FETCH(b3, 3, 0);
#pragma unroll 1
        for (int c = 0; c < 32; ++c) { P2_STEP(b0, 0); P2_STEP(b1, 1); P2_STEP(b2, 2); P2_STEP(b3, 3); }
#undef P2_FETCH
#undef P2_STEP
#pragma unroll
        for (int tk = 0; tk < 4; ++tk) {
            const size_t row = (size_t)tok0 + 4 * wave + tk;
            const v4u* hb = (const v4u*)((const bf16*)(F.ws + WS_XN2) + row * DM) + 2 * lane; f32x4* hp = (f32x4*)(F.out + row * DM) + 4 * lane; const f32x4* gp = (const f32x4*)F.in[I_NFG] + 4 * lane;
            float hv[16]; float ss = 0.f; const float ws = wsc[tk];
#pragma unroll
            for (int c = 0; c < 2; ++c) { const v4u w = hb[c]; hv[8 * c] = bf_lo(w.x); hv[8 * c + 1] = bf_hi(w.x); hv[8 * c + 2] = bf_lo(w.y); hv[8 * c + 3] = bf_hi(w.y); hv[8 * c + 4] = bf_lo(w.z); hv[8 * c + 5] = bf_hi(w.z); hv[8 * c + 6] = bf_lo(w.w); hv[8 * c + 7] = bf_hi(w.w); }
#pragma unroll
            for (int e = 0; e < 16; ++e) { hv[e] += ws * (float)yi[tk][e]; ss += hv[e] * hv[e]; }
            const float r = __builtin_amdgcn_rsqf(wave_sum(ss) * (1.f / DM) + EPS);
#pragma unroll
            for (int c = 0; c < 4; ++c) { const f32x4 g = gp[c]; hp[c] = (f32x4){hv[4 * c] * r * g.x, hv[4 * c + 1] * r * g.y, hv[4 * c + 2] * r * g.z, hv[4 * c + 3] * r * g.w}; }
        }
    TMS_END(14); }
}

__device__ __forceinline__ void peer_phase(Frame& F, bool never) {
    (void)never;
    for (int task = F.bid; task < MTOK / TOK; task += F.G) {
        const int tok0 = task * TOK;
        { TMS_BEGIN(10); route_task(F, tok0);
        __syncthreads(); TMS_END(10); }
        { TMS_BEGIN(11); gather_sweep(F, tok0);
        __syncthreads(); TMS_END(11); }
    }
}
}
#define XB_TMO      128
#define XB_XCNT(j)  (256  + 64 * (j))
#define XB_XSUB(j)  (1280 + 64 * (j))
#define XB_XGEN(j)  (2304 + 64 * (j))
#define XB_TOP      3328
#define XB_TOPGEN   3392
#define XCD_BAR_WORDS 3456
#define XB_SPIN_CAP (1u << 18)

__device__ __forceinline__ unsigned xb_ld(unsigned* p)              { return __hip_atomic_load(p, __ATOMIC_RELAXED, __HIP_MEMORY_SCOPE_AGENT); }
__device__ __forceinline__ unsigned xb_add(unsigned* p, unsigned v) { return __hip_atomic_fetch_add(p, v, __ATOMIC_RELAXED, __HIP_MEMORY_SCOPE_AGENT); }
__device__ __forceinline__ unsigned xb_xcc_id() { return (unsigned)__builtin_amdgcn_s_getreg((3 << 11) | 20) & 0xFu; }
#define XB_SPIN(cond, bar) do { unsigned _sp = 0; while (cond) { __builtin_amdgcn_s_sleep(1); \
    if ((++_sp & 255u) == 0u) { if (xb_ld(&(bar)[XB_TMO])) break; if (_sp > XB_SPIN_CAP) { atomicAdd(&(bar)[XB_TMO], 1u); break; } } } } while (0)

struct XcdBarrier {
    unsigned* bar; unsigned x;
    volatile LAS unsigned* st;
};

__device__ __forceinline__ XcdBarrier xcd_barrier_post(unsigned* bar, volatile LAS unsigned* st) {
    XcdBarrier b; b.bar = bar; b.x = xb_xcc_id(); b.st = st;
    if (threadIdx.x == 0) (void)xb_add(&bar[XB_XCNT(b.x)], 1u);
    return b;
}
__device__ __forceinline__ void xcd_barrier_complete(unsigned* bar, unsigned x, unsigned& nloc, unsigned& nx) {
    const unsigned G = gridDim.x * gridDim.y * gridDim.z;
    unsigned sum, cnt, mine, sp = 0u;
    for (;;) {
        sum = 0u; cnt = 0u; mine = 0u;
#pragma unroll
        for (unsigned j = 0; j < 16; ++j) { const unsigned c = xb_ld(&bar[XB_XCNT(j)]); sum += c; cnt += (c > 0u) ? 1u : 0u; mine = (j == x) ? c : mine; }
        if (sum == G) break;
        __builtin_amdgcn_s_sleep(1);
        if ((++sp & 255u) == 0u) { if (xb_ld(&bar[XB_TMO])) break; if (sp > XB_SPIN_CAP) { atomicAdd(&bar[XB_TMO], 1u); break; } }
    }
    nloc = mine > 0u ? mine : 1u; nx = cnt > 0u ? cnt : 1u;
}

__device__ __forceinline__ void xcd_barrier(const XcdBarrier& b) {
    asm volatile("s_waitcnt vmcnt(0)" ::: "memory");
    __syncthreads();
    if (threadIdx.x == 0) {
        unsigned* bar = b.bar;
        __builtin_amdgcn_s_waitcnt(0);
        unsigned nloc = b.st[0], nx = b.st[1];
        if (nloc == 0u) { xcd_barrier_complete(bar, b.x, nloc, nx); b.st[0] = nloc; b.st[1] = nx; }
        const unsigned old = xb_add(&bar[XB_XSUB(b.x)], 1u);
        const unsigned gen = old / nloc;
        if (old + 1u == (gen + 1u) * nloc) {
            __builtin_amdgcn_fence(__ATOMIC_RELEASE, "agent");
            asm volatile("s_waitcnt vmcnt(0)" ::: "memory");
            const unsigned og = xb_add(&bar[XB_TOP], 1u);
            const unsigned tg = og / nx;
            if (og + 1u == (tg + 1u) * nx) xb_add(&bar[XB_TOPGEN], 1u);
            else XB_SPIN(xb_ld(&bar[XB_TOPGEN]) == tg, bar);
            __builtin_amdgcn_fence(__ATOMIC_ACQUIRE, "agent");
            xb_add(&bar[XB_XGEN(b.x)], 1u);
            asm volatile("s_waitcnt vmcnt(0)" ::: "memory");
        } else {
            XB_SPIN(xb_ld(&bar[XB_XGEN(b.x)]) == gen, bar);
            __builtin_amdgcn_fence(__ATOMIC_ACQUIRE, "agent");
            asm volatile("s_waitcnt vmcnt(0)" ::: "memory");
        }
    }
    __syncthreads();
}

#ifndef MK_ONE_LAUNCH
#define MK_ONE_LAUNCH 1
#endif
#ifndef DBL_MASK
#define DBL_MASK 0
#endif
constexpr int N_PHASES = 9;
struct Args { const void* in[N_IN]; float* out; unsigned char* ws; int ph_lo, ph_hi; };
#define PHASE_FN __device__ __forceinline__ void
#define PHASE_FRAME \
    Frame F; F.lds = (LAS unsigned char*)(uintptr_t)(unsigned)__builtin_amdgcn_readfirstlane((int)ldsaddr); F.tid = threadIdx.x; F.lane = F.tid & 63; F.wave = __builtin_amdgcn_readfirstlane(F.tid >> 6); \
    F.G = gridDim.x; F.bid = blockIdx.x; F.in = (const float* const*)ap->in; F.pos = (const int*)ap->in[I_POS]; F.out = ap->out; F.ws = ap->ws; unsigned char* ws = F.ws; (void)ws;
#define REP(k) for (int rep_ = 0; rep_ < (((DBL_MASK >> (k)) & 1) ? 2 : 1); ++rep_)

PHASE_FN ph_prologue(const Args* ap, unsigned ldsaddr) { PHASE_FRAME REP(0) p0_prologue(F); }
PHASE_FN ph_inproj(const Args* ap, unsigned ldsaddr) { PHASE_FRAME REP(1) {
    pg8::StaticOrder S;
    pg8::Gemm g = pg8::make_gemm((const bf16*)(ws + WS_XN), 1024, (const bf16*)(ws + WS_WIN), 1024, MTOK, NPROJ, 1024);
    S.init(MTOK, NPROJ, F.G, F.bid);
    EpiInProj E{(bf16*)(ws + WS_QKV), (bf16*)(ws + WS_CQ), (bf16*)(ws + WS_MISC), (bf16*)(ws + WS_GATES), (float*)(ws + WS_SSQ), (float*)(ws + WS_SSKV)};
    pg8::gemm_phase<EpiInProj, pg8::StaticOrder, true>(F.lds, g, S, E); } }
PHASE_FN ph_upq(const Args* ap, unsigned ldsaddr) { PHASE_FRAME REP(2) {
    pg8::StaticOrder S;
    pg8::Gemm g = pg8::make_gemm((const bf16*)(ws + WS_CQ), 256, (const bf16*)(ws + WS_WUQ), 256, MTOK, 768, 256);
    S.init(MTOK, 768, F.G, F.bid);
    EpiRowScale<256> E{(const float*)(ws + WS_SSQ), (bf16*)(ws + WS_MLAQ), 768, QSCALE_MLA};
    pg8::gemm_phase<EpiRowScale<256>, pg8::StaticOrder, true>(F.lds, g, S, E); } }
PHASE_FN ph_upkv(const Args* ap, unsigned ldsaddr) { PHASE_FRAME REP(2) {
    pg8::StaticOrder S;
    pg8::Gemm g = pg8::make_gemm((const bf16*)(ws + WS_MISC), 256, (const bf16*)(ws + WS_WUKV), 256, MTOK, 1024, 256);
    S.init(MTOK, 1024, F.G, F.bid);
    EpiRowScale<128> E{(const float*)(ws + WS_SSKV), (bf16*)(ws + WS_MLAKV), 1024, 1.0f};
    pg8::gemm_phase<EpiRowScale<128>, pg8::StaticOrder, true>(F.lds, g, S, E); } }
PHASE_FN ph_cmpu(const Args* ap, unsigned ldsaddr) { PHASE_FRAME REP(2) {
    pg8::StaticOrder S;
#pragma unroll 1
    for (int ks = 0; ks < 8; ++ks) { const int kv = ks >> 2, s = ks & 3;
        pg8::Gemm g; g.A = (const bf16*)(ws + WS_QKV) + 512 + 128 * kv + (size_t)s * 4 * 1280; g.Bt = (const bf16*)(ws + (kv ? WS_WC1V : WS_WC1K)) + s * 256; g.M = 2048; g.N = 256; g.K = 256;
        g.aRow = (size_t)16 * 1280 * 2; g.aHalf = 128; g.aTile = (size_t)SEQ * 1280 * 2; g.aK = (size_t)1280 * 2; g.bRow = 1024 * 2;
        S.init(2048, 256, F.G, (F.bid + F.G - (192 + 8 * ks) % F.G) % F.G);
        EpiF32 E{(float*)(ws + WS_USLAB) + (size_t)ks * 2048 * 256, 256, nullptr};
        pg8::gemm_phase<EpiF32, pg8::StaticOrder, true>(F.lds, g, S, E);
    }
    kpe_pass(F); } }
PHASE_FN ph_cmpfin(const Args* ap, unsigned ldsaddr) { PHASE_FRAME REP(3) cmp_finalize(F); }
PHASE_FN ph_nsa(const Args* ap, unsigned ldsaddr) { PHASE_FRAME REP(10) { TMS_BEGIN(30); att::nsa_loop(F); TMS_END(30); } }
PHASE_FN ph_mla(const Args* ap, unsigned ldsaddr) { PHASE_FRAME REP(11) { TMS_BEGIN(31); att::mla_loop(F); TMS_END(31); } }
PHASE_FN ph_branch(const Args* ap, unsigned ldsaddr) { PHASE_FRAME REP(5) {
    pg8::ChainOrder S; S.init(MTOK, 1024, F.G, F.bid);
    pg8::Gemm g = pg8::make_gemm((const bf16*)(ws + WS_OCAT), 1024, (const bf16*)(ws + WS_WBR), 1024, MTOK, 1024, 512); g.aSeg = 1024; g.bSeg = 1024;
    EpiGateChain E{(const bf16*)(ws + WS_GATES), (bf16*)(ws + WS_MERGED)};
    pg8::gemm_phase<EpiGateChain, pg8::ChainOrder, true, true>(F.lds, g, S, E);
    quant_table<true>(F, F.in[I_EDN], ws + WS_EXPD, (float*)(ws + WS_EXPD_SC)); } }
PHASE_FN ph_outproj(const Args* ap, unsigned ldsaddr) { PHASE_FRAME REP(6) {
    pg8::StaticOrder S; S.init(MTOK, 1024, F.G, F.bid);
    pg8::Gemm g = pg8::make_gemm((const bf16*)(ws + WS_MERGED), 1024, (const bf16*)(ws + WS_WOUT), 1024, MTOK, 1024, 1024);
    EpiResid E{F.in[I_X], (bf16*)(ws + WS_XN2), (float*)(ws + WS_SS)};
    pg8::gemm_phase<EpiResid, pg8::StaticOrder, true>(F.lds, g, S, E);
    quant_table<true>(F, F.in[I_EUP], ws + WS_EXPU, (float*)(ws + WS_EXPU_SC)); } }
PHASE_FN ph_peerq(const Args* ap, unsigned ldsaddr) { PHASE_FRAME REP(8) {
    pg8::StaticOrder S; S.init(MTOK, 2048, F.G, F.bid);
    pg8::Gemm g = pg8::make_gemm((const bf16*)(ws + WS_XN2), 1024, (const bf16*)(ws + WS_WPQ), 1024, MTOK, 2048, 1024);
    EpiRowSS E{(const float*)(ws + WS_SS), (bf16*)(ws + WS_QP), 2048};
    pg8::gemm_phase<EpiRowSS, pg8::StaticOrder, true>(F.lds, g, S, E); } }
PHASE_FN ph_peer(const Args* ap, unsigned ldsaddr) { PHASE_FRAME peer::peer_phase(F, ap->ph_lo < 0); }

__global__ void __launch_bounds__(NTHREADS, 2) fwd(Args a) {
    extern __shared__ __attribute__((aligned(16))) unsigned char lds_raw[];
    const unsigned ldsaddr = (unsigned)(uintptr_t)(LAS unsigned char*)lds_raw;
    const int lo = a.ph_lo, hi = a.ph_hi;
#define IN(k) (lo <= (k) && (k) < hi)
    { LAS unsigned* misc = (LAS unsigned*)((LAS unsigned char*)lds_raw + RING_BYTES); if (threadIdx.x < 256) misc[threadIdx.x] = 0u; }
    __syncthreads();
    XcdBarrier bar = xcd_barrier_post((unsigned*)(a.ws + WS_CTL) + 4096, (volatile LAS unsigned*)((LAS unsigned char*)lds_raw + RING_BYTES) + 8);
#define SEAM(k) do { if (IN(k) && IN((k) + 1)) { if (MK_ONE_LAUNCH) xcd_barrier(bar); } } while (0)
#ifdef TIMER_PHASE
    unsigned long long tm_t0 = 0, tm_acc = 0;
#define TM_BEGIN(k) do { if ((k) == TIMER_PHASE) tm_t0 = __builtin_amdgcn_s_memrealtime(); } while (0)
#define TM_END(k) do { if ((k) == TIMER_PHASE) tm_acc += __builtin_amdgcn_s_memrealtime() - tm_t0; } while (0)
#else
#define TM_BEGIN(k) do {} while (0)
#define TM_END(k) do {} while (0)
#endif
    TM_BEGIN(0);
    if (IN(0)) ph_prologue(&a, ldsaddr);
    if (IN(0) && IN(1)) { if (MK_ONE_LAUNCH) xcd_barrier(bar); }
    TM_END(0); TM_BEGIN(1);
    if (IN(1)) ph_inproj(&a, ldsaddr);
    SEAM(1);
    TM_END(1); TM_BEGIN(2);
    if (IN(2)) { ph_upq(&a, ldsaddr); ph_upkv(&a, ldsaddr); ph_cmpu(&a, ldsaddr); }
    SEAM(2);
    TM_END(2); TM_BEGIN(3);
    if (IN(3)) ph_cmpfin(&a, ldsaddr);
    SEAM(3);
    TM_END(3); TM_BEGIN(4);
    if (IN(4)) { ph_nsa(&a, ldsaddr); ph_mla(&a, ldsaddr); }
    SEAM(4);
    TM_END(4); TM_BEGIN(5);
    if (IN(5)) ph_branch(&a, ldsaddr);
    SEAM(5);
    TM_END(5); TM_BEGIN(6);
    if (IN(6)) ph_outproj(&a, ldsaddr);
    SEAM(6);
    TM_END(6); TM_BEGIN(7);
    if (IN(7)) ph_peerq(&a, ldsaddr);
    SEAM(7);
    TM_END(7); TM_BEGIN(8);
    if (IN(8)) ph_peer(&a, ldsaddr);
    TM_END(8);
#ifdef TIMER_PHASE
    if (TIMER_PHASE >= 10) tm_acc = *(LAS unsigned long long*)((LAS unsigned char*)lds_raw + RING_BYTES + 512);
    __syncthreads();
    if (blockIdx.x == 0 && threadIdx.x == 0) { asm volatile("s_waitcnt vmcnt(0)" ::: "memory"); a.out[0] += (float)tm_acc * 0.001f; }
#endif
#undef IN
#undef SEAM
}

extern "C" void kernel_launch(void* const* d_in, const int* in_sizes, int n_in, void* d_out, int out_size, void* d_ws, size_t ws_size, hipStream_t stream) {
    static int grid = 0;
    if (grid == 0) {
        if (n_in != N_IN || out_size != MTOK * DM || ws_size < WS_END) { fprintf(stderr, "kernel_launch: unexpected shapes (n_in %d, out %d, ws %zu)\n", n_in, out_size, ws_size); grid = -1; return; }
        int dev = 0, cus = 0, per_cu = 0;
        if (hipGetDevice(&dev) != hipSuccess || hipDeviceGetAttribute(&cus, hipDeviceAttributeMultiprocessorCount, dev) != hipSuccess) { grid = -1; return; }
        if (hipFuncSetAttribute((const void*)fwd, hipFuncAttributeMaxDynamicSharedMemorySize, LDS_BYTES) != hipSuccess) { fprintf(stderr, "kernel_launch: hipFuncSetAttribute failed\n"); grid = -1; return; }
        if (hipOccupancyMaxActiveBlocksPerMultiprocessor(&per_cu, (const void*)fwd, NTHREADS, LDS_BYTES) != hipSuccess || per_cu < 1) { fprintf(stderr, "kernel_launch: occupancy query says %d\n", per_cu); (void)hipGetLastError(); grid = -1; return; }
        grid = cus;
    }
    if (grid < 0) return;
    Args a{};
    for (int i = 0; i < N_IN; ++i) a.in[i] = d_in[i];
    a.out = (float*)d_out; a.ws = (unsigned char*)d_ws;
#if MK_ONE_LAUNCH
    if (hipMemsetAsync((char*)d_ws + WS_CTL, 0, 65536, stream) != hipSuccess) { fprintf(stderr, "kernel_launch: hipMemsetAsync failed\n"); return; }
    a.ph_lo = 0; a.ph_hi = N_PHASES;
    void* args[] = {&a};
    hipError_t e = hipLaunchCooperativeKernel((const void*)fwd, dim3(grid), dim3(NTHREADS), args, LDS_BYTES, stream);
    if (e != hipSuccess) fprintf(stderr, "kernel_launch: cooperative launch failed: %s (grid %d)\n", hipGetErrorString(e), grid);
#else
    for (int p = 0; p < N_PHASES; ++p) { a.ph_lo = p; a.ph_hi = p + 1; hipLaunchKernelGGL(fwd, dim3(grid), dim3(NTHREADS), LDS_BYTES, stream, a); }
#endif
}
```

```cpp
#define DBL_MASK 0
#include <hip/hip_runtime.h>
#include <cstdio>
#include <cstdint>
#include <cmath>
namespace pg8 {
#define PG8_LAS __attribute__((address_space(3)))
typedef unsigned short bf16_t;
typedef short bf16x8 __attribute__((ext_vector_type(8)));
typedef float f32x4 __attribute__((ext_vector_type(4)));
typedef unsigned u32x4 __attribute__((ext_vector_type(4)));
constexpr int BM = 256, BK = 64, HALF = 128, HTB = HALF * BK * 2  , STAGE_BYTES = 8 * HTB, NXCD = 8, WGM = 8;

__host__ __device__ __forceinline__ int lds_byte(int r, int c) { const int st = (r >> 4) * 2 + (c >> 5), rr = r & 15, cc = c & 31, ob = rr * 64 + cc * 2; return st * 1024 + (ob ^ (((ob >> 9) & 1) << 5)); }
__host__ __device__ __forceinline__ void stage_rc(int b, int& R, int& C) { const int st = b / 1024, sb = b % 1024, swz = sb ^ (((sb >> 9) & 1) << 5); R = (st >> 1) * 16 + swz / 64; C = (st & 1) * 32 + (swz % 64) / 2; }
__host__ __device__ __forceinline__ int perm32(int rho) { const int n = rho >> 4, i = rho & 15; return 8 * (i >> 2) + 4 * n + (i & 3); }

struct Unit { int pm, pn, seg; };
struct Gemm { const bf16_t* A; const bf16_t* Bt; int M, N, K; size_t aRow, aHalf, aTile, aK, bRow, aSeg, bSeg; };
__host__ __device__ __forceinline__ Gemm make_gemm(const bf16_t* A, int lda, const bf16_t* Bt, int ldb, int M, int N, int K) {
    Gemm g; g.A = A; g.Bt = Bt; g.M = M; g.N = N; g.K = K; g.aRow = (size_t)lda * 2; g.aHalf = (size_t)HALF * lda * 2; g.aTile = (size_t)BM * lda * 2; g.aK = BK * 2; g.bRow = (size_t)ldb * 2; g.aSeg = 0; g.bSeg = 0; return g; }

struct StaticOrder {
    int nM, nN, nwg, G, c;
    __host__ __device__ void init(int M, int N, int G_, int c_) { nM = M / BM; nN = N / BM; nwg = nM * nN; G = G_; c = c_; }
    __host__ __device__ bool next(int i, Unit& u) const {
        const long L = (long)i * G + c; if (L >= nwg) return false;
        int wgid = (int)L; { const int q = nwg / NXCD, r = nwg % NXCD, xcd = wgid % NXCD, off = wgid / NXCD; wgid = (xcd < r ? xcd * (q + 1) : r * (q + 1) + (xcd - r) * q) + off; }
        const int nig = WGM * nN, gid = wgid / nig, fm = gid * WGM, gsz = (nM - fm) < WGM ? (nM - fm) : WGM;
        u.pm = fm + ((wgid % nig) % gsz); u.pn = (wgid % nig) / gsz; u.seg = 0; return true;
    }
};
struct ChainOrder : StaticOrder {
    __host__ __device__ bool next(int i, Unit& u) const { if (!StaticOrder::next(i >> 1, u)) return false; u.seg = i & 1; return true; }
};

__device__ __forceinline__ unsigned cvt_pk_bf16(float lo, float hi) { unsigned r; asm volatile("v_cvt_pk_bf16_f32 %0, %1, %2" : "=v"(r) : "v"(lo), "v"(hi)); return r; }

template <class Epi, class Sched, bool ALIGN_EPI, bool CHAIN = false>
__device__ __forceinline__ void gemm_phase(PG8_LAS unsigned char* lds, const Gemm g, const Sched& S, const Epi& E) {
    const int tid = threadIdx.x, wid = __builtin_amdgcn_readfirstlane(tid >> 6), lane = tid & 63, wr = wid >> 2, wc = wid & 3, fr = lane & 15, fq = lane >> 4;
    const int K = g.K, nt = K / BK;
    unsigned voffA[2], voffB[2];
#pragma unroll
    for (int i = 0; i < 2; ++i) { int R, C; stage_rc(tid * 16 + i * 8192, R, C); const int Rb = Epi::PERM ? ((R & ~31) + perm32(R & 31)) : R;
        voffA[i] = (unsigned)((size_t)R * g.aRow + (size_t)C * 2); voffB[i] = (unsigned)((size_t)Rb * g.bRow + (size_t)C * 2); }
    const size_t kstepA = g.aK, kstepB = (size_t)(BK * 2);
    const size_t hstepA = g.aHalf, hstepB = (size_t)HALF * g.bRow;
    const size_t tstepA = g.aTile, tstepB = (size_t)BM * g.bRow;
    const unsigned ldsw = (unsigned)wid * 1024u;
    const int aoff = lds_byte(wr * 64 + fr, fq * 8), boff = lds_byte(wc * 32 + fr, fq * 8);
#define PG8_SA(b, h) (((b) * 2 + (h)) * HTB)
#define PG8_SB(b, h) ((4 + (b) * 2 + (h)) * HTB)
#define PG8_STAGE(bufoff, gbase, voff) do { _Pragma("unroll") for (int _i = 0; _i < 2; ++_i) \
        __builtin_amdgcn_global_load_lds((const unsigned*)((const char*)(gbase) + (voff)[_i]), (PG8_LAS unsigned*)(lds + (bufoff) + ldsw + _i * 8192), 16, 0, 0); } while (0)
#define PG8_LDA(dst, b, h) do { _Pragma("unroll") for (int m = 0; m < 4; ++m) _Pragma("unroll") for (int k = 0; k < 2; ++k) dst[m][k] = *(const PG8_LAS bf16x8*)(lds + PG8_SA(b, h) + aoff + m * 2048 + k * 1024); } while (0)
#define PG8_LDB(dst, b, h) do { _Pragma("unroll") for (int n = 0; n < 2; ++n) _Pragma("unroll") for (int k = 0; k < 2; ++k) dst[n][k] = *(const PG8_LAS bf16x8*)(lds + PG8_SB(b, h) + boff + n * 2048 + k * 1024); } while (0)
#define PG8_MMA(ai, bj, At, Bt) do { __builtin_amdgcn_s_setprio(1); _Pragma("unroll") for (int m = 0; m < 4; ++m) _Pragma("unroll") for (int n = 0; n < 2; ++n) _Pragma("unroll") for (int k = 0; k < 2; ++k) \
        acc[ai][bj][m][n] = __builtin_amdgcn_mfma_f32_16x16x32_bf16(Bt[n][k], At[m][k], acc[ai][bj][m][n], 0, 0, 0); __builtin_amdgcn_s_setprio(0); } while (0)
#define PG8_WAIT_V(n) asm volatile("s_waitcnt vmcnt(" #n ")" ::: "memory")
#define PG8_WAIT_L(n) asm volatile("s_waitcnt lgkmcnt(" #n ")" ::: "memory")
#define PG8_BAR __builtin_amdgcn_s_barrier()
#define PG8_SCHED __builtin_amdgcn_sched_barrier(0)
    Unit cur, nxt; int ui = 0;
    if (!S.next(0, cur)) return;
    f32x4 acc[2][2][4][2];
#pragma unroll
    for (int a = 0; a < 2; ++a)
#pragma unroll
        for (int b = 0; b < 2; ++b)
#pragma unroll
            for (int m = 0; m < 4; ++m)
#pragma unroll
                for (int n = 0; n < 2; ++n) acc[a][b][m][n] = (f32x4){0.f, 0.f, 0.f, 0.f};
    bf16x8 At[4][2], B0[2][2], B1[2][2];
    const char* cA = (const char*)g.A + (size_t)cur.pm * tstepA + ((CHAIN && cur.seg) ? g.aSeg : 0); const char* cB = (const char*)g.Bt + (size_t)cur.pn * tstepB + ((CHAIN && cur.seg) ? g.bSeg : 0);
    PG8_STAGE(PG8_SB(0, 0), cB, voffB); PG8_STAGE(PG8_SB(0, 1), cB + hstepB, voffB); PG8_STAGE(PG8_SA(0, 0), cA, voffA); PG8_STAGE(PG8_SA(0, 1), cA + hstepA, voffA);
    if (wr == 1) PG8_BAR;
    PG8_WAIT_V(2); PG8_BAR;
    PG8_STAGE(PG8_SB(1, 0), cB + kstepB, voffB); PG8_STAGE(PG8_SA(1, 0), cA + kstepA, voffA); PG8_STAGE(PG8_SB(1, 1), cB + hstepB + kstepB, voffB);
    PG8_WAIT_V(6); PG8_BAR;
    for (;;) {
        const bool has_next = S.next(ui + 1, nxt);
        const char* nA = has_next ? (const char*)g.A + (size_t)nxt.pm * tstepA + ((CHAIN && nxt.seg) ? g.aSeg : 0) : cA; const char* nB = has_next ? (const char*)g.Bt + (size_t)nxt.pn * tstepB + ((CHAIN && nxt.seg) ? g.bSeg : 0) : cB;
        for (int t = 0; t < nt; t += 2) {
            const bool last = (t == nt - 2);
            const char* a1 = cA + (size_t)(t + 1) * kstepA;
            const char* a2 = last ? nA : cA + (size_t)(t + 2) * kstepA; const char* b2 = last ? nB : cB + (size_t)(t + 2) * kstepB;
            const char* a3 = a2 + kstepA; const char* b3 = b2 + kstepB;
            PG8_LDB(B0, 0, 0); PG8_LDB(B1, 0, 1); PG8_SCHED; PG8_LDA(At, 0, 0); PG8_STAGE(PG8_SA(1, 1), a1 + hstepA, voffA);
            PG8_WAIT_V(8); PG8_WAIT_L(0); PG8_BAR; PG8_MMA(0, 0, At, B0); PG8_MMA(0, 1, At, B1); PG8_BAR; PG8_SCHED;
            PG8_LDA(At, 0, 1); PG8_STAGE(PG8_SB(0, 0), b2, voffB); PG8_STAGE(PG8_SB(0, 1), b2 + hstepB, voffB); PG8_STAGE(PG8_SA(0, 0), a2, voffA);
            PG8_WAIT_V(8); PG8_WAIT_L(0); PG8_BAR; PG8_MMA(1, 0, At, B0); PG8_MMA(1, 1, At, B1); PG8_BAR; PG8_SCHED;
            PG8_LDB(B0, 1, 0); PG8_LDB(B1, 1, 1); PG8_SCHED; PG8_LDA(At, 1, 0); PG8_STAGE(PG8_SA(0, 1), a2 + hstepA, voffA);
            PG8_WAIT_V(8); PG8_WAIT_L(0); PG8_BAR; PG8_MMA(0, 0, At, B0); PG8_MMA(0, 1, At, B1); PG8_BAR; PG8_SCHED;
            PG8_LDA(At, 1, 1); PG8_STAGE(PG8_SB(1, 0), b3, voffB); PG8_STAGE(PG8_SB(1, 1), b3 + hstepB, voffB); PG8_STAGE(PG8_SA(1, 0), a3, voffA);
            PG8_WAIT_V(8); PG8_WAIT_L(0); PG8_BAR; PG8_MMA(1, 0, At, B0); PG8_MMA(1, 1, At, B1); PG8_BAR; PG8_SCHED;
        }
        if constexpr (ALIGN_EPI) { if (wr == 0) PG8_BAR; }
        bool keep = false;
        if constexpr (CHAIN) { if (cur.seg == 0) { E.mid(acc, cur, wr, wc, fr, fq); keep = true; } else E(acc, cur, wr, wc, fr, fq); }
        else E(acc, cur, wr, wc, fr, fq);
        if (!has_next) break;
        if (!keep) {
#pragma unroll
        for (int a = 0; a < 2; ++a)
#pragma unroll
            for (int b = 0; b < 2; ++b)
#pragma unroll
                for (int m = 0; m < 4; ++m)
#pragma unroll
                    for (int n = 0; n < 2; ++n) acc[a][b][m][n] = (f32x4){0.f, 0.f, 0.f, 0.f};
        }
        cur = nxt; cA = nA; cB = nB; ++ui;
        if constexpr (ALIGN_EPI) { if (wr == 1) PG8_BAR; }
    }
    PG8_WAIT_V(0);
    if constexpr (!ALIGN_EPI) { if (wr == 0) PG8_BAR; }
    PG8_BAR;
#undef PG8_SA
#undef PG8_SB
#undef PG8_STAGE
#undef PG8_LDA
#undef PG8_LDB
#undef PG8_MMA
#undef PG8_WAIT_V
#undef PG8_WAIT_L
#undef PG8_BAR
#undef PG8_SCHED
}
}
constexpr int NWAVES = 8, NTHREADS = 512;
constexpr int BATCH = 8, SEQ = 2048, DM = 1024, MTOK = BATCH * SEQ;
constexpr int NPROJ = 3840;
constexpr float EPS = 1e-6f, LOG2E = 1.4426950408889634f;
constexpr float QSCALE_NSA = 0.125f * LOG2E;
constexpr float QSCALE_MLA = 0.10206207261596575f * LOG2E;
constexpr size_t MiB = 1u << 20;
enum { I_X = 0, I_POS, I_N1G, I_WIN, I_CPK, I_CW1K, I_CW2K, I_CPV, I_CW1V, I_CW2V, I_QNG, I_KVNG, I_WUQ, I_WUKV, I_WBN, I_WBM, I_WOUT, I_N2G, I_WPQ, I_SK1, I_SK2, I_EDN, I_EUP, I_NFG, N_IN };
constexpr size_t WS_CTL = 0;
constexpr size_t WS_WIN = 1 * MiB;
constexpr size_t WS_WUQ = WS_WIN + (size_t)NPROJ * 1024 * 2;
constexpr size_t WS_WUKV = WS_WUQ + 768 * 256 * 2;
constexpr size_t WS_WBR = 10 * MiB;
constexpr size_t WS_WOUT = 12 * MiB;
constexpr size_t WS_WPQ = 14 * MiB;
constexpr size_t WS_WC1K = 18 * MiB;
constexpr size_t WS_WC1V = WS_WC1K + 256 * 1024 * 2;
constexpr size_t WS_SMALL = 19 * MiB;
constexpr size_t WS_C1K = WS_SMALL;
constexpr size_t WS_C1V = WS_SMALL + 512;
constexpr size_t WS_ORDER = WS_SMALL + 1024;
constexpr size_t WS_SK1 = WS_SMALL + 4096;
constexpr size_t WS_SK2 = WS_SK1 + 32768;
constexpr size_t WS_XN = 20 * MiB;
constexpr size_t WS_MLAQ = WS_XN, WS_EXPD = WS_XN;
constexpr size_t WS_EXPD_SC = WS_EXPD + (size_t)16384 * 1024;
constexpr size_t WS_QKV = 52 * MiB;
constexpr size_t WS_MERGED = WS_QKV;
constexpr size_t WS_CQ = 92 * MiB;
constexpr size_t WS_MISC = 100 * MiB;
constexpr size_t WS_ROUTE = 92 * MiB;
constexpr size_t WS_GATES = 108 * MiB;
constexpr size_t WS_QP = WS_GATES;
constexpr size_t WS_MLAKV = 172 * MiB;
constexpr size_t WS_XN2 = WS_MLAKV;
constexpr size_t WS_KPE = 204 * MiB;
constexpr size_t WS_KC = 205 * MiB;
constexpr size_t WS_VC = WS_KC + 16 * 128 * 64 * 2;
constexpr size_t WS_SSQ = 207 * MiB, WS_SSKV = 207 * MiB + 262144;
constexpr size_t WS_SS = 206 * MiB;
constexpr size_t WS_OCAT = 210 * MiB;
constexpr size_t WS_USLAB = WS_OCAT;
constexpr size_t WS_EXPU = WS_OCAT;
constexpr size_t WS_EXPU_SC = WS_EXPU + (size_t)16384 * 1024;
constexpr size_t WS_END = 242 * MiB;
constexpr int RING_BYTES = 131072;
constexpr int LDS_BYTES = 147456;

#define GAS __attribute__((address_space(1)))
#define LAS __attribute__((address_space(3)))
typedef unsigned short bf16;
typedef unsigned v4u __attribute__((ext_vector_type(4)));
typedef unsigned v2u __attribute__((ext_vector_type(2)));
typedef float f32x4 __attribute__((ext_vector_type(4)));
typedef float f32x16 __attribute__((ext_vector_type(16)));
typedef short bf16x8 __attribute__((ext_vector_type(8)));
typedef short s16x4 __attribute__((ext_vector_type(4)));

__device__ __forceinline__ unsigned f2bf(float f) { unsigned u = __builtin_bit_cast(unsigned, f); return (u + 0x7fffu + ((u >> 16) & 1u)) >> 16; }
__device__ __forceinline__ unsigned pk2(float lo, float hi) { return f2bf(lo) | (f2bf(hi) << 16); }
__device__ __forceinline__ float bf_lo(unsigned u) { return __builtin_bit_cast(float, u << 16); }
__device__ __forceinline__ float bf_hi(unsigned u) { return __builtin_bit_cast(float, u & 0xffff0000u); }
__device__ __forceinline__ float bf2f(bf16 h) { return __builtin_bit_cast(float, (unsigned)h << 16); }
__device__ __forceinline__ float sigmoidf_(float v) { return __builtin_amdgcn_rcpf(1.0f + __expf(-v)); }
__device__ __forceinline__ float gelu_tanh(float v) { const float u = 0.7978845608028654f * (v + 0.044715f * v * v * v); const float e = __expf(2.0f * u); const float th = 1.0f - 2.0f * __builtin_amdgcn_rcpf(e + 1.0f); return 0.5f * v * (1.0f + th); }
__device__ __forceinline__ float rope_inv(int i) { return exp2f(-(float)i * (13.287712379549449f / 16.0f)); }
__device__ __forceinline__ void rope_sincos(float ang, float& sn, float& cs) { float t = ang * 0.15915494309189535f; t -= floorf(t); sn = __builtin_amdgcn_sinf(t); cs = __builtin_amdgcn_cosf(t); }
__device__ __forceinline__ float wave_sum(float v) {
#pragma unroll
    for (int o = 1; o < 64; o <<= 1) v += __shfl_xor(v, o);
    return v;
}

#ifdef TIMER_PHASE
#define TMS_BEGIN(id) unsigned long long tms_t0_ = ((id) == TIMER_PHASE) ? __builtin_amdgcn_s_memrealtime() : 0ull
#define TMS_DECL unsigned long long tms_m0_ = 0ull
#define TMS_MARK(id) do { if ((id) == TIMER_PHASE) tms_m0_ = __builtin_amdgcn_s_memrealtime(); } while (0)
#define TMS_MARKEND(id) do { if ((id) == TIMER_PHASE && threadIdx.x == 448) { *(LAS unsigned long long*)(F.lds + RING_BYTES + 512) += __builtin_amdgcn_s_memrealtime() - tms_m0_; } } while (0)
#define TMS_COUNT(id) do { if ((id) == TIMER_PHASE && threadIdx.x == 448) { *(LAS unsigned long long*)(F.lds + RING_BYTES + 512) += 100ull; } } while (0)
#define TMS_END(id) do { if ((id) == TIMER_PHASE && threadIdx.x == (((id) >= 41 && (id) <= 49) ? 448 : 0)) { *(LAS unsigned long long*)(F.lds + RING_BYTES + 512) += __builtin_amdgcn_s_memrealtime() - tms_t0_; } } while (0)
#else
#define TMS_BEGIN(id) do {} while (0)
#define TMS_COUNT(id) do {} while (0)
#define TMS_DECL do {} while (0)
#define TMS_MARK(id) do {} while (0)
#define TMS_MARKEND(id) do {} while (0)
#define TMS_END(id) do {} while (0)
#endif
struct Frame {
    LAS unsigned char* lds;
    int tid, lane, wave, G, bid;
    const float* const* in; const int* pos; float* out; unsigned char* ws;
};

__device__ __forceinline__ int win_srccol(int n) {
    if (n < 1280) return n;
    if (n < 1536) return 1304 + (n - 1280);
    if (n < 1664) return 1560 + (n - 1536);
    if (n < 1696) return 1688 + (n - 1664);
    if (n < 1720) return 1280 + (n - 1696);
    if (n < 1792) return -1;
    return 1720 + (n - 1792);
}
template <bool WIN_PERM>
__device__ __forceinline__ void tr_item(const float* src, int ld_src, int ksrc0, const float* kscale, bf16* dst, int ld_dst, int drow0, int dcol0, int N, LAS float* scr, int item, int lane) {
    const int nblk = N / 32, kb = item / nblk, nb = item % nblk, k0 = 64 * kb, n0 = 32 * nb;
    const int nn = n0 + 4 * (lane & 7); const int sc = WIN_PERM ? win_srccol(nn) : nn;
    f32x4 v[8];
#pragma unroll
    for (int i = 0; i < 8; ++i) { const int kk = 8 * i + (lane >> 3); v[i] = (f32x4){0.f, 0.f, 0.f, 0.f}; if (sc >= 0) v[i] = *(const f32x4*)(src + (size_t)(ksrc0 + k0 + kk) * ld_src + sc); }
#pragma unroll
    for (int i = 0; i < 8; ++i) { const int kk = 8 * i + (lane >> 3); const float ks = kscale ? kscale[k0 + kk] : 1.0f; LAS float* d = scr + kk * 33 + 4 * (lane & 7);
        d[0] = v[i].x * ks; d[1] = v[i].y * ks; d[2] = v[i].z * ks; d[3] = v[i].w * ks; }
    asm volatile("s_waitcnt lgkmcnt(0)" ::: "memory");
    const int c = lane & 7;
#pragma unroll
    for (int j = 0; j < 4; ++j) { const int n = (lane >> 3) + 8 * j; const LAS float* s = scr + (8 * c) * 33 + n;
        v4u o; o.x = pk2(s[0 * 33], s[1 * 33]); o.y = pk2(s[2 * 33], s[3 * 33]); o.z = pk2(s[4 * 33], s[5 * 33]); o.w = pk2(s[6 * 33], s[7 * 33]);
        *(v4u*)(dst + (size_t)(drow0 + n0 + n) * ld_dst + dcol0 + k0 + 8 * c) = o; }
    asm volatile("s_waitcnt lgkmcnt(0)" ::: "memory");
}
__device__ __forceinline__ void rms_row_to_bf16(const float* xrow, const float* gain, bf16* orow, int lane) {
    const f32x4* xr = (const f32x4*)xrow + lane; const f32x4* gr = (const f32x4*)gain + lane;
    f32x4 v[4]; float s = 0.f;
#pragma unroll
    for (int j = 0; j < 4; ++j) { v[j] = xr[64 * j]; s += (v[j].x * v[j].x + v[j].y * v[j].y) + (v[j].z * v[j].z + v[j].w * v[j].w); }
    const float r = 1.0f / sqrtf(wave_sum(s) * (1.f / DM) + EPS);
    unsigned long long* o8 = (unsigned long long*)orow + lane;
#pragma unroll
    for (int j = 0; j < 4; ++j) { const f32x4 g = gr[64 * j]; o8[64 * j] = (unsigned long long)pk2(v[j].x * r * g.x, v[j].y * r * g.y) | ((unsigned long long)pk2(v[j].z * r * g.z, v[j].w * r * g.w) << 32); }
}
__device__ __forceinline__ void p0_prologue(Frame& F) {
    LAS float* scr = (LAS float*)(F.lds + F.wave * 16384);
    const int gw = F.bid * NWAVES + F.wave, NGW = F.G * NWAVES, lane = F.lane;
    bf16* const Win_t = (bf16*)(F.ws + WS_WIN); bf16* const Wuq_t = (bf16*)(F.ws + WS_WUQ); bf16* const Wukv_t = (bf16*)(F.ws + WS_WUKV);
    bf16* const Wbr_t = (bf16*)(F.ws + WS_WBR); bf16* const Wout_t = (bf16*)(F.ws + WS_WOUT); bf16* const Wpq_t = (bf16*)(F.ws + WS_WPQ);
    bf16* const Wc1k_t = (bf16*)(F.ws + WS_WC1K); bf16* const Wc1v_t = (bf16*)(F.ws + WS_WC1V);
    constexpr int I_IN = 16 * (NPROJ / 32), I_UQ = 4 * 24, I_UKV = 2 * 32, I_BR = 8 * 32, I_OUT = 16 * 32, I_PQ = 16 * 64, I_C1 = 16 * 4;
    constexpr int NITEMS = I_IN + I_UQ + I_UKV + 2 * I_BR + I_OUT + I_PQ + 4 * I_C1;
    for (int it = gw; it < NITEMS; it += NGW) {
        int r = it;
        if (r < I_IN) { tr_item<true>(F.in[I_WIN], 3768, 0, nullptr, Win_t, 1024, 0, 0, NPROJ, scr, r, lane); continue; } r -= I_IN;
        if (r < I_UQ) { tr_item<false>(F.in[I_WUQ], 768, 0, F.in[I_QNG], Wuq_t, 256, 0, 0, 768, scr, r, lane); continue; } r -= I_UQ;
        if (r < I_UKV) { tr_item<false>(F.in[I_WUKV], 1024, 0, F.in[I_KVNG], Wukv_t, 256, 0, 0, 1024, scr, r, lane); continue; } r -= I_UKV;
        if (r < I_BR) { tr_item<false>(F.in[I_WBN], 1024, 0, nullptr, Wbr_t, 1024, 0, 0, 1024, scr, r, lane); continue; } r -= I_BR;
        if (r < I_BR) { tr_item<false>(F.in[I_WBM], 1024, 0, nullptr, Wbr_t, 1024, 0, 512, 1024, scr, r, lane); continue; } r -= I_BR;
        if (r < I_OUT) { tr_item<false>(F.in[I_WOUT], 1024, 0, nullptr, Wout_t, 1024, 0, 0, 1024, scr, r, lane); continue; } r -= I_OUT;
        if (r < I_PQ) { tr_item<false>(F.in[I_WPQ], 2048, 0, F.in[I_N2G], Wpq_t, 1024, 0, 0, 2048, scr, r, lane); continue; } r -= I_PQ;
        if (r < I_C1) { tr_item<false>(F.in[I_CW1K], 128, 0, nullptr, Wc1k_t, 1024, 0, 0, 128, scr, r, lane); continue; } r -= I_C1;
        if (r < I_C1) { tr_item<false>(F.in[I_CW1K], 128, 1024, nullptr, Wc1k_t, 1024, 128, 0, 128, scr, r, lane); continue; } r -= I_C1;
        if (r < I_C1) { tr_item<false>(F.in[I_CW1V], 128, 0, nullptr, Wc1v_t, 1024, 0, 0, 128, scr, r, lane); continue; } r -= I_C1;
        tr_item<false>(F.in[I_CW1V], 128, 1024, nullptr, Wc1v_t, 1024, 128, 0, 128, scr, r, lane);
    }
    { bf16* XN = (bf16*)(F.ws + WS_XN); const float* X = F.in[I_X]; const f32x4* gr = (const f32x4*)F.in[I_N1G] + lane;
      for (int m = gw; m < MTOK; m += 2 * NGW) {
          const int m2 = (m + NGW < MTOK) ? m + NGW : m;
          const f32x4* xa = (const f32x4*)(X + (size_t)m * DM) + lane; const f32x4* xb = (const f32x4*)(X + (size_t)m2 * DM) + lane;
          f32x4 va[4], vb[4]; float sa = 0.f, sb = 0.f;
#pragma unroll
          for (int j = 0; j < 4; ++j) { va[j] = xa[64 * j]; vb[j] = xb[64 * j]; }
#pragma unroll
          for (int j = 0; j < 4; ++j) { sa += (va[j].x * va[j].x + va[j].y * va[j].y) + (va[j].z * va[j].z + va[j].w * va[j].w); sb += (vb[j].x * vb[j].x + vb[j].y * vb[j].y) + (vb[j].z * vb[j].z + vb[j].w * vb[j].w); }
#pragma unroll
          for (int o = 1; o < 64; o <<= 1) { sa += __shfl_xor(sa, o); sb += __shfl_xor(sb, o); }
          const float ra = 1.0f / sqrtf(sa * (1.f / DM) + EPS), rb = 1.0f / sqrtf(sb * (1.f / DM) + EPS);
          unsigned long long* oa = (unsigned long long*)(XN + (size_t)m * DM) + lane; unsigned long long* ob = (unsigned long long*)(XN + (size_t)m2 * DM) + lane;
#pragma unroll
          for (int j = 0; j < 4; ++j) { const f32x4 g = gr[64 * j];
              oa[64 * j] = (unsigned long long)pk2(va[j].x * ra * g.x, va[j].y * ra * g.y) | ((unsigned long long)pk2(va[j].z * ra * g.z, va[j].w * ra * g.w) << 32);
              ob[64 * j] = (unsigned long long)pk2(vb[j].x * rb * g.x, vb[j].y * rb * g.y) | ((unsigned long long)pk2(vb[j].z * rb * g.z, vb[j].w * rb * g.w) << 32); }
      } }
    const int gt = F.bid * NTHREADS + F.tid, NGT = F.G * NTHREADS;
    for (int i = gt; i < 1024 * 128; i += NGT) { const int n = i >> 7, k = 128 + (i & 127); Wukv_t[n * 256 + k] = 0; }
    { bf16* S1 = (bf16*)(F.ws + WS_SK1); bf16* S2 = (bf16*)(F.ws + WS_SK2);
      for (int i = gt; i < 128 * 128; i += NGT) { S1[i] = (bf16)f2bf(F.in[I_SK1][i]); S2[i] = (bf16)f2bf(F.in[I_SK2][i]); } }
    for (int o = gw; o < 256; o += NGW) {
        const int kv = o >> 7, j = o & 127; const float* pe = F.in[kv ? I_CPV : I_CPK]; const float* w1 = F.in[kv ? I_CW1V : I_CW1K];
        float s = 0.f;
        for (int k = lane; k < 2048; k += 64) s += pe[k] * w1[(size_t)k * 128 + j];
        s = wave_sum(s);
        if (lane == 0) ((float*)(F.ws + (kv ? WS_C1V : WS_C1K)))[j] = s;
    }
}

using pg8::Unit; using pg8::cvt_pk_bf16;
constexpr int PG_HALF = 128, PG_BM = 256;
struct EpiInProj {
    static constexpr bool PERM = true;
    bf16 *QKV, *CQ, *MISC, *GATES; float *SSQ, *SSKV;
    __device__ __forceinline__ void operator()(const f32x4 (&acc)[2][2][4][2], const Unit& u, int wr, int wc, int fr, int fq) const {
        bf16* base; int ldc, colt; float sc = 1.f;
        if (u.pn < 5) { base = QKV; ldc = 1280; colt = u.pn * 256; if (u.pn < 2) sc = QSCALE_NSA; }
        else if (u.pn == 5) { base = CQ; ldc = 256; colt = 0; }
        else if (u.pn == 6) { base = MISC; ldc = 256; colt = 0; }
        else { base = GATES; ldc = 2048; colt = (u.pn - 7) * 256; }
        const int row0 = u.pm * PG_BM + wr * 64 + fr, col0 = colt + wc * 32 + 8 * fq;
#pragma unroll
        for (int ai = 0; ai < 2; ++ai)
#pragma unroll
            for (int m = 0; m < 4; ++m) { bf16* rowp = base + (size_t)(row0 + ai * PG_HALF + m * 16) * ldc + col0;
#pragma unroll
                for (int bj = 0; bj < 2; ++bj) { const f32x4 v0 = acc[ai][bj][m][0] * sc, v1 = acc[ai][bj][m][1] * sc;
                    v4u w; w.x = cvt_pk_bf16(v0[0], v0[1]); w.y = cvt_pk_bf16(v0[2], v0[3]); w.z = cvt_pk_bf16(v1[0], v1[1]); w.w = cvt_pk_bf16(v1[2], v1[3]);
                    *(v4u*)(rowp + bj * PG_HALF) = w; }
                if (u.pn == 5 || u.pn == 6) {
                    float ss = 0.f;
#pragma unroll
                    for (int bj = 0; bj < 2; ++bj) if (u.pn == 5 || bj == 0) {
#pragma unroll
                        for (int n = 0; n < 2; ++n) { const f32x4 v = acc[ai][bj][m][n]; ss += (v[0] * v[0] + v[1] * v[1]) + (v[2] * v[2] + v[3] * v[3]); } }
                    ss += __shfl_xor(ss, 16); ss += __shfl_xor(ss, 32);
                    if (fq == 0) (u.pn == 5 ? SSQ : SSKV)[(size_t)(row0 + ai * PG_HALF + m * 16) * 4 + wc] = ss; } }
    }
};
struct EpiBf16 {
    static constexpr bool PERM = true;
    bf16* O; int ldc;
    __device__ __forceinline__ void operator()(const f32x4 (&acc)[2][2][4][2], const Unit& u, int wr, int wc, int fr, int fq) const {
        const int row0 = u.pm * PG_BM + wr * 64 + fr, col0 = u.pn * PG_BM + wc * 32 + 8 * fq;
#pragma unroll
        for (int ai = 0; ai < 2; ++ai)
#pragma unroll
            for (int m = 0; m < 4; ++m) { bf16* rowp = O + (size_t)(row0 + ai * PG_HALF + m * 16) * ldc + col0;
#pragma unroll
                for (int bj = 0; bj < 2; ++bj) { const f32x4 v0 = acc[ai][bj][m][0], v1 = acc[ai][bj][m][1];
                    v4u w; w.x = cvt_pk_bf16(v0[0], v0[1]); w.y = cvt_pk_bf16(v0[2], v0[3]); w.z = cvt_pk_bf16(v1[0], v1[1]); w.w = cvt_pk_bf16(v1[2], v1[3]);
                    *(v4u*)(rowp + bj * PG_HALF) = w; } }
    }
};
template <int NSRC> struct EpiRowScale {
    static constexpr bool PERM = true;
    const float* SS; bf16* O; int ldc; float cscale;
    __device__ __forceinline__ void operator()(const f32x4 (&acc)[2][2][4][2], const Unit& u, int wr, int wc, int fr, int fq) const {
        const int row0 = u.pm * PG_BM + wr * 64 + fr, col0 = u.pn * PG_BM + wc * 32 + 8 * fq;
#pragma unroll
        for (int ai = 0; ai < 2; ++ai)
#pragma unroll
            for (int m = 0; m < 4; ++m) { const int row = row0 + ai * PG_HALF + m * 16;
                const f32x4 s4 = *(const f32x4*)(SS + (size_t)row * 4); const float ss = (s4[0] + s4[1]) + (s4[2] + s4[3]);
                const float sc = cscale * __builtin_amdgcn_rsqf(ss * (1.0f / NSRC) + EPS);
                bf16* rowp = O + (size_t)row * ldc + col0;
#pragma unroll
                for (int bj = 0; bj < 2; ++bj) { const f32x4 v0 = acc[ai][bj][m][0] * sc, v1 = acc[ai][bj][m][1] * sc;
                    v4u w; w.x = cvt_pk_bf16(v0[0], v0[1]); w.y = cvt_pk_bf16(v0[2], v0[3]); w.z = cvt_pk_bf16(v1[0], v1[1]); w.w = cvt_pk_bf16(v1[2], v1[3]);
                    *(v4u*)(rowp + bj * PG_HALF) = w; } }
    }
};
struct EpiF32 {
    static constexpr bool PERM = false;
    float* C; int ldc; const float* resid;
    __device__ __forceinline__ void operator()(const f32x4 (&acc)[2][2][4][2], const Unit& u, int wr, int wc, int fr, int fq) const {
        const int row0 = u.pm * PG_BM + wr * 64 + fr, col0 = u.pn * PG_BM + wc * 32 + 4 * fq;
#pragma unroll
        for (int ai = 0; ai < 2; ++ai)
#pragma unroll
            for (int m = 0; m < 4; ++m) { const size_t off = (size_t)(row0 + ai * PG_HALF + m * 16) * ldc + col0;
#pragma unroll
                for (int bj = 0; bj < 2; ++bj)
#pragma unroll
                    for (int n = 0; n < 2; ++n) { f32x4 v = acc[ai][bj][m][n]; if (resid) v += *(const f32x4*)(resid + off + bj * PG_HALF + n * 16); *(f32x4*)(C + off + bj * PG_HALF + n * 16) = v; } }
    }
};
struct EpiGateChain {
    static constexpr bool PERM = true;
    const bf16* G; bf16* MG;
    __device__ __forceinline__ void mid(f32x4 (&acc)[2][2][4][2], const Unit& u, int wr, int wc, int fr, int fq) const {
        const int row0 = u.pm * PG_BM + wr * 64 + fr, col0 = u.pn * PG_BM + wc * 32 + 8 * fq;
#pragma unroll
        for (int ai = 0; ai < 2; ++ai)
#pragma unroll
            for (int m = 0; m < 4; ++m) { const int row = row0 + ai * PG_HALF + m * 16;
#pragma unroll
                for (int bj = 0; bj < 2; ++bj) { const int col = col0 + bj * PG_HALF;
                    const v4u gn = *(const v4u*)(G + (size_t)row * 2048 + col), gm = *(const v4u*)(G + (size_t)row * 2048 + 1024 + col);
#define RATIO(a, b) ((1.0f + __expf(-(b))) * __builtin_amdgcn_rcpf(1.0f + __expf(-(a))))
                    acc[ai][bj][m][0][0] *= RATIO(bf_lo(gn.x), bf_lo(gm.x)); acc[ai][bj][m][0][1] *= RATIO(bf_hi(gn.x), bf_hi(gm.x)); acc[ai][bj][m][0][2] *= RATIO(bf_lo(gn.y), bf_lo(gm.y)); acc[ai][bj][m][0][3] *= RATIO(bf_hi(gn.y), bf_hi(gm.y));
                    acc[ai][bj][m][1][0] *= RATIO(bf_lo(gn.z), bf_lo(gm.z)); acc[ai][bj][m][1][1] *= RATIO(bf_hi(gn.z), bf_hi(gm.z)); acc[ai][bj][m][1][2] *= RATIO(bf_lo(gn.w), bf_lo(gm.w)); acc[ai][bj][m][1][3] *= RATIO(bf_hi(gn.w), bf_hi(gm.w));
#undef RATIO
                } }
    }
    __device__ __forceinline__ void operator()(const f32x4 (&acc)[2][2][4][2], const Unit& u, int wr, int wc, int fr, int fq) const {
        const int row0 = u.pm * PG_BM + wr * 64 + fr, col0 = u.pn * PG_BM + wc * 32 + 8 * fq;
#pragma unroll
        for (int ai = 0; ai < 2; ++ai)
#pragma unroll
            for (int m = 0; m < 4; ++m) { const int row = row0 + ai * PG_HALF + m * 16;
#pragma unroll
                for (int bj = 0; bj < 2; ++bj) { const int col = col0 + bj * PG_HALF;
                    const v4u gm = *(const v4u*)(G + (size_t)row * 2048 + 1024 + col); const f32x4 a0 = acc[ai][bj][m][0], a1 = acc[ai][bj][m][1];
                    v4u w; w.x = cvt_pk_bf16(sigmoidf_(bf_lo(gm.x)) * a0[0], sigmoidf_(bf_hi(gm.x)) * a0[1]); w.y = cvt_pk_bf16(sigmoidf_(bf_lo(gm.y)) * a0[2], sigmoidf_(bf_hi(gm.y)) * a0[3]);
                    w.z = cvt_pk_bf16(sigmoidf_(bf_lo(gm.z)) * a1[0], sigmoidf_(bf_hi(gm.z)) * a1[1]); w.w = cvt_pk_bf16(sigmoidf_(bf_lo(gm.w)) * a1[2], sigmoidf_(bf_hi(gm.w)) * a1[3]);
                    *(v4u*)(MG + (size_t)row * 1024 + col) = w; } }
    }
};
struct EpiResid {
    static constexpr bool PERM = false;
    const float* X; bf16* HB; float* SS;
    __device__ __forceinline__ void operator()(const f32x4 (&acc)[2][2][4][2], const Unit& u, int wr, int wc, int fr, int fq) const {
        const int row0 = u.pm * PG_BM + wr * 64 + fr, col0 = u.pn * PG_BM + wc * 32 + 4 * fq;
#pragma unroll
        for (int ai = 0; ai < 2; ++ai)
#pragma unroll
            for (int m = 0; m < 4; ++m) { const int row = row0 + ai * PG_HALF + m * 16; const size_t off = (size_t)row * 1024 + col0; float ss = 0.f;
#pragma unroll
                for (int bj = 0; bj < 2; ++bj)
#pragma unroll
                    for (int n = 0; n < 2; ++n) { const f32x4 v = acc[ai][bj][m][n] + *(const f32x4*)(X + off + bj * PG_HALF + n * 16);
                        const unsigned w0 = cvt_pk_bf16(v[0], v[1]), w1 = cvt_pk_bf16(v[2], v[3]); *(v2u*)(HB + off + bj * PG_HALF + n * 16) = (v2u){w0, w1};
                        const float r0 = bf_lo(w0), r1 = bf_hi(w0), r2 = bf_lo(w1), r3 = bf_hi(w1); ss += (r0 * r0 + r1 * r1) + (r2 * r2 + r3 * r3); }
                ss += __shfl_xor(ss, 16); ss += __shfl_xor(ss, 32);
                if (fq == 0) SS[(size_t)row * 16 + u.pn * 4 + wc] = ss; }
    }
};
struct EpiRowSS {
    static constexpr bool PERM = true;
    const float* SS; bf16* O; int ldc;
    __device__ __forceinline__ void operator()(const f32x4 (&acc)[2][2][4][2], const Unit& u, int wr, int wc, int fr, int fq) const {
        const int row0 = u.pm * PG_BM + wr * 64 + fr, col0 = u.pn * PG_BM + wc * 32 + 8 * fq;
#pragma unroll
        for (int ai = 0; ai < 2; ++ai)
#pragma unroll
            for (int m = 0; m < 4; ++m) { const int row = row0 + ai * PG_HALF + m * 16;
                const f32x4* sp = (const f32x4*)(SS + (size_t)row * 16); const f32x4 s0 = sp[0], s1 = sp[1], s2 = sp[2], s3 = sp[3];
                const float ss = (((s0[0] + s0[1]) + (s0[2] + s0[3])) + ((s1[0] + s1[1]) + (s1[2] + s1[3]))) + (((s2[0] + s2[1]) + (s2[2] + s2[3])) + ((s3[0] + s3[1]) + (s3[2] + s3[3])));
                const float sc = __builtin_amdgcn_rsqf(ss * (1.0f / DM) + EPS);
                bf16* rowp = O + (size_t)row * ldc + col0;
#pragma unroll
                for (int bj = 0; bj < 2; ++bj) { const f32x4 v0 = acc[ai][bj][m][0] * sc, v1 = acc[ai][bj][m][1] * sc;
                    v4u w; w.x = cvt_pk_bf16(v0[0], v0[1]); w.y = cvt_pk_bf16(v0[2], v0[3]); w.z = cvt_pk_bf16(v1[0], v1[1]); w.w = cvt_pk_bf16(v1[2], v1[3]);
                    *(v4u*)(rowp + bj * PG_HALF) = w; } }
    }
};
namespace att {
constexpr int KB_BYTES = 12288, VB_BYTES = 12288, BUF_BYTES = KB_BYTES + VB_BYTES;
constexpr int NBUF = 4;
constexpr int OFF_IMP = 2 * BUF_BYTES;
constexpr int OFF_SC = OFF_IMP + 32768;
constexpr int OFF_IMP2 = 0, OFF_SC2 = 32768;
constexpr int OFF_SEL = NBUF * BUF_BYTES;
constexpr int OFF_END = OFF_SEL + 512;
static_assert(OFF_SC + 8192 <= NBUF * BUF_BYTES, "selection scratch must stay inside the aliased buffers");
static_assert(OFF_END <= RING_BYTES, "attention LDS map");

__device__ __forceinline__ int crow(int r, int hi) { return (r & 3) + 8 * (r >> 2) + 4 * hi; }
__device__ __forceinline__ s16x4 vtr(const LAS unsigned char* p) { typedef short v4i16_t __attribute__((ext_vector_type(4))); return __builtin_bit_cast(s16x4, __builtin_amdgcn_ds_read_tr16_b64_v4i16((LAS v4i16_t*)p)); }
__device__ __forceinline__ unsigned cvtpk(float lo, float hi) { typedef float f2 __attribute__((ext_vector_type(2))); typedef __bf16 b2 __attribute__((ext_vector_type(2))); f2 v = {lo, hi}; b2 b = __builtin_convertvector(v, b2); return __builtin_bit_cast(unsigned, b); }
__device__ __forceinline__ float swapmax(float m) { auto rr = __builtin_amdgcn_permlane32_swap(__float_as_uint(m), __float_as_uint(m), false, false); return fmaxf(__uint_as_float(rr[0]), __uint_as_float(rr[1])); }
__device__ __forceinline__ float swapsum(float m) { auto rr = __builtin_amdgcn_permlane32_swap(__float_as_uint(m), __float_as_uint(m), false, false); return __uint_as_float(rr[0]) + __uint_as_float(rr[1]); }

__device__ __forceinline__ float max3f(float a, float b, float c) { float r; asm("v_max3_f32 %0, %1, %2, %3" : "=v"(r) : "v"(a), "v"(b), "v"(c)); return r; }
__device__ __forceinline__ float max2f(float a, float b) { float r; asm("v_max_f32_e32 %0, %1, %2" : "=v"(r) : "v"(a), "v"(b)); return r; }
struct Flash { f32x16 o[3]; float m, l; };
constexpr float FLASH_THR = 8.0f;
__device__ __forceinline__ void flash_init(Flash& f) { f.o[0] = f32x16{}; f.o[1] = f32x16{}; f.o[2] = f32x16{}; f.m = 0.f; f.l = 0.f; }

template <int NKC>
__device__ __forceinline__ void issue_tile(LAS unsigned char* lds, int buf, const bf16* Kg, int ldk, const bf16* Kpe, const bf16* Vg, int ldv, int wave, int lane) {
    LAS unsigned char* kb = lds + buf * BUF_BYTES; LAS unsigned char* vb = kb + KB_BYTES;
    { const int row = 8 * wave + (lane >> 3), chunk = (lane & 7) ^ ((row >> 1) & 7);
      __builtin_amdgcn_global_load_lds((const unsigned*)(Kg + (size_t)row * ldk + chunk * 8), (LAS unsigned*)(kb + wave * 1024), 16, 0, 0); }
    if (NKC == 12) { if (wave < 4) { const int row = 16 * wave + (lane >> 2), chunk = (lane & 3) ^ ((row >> 2) & 3);
      __builtin_amdgcn_global_load_lds((const unsigned*)(Kpe + (size_t)row * 32 + chunk * 8), (LAS unsigned*)(kb + 8192 + wave * 1024), 16, 0, 0); } }
    __builtin_amdgcn_global_load_lds((const unsigned*)(Vg + (size_t)(16 * (wave & 3) + (lane >> 2)) * ldv + (wave >> 2) * 32 + (lane & 3) * 8), (LAS unsigned*)(vb + wave * 1024), 16, 0, 0);
}

template <int NKS, int NVB, bool HAS_BIAS>
__device__ __forceinline__ void tile_compute(Flash& f, const LAS unsigned char* kb, const LAS unsigned char* vb, const bf16x8* qr, float slope, float cb,
                                             int lo, int hi_, bool need_mask, bool set_ref, int r32, int hh, int lane) {
    const LAS unsigned char* vp = vb + ((lane >> 4) & 1) * 32 + (lane & 3) * 8 + (4 * hh + ((lane & 15) >> 2)) * 64;
    s16x4 vl[NVB][4], vh[NVB][4];
    f32x16 p0, p1;
    if (HAS_BIAS) {
        const float cb0 = (cb - f.m) + slope * (float)(4 * hh), cb1 = cb0 + slope * 32.f;
#pragma unroll
        for (int r = 0; r < 16; ++r) { const float cr = (float)((r & 3) + 8 * (r >> 2)); p0[r] = __builtin_fmaf(slope, cr, cb0); p1[r] = __builtin_fmaf(slope, cr, cb1); }
    } else {
        const float nm = -f.m;
#pragma unroll
        for (int r = 0; r < 16; ++r) { p0[r] = nm; p1[r] = nm; }
    }
    const LAS unsigned char* kp = kb + r32 * 128; const int sw = (r32 >> 1) & 7;
    const LAS unsigned char* kpe = kb + 8192 + r32 * 64; const int swe = (r32 >> 2) & 3;
    bf16x8 kf0[NKS], kf1[NKS];
    auto kload = [&](int d0) {
        const LAS unsigned char* a0 = (d0 < 4) ? kp + (((2 * d0 + hh) ^ sw) << 4) : kpe + (((2 * (d0 - 4) + hh) ^ swe) << 4);
        kf0[d0] = *(const LAS bf16x8*)(a0); kf1[d0] = *(const LAS bf16x8*)(a0 + ((d0 < 4) ? 4096 : 2048)); };
#pragma unroll
    for (int d0 = 0; d0 < 4; ++d0) kload(d0);
    __builtin_amdgcn_sched_barrier(0);
#pragma unroll
    for (int d0 = 0; d0 < NKS; ++d0) {
        p0 = __builtin_amdgcn_mfma_f32_32x32x16_bf16(kf0[d0], qr[d0], p0, 0, 0, 0);
        p1 = __builtin_amdgcn_mfma_f32_32x32x16_bf16(kf1[d0], qr[d0], p1, 0, 0, 0);
        if (d0 + 4 < NKS) { kload(d0 + 4); __builtin_amdgcn_sched_barrier(0); }
    }
#pragma unroll
    for (int b = 0; b < NVB; ++b)
#pragma unroll
        for (int ks = 0; ks < 4; ++ks) {
            asm volatile("ds_read_b64_tr_b16 %0, %1 offset:%c2" : "=&v"(vl[b][ks]) : "v"(vp), "i"(b * 4096 + ks * 1024) : "memory");
            asm volatile("ds_read_b64_tr_b16 %0, %1 offset:%c2" : "=&v"(vh[b][ks]) : "v"(vp), "i"(b * 4096 + ks * 1024 + 512) : "memory"); }
    if (need_mask) {
        asm volatile("" ::: "memory");
        const int l0 = lo - 4 * hh, h0 = hi_ - 4 * hh;
#pragma unroll
        for (int r = 0; r < 16; ++r) { const int c = (r & 3) + 8 * (r >> 2);
            if (c < l0 || c > h0) p0[r] = -INFINITY;
            if (c + 32 < l0 || c + 32 > h0) p1[r] = -INFINITY; }
    }
    if (set_ref) {
        asm volatile("s_nop 15\n\ts_nop 7" : "+v"(p0), "+v"(p1));
        float mt;
        { float a = max3f(p0[0], p0[1], p1[0]), b = max3f(p0[2], p0[3], p1[1]); a = max3f(a, p1[2], p1[3]);
#pragma unroll
          for (int r = 4; r < 16; r += 4) { a = max3f(a, p0[r], p0[r + 1]); b = max3f(b, p0[r + 2], p0[r + 3]); a = max3f(a, p1[r], p1[r + 1]); b = max3f(b, p1[r + 2], p1[r + 3]); }
          mt = max2f(a, b); }
        { auto rr = __builtin_amdgcn_permlane32_swap(__float_as_uint(mt), __float_as_uint(mt), false, false); mt = max2f(__uint_as_float(rr[0]), __uint_as_float(rr[1])); }
        if (__any(mt > FLASH_THR)) {
            const float delta = fmaxf(mt, 0.f), alpha = __builtin_amdgcn_exp2f(-delta);
            f.m += delta; f.l *= alpha;
#pragma unroll
            for (int r = 0; r < 16; ++r) { p0[r] -= delta; p1[r] -= delta; }
#pragma unroll
            for (int b = 0; b < NVB; ++b)
#pragma unroll
                for (int r = 0; r < 16; ++r) f.o[b][r] *= alpha;
        }
    }
    float sum = 0.f;
#pragma unroll
    for (int r = 0; r < 16; ++r) { p0[r] = __builtin_amdgcn_exp2f(p0[r]); p1[r] = __builtin_amdgcn_exp2f(p1[r]); sum += p0[r] + p1[r]; }
    f.l += sum;
    if (__any(f.l > 0x1p60f)) {
        asm volatile("" ::: "memory");
        f.m += 60.f; f.l *= 0x1p-60f;
#pragma unroll
        for (int b = 0; b < NVB; ++b)
#pragma unroll
            for (int r = 0; r < 16; ++r) f.o[b][r] *= 0x1p-60f;
    }
    v4u pw[4];
    pw[0] = (v4u){cvtpk(p0[0], p0[1]), cvtpk(p0[2], p0[3]), cvtpk(p0[4], p0[5]), cvtpk(p0[6], p0[7])};
    pw[1] = (v4u){cvtpk(p0[8], p0[9]), cvtpk(p0[10], p0[11]), cvtpk(p0[12], p0[13]), cvtpk(p0[14], p0[15])};
    pw[2] = (v4u){cvtpk(p1[0], p1[1]), cvtpk(p1[2], p1[3]), cvtpk(p1[4], p1[5]), cvtpk(p1[6], p1[7])};
    pw[3] = (v4u){cvtpk(p1[8], p1[9]), cvtpk(p1[10], p1[11]), cvtpk(p1[12], p1[13]), cvtpk(p1[14], p1[15])};
    if (NVB == 3) asm volatile("s_waitcnt lgkmcnt(0)" : "+v"(vl[0][0]), "+v"(vl[0][1]), "+v"(vl[0][2]), "+v"(vl[0][3]), "+v"(vh[0][0]), "+v"(vh[0][1]), "+v"(vh[0][2]), "+v"(vh[0][3]),
                                                         "+v"(vl[1][0]), "+v"(vl[1][1]), "+v"(vl[1][2]), "+v"(vl[1][3]), "+v"(vh[1][0]), "+v"(vh[1][1]), "+v"(vh[1][2]), "+v"(vh[1][3]),
                                                         "+v"(vl[NVB - 1][0]), "+v"(vl[NVB - 1][1]), "+v"(vl[NVB - 1][2]), "+v"(vl[NVB - 1][3]), "+v"(vh[NVB - 1][0]), "+v"(vh[NVB - 1][1]), "+v"(vh[NVB - 1][2]), "+v"(vh[NVB - 1][3]) :: "memory");
    else          asm volatile("s_waitcnt lgkmcnt(0)" : "+v"(vl[0][0]), "+v"(vl[0][1]), "+v"(vl[0][2]), "+v"(vl[0][3]), "+v"(vh[0][0]), "+v"(vh[0][1]), "+v"(vh[0][2]), "+v"(vh[0][3]),
                                                         "+v"(vl[1][0]), "+v"(vl[1][1]), "+v"(vl[1][2]), "+v"(vl[1][3]), "+v"(vh[1][0]), "+v"(vh[1][1]), "+v"(vh[1][2]), "+v"(vh[1][3]) :: "memory");
    __builtin_amdgcn_sched_barrier(0);
#pragma unroll
    for (int b = 0; b < NVB; ++b)
#pragma unroll
        for (int ks = 0; ks < 4; ++ks) {
            const bf16x8 va = (bf16x8){vl[b][ks][0], vl[b][ks][1], vl[b][ks][2], vl[b][ks][3], vh[b][ks][0], vh[b][ks][1], vh[b][ks][2], vh[b][ks][3]};
            f.o[b] = __builtin_amdgcn_mfma_f32_32x32x16_bf16(va, __builtin_bit_cast(bf16x8, pw[ks]), f.o[b], 0, 0, 0);
        }
}
__device__ __forceinline__ void dma_wait_bar(int outstanding) {
    if (outstanding == 3) asm volatile("s_waitcnt vmcnt(3) lgkmcnt(0)\n\ts_barrier" ::: "memory");
    else if (outstanding == 2) asm volatile("s_waitcnt vmcnt(2) lgkmcnt(0)\n\ts_barrier" ::: "memory");
    else asm volatile("s_waitcnt vmcnt(0) lgkmcnt(0)\n\ts_barrier" ::: "memory");
}
template <bool DESC> __device__ __forceinline__ int pick_tile(unsigned m) { return DESC ? 31 - __builtin_clz(m) : __builtin_ctz(m); }
struct NoNext { __device__ __forceinline__ void operator()(int, int) const {} };
template <int NKS, int NVB, bool HAS_BIAS, bool DESC, bool NDESC, bool MAXALL, class Src, class Par, class NSrc>
__device__ __forceinline__ int flash_run(Flash& f, LAS unsigned char* lds, unsigned tm, const bf16x8* qr, float slope, const Src& src, const Par& par, bool pre, int slot0, unsigned ntm, const NSrc& nsrc, int r32, int hh, int lane) {
#ifdef TIMER_PHASE
    struct { LAS unsigned char* lds; } F{lds};
#endif
    unsigned rem = tm, ahead = tm;
    int islot = slot0, cslot = slot0, nslot = -1;
    bool first = true;
    auto issue_pair = [&]() {
        if (ahead) { const int j = pick_tile<DESC>(ahead); src(j, 2 * islot); ahead &= ~(1u << j);
            if (ahead) { const int j2 = pick_tile<DESC>(ahead); src(j2, 2 * islot + 1); ahead &= ~(1u << j2); } }
        else if (ntm && nslot < 0) { unsigned nm = ntm; const int j = pick_tile<NDESC>(nm); nsrc(j, 2 * islot); nm &= ~(1u << j);
            if (nm) { const int j2 = pick_tile<NDESC>(nm); nsrc(j2, 2 * islot + 1); } nslot = islot; }
        islot ^= 1; };
    if (pre) { int n = 0; unsigned a2 = ahead; while (a2 && n < 2) { const int j = pick_tile<DESC>(a2); a2 &= ~(1u << j); ++n; } ahead = a2; islot ^= 1; }
    else { TMS_BEGIN(44); issue_pair(); TMS_END(44); }
#pragma unroll 1
    while (rem) {
        const int ja = pick_tile<DESC>(rem); rem &= ~(1u << ja);
        int jb = -1; if (rem) { jb = pick_tile<DESC>(rem); rem &= ~(1u << jb); }
#ifdef TIMER_PHASE
        const unsigned long long tb0_ = (TIMER_PHASE == 40 || TIMER_PHASE == 41) ? __builtin_amdgcn_s_memrealtime() : 0ull;
#endif
        asm volatile("s_waitcnt vmcnt(0) lgkmcnt(0)\n\ts_barrier" ::: "memory");
#ifdef TIMER_PHASE
        if ((TIMER_PHASE == 40 && threadIdx.x == 0) || (TIMER_PHASE == 41 && threadIdx.x == 448)) *(LAS unsigned long long*)(lds + RING_BYTES + 512) += __builtin_amdgcn_s_memrealtime() - tb0_;
#endif
        { TMS_BEGIN(44); issue_pair(); TMS_END(44); }
        int lo, hi_; bool need; float cb;
        if (par(ja, lo, hi_, need, cb)) { const LAS unsigned char* kb = lds + (2 * cslot) * BUF_BYTES;
            TMS_BEGIN(43); tile_compute<NKS, NVB, HAS_BIAS>(f, kb, kb + KB_BYTES, qr, slope, cb, lo, hi_, need, MAXALL || first, r32, hh, lane); first = false; TMS_END(43); TMS_COUNT(42); }
        if (jb >= 0 && par(jb, lo, hi_, need, cb)) { const LAS unsigned char* kb = lds + (2 * cslot + 1) * BUF_BYTES;
            TMS_BEGIN(43); tile_compute<NKS, NVB, HAS_BIAS>(f, kb, kb + KB_BYTES, qr, slope, cb, lo, hi_, need, MAXALL || first, r32, hh, lane); first = false; TMS_END(43); TMS_COUNT(42); }
        cslot ^= 1;
    }
    if (nslot < 0) asm volatile("s_waitcnt lgkmcnt(0)\n\ts_barrier" ::: "memory");
    return nslot;
}

__device__ __forceinline__ void flash_finish(Flash& f, int nvb) {
    const float lt = swapsum(f.l); const float inv = lt > 0.f ? 1.0f / lt : 0.f;
#pragma unroll
    for (int b = 0; b < 3; ++b) if (b < nvb) {
#pragma unroll
        for (int r = 0; r < 16; ++r) f.o[b][r] *= inv; }
}

__device__ __forceinline__ void nsa_unit(Frame& F, int b, int g, int qc) {
    int lane; asm volatile("v_and_b32_e32 %0, 63, %1" : "=v"(lane) : "v"(F.tid));
    LAS unsigned char* lds = F.lds; const int wave = F.wave, r32 = lane & 31, hh = lane >> 5;
    const int head = g * 4 + (wave >> 1);
    const int qloc = 32 * (wave & 1) + r32;
    const int t = 64 * qc + qloc;
    const size_t row = (size_t)b * SEQ + t;
    const bf16* QKV = (const bf16*)(F.ws + WS_QKV); const bf16* MISC = (const bf16*)(F.ws + WS_MISC);
    bf16x8 qr[4];
#pragma unroll
    for (int d0 = 0; d0 < 4; ++d0) qr[d0] = *(const bf16x8*)(QKV + row * 1280 + head * 64 + d0 * 16 + hh * 8);
    float graw_c = bf2f(MISC[row * 256 + 160 + head]), graw_s = bf2f(MISC[row * 256 + 160 + 8 + head]), graw_w = bf2f(MISC[row * 256 + 160 + 16 + head]);
    asm volatile("" : "+v"(graw_c), "+v"(graw_s), "+v"(graw_w) : "v"(qr[0]), "v"(qr[1]), "v"(qr[2]), "v"(qr[3]));
    const float slope2 = exp2f(-(float)(head + 1)) * LOG2E;
    LAS unsigned* selw = (LAS unsigned*)(lds + OFF_SEL);
    if (F.tid < 80) selw[F.tid] = 0u;
    f32x16 ot0, ot1;
    const bf16* Kw = QKV + (size_t)b * SEQ * 1280 + 1024 + g * 64; const bf16* Vw = QKV + (size_t)b * SEQ * 1280 + 1152 + g * 64;
    const bf16* Ks = QKV + (size_t)b * SEQ * 1280 + 768 + g * 64; const bf16* Vs = QKV + (size_t)b * SEQ * 1280 + 896 + g * 64;
    auto src_win = [&](int j, int buf) { issue_tile<8>(lds, buf, Kw + (size_t)j * 64 * 1280, 1280, nullptr, Vw + (size_t)j * 64 * 1280, 1280, wave, lane); };
    auto src_sel = [&](int j, int buf) { issue_tile<8>(lds, buf, Ks + (size_t)j * 64 * 1280, 1280, nullptr, Vs + (size_t)j * 64 * 1280, 1280, wave, lane); };
    const int j0w = qc >= 8 ? qc - 8 : 0;
    const unsigned tm_win = (qc == 31 ? 0xffffffffu : ((2u << qc) - 1u)) & ~((1u << j0w) - 1u);
    TMS_DECL; TMS_MARK(47);
    int hand;
    {
        const bf16* KC = (const bf16*)(F.ws + WS_KC) + (size_t)(b * 2 + g) * 128 * 64; const bf16* VC = (const bf16*)(F.ws + WS_VC) + (size_t)(b * 2 + g) * 128 * 64;
        Flash f; flash_init(f);
        int nmax = (t >= 31) ? ((t - 31) >> 4) : -1; if (nmax > 126) nmax = 126;
        const int tid = F.tid;
        auto src = [&](int ti, int buf) {
            issue_tile<8>(lds, buf, KC + (size_t)ti * 64 * 64, 64, nullptr, VC + (size_t)ti * 64 * 64, 64, wave, lane);
            LAS bf16* ov = (LAS bf16*)(lds + buf * BUF_BYTES + KB_BYTES + 2 * 4096);
#pragma unroll
            for (int e = 0; e < 4; ++e) { const int idx = tid * 4 + e, nl = idx >> 5, s_ = idx & 31, n = 64 * ti + nl;
                float v = 0.f; if (s_ == (n >> 2)) v = ((n & 3) == 3) ? 0.5f : 1.0f; else if (s_ == (n >> 2) + 1 && (n & 3) == 3) v = 0.5f;
                ov[(nl >> 4) * 512 + (nl & 15) * 32 + s_] = (bf16)f2bf(v); } };
        auto par = [&](int ti, int& lo, int& hi_, bool& need, float& cb) { lo = 0; hi_ = nmax - 64 * ti; need = true; cb = 16.f * slope2 * (float)(64 * ti); return true; };
        TMS_MARKEND(47);
        hand = flash_run<4, 3, true, true, true, true>(f, lds, 3u, qr, 16.f * slope2, src, par, false, 0, tm_win, src_win, r32, hh, lane);
        flash_finish(f, 3);
        TMS_MARK(45);
        asm volatile("s_waitcnt lgkmcnt(0)\n\ts_barrier" ::: "memory");
        LAS float* imp = (LAS float*)(lds + OFF_IMP2) + (wave * 32 + r32) * 32;
#pragma unroll
        for (int r = 0; r < 16; ++r) imp[crow(r, hh)] = f.o[2][r];
        const float gc = sigmoidf_(graw_c);
        ot0 = f.o[0] * gc; ot1 = f.o[1] * gc;
    }
    asm volatile("s_waitcnt lgkmcnt(0)\n\ts_barrier" ::: "memory");
    if (qc < 16) { if (F.tid <= 64) selw[F.tid] = (2u << qc) - 1u; }
    else {
        LAS float* IMP = (LAS float*)(lds + OFF_IMP2); LAS float* SC = (LAS float*)(lds + OFF_SC2);
        const int q = F.tid >> 3, s4 = (F.tid & 7) * 4;
#pragma unroll
        for (int e = 0; e < 4; ++e) { const int s_ = s4 + e; float v = 0.f;
#pragma unroll
            for (int h4 = 0; h4 < 4; ++h4) v += IMP[((2 * h4 + (q >> 5)) * 32 + (q & 31)) * 32 + s_];
            const bool causal = s_ <= qc, forced = causal && (s_ == 0 || s_ + 2 > qc);
            SC[q * 32 + s_] = causal ? (v + (forced ? 1e4f : 0.f)) : -1e30f; }
        asm volatile("s_waitcnt lgkmcnt(0)\n\ts_barrier" ::: "memory");
        float sc[32];
#pragma unroll
        for (int s_ = 0; s_ < 32; ++s_) sc[s_] = SC[q * 32 + s_];
        unsigned bits = 0u;
#pragma unroll
        for (int e = 0; e < 4; ++e) { const int s_ = s4 + e; const float me = SC[q * 32 + s_]; int rank = 0;
#pragma unroll
            for (int s2 = 0; s2 < 32; ++s2) rank += (sc[s2] > me || (sc[s2] == me && s2 < s_)) ? 1 : 0;
            if (s_ <= qc && rank < 16) bits |= 1u << s_; }
        atomicOr((unsigned*)&selw[q], bits); atomicOr((unsigned*)&selw[64], bits);
    }
    asm volatile("s_waitcnt lgkmcnt(0)\n\ts_barrier" ::: "memory");
    const unsigned mymask = selw[qloc], anymask = selw[64];
    TMS_MARKEND(45);
    {
        Flash f; flash_init(f);
        auto par = [&](int j, int& lo, int& hi_, bool& need, float& cb) { lo = t - 511 - 64 * j; if (lo < 0) lo = 0; hi_ = t - 64 * j; if (hi_ > 63) hi_ = 63;
            need = (j == qc) || (j + 8 == qc); cb = slope2 * (float)(64 * j); return slope2 * (float)(64 * qc + 32 * (wave & 1) - (64 * j + 63)) < 256.f; };
        hand = flash_run<4, 2, true, true, true, false>(f, lds, tm_win, qr, slope2, src_win, par, true, hand, anymask, src_sel, r32, hh, lane);
        flash_finish(f, 2);
        const float gw = sigmoidf_(graw_w);
        ot0 += f.o[0] * gw; ot1 += f.o[1] * gw;
    }
    {
        Flash f; flash_init(f);
        const int tmin_w = 64 * qc + 32 * (wave & 1);
        auto par = [&](int j, int& lo, int& hi_, bool& need, float& cb) { const bool sel = (mymask >> j) & 1u; lo = 0; hi_ = (j == qc) ? (t - 64 * j) : 63;
            need = (j == qc); cb = sel ? slope2 * (float)(64 * j) : -INFINITY;
            return __any(sel) && slope2 * (float)(tmin_w - (64 * j + 63)) < 256.f; };
        (void)flash_run<4, 2, true, true, true, false>(f, lds, anymask, qr, slope2, src_sel, par, true, hand, 0u, NoNext(), r32, hh, lane);
        TMS_MARK(48);
        flash_finish(f, 2);
        const float gs = sigmoidf_(graw_s);
        ot0 += f.o[0] * gs; ot1 += f.o[1] * gs;
    }
    { bf16* op = (bf16*)(F.ws + WS_OCAT) + row * 1024 + head * 64 + 4 * hh;
#pragma unroll
      for (int k = 0; k < 4; ++k) {
          *(v2u*)(op + 8 * k) = (v2u){cvtpk(ot0[4 * k], ot0[4 * k + 1]), cvtpk(ot0[4 * k + 2], ot0[4 * k + 3])};
          *(v2u*)(op + 32 + 8 * k) = (v2u){cvtpk(ot1[4 * k], ot1[4 * k + 1]), cvtpk(ot1[4 * k + 2], ot1[4 * k + 3])}; } }
    TMS_MARKEND(48);
}

__device__ __forceinline__ void mla_unit(Frame& F, int b, int h, int qb) {
    int lane; asm volatile("v_and_b32_e32 %0, 63, %1" : "=v"(lane) : "v"(F.tid));
    LAS unsigned char* lds = F.lds; const int wave = F.wave, r32 = lane & 31, hh = lane >> 5;
    const int t = 256 * qb + 32 * wave + r32;
    const size_t row = (size_t)b * SEQ + t;
    const bf16* MQ = (const bf16*)(F.ws + WS_MLAQ); const bf16* MKV = (const bf16*)(F.ws + WS_MLAKV); const bf16* KPE = (const bf16*)(F.ws + WS_KPE);
    bf16x8 qr[6];
#pragma unroll
    for (int d0 = 0; d0 < 6; ++d0) qr[d0] = *(const bf16x8*)(MQ + row * 768 + h * 96 + d0 * 16 + hh * 8);
    {
        const float pos = (float)F.pos[row];
        v4u a = __builtin_bit_cast(v4u, qr[4]), c = __builtin_bit_cast(v4u, qr[5]);
        float x1[8], x2[8];
        x1[0] = bf_lo(a.x); x1[1] = bf_hi(a.x); x1[2] = bf_lo(a.y); x1[3] = bf_hi(a.y); x1[4] = bf_lo(a.z); x1[5] = bf_hi(a.z); x1[6] = bf_lo(a.w); x1[7] = bf_hi(a.w);
        x2[0] = bf_lo(c.x); x2[1] = bf_hi(c.x); x2[2] = bf_lo(c.y); x2[3] = bf_hi(c.y); x2[4] = bf_lo(c.z); x2[5] = bf_hi(c.z); x2[6] = bf_lo(c.w); x2[7] = bf_hi(c.w);
        float y1[8], y2[8];
#pragma unroll
        for (int j = 0; j < 8; ++j) { const float ang = pos * rope_inv(8 * hh + j); float sn, cs; rope_sincos(ang, sn, cs);
            y1[j] = x1[j] * cs - x2[j] * sn; y2[j] = x1[j] * sn + x2[j] * cs; }
        a = (v4u){cvtpk(y1[0], y1[1]), cvtpk(y1[2], y1[3]), cvtpk(y1[4], y1[5]), cvtpk(y1[6], y1[7])};
        c = (v4u){cvtpk(y2[0], y2[1]), cvtpk(y2[2], y2[3]), cvtpk(y2[4], y2[5]), cvtpk(y2[6], y2[7])};
        qr[4] = __builtin_bit_cast(bf16x8, a); qr[5] = __builtin_bit_cast(bf16x8, c);
    }
    asm volatile("" :: "v"(qr[0]), "v"(qr[1]), "v"(qr[2]), "v"(qr[3]), "v"(qr[4]), "v"(qr[5]));
    const bf16* Kg = MKV + (size_t)b * SEQ * 1024 + h * 128; const bf16* Vg = Kg + 64; const bf16* Pg = KPE + (size_t)b * SEQ * 32;
    Flash f; flash_init(f);
    const int NT = 4 * qb + 4;
    const int tmin_w = 256 * qb + 32 * wave, tmax_w = tmin_w + 31;
    auto src = [&](int j, int buf) { issue_tile<12>(lds, buf, Kg + (size_t)j * 64 * 1024, 1024, Pg + (size_t)j * 64 * 32, Vg + (size_t)j * 64 * 1024, 1024, wave, lane); };
    auto par = [&](int j, int& lo, int& hi_, bool& need, float& cb) { lo = 0; hi_ = t - 64 * j; if (hi_ > 63) hi_ = 63; need = (64 * j + 63 > tmin_w); cb = 0.f; return 64 * j <= tmax_w; };
    (void)flash_run<6, 2, false, false, false, false>(f, lds, NT == 32 ? 0xffffffffu : ((1u << NT) - 1u), qr, 0.f, src, par, false, 0, 0u, NoNext(), r32, hh, lane);
    flash_finish(f, 2);
    { bf16* op = (bf16*)(F.ws + WS_OCAT) + row * 1024 + 512 + h * 64 + 4 * hh;
#pragma unroll
      for (int k = 0; k < 4; ++k) {
          *(v2u*)(op + 8 * k) = (v2u){cvtpk(f.o[0][4 * k], f.o[0][4 * k + 1]), cvtpk(f.o[0][4 * k + 2], f.o[0][4 * k + 3])};
          *(v2u*)(op + 32 + 8 * k) = (v2u){cvtpk(f.o[1][4 * k], f.o[1][4 * k + 1]), cvtpk(f.o[1][4 * k + 2], f.o[1][4 * k + 3])}; } }
}

__device__ __forceinline__ int draw_unit(Frame& F, unsigned* ctr) {
    TMS_BEGIN(46);
    LAS int* slot = (LAS int*)(F.lds + OFF_SEL + 384);
    if (F.tid == 0) *slot = (int)__hip_atomic_fetch_add(ctr, 1u, __ATOMIC_RELAXED, __HIP_MEMORY_SCOPE_AGENT);
    __syncthreads();
    const int v = *slot;
    __syncthreads();
    TMS_END(46);
    return __builtin_amdgcn_readfirstlane(v);
}
__device__ __forceinline__ void nsa_loop(Frame& F) {
    unsigned* ctr = (unsigned*)(F.ws + WS_CTL) + 8192;
#pragma unroll 1
    for (int first = 1;; first = 0) { const int idx = (first && F.bid < 256) ? F.bid : 256 + draw_unit(F, ctr); if (idx >= 512) break; const int qc = 31 - (idx >> 4), bg = idx & 15; nsa_unit(F, bg >> 1, bg & 1, qc); }
}
__device__ __forceinline__ void mla_loop(Frame& F) {
    unsigned* ctr = (unsigned*)(F.ws + WS_CTL) + 8192 + 64;
#pragma unroll 1
    for (int first = 1;; first = 0) { const int idx = (first && F.bid < 256) ? F.bid : 256 + draw_unit(F, ctr); if (idx >= 512) break; const int qb = 7 - (idx >> 6), bh = idx & 63; mla_unit(F, bh >> 3, bh & 7, qb); }
}
}
#define NET_SORT16(K) do { CE(K[0], K[1]); CE(K[2], K[3]); CE(K[0], K[2]); CE(K[1], K[3]); CE(K[1], K[2]); CE(K[4], K[5]); CE(K[6], K[7]); CE(K[4], K[6]); CE(K[5], K[7]); CE(K[5], K[6]); CE(K[0], K[4]); CE(K[2], K[6]); CE(K[2], K[4]); CE(K[1], K[5]); CE(K[3], K[7]); CE(K[3], K[5]); CE(K[1], K[2]); CE(K[3], K[4]); CE(K[5], K[6]); CE(K[8], K[9]); CE(K[10], K[11]); CE(K[8], K[10]); CE(K[9], K[11]); CE(K[9], K[10]); CE(K[12], K[13]); CE(K[14], K[15]); CE(K[12], K[14]); CE(K[13], K[15]); CE(K[13], K[14]); CE(K[8], K[12]); CE(K[10], K[14]); CE(K[10], K[12]); CE(K[9], K[13]); CE(K[11], K[15]); CE(K[11], K[13]); CE(K[9], K[10]); CE(K[11], K[12]); CE(K[13], K[14]); CE(K[0], K[8]); CE(K[4], K[12]); CE(K[4], K[8]); CE(K[2], K[10]); CE(K[6], K[14]); CE(K[6], K[10]); CE(K[2], K[4]); CE(K[6], K[8]); CE(K[10], K[12]); CE(K[1], K[9]); CE(K[5], K[13]); CE(K[5], K[9]); CE(K[3], K[11]); CE(K[7], K[15]); CE(K[7], K[11]); CE(K[3], K[5]); CE(K[7], K[9]); CE(K[11], K[13]); CE(K[1], K[2]); CE(K[3], K[4]); CE(K[5], K[6]); CE(K[7], K[8]); CE(K[9], K[10]); CE(K[11], K[12]); CE(K[13], K[14]); } while (0)
#define NET_BMERGE16(K) do { CE(K[0], K[8]); CE(K[1], K[9]); CE(K[2], K[10]); CE(K[3], K[11]); CE(K[4], K[12]); CE(K[5], K[13]); CE(K[6], K[14]); CE(K[7], K[15]); CE(K[0], K[4]); CE(K[1], K[5]); CE(K[2], K[6]); CE(K[3], K[7]); CE(K[8], K[12]); CE(K[9], K[13]); CE(K[10], K[14]); CE(K[11], K[15]); CE(K[0], K[2]); CE(K[1], K[3]); CE(K[4], K[6]); CE(K[5], K[7]); CE(K[8], K[10]); CE(K[9], K[11]); CE(K[12], K[14]); CE(K[13], K[15]); CE(K[0], K[1]); CE(K[2], K[3]); CE(K[4], K[5]); CE(K[6], K[7]); CE(K[8], K[9]); CE(K[10], K[11]); CE(K[12], K[13]); CE(K[14], K[15]); } while (0)
__device__ __forceinline__ void kpe_pass(Frame& F) {
    const bf16* MISC = (const bf16*)(F.ws + WS_MISC); bf16* KPE = (bf16*)(F.ws + WS_KPE);
    const int gt = F.bid * NTHREADS + F.tid, NGT = F.G * NTHREADS;
    for (int it = gt; it < MTOK * 16; it += NGT) { const int t = it >> 4, i = it & 15;
        const float x1 = bf2f(MISC[(size_t)t * 256 + 128 + i]), x2 = bf2f(MISC[(size_t)t * 256 + 144 + i]);
        const float ang = (float)F.pos[t] * rope_inv(i); float sn, cs; rope_sincos(ang, sn, cs);
        KPE[(size_t)t * 32 + i] = (bf16)f2bf(x1 * cs - x2 * sn); KPE[(size_t)t * 32 + 16 + i] = (bf16)f2bf(x1 * sn + x2 * cs); }
}
__device__ __forceinline__ void cmp_finalize(Frame& F) {
    const int gw = F.bid * NWAVES + F.wave, NGW = F.G * NWAVES, lane = F.lane;
    LAS float* W2S = (LAS float*)(F.lds + 16384);
    LAS float* hid = (LAS float*)(F.lds + F.wave * 1024);
    for (int i = F.tid; i < 2 * 128 * 64 / 4; i += NTHREADS) { const int kv = i >> 11, j = i & 2047; ((LAS f32x4*)W2S)[i] = ((const f32x4*)F.in[kv ? I_CW2V : I_CW2K])[j]; }
    __syncthreads();
    for (int it = gw; it < 2 * 16 * 128; it += NGW) {
        const int kv = it >> 11, bg = (it >> 7) & 15, n = it & 127;
        bf16* dst = (bf16*)(F.ws + (kv ? WS_VC : WS_KC)) + ((size_t)bg * 128 + n) * 64;
        if (n == 127) { dst[lane] = 0; continue; }
        const float* U = (const float*)(F.ws + WS_USLAB) + (size_t)kv * 4 * 2048 * 256 + (size_t)(bg * 128 + n) * 256; const float* c1 = (const float*)(F.ws + (kv ? WS_C1V : WS_C1K));
        float a0 = c1[lane], a1 = c1[64 + lane];
#pragma unroll
        for (int s = 0; s < 4; ++s) { const float* Us = U + (size_t)s * 2048 * 256; a0 += Us[lane] + Us[256 + 128 + lane]; a1 += Us[64 + lane] + Us[256 + 192 + lane]; }
        hid[lane] = gelu_tanh(a0); hid[64 + lane] = gelu_tanh(a1);
        asm volatile("s_waitcnt lgkmcnt(0)" ::: "memory");
        const LAS float* w2 = W2S + kv * 8192 + lane;
        float s0 = 0.f, s1 = 0.f, s2 = 0.f, s3 = 0.f;
#pragma unroll 8
        for (int i = 0; i < 128; i += 4) { s0 += hid[i] * w2[i * 64]; s1 += hid[i + 1] * w2[(i + 1) * 64]; s2 += hid[i + 2] * w2[(i + 2) * 64]; s3 += hid[i + 3] * w2[(i + 3) * 64]; }
        dst[lane] = (bf16)f2bf((s0 + s1) + (s2 + s3));
        asm volatile("s_waitcnt lgkmcnt(0)" ::: "memory");
    }
}
template <bool SIGNED>
__device__ __forceinline__ void quant_table(Frame& F, const float* src, unsigned char* dst, float* steps) {
    const int gw = F.bid * NWAVES + F.wave, NGW = F.G * NWAVES, lane = F.lane;
    for (int e0 = gw; e0 < 16384; e0 += 2 * NGW) {
        const int e1 = (e0 + NGW < 16384) ? e0 + NGW : e0;
        const f32x4* spa = (const f32x4*)(src + (size_t)e0 * 1024) + 4 * lane; const f32x4* spb = (const f32x4*)(src + (size_t)e1 * 1024) + 4 * lane;
        f32x4 va[4], vb[4];
#pragma unroll
        for (int j = 0; j < 4; ++j) { va[j] = spa[j]; vb[j] = spb[j]; }
        float ma = 0.f, mb = 0.f;
#pragma unroll
        for (int j = 0; j < 4; ++j) { ma = fmaxf(ma, fmaxf(fmaxf(fabsf(va[j].x), fabsf(va[j].y)), fmaxf(fabsf(va[j].z), fabsf(va[j].w)))); mb = fmaxf(mb, fmaxf(fmaxf(fabsf(vb[j].x), fabsf(vb[j].y)), fmaxf(fabsf(vb[j].z), fabsf(vb[j].w)))); }
#pragma unroll
        for (int o = 1; o < 64; o <<= 1) { ma = fmaxf(ma, __shfl_xor(ma, o)); mb = fmaxf(mb, __shfl_xor(mb, o)); }
        const float offs = SIGNED ? 0.f : 128.f;
        const float sta = ma > 0.f ? ma * (1.0f / 127.0f) : 1.0f, ia = 1.0f / sta, stb = mb > 0.f ? mb * (1.0f / 127.0f) : 1.0f, ib = 1.0f / stb;
        v4u wa, wb;
#pragma unroll
        for (int j = 0; j < 4; ++j) {
            wa[j] = ((unsigned)(int)(rintf(va[j].x * ia) + offs) & 0xffu) | (((unsigned)(int)(rintf(va[j].y * ia) + offs) & 0xffu) << 8) | (((unsigned)(int)(rintf(va[j].z * ia) + offs) & 0xffu) << 16) | (((unsigned)(int)(rintf(va[j].w * ia) + offs) & 0xffu) << 24);
            wb[j] = ((unsigned)(int)(rintf(vb[j].x * ib) + offs) & 0xffu) | (((unsigned)(int)(rintf(vb[j].y * ib) + offs) & 0xffu) << 8) | (((unsigned)(int)(rintf(vb[j].z * ib) + offs) & 0xffu) << 16) | (((unsigned)(int)(rintf(vb[j].w * ib) + offs) & 0xffu) << 24); }
        ((v4u*)(dst + (size_t)e0 * 1024))[lane] = wa; ((v4u*)(dst + (size_t)e1 * 1024))[lane] = wb;
        if (lane == 0) { steps[e0] = sta; steps[e1] = stb; }
    }
}

namespace peer {
constexpr int TOK = 32;
constexpr int LSTR = 17;
constexpr int OFF_LISTV = 0, OFF_LISTK = 34816;
constexpr int OFF_ROUTE = 45056;
constexpr int OFF_SKB = 77824;
struct Ent { float v; unsigned k; };
__device__ __forceinline__ unsigned ordkey(float f) { const unsigned u = __float_as_uint(f); return u ^ ((u >> 31) ? 0xffffffffu : 0x80000000u); }
__device__ __forceinline__ float ordinv(unsigned k) { return __uint_as_float(k ^ ((k >> 31) ? 0x80000000u : 0xffffffffu)); }
__device__ __forceinline__ void swap2(int x, int& lo, int& hi) { auto rr = __builtin_amdgcn_permlane32_swap((unsigned)x, (unsigned)x, false, false); lo = (int)rr[0]; hi = (int)rr[1]; }

#define CE(a, b) do { const unsigned x_ = (a) > (b) ? (a) : (b), y_ = (a) > (b) ? (b) : (a); (a) = x_; (b) = y_; } while (0)
__device__ __forceinline__ void merge_top16(unsigned (&a)[16], const unsigned (&b)[16]) {
#pragma unroll
    for (int i = 0; i < 16; ++i) a[i] = a[i] > b[15 - i] ? a[i] : b[15 - i];
    NET_BMERGE16(a);
}
__device__ __forceinline__ void top16_of64(unsigned (&w)[4][16]) {
    NET_SORT16(w[0]); NET_SORT16(w[1]); NET_SORT16(w[2]); NET_SORT16(w[3]);
    merge_top16(w[0], w[1]); merge_top16(w[2], w[3]); merge_top16(w[0], w[2]);
}

#define PEER_CANDS(X) X(0,0) X(0,1) X(0,2) X(0,3) X(0,4) X(0,5) X(0,6) X(0,7) X(0,8) X(0,9) X(0,10) X(0,11) X(0,12) X(0,13) X(0,14) X(0,15) \
    X(1,0) X(1,1) X(1,2) X(1,3) X(1,4) X(1,5) X(1,6) X(1,7) X(2,0) X(2,1) X(2,2) X(2,3) X(2,4) X(3,0) X(3,1) X(3,2) X(3,3) X(4,0) X(4,1) X(4,2) \
    X(5,0) X(5,1) X(6,0) X(6,1) X(7,0) X(7,1) X(8,0) X(9,0) X(10,0) X(11,0) X(12,0) X(13,0) X(14,0) X(15,0)

__device__ __forceinline__ void route_task(Frame& F, int tok0) {
    int lane; asm volatile("v_and_b32_e32 %0, 63, %1" : "=v"(lane) : "v"(F.tid));
    const int wave = F.wave, r32 = lane & 31, hh = lane >> 5;
    const bf16* QP = (const bf16*)(F.ws + WS_QP);
    const size_t row = (size_t)tok0 + r32;
    LAS unsigned char* LK = F.lds + OFF_LISTK + (size_t)wave * 2 * TOK * LSTR;
    LAS unsigned char* SKB = F.lds + OFF_SKB;
    LAS unsigned char* CANDT = F.lds + OFF_LISTV;
    if (F.tid < 64) { int ci = 0; unsigned ab = 0u;
#define X(a, b) ab = ((int)F.tid == ci) ? (unsigned)((a) * 16 + (b)) : ab; ++ci;
        PEER_CANDS(X)
#undef X
        CANDT[F.tid] = (unsigned char)ab; }
    unsigned l1[16], l2[16];
#pragma unroll 1
    for (int half = 0; half < 2; ++half) {
        const bf16* SK = (const bf16*)(F.ws + (half ? WS_SK2 : WS_SK1));
        if (half) __syncthreads();
#pragma unroll
        for (int i = 0; i < 4; ++i) { const int pc = 4 * wave + i, c = pc >> 1, kbk = pc & 1;
            __builtin_amdgcn_global_load_lds((const unsigned*)(SK + (size_t)(64 * kbk + lane) * 128 + c * 8), (LAS unsigned*)(SKB + c * 2048 + kbk * 1024), 16, 0, 0); }
        bf16x8 qf[8];
#pragma unroll
        for (int d0 = 0; d0 < 8; ++d0) qf[d0] = *(const bf16x8*)(QP + row * 2048 + wave * 256 + half * 128 + d0 * 16 + hh * 8);
        __syncthreads();
        unsigned w[4][16];
#pragma unroll
        for (int kb = 0; kb < 4; ++kb) { f32x16 pacc = f32x16{};
#pragma unroll
            for (int d0 = 0; d0 < 8; ++d0) { const bf16x8 a = *(const LAS bf16x8*)(SKB + (2 * d0 + hh) * 2048 + (32 * kb + r32) * 16);
                pacc = __builtin_amdgcn_mfma_f32_32x32x16_bf16(a, qf[d0], pacc, 0, 0, 0); }
#pragma unroll
            for (int r = 0; r < 16; ++r) w[kb][r] = (ordkey(pacc[r]) & ~127u) | (unsigned)(127 - (32 * kb + (r & 3) + 8 * (r >> 2))); }
        top16_of64(w);
        unsigned la[16], lb[16];
#pragma unroll
        for (int i = 0; i < 16; ++i) { const unsigned x = w[0][i] ^ (unsigned)(4 * hh); auto rr = __builtin_amdgcn_permlane32_swap(x, x, false, false); la[i] = rr[0]; lb[i] = rr[1]; }
        merge_top16(la, lb);
        { LAS unsigned char* Lk = LK + ((size_t)half * TOK + r32) * LSTR + 8 * hh;
#pragma unroll
          for (int j = 0; j < 8; ++j) { const unsigned kx = hh ? la[8 + j] : la[j]; Lk[j] = (unsigned char)(127u - (kx & 127u)); } }
#pragma unroll
        for (int i = 0; i < 16; ++i) { if (half == 0) l1[i] = la[i]; else l2[i] = la[i]; }
    }
    asm volatile("s_waitcnt lgkmcnt(0)" ::: "memory");
    {
        const LAS unsigned char* L1k = LK + ((size_t)0 * TOK + r32) * LSTR; const LAS unsigned char* L2k = LK + ((size_t)1 * TOK + r32) * LSTR;
        float v1[16], v2[16];
#pragma unroll
        for (int a = 0; a < 16; ++a) { v1[a] = ordinv(l1[a] & ~127u); v2[a] = ordinv(l2[a] & ~127u); }
        unsigned w[4][16]; { int ci = 0;
#define X(a, b) w[ci >> 4][ci & 15] = (ordkey(v1[a] + v2[b]) & ~63u) | (unsigned)(63 - ci); ++ci;
        PEER_CANDS(X)
#undef X
#pragma unroll
          for (int i = 50; i < 64; ++i) w[i >> 4][i & 15] = 0u; }
        const float cmax = v1[0] + v2[0];
        top16_of64(w);
        float ge[8]; float gsum = 0.f; unsigned id[8];
#pragma unroll
        for (int j = 0; j < 8; ++j) { const unsigned kx = hh ? w[0][8 + j] : w[0][j]; id[j] = 63u - (kx & 63u); ge[j] = __expf(ordinv(kx & ~63u) - cmax); gsum += ge[j]; }
        { auto rr = __builtin_amdgcn_permlane32_swap(__float_as_uint(gsum), __float_as_uint(gsum), false, false); gsum = __uint_as_float(rr[0]) + __uint_as_float(rr[1]); }
        const float ginv = 1.0f / gsum;
        LAS Ent* R = (LAS Ent*)(F.lds + OFF_ROUTE) + ((size_t)wave * TOK + r32) * 16 + 8 * hh;
#pragma unroll
        for (int j = 0; j < 8; ++j) { const unsigned ab = CANDT[id[j]]; R[j].k = (unsigned)L1k[ab >> 4] * 128u + (unsigned)L2k[ab & 15u]; R[j].v = ge[j] * ginv; }
    }
}

constexpr int OFF_SORT = 77824;
constexpr int OFF_OFFS = 20480;
constexpr int NRANGE = 16, RSHIFT = 10;
__device__ __forceinline__ float ub0(unsigned w) { return (float)(w & 0xffu); }
__device__ __forceinline__ float ub1(unsigned w) { return (float)((w >> 8) & 0xffu); }
__device__ __forceinline__ float ub2(unsigned w) { return (float)((w >> 16) & 0xffu); }
__device__ __forceinline__ float ub3(unsigned w) { return (float)(w >> 24); }
__device__ __forceinline__ int mbcnt64(unsigned long long m) { return (int)__builtin_amdgcn_mbcnt_hi((unsigned)(m >> 32), __builtin_amdgcn_mbcnt_lo((unsigned)m, 0u)); }

constexpr int OFF_SDN = 0;
__device__ __forceinline__ void sort_token(Frame& F, int tl, int lane) {
    const LAS Ent* R = (const LAS Ent*)(F.lds + OFF_ROUTE); LAS Ent* SO = (LAS Ent*)(F.lds + OFF_SORT) + (size_t)tl * 128; LAS int* OF = (LAS int*)(F.lds + OFF_OFFS) + tl * 17;
    LAS float* SDN = (LAS float*)(F.lds + OFF_SDN) + tl * 128;
    const float* SD = (const float*)(F.ws + WS_EXPD_SC); const float* SU = (const float*)(F.ws + WS_EXPU_SC);
    const LAS Ent* p0 = R + ((size_t)(lane >> 4) * TOK + tl) * 16 + (lane & 15); const LAS Ent* p1 = R + ((size_t)(4 + (lane >> 4)) * TOK + tl) * 16 + (lane & 15);
    const unsigned e0 = p0->k, e1 = p1->k; const float g0 = p0->v * SU[e0], g1 = p1->v * SU[e1]; const float d0 = SD[e0], d1 = SD[e1];
    const int r0 = (int)(e0 >> RSHIFT), r1 = (int)(e1 >> RSHIFT);
    int base = 0, pos0 = 0, pos1 = 0;
#pragma unroll
    for (int r = 0; r < NRANGE; ++r) {
        const unsigned long long m0 = __ballot(r0 == r), m1 = __ballot(r1 == r);
        const int n0 = __popcll(m0), n1 = __popcll(m1);
        if (r0 == r) pos0 = base + mbcnt64(m0);
        if (r1 == r) pos1 = base + n0 + mbcnt64(m1);
        if (lane == 0) OF[r] = base;
        base += n0 + n1;
    }
    if (lane == 0) OF[NRANGE] = base;
    SO[pos0].k = e0; SO[pos0].v = g0; SO[pos1].k = e1; SO[pos1].v = g1; SDN[pos0] = d0; SDN[pos1] = d1;
}

struct Rows4 { v4u r[4]; };
__device__ __forceinline__ void fetch_rows(const unsigned char* tab, const LAS Ent* SO, Rows4& q, int lane) {
    unsigned ex[4];
#pragma unroll
    for (int k = 0; k < 4; ++k) ex[k] = (unsigned)__builtin_amdgcn_readfirstlane((int)SO[k].k);
#pragma unroll
    for (int k = 0; k < 4; ++k) q.r[k] = ((const v4u*)(tab + (size_t)ex[k] * 1024))[lane];
}
__device__ __forceinline__ void down_chunk(const Rows4& q, const int (&xq)[4], float sx, LAS Ent* SO, const LAS float* SDN, int lane) {
    int s[4];
#pragma unroll
    for (int k = 0; k < 4; ++k) { s[k] = 0;
#pragma unroll
        for (int c = 0; c < 4; ++c) s[k] = __builtin_amdgcn_sdot4((int)q.r[k][c], xq[c], s[k], false); }
#pragma unroll
    for (int k = 0; k < 4; ++k) s[k] += __builtin_amdgcn_update_dpp(0, s[k], 0xB1, 0xF, 0xF, true);
#pragma unroll
    for (int k = 0; k < 4; ++k) s[k] += __builtin_amdgcn_update_dpp(0, s[k], 0x4E, 0xF, 0xF, true);
#pragma unroll
    for (int k = 0; k < 4; ++k) s[k] += __builtin_amdgcn_update_dpp(0, s[k], 0x141, 0xF, 0xF, true);
#pragma unroll
    for (int k = 0; k < 4; ++k) s[k] += __builtin_amdgcn_update_dpp(0, s[k], 0x140, 0xF, 0xF, true);
    int dv = 0;
#pragma unroll
    for (int k = 0; k < 4; ++k) { const int dt = (__builtin_amdgcn_readlane(s[k], 0) + __builtin_amdgcn_readlane(s[k], 16)) + (__builtin_amdgcn_readlane(s[k], 32) + __builtin_amdgcn_readlane(s[k], 48)); dv = (lane == k) ? dt : dv; }
    if (lane < 4) { const float hk = SDN[lane] * sx * (float)dv; SO[lane].v = SO[lane].v * gelu_tanh(hk); }
}
__device__ __forceinline__ void up_chunk(const Rows4& q, unsigned wq4, int (&yi)[16]) {
#pragma unroll
    for (int c = 0; c < 4; ++c) {
        const unsigned r0 = q.r[0][c], r1 = q.r[1][c], r2 = q.r[2][c], r3 = q.r[3][c];
        const unsigned a_lo = __builtin_amdgcn_perm(r1, r0, 0x05010400u), a_hi = __builtin_amdgcn_perm(r1, r0, 0x07030602u);
        const unsigned b_lo = __builtin_amdgcn_perm(r3, r2, 0x05010400u), b_hi = __builtin_amdgcn_perm(r3, r2, 0x07030602u);
        yi[4 * c + 0] = __builtin_amdgcn_sdot4((int)__builtin_amdgcn_perm(b_lo, a_lo, 0x05040100u), (int)wq4, yi[4 * c + 0], false);
        yi[4 * c + 1] = __builtin_amdgcn_sdot4((int)__builtin_amdgcn_perm(b_lo, a_lo, 0x07060302u), (int)wq4, yi[4 * c + 1], false);
        yi[4 * c + 2] = __builtin_amdgcn_sdot4((int)__builtin_amdgcn_perm(b_hi, a_hi, 0x05040100u), (int)wq4, yi[4 * c + 2], false);
        yi[4 * c + 3] = __builtin_amdgcn_sdot4((int)__builtin_amdgcn_perm(b_hi, a_hi, 0x07060302u), (int)wq4, yi[4 * c + 3], false);
    }
}

__device__ __forceinline__ void gather_sweep(Frame& F, int tok0) {
    int lane; asm volatile("v_and_b32_e32 %0, 63, %1" : "=v"(lane) : "v"(F.tid));
    const int wave = F.wave;
#pragma unroll 1
    for (int i = 0; i < 4; ++i) sort_token(F, 4 * wave + i, lane);
    const unsigned char* EXPD = F.ws + WS_EXPD; const unsigned char* EXPU = F.ws + WS_EXPU;
    LAS Ent* SOW = (LAS Ent*)(F.lds + OFF_SORT) + (size_t)(4 * wave) * 128; const LAS float* SDW = (const LAS float*)(F.lds + OFF_SDN) + (4 * wave) * 128;
    {
        int xq[4][4]; float sxs[4];
#pragma unroll
        for (int tk = 0; tk < 4; ++tk) {
            const size_t row = (size_t)tok0 + 4 * wave + tk;
            const v4u* hp = (const v4u*)((const bf16*)(F.ws + WS_XN2) + row * DM) + 2 * lane; const f32x4* gp = (const f32x4*)F.in[I_N2G] + 4 * lane;
            float xh[16]; float ss = 0.f;
#pragma unroll
            for (int c = 0; c < 2; ++c) { const v4u w = hp[c]; xh[8 * c] = bf_lo(w.x); xh[8 * c + 1] = bf_hi(w.x); xh[8 * c + 2] = bf_lo(w.y); xh[8 * c + 3] = bf_hi(w.y); xh[8 * c + 4] = bf_lo(w.z); xh[8 * c + 5] = bf_hi(w.z); xh[8 * c + 6] = bf_lo(w.w); xh[8 * c + 7] = bf_hi(w.w); }
#pragma unroll
            for (int e = 0; e < 16; ++e) ss += xh[e] * xh[e];
            const float r = __builtin_amdgcn_rsqf(wave_sum(ss) * (1.f / DM) + EPS);
            float mx = 0.f;
#pragma unroll
            for (int c = 0; c < 4; ++c) { const f32x4 g = gp[c]; xh[4 * c] *= r * g.x; xh[4 * c + 1] *= r * g.y; xh[4 * c + 2] *= r * g.z; xh[4 * c + 3] *= r * g.w;
                mx = fmaxf(mx, fmaxf(fmaxf(fabsf(xh[4 * c]), fabsf(xh[4 * c + 1])), fmaxf(fabsf(xh[4 * c + 2]), fabsf(xh[4 * c + 3])))); }
#pragma unroll
            for (int o = 1; o < 64; o <<= 1) mx = fmaxf(mx, __shfl_xor(mx, o));
            mx = __uint_as_float((unsigned)__builtin_amdgcn_readfirstlane((int)__float_as_uint(mx)));
            const float step = mx > 0.f ? mx * (1.0f / 127.0f) : 1.0f, inv = 1.0f / step;
            sxs[tk] = step;
#pragma unroll
            for (int c = 0; c < 4; ++c) { const unsigned b0 = (unsigned)(int)rintf(xh[4 * c] * inv) & 0xffu, b1 = (unsigned)(int)rintf(xh[4 * c + 1] * inv) & 0xffu, b2 = (unsigned)(int)rintf(xh[4 * c + 2] * inv) & 0xffu, b3 = (unsigned)(int)rintf(xh[4 * c + 3] * inv) & 0xffu;
                xq[tk][c] = (int)(b0 | (b1 << 8) | (b2 << 16) | (b3 << 24)); }
        }
        asm volatile("s_waitcnt lgkmcnt(0)" ::: "memory");
        Rows4 b0, b1, b2, b3, b4, b5, b6, b7;
#define P1_FETCH(buf, u, j) fetch_rows(EXPD, SOW + ((u) & 3) * 128 + 4 * (2 * (j) + ((u) >> 2)), buf, lane)
#define P1_STEP(buf, u) do { down_chunk(buf, xq[(u) & 3], sxs[(u) & 3], SOW + ((u) & 3) * 128 + 4 * (2 * j + ((u) >> 2)), SDW + ((u) & 3) * 128 + 4 * (2 * j + ((u) >> 2)), lane); \
        if (j < 15) P1_FETCH(buf, u, j + 1); } while (0)
        P1_FETCH(b0, 0, 0); P1_FETCH(b1, 1, 0); P1_FETCH(b2, 2, 0); P1_FETCH(b3, 3, 0); P1_FETCH(b4, 4, 0); P1_FETCH(b5, 5, 0); P1_FETCH(b6, 6, 0); P1_FETCH(b7, 7, 0);
#pragma unroll 1
        for (int j = 0; j < 16; ++j) { P1_STEP(b0, 0); P1_STEP(b1, 1); P1_STEP(b2, 2); P1_STEP(b3, 3); P1_STEP(b4, 4); P1_STEP(b5, 5); P1_STEP(b6, 6); P1_STEP(b7, 7); }
#undef P1_FETCH
#undef P1_STEP
    }
    asm volatile("s_waitcnt lgkmcnt(0)" ::: "memory");
    constexpr int OFF_W8 = 16384;
    float wsc[4];
#pragma unroll
    for (int tk = 0; tk < 4; ++tk) {
        const float w0 = SOW[tk * 128 + lane].v, w1 = SOW[tk * 128 + 64 + lane].v;
        float mx = fmaxf(fabsf(w0), fabsf(w1));
#pragma unroll
        for (int o = 1; o < 64; o <<= 1) mx = fmaxf(mx, __shfl_xor(mx, o));
        mx = __uint_as_float((unsigned)__builtin_amdgcn_readfirstlane((int)__float_as_uint(mx)));
        const float step = mx > 0.f ? mx * (1.0f / 127.0f) : 1.0f, inv = 1.0f / step; wsc[tk] = step;
        LAS unsigned char* W8 = F.lds + OFF_W8 + (4 * wave + tk) * 128;
        W8[lane] = (unsigned char)((int)rintf(w0 * inv) & 0xff); W8[64 + lane] = (unsigned char)((int)rintf(w1 * inv) & 0xff);
    }
    asm volatile("s_waitcnt lgkmcnt(0)" ::: "memory");
    { TMS_BEGIN(14);
        int yi[4][16];
#pragma unroll
        for (int tk = 0; tk < 4; ++tk)
#pragma unroll
            for (int e = 0; e < 16; ++e) yi[tk][e] = 0;
        const LAS unsigned* W8W = (const LAS unsigned*)(F.lds + OFF_W8 + (4 * wave) * 128);
        Rows4 b0, b1, b2, b3;
#define P2_FETCH(buf, u, c) fetch_rows(EXPU, SOW + (u) * 128 + 4 * (c), buf, lane)
#define P2_STEP(buf, u) do { up_chunk(buf, (unsigned)__builtin_amdgcn_readfirstlane((int)W8W[(u) * 32 + c]), yi[u]); if (c < 31) P2_FETCH(buf, u, c + 1); } while (0)
        P2_FETCH(b0, 0, 0); P2_FETCH(b1, 1, 0); P2_FETCH(b2, 2, 0); P2_FETCH(b3, 3, 0);
#pragma unroll 1
        for (int c = 0; c < 32; ++c) { P2_STEP(b0, 0); P2_STEP(b1, 1); P2_STEP(b2, 2); P2_STEP(b3, 3); }
#undef P2_FETCH
#undef P2_STEP
#pragma unroll
        for (int tk = 0; tk < 4; ++tk) {
            const size_t row = (size_t)tok0 + 4 * wave + tk;
            const v4u* hb = (const v4u*)((const bf16*)(F.ws + WS_XN2) + row * DM) + 2 * lane; f32x4* hp = (f32x4*)(F.out + row * DM) + 4 * lane; const f32x4* gp = (const f32x4*)F.in[I_NFG] + 4 * lane;
            float hv[16]; float ss = 0.f; const float ws = wsc[tk];
#pragma unroll
            for (int c = 0; c < 2; ++c) { const v4u w = hb[c]; hv[8 * c] = bf_lo(w.x); hv[8 * c + 1] = bf_hi(w.x); hv[8 * c + 2] = bf_lo(w.y); hv[8 * c + 3] = bf_hi(w.y); hv[8 * c + 4] = bf_lo(w.z); hv[8 * c + 5] = bf_hi(w.z); hv[8 * c + 6] = bf_lo(w.w); hv[8 * c + 7] = bf_hi(w.w); }
#pragma unroll
            for (int e = 0; e < 16; ++e) { hv[e] += ws * (float)yi[tk][e]; ss += hv[e] * hv[e]; }
            const float r = __builtin_amdgcn_rsqf(wave_sum(ss) * (1.f / DM) + EPS);
#pragma unroll
            for (int c = 0; c < 4; ++c) { const f32x4 g = gp[c]; hp[c] = (f32x4){hv[4 * c] * r * g.x, hv[4 * c + 1] * r * g.y, hv[4 * c + 2] * r * g.z, hv[4 * c + 3] * r * g.w}; }
        }
    TMS_END(14); }
}

__device__ __forceinline__ void peer_phase(Frame& F, bool never) {
    (void)never;
    for (int task = F.bid; task < MTOK / TOK; task += F.G) {
        const int tok0 = task * TOK;
        { TMS_BEGIN(10); route_task(F, tok0);
        __syncthreads(); TMS_END(10); }
        { TMS_BEGIN(11); gather_sweep(F, tok0);
        __syncthreads(); TMS_END(11); }
    }
}
}
#define XB_TMO      128
#define XB_XCNT(j)  (256  + 64 * (j))
#define XB_XSUB(j)  (1280 + 64 * (j))
#define XB_XGEN(j)  (2304 + 64 * (j))
#define XB_TOP      3328
#define XB_TOPGEN   3392
#define XCD_BAR_WORDS 3456
#define XB_SPIN_CAP (1u << 18)

__device__ __forceinline__ unsigned xb_ld(unsigned* p)              { return __hip_atomic_load(p, __ATOMIC_RELAXED, __HIP_MEMORY_SCOPE_AGENT); }
__device__ __forceinline__ unsigned xb_add(unsigned* p, unsigned v) { return __hip_atomic_fetch_add(p, v, __ATOMIC_RELAXED, __HIP_MEMORY_SCOPE_AGENT); }
__device__ __forceinline__ unsigned xb_xcc_id() { return (unsigned)__builtin_amdgcn_s_getreg((3 << 11) | 20) & 0xFu; }
#define XB_SPIN(cond, bar) do { unsigned _sp = 0; while (cond) { __builtin_amdgcn_s_sleep(1); \
    if ((++_sp & 255u) == 0u) { if (xb_ld(&(bar)[XB_TMO])) break; if (_sp > XB_SPIN_CAP) { atomicAdd(&(bar)[XB_TMO], 1u); break; } } } } while (0)

struct XcdBarrier {
    unsigned* bar; unsigned x;
    volatile LAS unsigned* st;
};

__device__ __forceinline__ XcdBarrier xcd_barrier_post(unsigned* bar, volatile LAS unsigned* st) {
    XcdBarrier b; b.bar = bar; b.x = xb_xcc_id(); b.st = st;
    if (threadIdx.x == 0) (void)xb_add(&bar[XB_XCNT(b.x)], 1u);
    return b;
}
__device__ __forceinline__ void xcd_barrier_complete(unsigned* bar, unsigned x, unsigned& nloc, unsigned& nx) {
    const unsigned G = gridDim.x * gridDim.y * gridDim.z;
    unsigned sum, cnt, mine, sp = 0u;
    for (;;) {
        sum = 0u; cnt = 0u; mine = 0u;
#pragma unroll
        for (unsigned j = 0; j < 16; ++j) { const unsigned c = xb_ld(&bar[XB_XCNT(j)]); sum += c; cnt += (c > 0u) ? 1u : 0u; mine = (j == x) ? c : mine; }
        if (sum == G) break;
        __builtin_amdgcn_s_sleep(1);
        if ((++sp & 255u) == 0u) { if (xb_ld(&bar[XB_TMO])) break; if (sp > XB_SPIN_CAP) { atomicAdd(&bar[XB_TMO], 1u); break; } }
    }
    nloc = mine > 0u ? mine : 1u; nx = cnt > 0u ? cnt : 1u;
}

__device__ __forceinline__ void xcd_barrier(const XcdBarrier& b) {
    asm volatile("s_waitcnt vmcnt(0)" ::: "memory");
    __syncthreads();
    if (threadIdx.x == 0) {
        unsigned* bar = b.bar;
        __builtin_amdgcn_s_waitcnt(0);
        unsigned nloc = b.st[0], nx = b.st[1];
        if (nloc == 0u) { xcd_barrier_complete(bar, b.x, nloc, nx); b.st[0] = nloc; b.st[1] = nx; }
        const unsigned old = xb_add(&bar[XB_XSUB(b.x)], 1u);
        const unsigned gen = old / nloc;
        if (old + 1u == (gen + 1u) * nloc) {
            __builtin_amdgcn_fence(__ATOMIC_RELEASE, "agent");
            asm volatile("s_waitcnt vmcnt(0)" ::: "memory");
            const unsigned og = xb_add(&bar[XB_TOP], 1u);
            const unsigned tg = og / nx;
            if (og + 1u == (tg + 1u) * nx) xb_add(&bar[XB_TOPGEN], 1u);
            else XB_SPIN(xb_ld(&bar[XB_TOPGEN]) == tg, bar);
            __builtin_amdgcn_fence(__ATOMIC_ACQUIRE, "agent");
            xb_add(&bar[XB_XGEN(b.x)], 1u);
            asm volatile("s_waitcnt vmcnt(0)" ::: "memory");
        } else {
            XB_SPIN(xb_ld(&bar[XB_XGEN(b.x)]) == gen, bar);
            __builtin_amdgcn_fence(__ATOMIC_ACQUIRE, "agent");
            asm volatile("s_waitcnt vmcnt(0)" ::: "memory");
        }
    }
    __syncthreads();
}

#ifndef MK_ONE_LAUNCH
#define MK_ONE_LAUNCH 1
#endif
#ifndef DBL_MASK
#define DBL_MASK 0
#endif
constexpr int N_PHASES = 9;
struct Args { const void* in[N_IN]; float* out; unsigned char* ws; int ph_lo, ph_hi; };
#define PHASE_FN __device__ __forceinline__ void
#define PHASE_FRAME \
    Frame F; F.lds = (LAS unsigned char*)(uintptr_t)(unsigned)__builtin_amdgcn_readfirstlane((int)ldsaddr); F.tid = threadIdx.x; F.lane = F.tid & 63; F.wave = __builtin_amdgcn_readfirstlane(F.tid >> 6); \
    F.G = gridDim.x; F.bid = blockIdx.x; F.in = (const float* const*)ap->in; F.pos = (const int*)ap->in[I_POS]; F.out = ap->out; F.ws = ap->ws; unsigned char* ws = F.ws; (void)ws;
#define REP(k) for (int rep_ = 0; rep_ < (((DBL_MASK >> (k)) & 1) ? 2 : 1); ++rep_)

PHASE_FN ph_prologue(const Args* ap, unsigned ldsaddr) { PHASE_FRAME REP(0) p0_prologue(F); }
PHASE_FN ph_inproj(const Args* ap, unsigned ldsaddr) { PHASE_FRAME REP(1) {
    pg8::StaticOrder S;
    pg8::Gemm g = pg8::make_gemm((const bf16*)(ws + WS_XN), 1024, (const bf16*)(ws + WS_WIN), 1024, MTOK, NPROJ, 1024);
    S.init(MTOK, NPROJ, F.G, F.bid);
    EpiInProj E{(bf16*)(ws + WS_QKV), (bf16*)(ws + WS_CQ), (bf16*)(ws + WS_MISC), (bf16*)(ws + WS_GATES), (float*)(ws + WS_SSQ), (float*)(ws + WS_SSKV)};
    pg8::gemm_phase<EpiInProj, pg8::StaticOrder, true>(F.lds, g, S, E); } }
PHASE_FN ph_upq(const Args* ap, unsigned ldsaddr) { PHASE_FRAME REP(2) {
    pg8::StaticOrder S;
    pg8::Gemm g = pg8::make_gemm((const bf16*)(ws + WS_CQ), 256, (const bf16*)(ws + WS_WUQ), 256, MTOK, 768, 256);
    S.init(MTOK, 768, F.G, F.bid);
    EpiRowScale<256> E{(const float*)(ws + WS_SSQ), (bf16*)(ws + WS_MLAQ), 768, QSCALE_MLA};
    pg8::gemm_phase<EpiRowScale<256>, pg8::StaticOrder, true>(F.lds, g, S, E); } }
PHASE_FN ph_upkv(const Args* ap, unsigned ldsaddr) { PHASE_FRAME REP(2) {
    pg8::StaticOrder S;
    pg8::Gemm g = pg8::make_gemm((const bf16*)(ws + WS_MISC), 256, (const bf16*)(ws + WS_WUKV), 256, MTOK, 1024, 256);
    S.init(MTOK, 1024, F.G, F.bid);
    EpiRowScale<128> E{(const float*)(ws + WS_SSKV), (bf16*)(ws + WS_MLAKV), 1024, 1.0f};
    pg8::gemm_phase<EpiRowScale<128>, pg8::StaticOrder, true>(F.lds, g, S, E); } }
PHASE_FN ph_cmpu(const Args* ap, unsigned ldsaddr) { PHASE_FRAME REP(2) {
    pg8::StaticOrder S;
#pragma unroll 1
    for (int ks = 0; ks < 8; ++ks) { const int kv = ks >> 2, s = ks & 3;
        pg8::Gemm g; g.A = (const bf16*)(ws + WS_QKV) + 512 + 128 * kv + (size_t)s * 4 * 1280; g.Bt = (const bf16*)(ws + (kv ? WS_WC1V : WS_WC1K)) + s * 256; g.M = 2048; g.N = 256; g.K = 256;
        g.aRow = (size_t)16 * 1280 * 2; g.aHalf = 128; g.aTile = (size_t)SEQ * 1280 * 2; g.aK = (size_t)1280 * 2; g.bRow = 1024 * 2;
        S.init(2048, 256, F.G, (F.bid + F.G - (192 + 8 * ks) % F.G) % F.G);
        EpiF32 E{(float*)(ws + WS_USLAB) + (size_t)ks * 2048 * 256, 256, nullptr};
        pg8::gemm_phase<EpiF32, pg8::StaticOrder, true>(F.lds, g, S, E);
    }
    kpe_pass(F); } }
PHASE_FN ph_cmpfin(const Args* ap, unsigned ldsaddr) { PHASE_FRAME REP(3) cmp_finalize(F); }
PHASE_FN ph_nsa(const Args* ap, unsigned ldsaddr) { PHASE_FRAME REP(10) { TMS_BEGIN(30); att::nsa_loop(F); TMS_END(30); } }
PHASE_FN ph_mla(const Args* ap, unsigned ldsaddr) { PHASE_FRAME REP(11) { TMS_BEGIN(31); att::mla_loop(F); TMS_END(31); } }
PHASE_FN ph_branch(const Args* ap, unsigned ldsaddr) { PHASE_FRAME REP(5) {
    pg8::ChainOrder S; S.init(MTOK, 1024, F.G, F.bid);
    pg8::Gemm g = pg8::make_gemm((const bf16*)(ws + WS_OCAT), 1024, (const bf16*)(ws + WS_WBR), 1024, MTOK, 1024, 512); g.aSeg = 1024; g.bSeg = 1024;
    EpiGateChain E{(const bf16*)(ws + WS_GATES), (bf16*)(ws + WS_MERGED)};
    pg8::gemm_phase<EpiGateChain, pg8::ChainOrder, true, true>(F.lds, g, S, E);
    quant_table<true>(F, F.in[I_EDN], ws + WS_EXPD, (float*)(ws + WS_EXPD_SC)); } }
PHASE_FN ph_outproj(const Args* ap, unsigned ldsaddr) { PHASE_FRAME REP(6) {
    pg8::StaticOrder S; S.init(MTOK, 1024, F.G, F.bid);
    pg8::Gemm g = pg8::make_gemm((const bf16*)(ws + WS_MERGED), 1024, (const bf16*)(ws + WS_WOUT), 1024, MTOK, 1024, 1024);
    EpiResid E{F.in[I_X], (bf16*)(ws + WS_XN2), (float*)(ws + WS_SS)};
    pg8::gemm_phase<EpiResid, pg8::StaticOrder, true>(F.lds, g, S, E);
    quant_table<true>(F, F.in[I_EUP], ws + WS_EXPU, (float*)(ws + WS_EXPU_SC)); } }
PHASE_FN ph_peerq(const Args* ap, unsigned ldsaddr) { PHASE_FRAME REP(8) {
    pg8::StaticOrder S; S.init(MTOK, 2048, F.G, F.bid);
    pg8::Gemm g = pg8::make_gemm((const bf16*)(ws + WS_XN2), 1024, (const bf16*)(ws + WS_WPQ), 1024, MTOK, 2048, 1024);
    EpiRowSS E{(const float*)(ws + WS_SS), (bf16*)(ws + WS_QP), 2048};
    pg8::gemm_phase<EpiRowSS, pg8::StaticOrder, true>(F.lds, g, S, E); } }
PHASE_FN ph_peer(const Args* ap, unsigned ldsaddr) { PHASE_FRAME peer::peer_phase(F, ap->ph_lo < 0); }

__global__ void __launch_bounds__(NTHREADS, 2) fwd(Args a) {
    extern __shared__ __attribute__((aligned(16))) unsigned char lds_raw[];
    const unsigned ldsaddr = (unsigned)(uintptr_t)(LAS unsigned char*)lds_raw;
    const int lo = a.ph_lo, hi = a.ph_hi;
#define IN(k) (lo <= (k) && (k) < hi)
    { LAS unsigned* misc = (LAS unsigned*)((LAS unsigned char*)lds_raw + RING_BYTES); if (threadIdx.x < 256) misc[threadIdx.x] = 0u; }
    __syncthreads();
    XcdBarrier bar = xcd_barrier_post((unsigned*)(a.ws + WS_CTL) + 4096, (volatile LAS unsigned*)((LAS unsigned char*)lds_raw + RING_BYTES) + 8);
#define SEAM(k) do { if (IN(k) && IN((k) + 1)) { if (MK_ONE_LAUNCH) xcd_barrier(bar); } } while (0)
#ifdef TIMER_PHASE
    unsigned long long tm_t0 = 0, tm_acc = 0;
#define TM_BEGIN(k) do { if ((k) == TIMER_PHASE) tm_t0 = __builtin_amdgcn_s_memrealtime(); } while (0)
#define TM_END(k) do { if ((k) == TIMER_PHASE) tm_acc += __builtin_amdgcn_s_memrealtime() - tm_t0; } while (0)
#else
#define TM_BEGIN(k) do {} while (0)
#define TM_END(k) do {} while (0)
#endif
    TM_BEGIN(0);
    if (IN(0)) ph_prologue(&a, ldsaddr);
    if (IN(0) && IN(1)) { if (MK_ONE_LAUNCH) xcd_barrier(bar); }
    TM_END(0); TM_BEGIN(1);
    if (IN(1)) ph_inproj(&a, ldsaddr);
    SEAM(1);
    TM_END(1); TM_BEGIN(2);
    if (IN(2)) { ph_upq(&a, ldsaddr); ph_upkv(&a, ldsaddr); ph_cmpu(&a, ldsaddr); }
    SEAM(2);
    TM_END(2); TM_BEGIN(3);
    if (IN(3)) ph_cmpfin(&a, ldsaddr);
    SEAM(3);
    TM_END(3); TM_BEGIN(4);
#ifdef TIMER_PHASE
    const unsigned long long clk0_ = (TIMER_PHASE == 9) ? __builtin_amdgcn_s_memtime() : 0ull;
#endif
    if (IN(4)) { ph_nsa(&a, ldsaddr); ph_mla(&a, ldsaddr); }
#ifdef TIMER_PHASE
    if (TIMER_PHASE == 9) tm_acc = (__builtin_amdgcn_s_memtime() - clk0_) / 100ull;
#endif
    SEAM(4);
    TM_END(4); TM_BEGIN(5);
    if (IN(5)) ph_branch(&a, ldsaddr);
    SEAM(5);
    TM_END(5); TM_BEGIN(6);
    if (IN(6)) ph_outproj(&a, ldsaddr);
    SEAM(6);
    TM_END(6); TM_BEGIN(7);
    if (IN(7)) ph_peerq(&a, ldsaddr);
    SEAM(7);
    TM_END(7); TM_BEGIN(8);
    if (IN(8)) ph_peer(&a, ldsaddr);
    TM_END(8);
#ifdef TIMER_PHASE
    if (TIMER_PHASE >= 10) tm_acc = *(LAS unsigned long long*)((LAS unsigned char*)lds_raw + RING_BYTES + 512);
    __syncthreads();
    if (blockIdx.x == 0 && threadIdx.x == 0) { asm volatile("s_waitcnt vmcnt(0)" ::: "memory"); a.out[0] += (float)tm_acc * 0.001f; }
#endif
#undef IN
#undef SEAM
}

extern "C" void kernel_launch(void* const* d_in, const int* in_sizes, int n_in, void* d_out, int out_size, void* d_ws, size_t ws_size, hipStream_t stream) {
    static int grid = 0;
    if (grid == 0) {
        if (n_in != N_IN || out_size != MTOK * DM || ws_size < WS_END) { fprintf(stderr, "kernel_launch: unexpected shapes (n_in %d, out %d, ws %zu)\n", n_in, out_size, ws_size); grid = -1; return; }
        int dev = 0, cus = 0, per_cu = 0;
        if (hipGetDevice(&dev) != hipSuccess || hipDeviceGetAttribute(&cus, hipDeviceAttributeMultiprocessorCount, dev) != hipSuccess) { grid = -1; return; }
        if (hipFuncSetAttribute((const void*)fwd, hipFuncAttributeMaxDynamicSharedMemorySize, LDS_BYTES) != hipSuccess) { fprintf(stderr, "kernel_launch: hipFuncSetAttribute failed\n"); grid = -1; return; }
        if (hipOccupancyMaxActiveBlocksPerMultiprocessor(&per_cu, (const void*)fwd, NTHREADS, LDS_BYTES) != hipSuccess || per_cu < 1) { fprintf(stderr, "kernel_launch: occupancy query says %d\n", per_cu); (void)hipGetLastError(); grid = -1; return; }
        grid = cus;
    }
    if (grid < 0) return;
    Args a{};
    for (int i = 0; i < N_IN; ++i) a.in[i] = d_in[i];
    a.out = (float*)d_out; a.ws = (unsigned char*)d_ws;
#if MK_ONE_LAUNCH
    if (hipMemsetAsync((char*)d_ws + WS_CTL, 0, 65536, stream) != hipSuccess) { fprintf(stderr, "kernel_launch: hipMemsetAsync failed\n"); return; }
    a.ph_lo = 0; a.ph_hi = N_PHASES;
    void* args[] = {&a};
    hipError_t e = hipLaunchCooperativeKernel((const void*)fwd, dim3(grid), dim3(NTHREADS), args, LDS_BYTES, stream);
    if (e != hipSuccess) fprintf(stderr, "kernel_launch: cooperative launch failed: %s (grid %d)\n", hipGetErrorString(e), grid);
#else
    for (int p = 0; p < N_PHASES; ++p) { a.ph_lo = p; a.ph_hi = p + 1; hipLaunchKernelGGL(fwd, dim3(grid), dim3(NTHREADS), LDS_BYTES, stream, a); }
#endif
}
```

```cpp
#define DBL_MASK 0
#include <hip/hip_runtime.h>
#include <cstdio>
#include <cstdint>
#include <cmath>
namespace pg8 {
#define PG8_LAS __attribute__((address_space(3)))
typedef unsigned short bf16_t;
typedef short bf16x8 __attribute__((ext_vector_type(8)));
typedef float f32x4 __attribute__((ext_vector_type(4)));
typedef unsigned u32x4 __attribute__((ext_vector_type(4)));
constexpr int BM = 256, BK = 64, HALF = 128, HTB = HALF * BK * 2  , STAGE_BYTES = 8 * HTB, NXCD = 8, WGM = 8;

__host__ __device__ __forceinline__ int lds_byte(int r, int c) { const int st = (r >> 4) * 2 + (c >> 5), rr = r & 15, cc = c & 31, ob = rr * 64 + cc * 2; return st * 1024 + (ob ^ (((ob >> 9) & 1) << 5)); }
__host__ __device__ __forceinline__ void stage_rc(int b, int& R, int& C) { const int st = b / 1024, sb = b % 1024, swz = sb ^ (((sb >> 9) & 1) << 5); R = (st >> 1) * 16 + swz / 64; C = (st & 1) * 32 + (swz % 64) / 2; }
__host__ __device__ __forceinline__ int perm32(int rho) { const int n = rho >> 4, i = rho & 15; return 8 * (i >> 2) + 4 * n + (i & 3); }

struct Unit { int pm, pn, seg; };
struct Gemm { const bf16_t* A; const bf16_t* Bt; int M, N, K; size_t aRow, aHalf, aTile, aK, bRow, aSeg, bSeg; };
__host__ __device__ __forceinline__ Gemm make_gemm(const bf16_t* A, int lda, const bf16_t* Bt, int ldb, int M, int N, int K) {
    Gemm g; g.A = A; g.Bt = Bt; g.M = M; g.N = N; g.K = K; g.aRow = (size_t)lda * 2; g.aHalf = (size_t)HALF * lda * 2; g.aTile = (size_t)BM * lda * 2; g.aK = BK * 2; g.bRow = (size_t)ldb * 2; g.aSeg = 0; g.bSeg = 0; return g; }

struct StaticOrder {
    int nM, nN, nwg, G, c;
    __host__ __device__ void init(int M, int N, int G_, int c_) { nM = M / BM; nN = N / BM; nwg = nM * nN; G = G_; c = c_; }
    __host__ __device__ bool next(int i, Unit& u) const {
        const long L = (long)i * G + c; if (L >= nwg) return false;
        int wgid = (int)L; { const int q = nwg / NXCD, r = nwg % NXCD, xcd = wgid % NXCD, off = wgid / NXCD; wgid = (xcd < r ? xcd * (q + 1) : r * (q + 1) + (xcd - r) * q) + off; }
        const int nig = WGM * nN, gid = wgid / nig, fm = gid * WGM, gsz = (nM - fm) < WGM ? (nM - fm) : WGM;
        u.pm = fm + ((wgid % nig) % gsz); u.pn = (wgid % nig) / gsz; u.seg = 0; return true;
    }
};
struct ChainOrder : StaticOrder {
    __host__ __device__ bool next(int i, Unit& u) const { if (!StaticOrder::next(i >> 1, u)) return false; u.seg = i & 1; return true; }
};

__device__ __forceinline__ unsigned cvt_pk_bf16(float lo, float hi) { unsigned r; asm volatile("v_cvt_pk_bf16_f32 %0, %1, %2" : "=v"(r) : "v"(lo), "v"(hi)); return r; }

template <class Epi, class Sched, bool ALIGN_EPI, bool CHAIN = false>
__device__ __forceinline__ void gemm_phase(PG8_LAS unsigned char* lds, const Gemm g, const Sched& S, const Epi& E) {
    const int tid = threadIdx.x, wid = __builtin_amdgcn_readfirstlane(tid >> 6), lane = tid & 63, wr = wid >> 2, wc = wid & 3, fr = lane & 15, fq = lane >> 4;
    const int K = g.K, nt = K / BK;
    unsigned voffA[2], voffB[2];
#pragma unroll
    for (int i = 0; i < 2; ++i) { int R, C; stage_rc(tid * 16 + i * 8192, R, C); const int Rb = Epi::PERM ? ((R & ~31) + perm32(R & 31)) : R;
        voffA[i] = (unsigned)((size_t)R * g.aRow + (size_t)C * 2); voffB[i] = (unsigned)((size_t)Rb * g.bRow + (size_t)C * 2); }
    const size_t kstepA = g.aK, kstepB = (size_t)(BK * 2);
    const size_t hstepA = g.aHalf, hstepB = (size_t)HALF * g.bRow;
    const size_t tstepA = g.aTile, tstepB = (size_t)BM * g.bRow;
    const unsigned ldsw = (unsigned)wid * 1024u;
    const int aoff = lds_byte(wr * 64 + fr, fq * 8), boff = lds_byte(wc * 32 + fr, fq * 8);
#define PG8_SA(b, h) (((b) * 2 + (h)) * HTB)
#define PG8_SB(b, h) ((4 + (b) * 2 + (h)) * HTB)
#define PG8_STAGE(bufoff, gbase, voff) do { _Pragma("unroll") for (int _i = 0; _i < 2; ++_i) \
        __builtin_amdgcn_global_load_lds((const unsigned*)((const char*)(gbase) + (voff)[_i]), (PG8_LAS unsigned*)(lds + (bufoff) + ldsw + _i * 8192), 16, 0, 0); } while (0)
#define PG8_LDA(dst, b, h) do { _Pragma("unroll") for (int m = 0; m < 4; ++m) _Pragma("unroll") for (int k = 0; k < 2; ++k) dst[m][k] = *(const PG8_LAS bf16x8*)(lds + PG8_SA(b, h) + aoff + m * 2048 + k * 1024); } while (0)
#define PG8_LDB(dst, b, h) do { _Pragma("unroll") for (int n = 0; n < 2; ++n) _Pragma("unroll") for (int k = 0; k < 2; ++k) dst[n][k] = *(const PG8_LAS bf16x8*)(lds + PG8_SB(b, h) + boff + n * 2048 + k * 1024); } while (0)
#define PG8_MMA(ai, bj, At, Bt) do { __builtin_amdgcn_s_setprio(1); _Pragma("unroll") for (int m = 0; m < 4; ++m) _Pragma("unroll") for (int n = 0; n < 2; ++n) _Pragma("unroll") for (int k = 0; k < 2; ++k) \
        acc[ai][bj][m][n] = __builtin_amdgcn_mfma_f32_16x16x32_bf16(Bt[n][k], At[m][k], acc[ai][bj][m][n], 0, 0, 0); __builtin_amdgcn_s_setprio(0); } while (0)
#define PG8_WAIT_V(n) asm volatile("s_waitcnt vmcnt(" #n ")" ::: "memory")
#define PG8_WAIT_L(n) asm volatile("s_waitcnt lgkmcnt(" #n ")" ::: "memory")
#define PG8_BAR __builtin_amdgcn_s_barrier()
#define PG8_SCHED __builtin_amdgcn_sched_barrier(0)
    Unit cur, nxt; int ui = 0;
    if (!S.next(0, cur)) return;
    f32x4 acc[2][2][4][2];
#pragma unroll
    for (int a = 0; a < 2; ++a)
#pragma unroll
        for (int b = 0; b < 2; ++b)
#pragma unroll
            for (int m = 0; m < 4; ++m)
#pragma unroll
                for (int n = 0; n < 2; ++n) acc[a][b][m][n] = (f32x4){0.f, 0.f, 0.f, 0.f};
    bf16x8 At[4][2], B0[2][2], B1[2][2];
    const char* cA = (const char*)g.A + (size_t)cur.pm * tstepA + ((CHAIN && cur.seg) ? g.aSeg : 0); const char* cB = (const char*)g.Bt + (size_t)cur.pn * tstepB + ((CHAIN && cur.seg) ? g.bSeg : 0);
    PG8_STAGE(PG8_SB(0, 0), cB, voffB); PG8_STAGE(PG8_SB(0, 1), cB + hstepB, voffB); PG8_STAGE(PG8_SA(0, 0), cA, voffA); PG8_STAGE(PG8_SA(0, 1), cA + hstepA, voffA);
    if (wr == 1) PG8_BAR;
    PG8_WAIT_V(2); PG8_BAR;
    PG8_STAGE(PG8_SB(1, 0), cB + kstepB, voffB); PG8_STAGE(PG8_SA(1, 0), cA + kstepA, voffA); PG8_STAGE(PG8_SB(1, 1), cB + hstepB + kstepB, voffB);
    PG8_WAIT_V(6); PG8_BAR;
    for (;;) {
        const bool has_next = S.next(ui + 1, nxt);
        const char* nA = has_next ? (const char*)g.A + (size_t)nxt.pm * tstepA + ((CHAIN && nxt.seg) ? g.aSeg : 0) : cA; const char* nB = has_next ? (const char*)g.Bt + (size_t)nxt.pn * tstepB + ((CHAIN && nxt.seg) ? g.bSeg : 0) : cB;
        for (int t = 0; t < nt; t += 2) {
            const bool last = (t == nt - 2);
            const char* a1 = cA + (size_t)(t + 1) * kstepA;
            const char* a2 = last ? nA : cA + (size_t)(t + 2) * kstepA; const char* b2 = last ? nB : cB + (size_t)(t + 2) * kstepB;
            const char* a3 = a2 + kstepA; const char* b3 = b2 + kstepB;
            PG8_LDB(B0, 0, 0); PG8_LDB(B1, 0, 1); PG8_SCHED; PG8_LDA(At, 0, 0); PG8_STAGE(PG8_SA(1, 1), a1 + hstepA, voffA);
            PG8_WAIT_V(8); PG8_WAIT_L(0); PG8_BAR; PG8_MMA(0, 0, At, B0); PG8_MMA(0, 1, At, B1); PG8_BAR; PG8_SCHED;
            PG8_LDA(At, 0, 1); PG8_STAGE(PG8_SB(0, 0), b2, voffB); PG8_STAGE(PG8_SB(0, 1), b2 + hstepB, voffB); PG8_STAGE(PG8_SA(0, 0), a2, voffA);
            PG8_WAIT_V(8); PG8_WAIT_L(0); PG8_BAR; PG8_MMA(1, 0, At, B0); PG8_MMA(1, 1, At, B1); PG8_BAR; PG8_SCHED;
            PG8_LDB(B0, 1, 0); PG8_LDB(B1, 1, 1); PG8_SCHED; PG8_LDA(At, 1, 0); PG8_STAGE(PG8_SA(0, 1), a2 + hstepA, voffA);
            PG8_WAIT_V(8); PG8_WAIT_L(0); PG8_BAR; PG8_MMA(0, 0, At, B0); PG8_MMA(0, 1, At, B1); PG8_BAR; PG8_SCHED;
            PG8_LDA(At, 1, 1); PG8_STAGE(PG8_SB(1, 0), b3, voffB); PG8_STAGE(PG8_SB(1, 1), b3 + hstepB, voffB); PG8_STAGE(PG8_SA(1, 0), a3, voffA);
            PG8_WAIT_V(8); PG8_WAIT_L(0); PG8_BAR; PG8_MMA(1, 0, At, B0); PG8_MMA(1, 1, At, B1); PG8_BAR; PG8_SCHED;
        }
        if constexpr (ALIGN_EPI) { if (wr == 0) PG8_BAR; }
        bool keep = false;
        if constexpr (CHAIN) { if (cur.seg == 0) { E.mid(acc, cur, wr, wc, fr, fq); keep = true; } else E(acc, cur, wr, wc, fr, fq); }
        else E(acc, cur, wr, wc, fr, fq);
        if (!has_next) break;
        if (!keep) {
#pragma unroll
        for (int a = 0; a < 2; ++a)
#pragma unroll
            for (int b = 0; b < 2; ++b)
#pragma unroll
                for (int m = 0; m < 4; ++m)
#pragma unroll
                    for (int n = 0; n < 2; ++n) acc[a][b][m][n] = (f32x4){0.f, 0.f, 0.f, 0.f};
        }
        cur = nxt; cA = nA; cB = nB; ++ui;
        if constexpr (ALIGN_EPI) { if (wr == 1) PG8_BAR; }
    }
    PG8_WAIT_V(0);
    if constexpr (!ALIGN_EPI) { if (wr == 0) PG8_BAR; }
    PG8_BAR;
#undef PG8_SA
#undef PG8_SB
#undef PG8_STAGE
#undef PG8_LDA
#undef PG8_LDB
#undef PG8_MMA
#undef PG8_WAIT_V
#undef PG8_WAIT_L
#undef PG8_BAR
#undef PG8_SCHED
}
}
constexpr int NWAVES = 8, NTHREADS = 512;
constexpr int BATCH = 8, SEQ = 2048, DM = 1024, MTOK = BATCH * SEQ;
constexpr int NPROJ = 3840;
constexpr float EPS = 1e-6f, LOG2E = 1.4426950408889634f;
constexpr float QSCALE_NSA = 0.125f * LOG2E;
constexpr float QSCALE_MLA = 0.10206207261596575f * LOG2E;
constexpr size_t MiB = 1u << 20;
enum { I_X = 0, I_POS, I_N1G, I_WIN, I_CPK, I_CW1K, I_CW2K, I_CPV, I_CW1V, I_CW2V, I_QNG, I_KVNG, I_WUQ, I_WUKV, I_WBN, I_WBM, I_WOUT, I_N2G, I_WPQ, I_SK1, I_SK2, I_EDN, I_EUP, I_NFG, N_IN };
constexpr size_t WS_CTL = 0;
constexpr size_t WS_WIN = 1 * MiB;
constexpr size_t WS_WUQ = WS_WIN + (size_t)NPROJ * 1024 * 2;
constexpr size_t WS_WUKV = WS_WUQ + 768 * 256 * 2;
constexpr size_t WS_WBR = 10 * MiB;
constexpr size_t WS_WOUT = 12 * MiB;
constexpr size_t WS_WPQ = 14 * MiB;
constexpr size_t WS_WC1K = 18 * MiB;
constexpr size_t WS_WC1V = WS_WC1K + 256 * 1024 * 2;
constexpr size_t WS_SMALL = 19 * MiB;
constexpr size_t WS_C1K = WS_SMALL;
constexpr size_t WS_C1V = WS_SMALL + 512;
constexpr size_t WS_ORDER = WS_SMALL + 1024;
constexpr size_t WS_SK1 = WS_SMALL + 4096;
constexpr size_t WS_SK2 = WS_SK1 + 32768;
constexpr size_t WS_XN = 20 * MiB;
constexpr size_t WS_MLAQ = WS_XN, WS_EXPD = WS_XN;
constexpr size_t WS_EXPD_SC = WS_EXPD + (size_t)16384 * 1024;
constexpr size_t WS_QKV = 52 * MiB;
constexpr size_t WS_MERGED = WS_QKV;
constexpr size_t WS_CQ = 92 * MiB;
constexpr size_t WS_MISC = 100 * MiB;
constexpr size_t WS_ROUTE = 92 * MiB;
constexpr size_t WS_GATES = 108 * MiB;
constexpr size_t WS_QP = WS_GATES;
constexpr size_t WS_MLAKV = 172 * MiB;
constexpr size_t WS_XN2 = WS_MLAKV;
constexpr size_t WS_KPE = 204 * MiB;
constexpr size_t WS_KC = 205 * MiB;
constexpr size_t WS_VC = WS_KC + 16 * 128 * 64 * 2;
constexpr size_t WS_SSQ = 207 * MiB, WS_SSKV = 207 * MiB + 262144;
constexpr size_t WS_SS = 206 * MiB;
constexpr size_t WS_OCAT = 210 * MiB;
constexpr size_t WS_USLAB = WS_OCAT;
constexpr size_t WS_EXPU = WS_OCAT;
constexpr size_t WS_EXPU_SC = WS_EXPU + (size_t)16384 * 1024;
constexpr size_t WS_END = 242 * MiB;
constexpr int RING_BYTES = 131072;
constexpr int LDS_BYTES = 147456;

#define GAS __attribute__((address_space(1)))
#define LAS __attribute__((address_space(3)))
typedef unsigned short bf16;
typedef unsigned v4u __attribute__((ext_vector_type(4)));
typedef unsigned v2u __attribute__((ext_vector_type(2)));
typedef float f32x4 __attribute__((ext_vector_type(4)));
typedef float f32x16 __attribute__((ext_vector_type(16)));
typedef short bf16x8 __attribute__((ext_vector_type(8)));
typedef short s16x4 __attribute__((ext_vector_type(4)));

__device__ __forceinline__ unsigned f2bf(float f) { unsigned u = __builtin_bit_cast(unsigned, f); return (u + 0x7fffu + ((u >> 16) & 1u)) >> 16; }
__device__ __forceinline__ unsigned pk2(float lo, float hi) { return f2bf(lo) | (f2bf(hi) << 16); }
__device__ __forceinline__ float bf_lo(unsigned u) { return __builtin_bit_cast(float, u << 16); }
__device__ __forceinline__ float bf_hi(unsigned u) { return __builtin_bit_cast(float, u & 0xffff0000u); }
__device__ __forceinline__ float bf2f(bf16 h) { return __builtin_bit_cast(float, (unsigned)h << 16); }
__device__ __forceinline__ float sigmoidf_(float v) { return __builtin_amdgcn_rcpf(1.0f + __expf(-v)); }
__device__ __forceinline__ float gelu_tanh(float v) { const float u = 0.7978845608028654f * (v + 0.044715f * v * v * v); const float e = __expf(2.0f * u); const float th = 1.0f - 2.0f * __builtin_amdgcn_rcpf(e + 1.0f); return 0.5f * v * (1.0f + th); }
__device__ __forceinline__ float rope_inv(int i) { return exp2f(-(float)i * (13.287712379549449f / 16.0f)); }
__device__ __forceinline__ void rope_sincos(float ang, float& sn, float& cs) { float t = ang * 0.15915494309189535f; t -= floorf(t); sn = __builtin_amdgcn_sinf(t); cs = __builtin_amdgcn_cosf(t); }
__device__ __forceinline__ float wave_sum(float v) {
#pragma unroll
    for (int o = 1; o < 64; o <<= 1) v += __shfl_xor(v, o);
    return v;
}

#ifdef TIMER_PHASE
#define TMS_BEGIN(id) unsigned long long tms_t0_ = ((id) == TIMER_PHASE) ? __builtin_amdgcn_s_memrealtime() : 0ull
#define TMS_DECL unsigned long long tms_m0_ = 0ull
#define TMS_MARK(id) do { if ((id) == TIMER_PHASE) tms_m0_ = __builtin_amdgcn_s_memrealtime(); } while (0)
#define TMS_MARKEND(id) do { if ((id) == TIMER_PHASE && threadIdx.x == 448) { *(LAS unsigned long long*)(F.lds + RING_BYTES + 512) += __builtin_amdgcn_s_memrealtime() - tms_m0_; } } while (0)
#define TMS_COUNT(id) do { if ((id) == TIMER_PHASE && threadIdx.x == 448) { *(LAS unsigned long long*)(F.lds + RING_BYTES + 512) += 100ull; } } while (0)
#define TMS_END(id) do { if ((id) == TIMER_PHASE && threadIdx.x == (((id) >= 41 && (id) <= 49) ? 448 : 0)) { *(LAS unsigned long long*)(F.lds + RING_BYTES + 512) += __builtin_amdgcn_s_memrealtime() - tms_t0_; } } while (0)
#else
#define TMS_BEGIN(id) do {} while (0)
#define TMS_COUNT(id) do {} while (0)
#define TMS_DECL do {} while (0)
#define TMS_MARK(id) do {} while (0)
#define TMS_MARKEND(id) do {} while (0)
#define TMS_END(id) do {} while (0)
#endif
struct Frame {
    LAS unsigned char* lds;
    int tid, lane, wave, G, bid;
    const float* const* in; const int* pos; float* out; unsigned char* ws;
};

__device__ __forceinline__ int win_srccol(int n) {
    if (n < 1280) return n;
    if (n < 1536) return 1304 + (n - 1280);
    if (n < 1664) return 1560 + (n - 1536);
    if (n < 1696) return 1688 + (n - 1664);
    if (n < 1720) return 1280 + (n - 1696);
    if (n < 1792) return -1;
    return 1720 + (n - 1792);
}
template <bool WIN_PERM>
__device__ __forceinline__ void tr_item(const float* src, int ld_src, int ksrc0, const float* kscale, bf16* dst, int ld_dst, int drow0, int dcol0, int N, LAS float* scr, int item, int lane) {
    const int nblk = N / 32, kb = item / nblk, nb = item % nblk, k0 = 64 * kb, n0 = 32 * nb;
    const int nn = n0 + 4 * (lane & 7); const int sc = WIN_PERM ? win_srccol(nn) : nn;
    f32x4 v[8];
#pragma unroll
    for (int i = 0; i < 8; ++i) { const int kk = 8 * i + (lane >> 3); v[i] = (f32x4){0.f, 0.f, 0.f, 0.f}; if (sc >= 0) v[i] = *(const f32x4*)(src + (size_t)(ksrc0 + k0 + kk) * ld_src + sc); }
#pragma unroll
    for (int i = 0; i < 8; ++i) { const int kk = 8 * i + (lane >> 3); const float ks = kscale ? kscale[k0 + kk] : 1.0f; LAS float* d = scr + kk * 33 + 4 * (lane & 7);
        d[0] = v[i].x * ks; d[1] = v[i].y * ks; d[2] = v[i].z * ks; d[3] = v[i].w * ks; }
    asm volatile("s_waitcnt lgkmcnt(0)" ::: "memory");
    const int c = lane & 7;
#pragma unroll
    for (int j = 0; j < 4; ++j) { const int n = (lane >> 3) + 8 * j; const LAS float* s = scr + (8 * c) * 33 + n;
        v4u o; o.x = pk2(s[0 * 33], s[1 * 33]); o.y = pk2(s[2 * 33], s[3 * 33]); o.z = pk2(s[4 * 33], s[5 * 33]); o.w = pk2(s[6 * 33], s[7 * 33]);
        *(v4u*)(dst + (size_t)(drow0 + n0 + n) * ld_dst + dcol0 + k0 + 8 * c) = o; }
    asm volatile("s_waitcnt lgkmcnt(0)" ::: "memory");
}
__device__ __forceinline__ void rms_row_to_bf16(const float* xrow, const float* gain, bf16* orow, int lane) {
    const f32x4* xr = (const f32x4*)xrow + lane; const f32x4* gr = (const f32x4*)gain + lane;
    f32x4 v[4]; float s = 0.f;
#pragma unroll
    for (int j = 0; j < 4; ++j) { v[j] = xr[64 * j]; s += (v[j].x * v[j].x + v[j].y * v[j].y) + (v[j].z * v[j].z + v[j].w * v[j].w); }
    const float r = 1.0f / sqrtf(wave_sum(s) * (1.f / DM) + EPS);
    unsigned long long* o8 = (unsigned long long*)orow + lane;
#pragma unroll
    for (int j = 0; j < 4; ++j) { const f32x4 g = gr[64 * j]; o8[64 * j] = (unsigned long long)pk2(v[j].x * r * g.x, v[j].y * r * g.y) | ((unsigned long long)pk2(v[j].z * r * g.z, v[j].w * r * g.w) << 32); }
}
__device__ __forceinline__ void p0_prologue(Frame& F) {
    LAS float* scr = (LAS float*)(F.lds + F.wave * 16384);
    const int gw = F.bid * NWAVES + F.wave, NGW = F.G * NWAVES, lane = F.lane;
    bf16* const Win_t = (bf16*)(F.ws + WS_WIN); bf16* const Wuq_t = (bf16*)(F.ws + WS_WUQ); bf16* const Wukv_t = (bf16*)(F.ws + WS_WUKV);
    bf16* const Wbr_t = (bf16*)(F.ws + WS_WBR); bf16* const Wout_t = (bf16*)(F.ws + WS_WOUT); bf16* const Wpq_t = (bf16*)(F.ws + WS_WPQ);
    bf16* const Wc1k_t = (bf16*)(F.ws + WS_WC1K); bf16* const Wc1v_t = (bf16*)(F.ws + WS_WC1V);
    constexpr int I_IN = 16 * (NPROJ / 32), I_UQ = 4 * 24, I_UKV = 2 * 32, I_BR = 8 * 32, I_OUT = 16 * 32, I_PQ = 16 * 64, I_C1 = 16 * 4;
    constexpr int NITEMS = I_IN + I_UQ + I_UKV + 2 * I_BR + I_OUT + I_PQ + 4 * I_C1;
    for (int it = gw; it < NITEMS; it += NGW) {
        int r = it;
        if (r < I_IN) { tr_item<true>(F.in[I_WIN], 3768, 0, nullptr, Win_t, 1024, 0, 0, NPROJ, scr, r, lane); continue; } r -= I_IN;
        if (r < I_UQ) { tr_item<false>(F.in[I_WUQ], 768, 0, F.in[I_QNG], Wuq_t, 256, 0, 0, 768, scr, r, lane); continue; } r -= I_UQ;
        if (r < I_UKV) { tr_item<false>(F.in[I_WUKV], 1024, 0, F.in[I_KVNG], Wukv_t, 256, 0, 0, 1024, scr, r, lane); continue; } r -= I_UKV;
        if (r < I_BR) { tr_item<false>(F.in[I_WBN], 1024, 0, nullptr, Wbr_t, 1024, 0, 0, 1024, scr, r, lane); continue; } r -= I_BR;
        if (r < I_BR) { tr_item<false>(F.in[I_WBM], 1024, 0, nullptr, Wbr_t, 1024, 0, 512, 1024, scr, r, lane); continue; } r -= I_BR;
        if (r < I_OUT) { tr_item<false>(F.in[I_WOUT], 1024, 0, nullptr, Wout_t, 1024, 0, 0, 1024, scr, r, lane); continue; } r -= I_OUT;
        if (r < I_PQ) { tr_item<false>(F.in[I_WPQ], 2048, 0, F.in[I_N2G], Wpq_t, 1024, 0, 0, 2048, scr, r, lane); continue; } r -= I_PQ;
        if (r < I_C1) { tr_item<false>(F.in[I_CW1K], 128, 0, nullptr, Wc1k_t, 1024, 0, 0, 128, scr, r, lane); continue; } r -= I_C1;
        if (r < I_C1) { tr_item<false>(F.in[I_CW1K], 128, 1024, nullptr, Wc1k_t, 1024, 128, 0, 128, scr, r, lane); continue; } r -= I_C1;
        if (r < I_C1) { tr_item<false>(F.in[I_CW1V], 128, 0, nullptr, Wc1v_t, 1024, 0, 0, 128, scr, r, lane); continue; } r -= I_C1;
        tr_item<false>(F.in[I_CW1V], 128, 1024, nullptr, Wc1v_t, 1024, 128, 0, 128, scr, r, lane);
    }
    { bf16* XN = (bf16*)(F.ws + WS_XN); const float* X = F.in[I_X]; const f32x4* gr = (const f32x4*)F.in[I_N1G] + lane;
      for (int m = gw; m < MTOK; m += 2 * NGW) {
          const int m2 = (m + NGW < MTOK) ? m + NGW : m;
          const f32x4* xa = (const f32x4*)(X + (size_t)m * DM) + lane; const f32x4* xb = (const f32x4*)(X + (size_t)m2 * DM) + lane;
          f32x4 va[4], vb[4]; float sa = 0.f, sb = 0.f;
#pragma unroll
          for (int j = 0; j < 4; ++j) { va[j] = xa[64 * j]; vb[j] = xb[64 * j]; }
#pragma unroll
          for (int j = 0; j < 4; ++j) { sa += (va[j].x * va[j].x + va[j].y * va[j].y) + (va[j].z * va[j].z + va[j].w * va[j].w); sb += (vb[j].x * vb[j].x + vb[j].y * vb[j].y) + (vb[j].z * vb[j].z + vb[j].w * vb[j].w); }
#pragma unroll
          for (int o = 1; o < 64; o <<= 1) { sa += __shfl_xor(sa, o); sb += __shfl_xor(sb, o); }
          const float ra = 1.0f / sqrtf(sa * (1.f / DM) + EPS), rb = 1.0f / sqrtf(sb * (1.f / DM) + EPS);
          unsigned long long* oa = (unsigned long long*)(XN + (size_t)m * DM) + lane; unsigned long long* ob = (unsigned long long*)(XN + (size_t)m2 * DM) + lane;
#pragma unroll
          for (int j = 0; j < 4; ++j) { const f32x4 g = gr[64 * j];
              oa[64 * j] = (unsigned long long)pk2(va[j].x * ra * g.x, va[j].y * ra * g.y) | ((unsigned long long)pk2(va[j].z * ra * g.z, va[j].w * ra * g.w) << 32);
              ob[64 * j] = (unsigned long long)pk2(vb[j].x * rb * g.x, vb[j].y * rb * g.y) | ((unsigned long long)pk2(vb[j].z * rb * g.z, vb[j].w * rb * g.w) << 32); }
      } }
    const int gt = F.bid * NTHREADS + F.tid, NGT = F.G * NTHREADS;
    for (int i = gt; i < 1024 * 128; i += NGT) { const int n = i >> 7, k = 128 + (i & 127); Wukv_t[n * 256 + k] = 0; }
    { bf16* S1 = (bf16*)(F.ws + WS_SK1); bf16* S2 = (bf16*)(F.ws + WS_SK2);
      for (int i = gt; i < 128 * 128; i += NGT) { S1[i] = (bf16)f2bf(F.in[I_SK1][i]); S2[i] = (bf16)f2bf(F.in[I_SK2][i]); } }
    for (int o = gw; o < 256; o += NGW) {
        const int kv = o >> 7, j = o & 127; const float* pe = F.in[kv ? I_CPV : I_CPK]; const float* w1 = F.in[kv ? I_CW1V : I_CW1K];
        float s = 0.f;
        for (int k = lane; k < 2048; k += 64) s += pe[k] * w1[(size_t)k * 128 + j];
        s = wave_sum(s);
        if (lane == 0) ((float*)(F.ws + (kv ? WS_C1V : WS_C1K)))[j] = s;
    }
}

using pg8::Unit; using pg8::cvt_pk_bf16;
constexpr int PG_HALF = 128, PG_BM = 256;
struct EpiInProj {
    static constexpr bool PERM = true;
    bf16 *QKV, *CQ, *MISC, *GATES; float *SSQ, *SSKV;
    __device__ __forceinline__ void operator()(const f32x4 (&acc)[2][2][4][2], const Unit& u, int wr, int wc, int fr, int fq) const {
        bf16* base; int ldc, colt; float sc = 1.f;
        if (u.pn < 5) { base = QKV; ldc = 1280; colt = u.pn * 256; if (u.pn < 2) sc = QSCALE_NSA; }
        else if (u.pn == 5) { base = CQ; ldc = 256; colt = 0; }
        else if (u.pn == 6) { base = MISC; ldc = 256; colt = 0; }
        else { base = GATES; ldc = 2048; colt = (u.pn - 7) * 256; }
        const int row0 = u.pm * PG_BM + wr * 64 + fr, col0 = colt + wc * 32 + 8 * fq;
#pragma unroll
        for (int ai = 0; ai < 2; ++ai)
#pragma unroll
            for (int m = 0; m < 4; ++m) { bf16* rowp = base + (size_t)(row0 + ai * PG_HALF + m * 16) * ldc + col0;
#pragma unroll
                for (int bj = 0; bj < 2; ++bj) { const f32x4 v0 = acc[ai][bj][m][0] * sc, v1 = acc[ai][bj][m][1] * sc;
                    v4u w; w.x = cvt_pk_bf16(v0[0], v0[1]); w.y = cvt_pk_bf16(v0[2], v0[3]); w.z = cvt_pk_bf16(v1[0], v1[1]); w.w = cvt_pk_bf16(v1[2], v1[3]);
                    *(v4u*)(rowp + bj * PG_HALF) = w; }
                if (u.pn == 5 || u.pn == 6) {
                    float ss = 0.f;
#pragma unroll
                    for (int bj = 0; bj < 2; ++bj) if (u.pn == 5 || bj == 0) {
#pragma unroll
                        for (int n = 0; n < 2; ++n) { const f32x4 v = acc[ai][bj][m][n]; ss += (v[0] * v[0] + v[1] * v[1]) + (v[2] * v[2] + v[3] * v[3]); } }
                    ss += __shfl_xor(ss, 16); ss += __shfl_xor(ss, 32);
                    if (fq == 0) (u.pn == 5 ? SSQ : SSKV)[(size_t)(row0 + ai * PG_HALF + m * 16) * 4 + wc] = ss; } }
    }
};
struct EpiBf16 {
    static constexpr bool PERM = true;
    bf16* O; int ldc;
    __device__ __forceinline__ void operator()(const f32x4 (&acc)[2][2][4][2], const Unit& u, int wr, int wc, int fr, int fq) const {
        const int row0 = u.pm * PG_BM + wr * 64 + fr, col0 = u.pn * PG_BM + wc * 32 + 8 * fq;
#pragma unroll
        for (int ai = 0; ai < 2; ++ai)
#pragma unroll
            for (int m = 0; m < 4; ++m) { bf16* rowp = O + (size_t)(row0 + ai * PG_HALF + m * 16) * ldc + col0;
#pragma unroll
                for (int bj = 0; bj < 2; ++bj) { const f32x4 v0 = acc[ai][bj][m][0], v1 = acc[ai][bj][m][1];
                    v4u w; w.x = cvt_pk_bf16(v0[0], v0[1]); w.y = cvt_pk_bf16(v0[2], v0[3]); w.z = cvt_pk_bf16(v1[0], v1[1]); w.w = cvt_pk_bf16(v1[2], v1[3]);
                    *(v4u*)(rowp + bj * PG_HALF) = w; } }
    }
};
template <int NSRC> struct EpiRowScale {
    static constexpr bool PERM = true;
    const float* SS; bf16* O; int ldc; float cscale;
    __device__ __forceinline__ void operator()(const f32x4 (&acc)[2][2][4][2], const Unit& u, int wr, int wc, int fr, int fq) const {
        const int row0 = u.pm * PG_BM + wr * 64 + fr, col0 = u.pn * PG_BM + wc * 32 + 8 * fq;
#pragma unroll
        for (int ai = 0; ai < 2; ++ai)
#pragma unroll
            for (int m = 0; m < 4; ++m) { const int row = row0 + ai * PG_HALF + m * 16;
                const f32x4 s4 = *(const f32x4*)(SS + (size_t)row * 4); const float ss = (s4[0] + s4[1]) + (s4[2] + s4[3]);
                const float sc = cscale * __builtin_amdgcn_rsqf(ss * (1.0f / NSRC) + EPS);
                bf16* rowp = O + (size_t)row * ldc + col0;
#pragma unroll
                for (int bj = 0; bj < 2; ++bj) { const f32x4 v0 = acc[ai][bj][m][0] * sc, v1 = acc[ai][bj][m][1] * sc;
                    v4u w; w.x = cvt_pk_bf16(v0[0], v0[1]); w.y = cvt_pk_bf16(v0[2], v0[3]); w.z = cvt_pk_bf16(v1[0], v1[1]); w.w = cvt_pk_bf16(v1[2], v1[3]);
                    *(v4u*)(rowp + bj * PG_HALF) = w; } }
    }
};
struct EpiF32 {
    static constexpr bool PERM = false;
    float* C; int ldc; const float* resid;
    __device__ __forceinline__ void operator()(const f32x4 (&acc)[2][2][4][2], const Unit& u, int wr, int wc, int fr, int fq) const {
        const int row0 = u.pm * PG_BM + wr * 64 + fr, col0 = u.pn * PG_BM + wc * 32 + 4 * fq;
#pragma unroll
        for (int ai = 0; ai < 2; ++ai)
#pragma unroll
            for (int m = 0; m < 4; ++m) { const size_t off = (size_t)(row0 + ai * PG_HALF + m * 16) * ldc + col0;
#pragma unroll
                for (int bj = 0; bj < 2; ++bj)
#pragma unroll
                    for (int n = 0; n < 2; ++n) { f32x4 v = acc[ai][bj][m][n]; if (resid) v += *(const f32x4*)(resid + off + bj * PG_HALF + n * 16); *(f32x4*)(C + off + bj * PG_HALF + n * 16) = v; } }
    }
};
struct EpiGateChain {
    static constexpr bool PERM = true;
    const bf16* G; bf16* MG;
    __device__ __forceinline__ void mid(f32x4 (&acc)[2][2][4][2], const Unit& u, int wr, int wc, int fr, int fq) const {
        const int row0 = u.pm * PG_BM + wr * 64 + fr, col0 = u.pn * PG_BM + wc * 32 + 8 * fq;
#pragma unroll
        for (int ai = 0; ai < 2; ++ai)
#pragma unroll
            for (int m = 0; m < 4; ++m) { const int row = row0 + ai * PG_HALF + m * 16;
#pragma unroll
                for (int bj = 0; bj < 2; ++bj) { const int col = col0 + bj * PG_HALF;
                    const v4u gn = *(const v4u*)(G + (size_t)row * 2048 + col), gm = *(const v4u*)(G + (size_t)row * 2048 + 1024 + col);
#define RATIO(a, b) ((1.0f + __expf(-(b))) * __builtin_amdgcn_rcpf(1.0f + __expf(-(a))))
                    acc[ai][bj][m][0][0] *= RATIO(bf_lo(gn.x), bf_lo(gm.x)); acc[ai][bj][m][0][1] *= RATIO(bf_hi(gn.x), bf_hi(gm.x)); acc[ai][bj][m][0][2] *= RATIO(bf_lo(gn.y), bf_lo(gm.y)); acc[ai][bj][m][0][3] *= RATIO(bf_hi(gn.y), bf_hi(gm.y));
                    acc[ai][bj][m][1][0] *= RATIO(bf_lo(gn.z), bf_lo(gm.z)); acc[ai][bj][m][1][1] *= RATIO(bf_hi(gn.z), bf_hi(gm.z)); acc[ai][bj][m][1][2] *= RATIO(bf_lo(gn.w), bf_lo(gm.w)); acc[ai][bj][m][1][3] *= RATIO(bf_hi(gn.w), bf_hi(gm.w));
#undef RATIO
                } }
    }
    __device__ __forceinline__ void operator()(const f32x4 (&acc)[2][2][4][2], const Unit& u, int wr, int wc, int fr, int fq) const {
        const int row0 = u.pm * PG_BM + wr * 64 + fr, col0 = u.pn * PG_BM + wc * 32 + 8 * fq;
#pragma unroll
        for (int ai = 0; ai < 2; ++ai)
#pragma unroll
            for (int m = 0; m < 4; ++m) { const int row = row0 + ai * PG_HALF + m * 16;
#pragma unroll
                for (int bj = 0; bj < 2; ++bj) { const int col = col0 + bj * PG_HALF;
                    const v4u gm = *(const v4u*)(G + (size_t)row * 2048 + 1024 + col); const f32x4 a0 = acc[ai][bj][m][0], a1 = acc[ai][bj][m][1];
                    v4u w; w.x = cvt_pk_bf16(sigmoidf_(bf_lo(gm.x)) * a0[0], sigmoidf_(bf_hi(gm.x)) * a0[1]); w.y = cvt_pk_bf16(sigmoidf_(bf_lo(gm.y)) * a0[2], sigmoidf_(bf_hi(gm.y)) * a0[3]);
                    w.z = cvt_pk_bf16(sigmoidf_(bf_lo(gm.z)) * a1[0], sigmoidf_(bf_hi(gm.z)) * a1[1]); w.w = cvt_pk_bf16(sigmoidf_(bf_lo(gm.w)) * a1[2], sigmoidf_(bf_hi(gm.w)) * a1[3]);
                    *(v4u*)(MG + (size_t)row * 1024 + col) = w; } }
    }
};
struct EpiResid {
    static constexpr bool PERM = false;
    const float* X; bf16* HB; float* SS;
    __device__ __forceinline__ void operator()(const f32x4 (&acc)[2][2][4][2], const Unit& u, int wr, int wc, int fr, int fq) const {
        const int row0 = u.pm * PG_BM + wr * 64 + fr, col0 = u.pn * PG_BM + wc * 32 + 4 * fq;
#pragma unroll
        for (int ai = 0; ai < 2; ++ai)
#pragma unroll
            for (int m = 0; m < 4; ++m) { const int row = row0 + ai * PG_HALF + m * 16; const size_t off = (size_t)row * 1024 + col0; float ss = 0.f;
#pragma unroll
                for (int bj = 0; bj < 2; ++bj)
#pragma unroll
                    for (int n = 0; n < 2; ++n) { const f32x4 v = acc[ai][bj][m][n] + *(const f32x4*)(X + off + bj * PG_HALF + n * 16);
                        const unsigned w0 = cvt_pk_bf16(v[0], v[1]), w1 = cvt_pk_bf16(v[2], v[3]); *(v2u*)(HB + off + bj * PG_HALF + n * 16) = (v2u){w0, w1};
                        const float r0 = bf_lo(w0), r1 = bf_hi(w0), r2 = bf_lo(w1), r3 = bf_hi(w1); ss += (r0 * r0 + r1 * r1) + (r2 * r2 + r3 * r3); }
                ss += __shfl_xor(ss, 16); ss += __shfl_xor(ss, 32);
                if (fq == 0) SS[(size_t)row * 16 + u.pn * 4 + wc] = ss; }
    }
};
struct EpiRowSS {
    static constexpr bool PERM = true;
    const float* SS; bf16* O; int ldc;
    __device__ __forceinline__ void operator()(const f32x4 (&acc)[2][2][4][2], const Unit& u, int wr, int wc, int fr, int fq) const {
        const int row0 = u.pm * PG_BM + wr * 64 + fr, col0 = u.pn * PG_BM + wc * 32 + 8 * fq;
#pragma unroll
        for (int ai = 0; ai < 2; ++ai)
#pragma unroll
            for (int m = 0; m < 4; ++m) { const int row = row0 + ai * PG_HALF + m * 16;
                const f32x4* sp = (const f32x4*)(SS + (size_t)row * 16); const f32x4 s0 = sp[0], s1 = sp[1], s2 = sp[2], s3 = sp[3];
                const float ss = (((s0[0] + s0[1]) + (s0[2] + s0[3])) + ((s1[0] + s1[1]) + (s1[2] + s1[3]))) + (((s2[0] + s2[1]) + (s2[2] + s2[3])) + ((s3[0] + s3[1]) + (s3[2] + s3[3])));
                const float sc = __builtin_amdgcn_rsqf(ss * (1.0f / DM) + EPS);
                bf16* rowp = O + (size_t)row * ldc + col0;
#pragma unroll
                for (int bj = 0; bj < 2; ++bj) { const f32x4 v0 = acc[ai][bj][m][0] * sc, v1 = acc[ai][bj][m][1] * sc;
                    v4u w; w.x = cvt_pk_bf16(v0[0], v0[1]); w.y = cvt_pk_bf16(v0[2], v0[3]); w.z = cvt_pk_bf16(v1[0], v1[1]); w.w = cvt_pk_bf16(v1[2], v1[3]);
                    *(v4u*)(rowp + bj * PG_HALF) = w; } }
    }
};
namespace att {
constexpr int KB_BYTES = 12288, VB_BYTES = 12288, BUF_BYTES = KB_BYTES + VB_BYTES;
constexpr int NBUF = 4;
constexpr int OFF_IMP = 2 * BUF_BYTES;
constexpr int OFF_SC = OFF_IMP + 32768;
constexpr int OFF_IMP2 = 0, OFF_SC2 = 32768;
constexpr int OFF_SEL = NBUF * BUF_BYTES;
constexpr int OFF_END = OFF_SEL + 512;
static_assert(OFF_SC + 8192 <= NBUF * BUF_BYTES, "selection scratch must stay inside the aliased buffers");
static_assert(OFF_END <= RING_BYTES, "attention LDS map");

__device__ __forceinline__ int crow(int r, int hi) { return (r & 3) + 8 * (r >> 2) + 4 * hi; }
__device__ __forceinline__ s16x4 vtr(const LAS unsigned char* p) { typedef short v4i16_t __attribute__((ext_vector_type(4))); return __builtin_bit_cast(s16x4, __builtin_amdgcn_ds_read_tr16_b64_v4i16((LAS v4i16_t*)p)); }
__device__ __forceinline__ unsigned cvtpk(float lo, float hi) { typedef float f2 __attribute__((ext_vector_type(2))); typedef __bf16 b2 __attribute__((ext_vector_type(2))); f2 v = {lo, hi}; b2 b = __builtin_convertvector(v, b2); return __builtin_bit_cast(unsigned, b); }
__device__ __forceinline__ float swapmax(float m) { auto rr = __builtin_amdgcn_permlane32_swap(__float_as_uint(m), __float_as_uint(m), false, false); return fmaxf(__uint_as_float(rr[0]), __uint_as_float(rr[1])); }
__device__ __forceinline__ float swapsum(float m) { auto rr = __builtin_amdgcn_permlane32_swap(__float_as_uint(m), __float_as_uint(m), false, false); return __uint_as_float(rr[0]) + __uint_as_float(rr[1]); }

__device__ __forceinline__ float max3f(float a, float b, float c) { float r; asm("v_max3_f32 %0, %1, %2, %3" : "=v"(r) : "v"(a), "v"(b), "v"(c)); return r; }
__device__ __forceinline__ float max2f(float a, float b) { float r; asm("v_max_f32_e32 %0, %1, %2" : "=v"(r) : "v"(a), "v"(b)); return r; }
struct Flash { f32x16 o[3]; float m, l; };
constexpr float FLASH_THR = 8.0f;
__device__ __forceinline__ void flash_init(Flash& f) { f.o[0] = f32x16{}; f.o[1] = f32x16{}; f.o[2] = f32x16{}; f.m = 0.f; f.l = 0.f; }

template <int NKC>
__device__ __forceinline__ void issue_tile(LAS unsigned char* lds, int buf, const bf16* Kg, int ldk, const bf16* Kpe, const bf16* Vg, int ldv, int wave, int lane) {
    LAS unsigned char* kb = lds + buf * BUF_BYTES; LAS unsigned char* vb = kb + KB_BYTES;
    { const int row = 8 * wave + (lane >> 3), chunk = (lane & 7) ^ ((row >> 1) & 7);
      __builtin_amdgcn_global_load_lds((const unsigned*)(Kg + (size_t)row * ldk + chunk * 8), (LAS unsigned*)(kb + wave * 1024), 16, 0, 0); }
    if (NKC == 12) { if (wave < 4) { const int row = 16 * wave + (lane >> 2), chunk = (lane & 3) ^ ((row >> 2) & 3);
      __builtin_amdgcn_global_load_lds((const unsigned*)(Kpe + (size_t)row * 32 + chunk * 8), (LAS unsigned*)(kb + 8192 + wave * 1024), 16, 0, 0); } }
    __builtin_amdgcn_global_load_lds((const unsigned*)(Vg + (size_t)(16 * (wave & 3) + (lane >> 2)) * ldv + (wave >> 2) * 32 + (lane & 3) * 8), (LAS unsigned*)(vb + wave * 1024), 16, 0, 0);
}

template <int NKS, int NVB, bool HAS_BIAS>
__device__ __forceinline__ void tile_compute(Flash& f, const LAS unsigned char* kb, const LAS unsigned char* vb, const bf16x8* qr, float slope, float cb,
                                             int lo, int hi_, bool need_mask, bool set_ref, int r32, int hh, int lane) {
    const LAS unsigned char* vp = vb + ((lane >> 4) & 1) * 32 + (lane & 3) * 8 + (4 * hh + ((lane & 15) >> 2)) * 64;
    s16x4 vl[NVB][4], vh[NVB][4];
    f32x16 p0, p1;
    if (HAS_BIAS) {
        const float cb0 = (cb - f.m) + slope * (float)(4 * hh), cb1 = cb0 + slope * 32.f;
#pragma unroll
        for (int r = 0; r < 16; ++r) { const float cr = (float)((r & 3) + 8 * (r >> 2)); p0[r] = __builtin_fmaf(slope, cr, cb0); p1[r] = __builtin_fmaf(slope, cr, cb1); }
    } else {
        const float nm = -f.m;
#pragma unroll
        for (int r = 0; r < 16; ++r) { p0[r] = nm; p1[r] = nm; }
    }
    const LAS unsigned char* kp = kb + r32 * 128; const int sw = (r32 >> 1) & 7;
    const LAS unsigned char* kpe = kb + 8192 + r32 * 64; const int swe = (r32 >> 2) & 3;
    bf16x8 kf0[NKS], kf1[NKS];
    auto kload = [&](int d0) {
        const LAS unsigned char* a0 = (d0 < 4) ? kp + (((2 * d0 + hh) ^ sw) << 4) : kpe + (((2 * (d0 - 4) + hh) ^ swe) << 4);
        kf0[d0] = *(const LAS bf16x8*)(a0); kf1[d0] = *(const LAS bf16x8*)(a0 + ((d0 < 4) ? 4096 : 2048)); };
#pragma unroll
    for (int d0 = 0; d0 < 4; ++d0) kload(d0);
    __builtin_amdgcn_sched_barrier(0);
#pragma unroll
    for (int d0 = 0; d0 < NKS; ++d0) {
        p0 = __builtin_amdgcn_mfma_f32_32x32x16_bf16(kf0[d0], qr[d0], p0, 0, 0, 0);
        p1 = __builtin_amdgcn_mfma_f32_32x32x16_bf16(kf1[d0], qr[d0], p1, 0, 0, 0);
        if (d0 + 4 < NKS) { kload(d0 + 4); __builtin_amdgcn_sched_barrier(0); }
    }
#pragma unroll
    for (int b = 0; b < NVB; ++b)
#pragma unroll
        for (int ks = 0; ks < 4; ++ks) {
            asm volatile("ds_read_b64_tr_b16 %0, %1 offset:%c2" : "=&v"(vl[b][ks]) : "v"(vp), "i"(b * 4096 + ks * 1024) : "memory");
            asm volatile("ds_read_b64_tr_b16 %0, %1 offset:%c2" : "=&v"(vh[b][ks]) : "v"(vp), "i"(b * 4096 + ks * 1024 + 512) : "memory"); }
    if (need_mask) {
        asm volatile("" ::: "memory");
        const int l0 = lo - 4 * hh, h0 = hi_ - 4 * hh;
#pragma unroll
        for (int r = 0; r < 16; ++r) { const int c = (r & 3) + 8 * (r >> 2);
            if (c < l0 || c > h0) p0[r] = -INFINITY;
            if (c + 32 < l0 || c + 32 > h0) p1[r] = -INFINITY; }
    }
    if (set_ref) {
        asm volatile("s_nop 15\n\ts_nop 7" : "+v"(p0), "+v"(p1));
        float mt;
        { float a = max3f(p0[0], p0[1], p1[0]), b = max3f(p0[2], p0[3], p1[1]); a = max3f(a, p1[2], p1[3]);
#pragma unroll
          for (int r = 4; r < 16; r += 4) { a = max3f(a, p0[r], p0[r + 1]); b = max3f(b, p0[r + 2], p0[r + 3]); a = max3f(a, p1[r], p1[r + 1]); b = max3f(b, p1[r + 2], p1[r + 3]); }
          mt = max2f(a, b); }
        { auto rr = __builtin_amdgcn_permlane32_swap(__float_as_uint(mt), __float_as_uint(mt), false, false); mt = max2f(__uint_as_float(rr[0]), __uint_as_float(rr[1])); }
        if (__any(mt > FLASH_THR)) {
            const float delta = fmaxf(mt, 0.f), alpha = __builtin_amdgcn_exp2f(-delta);
            f.m += delta; f.l *= alpha;
#pragma unroll
            for (int r = 0; r < 16; ++r) { p0[r] -= delta; p1[r] -= delta; }
#pragma unroll
            for (int b = 0; b < NVB; ++b)
#pragma unroll
                for (int r = 0; r < 16; ++r) f.o[b][r] *= alpha;
        }
    }
    float sum = 0.f;
#pragma unroll
    for (int r = 0; r < 16; ++r) { p0[r] = __builtin_amdgcn_exp2f(p0[r]); p1[r] = __builtin_amdgcn_exp2f(p1[r]); sum += p0[r] + p1[r]; }
    f.l += sum;
    if (__any(f.l > 0x1p60f)) {
        asm volatile("" ::: "memory");
        f.m += 60.f; f.l *= 0x1p-60f;
#pragma unroll
        for (int b = 0; b < NVB; ++b)
#pragma unroll
            for (int r = 0; r < 16; ++r) f.o[b][r] *= 0x1p-60f;
    }
    v4u pw[4];
    pw[0] = (v4u){cvtpk(p0[0], p0[1]), cvtpk(p0[2], p0[3]), cvtpk(p0[4], p0[5]), cvtpk(p0[6], p0[7])};
    pw[1] = (v4u){cvtpk(p0[8], p0[9]), cvtpk(p0[10], p0[11]), cvtpk(p0[12], p0[13]), cvtpk(p0[14], p0[15])};
    pw[2] = (v4u){cvtpk(p1[0], p1[1]), cvtpk(p1[2], p1[3]), cvtpk(p1[4], p1[5]), cvtpk(p1[6], p1[7])};
    pw[3] = (v4u){cvtpk(p1[8], p1[9]), cvtpk(p1[10], p1[11]), cvtpk(p1[12], p1[13]), cvtpk(p1[14], p1[15])};
    if (NVB == 3) asm volatile("s_waitcnt lgkmcnt(0)" : "+v"(vl[0][0]), "+v"(vl[0][1]), "+v"(vl[0][2]), "+v"(vl[0][3]), "+v"(vh[0][0]), "+v"(vh[0][1]), "+v"(vh[0][2]), "+v"(vh[0][3]),
                                                         "+v"(vl[1][0]), "+v"(vl[1][1]), "+v"(vl[1][2]), "+v"(vl[1][3]), "+v"(vh[1][0]), "+v"(vh[1][1]), "+v"(vh[1][2]), "+v"(vh[1][3]),
                                                         "+v"(vl[NVB - 1][0]), "+v"(vl[NVB - 1][1]), "+v"(vl[NVB - 1][2]), "+v"(vl[NVB - 1][3]), "+v"(vh[NVB - 1][0]), "+v"(vh[NVB - 1][1]), "+v"(vh[NVB - 1][2]), "+v"(vh[NVB - 1][3]) :: "memory");
    else          asm volatile("s_waitcnt lgkmcnt(0)" : "+v"(vl[0][0]), "+v"(vl[0][1]), "+v"(vl[0][2]), "+v"(vl[0][3]), "+v"(vh[0][0]), "+v"(vh[0][1]), "+v"(vh[0][2]), "+v"(vh[0][3]),
                                                         "+v"(vl[1][0]), "+v"(vl[1][1]), "+v"(vl[1][2]), "+v"(vl[1][3]), "+v"(vh[1][0]), "+v"(vh[1][1]), "+v"(vh[1][2]), "+v"(vh[1][3]) :: "memory");
    __builtin_amdgcn_sched_barrier(0);
#pragma unroll
    for (int b = 0; b < NVB; ++b)
#pragma unroll
        for (int ks = 0; ks < 4; ++ks) {
            const bf16x8 va = (bf16x8){vl[b][ks][0], vl[b][ks][1], vl[b][ks][2], vl[b][ks][3], vh[b][ks][0], vh[b][ks][1], vh[b][ks][2], vh[b][ks][3]};
            f.o[b] = __builtin_amdgcn_mfma_f32_32x32x16_bf16(va, __builtin_bit_cast(bf16x8, pw[ks]), f.o[b], 0, 0, 0);
        }
}
__device__ __forceinline__ void dma_wait_bar(int outstanding) {
    if (outstanding == 3) asm volatile("s_waitcnt vmcnt(3) lgkmcnt(0)\n\ts_barrier" ::: "memory");
    else if (outstanding == 2) asm volatile("s_waitcnt vmcnt(2) lgkmcnt(0)\n\ts_barrier" ::: "memory");
    else asm volatile("s_waitcnt vmcnt(0) lgkmcnt(0)\n\ts_barrier" ::: "memory");
}
template <bool DESC> __device__ __forceinline__ int pick_tile(unsigned m) { return DESC ? 31 - __builtin_clz(m) : __builtin_ctz(m); }
struct NoNext { __device__ __forceinline__ void operator()(int, int) const {} };
template <int NKS, int NVB, bool HAS_BIAS, bool DESC, bool NDESC, bool MAXALL, class Src, class Par, class NSrc>
__device__ __forceinline__ int flash_run(Flash& f, LAS unsigned char* lds, unsigned tm, const bf16x8* qr, float slope, const Src& src, const Par& par, bool pre, int slot0, unsigned ntm, const NSrc& nsrc, int r32, int hh, int lane) {
#ifdef TIMER_PHASE
    struct { LAS unsigned char* lds; } F{lds};
#endif
    unsigned rem = tm, ahead = tm;
    int islot = slot0, cslot = slot0, nslot = -1;
    bool first = true;
    auto issue_pair = [&]() {
        if (ahead) { const int j = pick_tile<DESC>(ahead); src(j, 2 * islot); ahead &= ~(1u << j);
            if (ahead) { const int j2 = pick_tile<DESC>(ahead); src(j2, 2 * islot + 1); ahead &= ~(1u << j2); } }
        else if (ntm && nslot < 0) { unsigned nm = ntm; const int j = pick_tile<NDESC>(nm); nsrc(j, 2 * islot); nm &= ~(1u << j);
            if (nm) { const int j2 = pick_tile<NDESC>(nm); nsrc(j2, 2 * islot + 1); } nslot = islot; }
        islot ^= 1; };
    if (pre) { int n = 0; unsigned a2 = ahead; while (a2 && n < 2) { const int j = pick_tile<DESC>(a2); a2 &= ~(1u << j); ++n; } ahead = a2; islot ^= 1; }
    else { TMS_BEGIN(44); issue_pair(); TMS_END(44); }
#pragma unroll 1
    while (rem) {
        const int ja = pick_tile<DESC>(rem); rem &= ~(1u << ja);
        int jb = -1; if (rem) { jb = pick_tile<DESC>(rem); rem &= ~(1u << jb); }
#ifdef TIMER_PHASE
        const unsigned long long tb0_ = (TIMER_PHASE == 40 || TIMER_PHASE == 41) ? __builtin_amdgcn_s_memrealtime() : 0ull;
#endif
        asm volatile("s_waitcnt vmcnt(0) lgkmcnt(0)\n\ts_barrier" ::: "memory");
#ifdef TIMER_PHASE
        if ((TIMER_PHASE == 40 && threadIdx.x == 0) || (TIMER_PHASE == 41 && threadIdx.x == 448)) *(LAS unsigned long long*)(lds + RING_BYTES + 512) += __builtin_amdgcn_s_memrealtime() - tb0_;
#endif
        { TMS_BEGIN(44); issue_pair(); TMS_END(44); }
        int lo, hi_; bool need; float cb;
        if (par(ja, lo, hi_, need, cb)) { const LAS unsigned char* kb = lds + (2 * cslot) * BUF_BYTES;
            TMS_BEGIN(43); tile_compute<NKS, NVB, HAS_BIAS>(f, kb, kb + KB_BYTES, qr, slope, cb, lo, hi_, need, MAXALL || first, r32, hh, lane); first = false; TMS_END(43); TMS_COUNT(42); }
        if (jb >= 0 && par(jb, lo, hi_, need, cb)) { const LAS unsigned char* kb = lds + (2 * cslot + 1) * BUF_BYTES;
            TMS_BEGIN(43); tile_compute<NKS, NVB, HAS_BIAS>(f, kb, kb + KB_BYTES, qr, slope, cb, lo, hi_, need, MAXALL || first, r32, hh, lane); first = false; TMS_END(43); TMS_COUNT(42); }
        cslot ^= 1;
    }
    if (nslot < 0) asm volatile("s_waitcnt lgkmcnt(0)\n\ts_barrier" ::: "memory");
    return nslot;
}

__device__ __forceinline__ void flash_finish(Flash& f, int nvb) {
    const float lt = swapsum(f.l); const float inv = lt > 0.f ? 1.0f / lt : 0.f;
#pragma unroll
    for (int b = 0; b < 3; ++b) if (b < nvb) {
#pragma unroll
        for (int r = 0; r < 16; ++r) f.o[b][r] *= inv; }
}

__device__ __forceinline__ void nsa_unit(Frame& F, int b, int g, int qc) {
    int lane; asm volatile("v_and_b32_e32 %0, 63, %1" : "=v"(lane) : "v"(F.tid));
    LAS unsigned char* lds = F.lds; const int wave = F.wave, r32 = lane & 31, hh = lane >> 5;
    const int head = g * 4 + (wave >> 1);
    const int qloc = 32 * (wave & 1) + r32;
    const int t = 64 * qc + qloc;
    const size_t row = (size_t)b * SEQ + t;
    const bf16* QKV = (const bf16*)(F.ws + WS_QKV); const bf16* MISC = (const bf16*)(F.ws + WS_MISC);
    bf16x8 qr[4];
#pragma unroll
    for (int d0 = 0; d0 < 4; ++d0) qr[d0] = *(const bf16x8*)(QKV + row * 1280 + head * 64 + d0 * 16 + hh * 8);
    float graw_c = bf2f(MISC[row * 256 + 160 + head]), graw_s = bf2f(MISC[row * 256 + 160 + 8 + head]), graw_w = bf2f(MISC[row * 256 + 160 + 16 + head]);
    asm volatile("" : "+v"(graw_c), "+v"(graw_s), "+v"(graw_w) : "v"(qr[0]), "v"(qr[1]), "v"(qr[2]), "v"(qr[3]));
    const float slope2 = exp2f(-(float)(head + 1)) * LOG2E;
    LAS unsigned* selw = (LAS unsigned*)(lds + OFF_SEL);
    if (F.tid < 80) selw[F.tid] = 0u;
    f32x16 ot0, ot1;
    const bf16* Kw = QKV + (size_t)b * SEQ * 1280 + 1024 + g * 64; const bf16* Vw = QKV + (size_t)b * SEQ * 1280 + 1152 + g * 64;
    const bf16* Ks = QKV + (size_t)b * SEQ * 1280 + 768 + g * 64; const bf16* Vs = QKV + (size_t)b * SEQ * 1280 + 896 + g * 64;
    auto src_win = [&](int j, int buf) { issue_tile<8>(lds, buf, Kw + (size_t)j * 64 * 1280, 1280, nullptr, Vw + (size_t)j * 64 * 1280, 1280, wave, lane); };
    auto src_sel = [&](int j, int buf) { issue_tile<8>(lds, buf, Ks + (size_t)j * 64 * 1280, 1280, nullptr, Vs + (size_t)j * 64 * 1280, 1280, wave, lane); };
    const int j0w = qc >= 8 ? qc - 8 : 0;
    const unsigned tm_win = (qc == 31 ? 0xffffffffu : ((2u << qc) - 1u)) & ~((1u << j0w) - 1u);
    TMS_DECL; TMS_MARK(47);
    int hand;
    {
        const bf16* KC = (const bf16*)(F.ws + WS_KC) + (size_t)(b * 2 + g) * 128 * 64; const bf16* VC = (const bf16*)(F.ws + WS_VC) + (size_t)(b * 2 + g) * 128 * 64;
        Flash f; flash_init(f);
        int nmax = (t >= 31) ? ((t - 31) >> 4) : -1; if (nmax > 126) nmax = 126;
        const int tid = F.tid;
        auto src = [&](int ti, int buf) {
            issue_tile<8>(lds, buf, KC + (size_t)ti * 64 * 64, 64, nullptr, VC + (size_t)ti * 64 * 64, 64, wave, lane);
            LAS bf16* ov = (LAS bf16*)(lds + buf * BUF_BYTES + KB_BYTES + 2 * 4096);
#pragma unroll
            for (int e = 0; e < 4; ++e) { const int idx = tid * 4 + e, nl = idx >> 5, s_ = idx & 31, n = 64 * ti + nl;
                float v = 0.f; if (s_ == (n >> 2)) v = ((n & 3) == 3) ? 0.5f : 1.0f; else if (s_ == (n >> 2) + 1 && (n & 3) == 3) v = 0.5f;
                ov[(nl >> 4) * 512 + (nl & 15) * 32 + s_] = (bf16)f2bf(v); } };
        auto par = [&](int ti, int& lo, int& hi_, bool& need, float& cb) { lo = 0; hi_ = nmax - 64 * ti; need = true; cb = 16.f * slope2 * (float)(64 * ti); return true; };
        TMS_MARKEND(47);
        hand = flash_run<4, 3, true, true, true, true>(f, lds, 3u, qr, 16.f * slope2, src, par, false, 0, tm_win, src_win, r32, hh, lane);
        flash_finish(f, 3);
        TMS_MARK(45);
        asm volatile("s_waitcnt lgkmcnt(0)\n\ts_barrier" ::: "memory");
        LAS float* imp = (LAS float*)(lds + OFF_IMP2) + (wave * 32 + r32) * 32;
#pragma unroll
        for (int r = 0; r < 16; ++r) imp[crow(r, hh)] = f.o[2][r];
        const float gc = sigmoidf_(graw_c);
        ot0 = f.o[0] * gc; ot1 = f.o[1] * gc;
    }
    asm volatile("s_waitcnt lgkmcnt(0)\n\ts_barrier" ::: "memory");
    if (qc < 16) { if (F.tid <= 64) selw[F.tid] = (2u << qc) - 1u; }
    else {
        LAS float* IMP = (LAS float*)(lds + OFF_IMP2); LAS float* SC = (LAS float*)(lds + OFF_SC2);
        const int q = F.tid >> 3, s4 = (F.tid & 7) * 4;
#pragma unroll
        for (int e = 0; e < 4; ++e) { const int s_ = s4 + e; float v = 0.f;
#pragma unroll
            for (int h4 = 0; h4 < 4; ++h4) v += IMP[((2 * h4 + (q >> 5)) * 32 + (q & 31)) * 32 + s_];
            const bool causal = s_ <= qc, forced = causal && (s_ == 0 || s_ + 2 > qc);
            SC[q * 32 + s_] = causal ? (v + (forced ? 1e4f : 0.f)) : -1e30f; }
        asm volatile("s_waitcnt lgkmcnt(0)\n\ts_barrier" ::: "memory");
        float sc[32];
#pragma unroll
        for (int s_ = 0; s_ < 32; ++s_) sc[s_] = SC[q * 32 + s_];
        unsigned bits = 0u;
#pragma unroll
        for (int e = 0; e < 4; ++e) { const int s_ = s4 + e; const float me = SC[q * 32 + s_]; int rank = 0;
#pragma unroll
            for (int s2 = 0; s2 < 32; ++s2) rank += (sc[s2] > me || (sc[s2] == me && s2 < s_)) ? 1 : 0;
            if (s_ <= qc && rank < 16) bits |= 1u << s_; }
        atomicOr((unsigned*)&selw[q], bits); atomicOr((unsigned*)&selw[64], bits);
    }
    asm volatile("s_waitcnt lgkmcnt(0)\n\ts_barrier" ::: "memory");
    const unsigned mymask = selw[qloc], anymask = selw[64];
    TMS_MARKEND(45);
    {
        Flash f; flash_init(f);
        auto par = [&](int j, int& lo, int& hi_, bool& need, float& cb) { lo = t - 511 - 64 * j; if (lo < 0) lo = 0; hi_ = t - 64 * j; if (hi_ > 63) hi_ = 63;
            need = (j == qc) || (j + 8 == qc); cb = slope2 * (float)(64 * j); return slope2 * (float)(64 * qc + 32 * (wave & 1) - (64 * j + 63)) < 256.f; };
        hand = flash_run<4, 2, true, true, true, false>(f, lds, tm_win, qr, slope2, src_win, par, true, hand, anymask, src_sel, r32, hh, lane);
        flash_finish(f, 2);
        const float gw = sigmoidf_(graw_w);
        ot0 += f.o[0] * gw; ot1 += f.o[1] * gw;
    }
    {
        Flash f; flash_init(f);
        const int tmin_w = 64 * qc + 32 * (wave & 1);
        auto par = [&](int j, int& lo, int& hi_, bool& need, float& cb) { const bool sel = (mymask >> j) & 1u; lo = 0; hi_ = (j == qc) ? (t - 64 * j) : 63;
            need = (j == qc); cb = sel ? slope2 * (float)(64 * j) : -INFINITY;
            return __any(sel) && slope2 * (float)(tmin_w - (64 * j + 63)) < 256.f; };
        (void)flash_run<4, 2, true, true, true, false>(f, lds, anymask, qr, slope2, src_sel, par, true, hand, 0u, NoNext(), r32, hh, lane);
        TMS_MARK(48);
        flash_finish(f, 2);
        const float gs = sigmoidf_(graw_s);
        ot0 += f.o[0] * gs; ot1 += f.o[1] * gs;
    }
    { bf16* op = (bf16*)(F.ws + WS_OCAT) + row * 1024 + head * 64 + 4 * hh;
#pragma unroll
      for (int k = 0; k < 4; ++k) {
          *(v2u*)(op + 8 * k) = (v2u){cvtpk(ot0[4 * k], ot0[4 * k + 1]), cvtpk(ot0[4 * k + 2], ot0[4 * k + 3])};
          *(v2u*)(op + 32 + 8 * k) = (v2u){cvtpk(ot1[4 * k], ot1[4 * k + 1]), cvtpk(ot1[4 * k + 2], ot1[4 * k + 3])}; } }
    TMS_MARKEND(48);
}

__device__ __forceinline__ void mla_unit(Frame& F, int b, int h, int qb) {
    int lane; asm volatile("v_and_b32_e32 %0, 63, %1" : "=v"(lane) : "v"(F.tid));
    LAS unsigned char* lds = F.lds; const int wave = F.wave, r32 = lane & 31, hh = lane >> 5;
    const int t = 256 * qb + 32 * wave + r32;
    const size_t row = (size_t)b * SEQ + t;
    const bf16* MQ = (const bf16*)(F.ws + WS_MLAQ); const bf16* MKV = (const bf16*)(F.ws + WS_MLAKV); const bf16* KPE = (const bf16*)(F.ws + WS_KPE);
    bf16x8 qr[6];
#pragma unroll
    for (int d0 = 0; d0 < 6; ++d0) qr[d0] = *(const bf16x8*)(MQ + row * 768 + h * 96 + d0 * 16 + hh * 8);
    {
        const float pos = (float)F.pos[row];
        v4u a = __builtin_bit_cast(v4u, qr[4]), c = __builtin_bit_cast(v4u, qr[5]);
        float x1[8], x2[8];
        x1[0] = bf_lo(a.x); x1[1] = bf_hi(a.x); x1[2] = bf_lo(a.y); x1[3] = bf_hi(a.y); x1[4] = bf_lo(a.z); x1[5] = bf_hi(a.z); x1[6] = bf_lo(a.w); x1[7] = bf_hi(a.w);
        x2[0] = bf_lo(c.x); x2[1] = bf_hi(c.x); x2[2] = bf_lo(c.y); x2[3] = bf_hi(c.y); x2[4] = bf_lo(c.z); x2[5] = bf_hi(c.z); x2[6] = bf_lo(c.w); x2[7] = bf_hi(c.w);
        float y1[8], y2[8];
#pragma unroll
        for (int j = 0; j < 8; ++j) { const float ang = pos * rope_inv(8 * hh + j); float sn, cs; rope_sincos(ang, sn, cs);
            y1[j] = x1[j] * cs - x2[j] * sn; y2[j] = x1[j] * sn + x2[j] * cs; }
        a = (v4u){cvtpk(y1[0], y1[1]), cvtpk(y1[2], y1[3]), cvtpk(y1[4], y1[5]), cvtpk(y1[6], y1[7])};
        c = (v4u){cvtpk(y2[0], y2[1]), cvtpk(y2[2], y2[3]), cvtpk(y2[4], y2[5]), cvtpk(y2[6], y2[7])};
        qr[4] = __builtin_bit_cast(bf16x8, a); qr[5] = __builtin_bit_cast(bf16x8, c);
    }
    asm volatile("" :: "v"(qr[0]), "v"(qr[1]), "v"(qr[2]), "v"(qr[3]), "v"(qr[4]), "v"(qr[5]));
    const bf16* Kg = MKV + (size_t)b * SEQ * 1024 + h * 128; const bf16* Vg = Kg + 64; const bf16* Pg = KPE + (size_t)b * SEQ * 32;
    Flash f; flash_init(f);
    const int NT = 4 * qb + 4;
    const int tmin_w = 256 * qb + 32 * wave, tmax_w = tmin_w + 31;
    auto src = [&](int j, int buf) { issue_tile<12>(lds, buf, Kg + (size_t)j * 64 * 1024, 1024, Pg + (size_t)j * 64 * 32, Vg + (size_t)j * 64 * 1024, 1024, wave, lane); };
    auto par = [&](int j, int& lo, int& hi_, bool& need, float& cb) { lo = 0; hi_ = t - 64 * j; if (hi_ > 63) hi_ = 63; need = (64 * j + 63 > tmin_w); cb = 0.f; return 64 * j <= tmax_w; };
    (void)flash_run<6, 2, false, false, false, false>(f, lds, NT == 32 ? 0xffffffffu : ((1u << NT) - 1u), qr, 0.f, src, par, false, 0, 0u, NoNext(), r32, hh, lane);
    flash_finish(f, 2);
    { bf16* op = (bf16*)(F.ws + WS_OCAT) + row * 1024 + 512 + h * 64 + 4 * hh;
#pragma unroll
      for (int k = 0; k < 4; ++k) {
          *(v2u*)(op + 8 * k) = (v2u){cvtpk(f.o[0][4 * k], f.o[0][4 * k + 1]), cvtpk(f.o[0][4 * k + 2], f.o[0][4 * k + 3])};
          *(v2u*)(op + 32 + 8 * k) = (v2u){cvtpk(f.o[1][4 * k], f.o[1][4 * k + 1]), cvtpk(f.o[1][4 * k + 2], f.o[1][4 * k + 3])}; } }
}

__device__ __forceinline__ int draw_unit(Frame& F, unsigned* ctr) {
    TMS_BEGIN(46);
    LAS int* slot = (LAS int*)(F.lds + OFF_SEL + 384);
    if (F.tid == 0) *slot = (int)__hip_atomic_fetch_add(ctr, 1u, __ATOMIC_RELAXED, __HIP_MEMORY_SCOPE_AGENT);
    __syncthreads();
    const int v = *slot;
    __syncthreads();
    TMS_END(46);
    return __builtin_amdgcn_readfirstlane(v);
}
__device__ __forceinline__ void nsa_loop(Frame& F) {
    unsigned* ctr = (unsigned*)(F.ws + WS_CTL) + 8192;
#pragma unroll 1
    for (int first = 1;; first = 0) { const int idx = (first && F.bid < 256) ? F.bid : 256 + draw_unit(F, ctr); if (idx >= 512) break; const int qc = 31 - (idx >> 4), bg = idx & 15; nsa_unit(F, bg >> 1, bg & 1, qc); }
}
__device__ __forceinline__ void mla_loop(Frame& F) {
    unsigned* ctr = (unsigned*)(F.ws + WS_CTL) + 8192 + 64;
#pragma unroll 1
    for (int first = 1;; first = 0) { const int idx = (first && F.bid < 256) ? F.bid : 256 + draw_unit(F, ctr); if (idx >= 512) break; const int qb = 7 - (idx >> 6), bh = idx & 63; mla_unit(F, bh >> 3, bh & 7, qb); }
}
}
#define NET_SORT16(K) do { CE(K[0], K[1]); CE(K[2], K[3]); CE(K[0], K[2]); CE(K[1], K[3]); CE(K[1], K[2]); CE(K[4], K[5]); CE(K[6], K[7]); CE(K[4], K[6]); CE(K[5], K[7]); CE(K[5], K[6]); CE(K[0], K[4]); CE(K[2], K[6]); CE(K[2], K[4]); CE(K[1], K[5]); CE(K[3], K[7]); CE(K[3], K[5]); CE(K[1], K[2]); CE(K[3], K[4]); CE(K[5], K[6]); CE(K[8], K[9]); CE(K[10], K[11]); CE(K[8], K[10]); CE(K[9], K[11]); CE(K[9], K[10]); CE(K[12], K[13]); CE(K[14], K[15]); CE(K[12], K[14]); CE(K[13], K[15]); CE(K[13], K[14]); CE(K[8], K[12]); CE(K[10], K[14]); CE(K[10], K[12]); CE(K[9], K[13]); CE(K[11], K[15]); CE(K[11], K[13]); CE(K[9], K[10]); CE(K[11], K[12]); CE(K[13], K[14]); CE(K[0], K[8]); CE(K[4], K[12]); CE(K[4], K[8]); CE(K[2], K[10]); CE(K[6], K[14]); CE(K[6], K[10]); CE(K[2], K[4]); CE(K[6], K[8]); CE(K[10], K[12]); CE(K[1], K[9]); CE(K[5], K[13]); CE(K[5], K[9]); CE(K[3], K[11]); CE(K[7], K[15]); CE(K[7], K[11]); CE(K[3], K[5]); CE(K[7], K[9]); CE(K[11], K[13]); CE(K[1], K[2]); CE(K[3], K[4]); CE(K[5], K[6]); CE(K[7], K[8]); CE(K[9], K[10]); CE(K[11], K[12]); CE(K[13], K[14]); } while (0)
#define NET_BMERGE16(K) do { CE(K[0], K[8]); CE(K[1], K[9]); CE(K[2], K[10]); CE(K[3], K[11]); CE(K[4], K[12]); CE(K[5], K[13]); CE(K[6], K[14]); CE(K[7], K[15]); CE(K[0], K[4]); CE(K[1], K[5]); CE(K[2], K[6]); CE(K[3], K[7]); CE(K[8], K[12]); CE(K[9], K[13]); CE(K[10], K[14]); CE(K[11], K[15]); CE(K[0], K[2]); CE(K[1], K[3]); CE(K[4], K[6]); CE(K[5], K[7]); CE(K[8], K[10]); CE(K[9], K[11]); CE(K[12], K[14]); CE(K[13], K[15]); CE(K[0], K[1]); CE(K[2], K[3]); CE(K[4], K[5]); CE(K[6], K[7]); CE(K[8], K[9]); CE(K[10], K[11]); CE(K[12], K[13]); CE(K[14], K[15]); } while (0)
__device__ __forceinline__ void kpe_pass(Frame& F) {
    const bf16* MISC = (const bf16*)(F.ws + WS_MISC); bf16* KPE = (bf16*)(F.ws + WS_KPE);
    const int gt = F.bid * NTHREADS + F.tid, NGT = F.G * NTHREADS;
    for (int it = gt; it < MTOK * 16; it += NGT) { const int t = it >> 4, i = it & 15;
        const float x1 = bf2f(MISC[(size_t)t * 256 + 128 + i]), x2 = bf2f(MISC[(size_t)t * 256 + 144 + i]);
        const float ang = (float)F.pos[t] * rope_inv(i); float sn, cs; rope_sincos(ang, sn, cs);
        KPE[(size_t)t * 32 + i] = (bf16)f2bf(x1 * cs - x2 * sn); KPE[(size_t)t * 32 + 16 + i] = (bf16)f2bf(x1 * sn + x2 * cs); }
}
__device__ __forceinline__ void cmp_finalize(Frame& F) {
    const int gw = F.bid * NWAVES + F.wave, NGW = F.G * NWAVES, lane = F.lane;
    LAS float* W2S = (LAS float*)(F.lds + 16384);
    LAS float* hid = (LAS float*)(F.lds + F.wave * 1024);
    for (int i = F.tid; i < 2 * 128 * 64 / 4; i += NTHREADS) { const int kv = i >> 11, j = i & 2047; ((LAS f32x4*)W2S)[i] = ((const f32x4*)F.in[kv ? I_CW2V : I_CW2K])[j]; }
    __syncthreads();
    for (int it = gw; it < 2 * 16 * 128; it += NGW) {
        const int kv = it >> 11, bg = (it >> 7) & 15, n = it & 127;
        bf16* dst = (bf16*)(F.ws + (kv ? WS_VC : WS_KC)) + ((size_t)bg * 128 + n) * 64;
        if (n == 127) { dst[lane] = 0; continue; }
        const float* U = (const float*)(F.ws + WS_USLAB) + (size_t)kv * 4 * 2048 * 256 + (size_t)(bg * 128 + n) * 256; const float* c1 = (const float*)(F.ws + (kv ? WS_C1V : WS_C1K));
        float a0 = c1[lane], a1 = c1[64 + lane];
#pragma unroll
        for (int s = 0; s < 4; ++s) { const float* Us = U + (size_t)s * 2048 * 256; a0 += Us[lane] + Us[256 + 128 + lane]; a1 += Us[64 + lane] + Us[256 + 192 + lane]; }
        hid[lane] = gelu_tanh(a0); hid[64 + lane] = gelu_tanh(a1);
        asm volatile("s_waitcnt lgkmcnt(0)" ::: "memory");
        const LAS float* w2 = W2S + kv * 8192 + lane;
        float s0 = 0.f, s1 = 0.f, s2 = 0.f, s3 = 0.f;
#pragma unroll 8
        for (int i = 0; i < 128; i += 4) { s0 += hid[i] * w2[i * 64]; s1 += hid[i + 1] * w2[(i + 1) * 64]; s2 += hid[i + 2] * w2[(i + 2) * 64]; s3 += hid[i + 3] * w2[(i + 3) * 64]; }
        dst[lane] = (bf16)f2bf((s0 + s1) + (s2 + s3));
        asm volatile("s_waitcnt lgkmcnt(0)" ::: "memory");
    }
}
template <bool SIGNED>
__device__ __forceinline__ void quant_table(Frame& F, const float* src, unsigned char* dst, float* steps) {
    const int gw = F.bid * NWAVES + F.wave, NGW = F.G * NWAVES, lane = F.lane;
    for (int e0 = gw; e0 < 16384; e0 += 2 * NGW) {
        const int e1 = (e0 + NGW < 16384) ? e0 + NGW : e0;
        const f32x4* spa = (const f32x4*)(src + (size_t)e0 * 1024) + 4 * lane; const f32x4* spb = (const f32x4*)(src + (size_t)e1 * 1024) + 4 * lane;
        f32x4 va[4], vb[4];
#pragma unroll
        for (int j = 0; j < 4; ++j) { va[j] = spa[j]; vb[j] = spb[j]; }
        float ma = 0.f, mb = 0.f;
#pragma unroll
        for (int j = 0; j < 4; ++j) { ma = fmaxf(ma, fmaxf(fmaxf(fabsf(va[j].x), fabsf(va[j].y)), fmaxf(fabsf(va[j].z), fabsf(va[j].w)))); mb = fmaxf(mb, fmaxf(fmaxf(fabsf(vb[j].x), fabsf(vb[j].y)), fmaxf(fabsf(vb[j].z), fabsf(vb[j].w)))); }
#pragma unroll
        for (int o = 1; o < 64; o <<= 1) { ma = fmaxf(ma, __shfl_xor(ma, o)); mb = fmaxf(mb, __shfl_xor(mb, o)); }
        const float offs = SIGNED ? 0.f : 128.f;
        const float sta = ma > 0.f ? ma * (1.0f / 127.0f) : 1.0f, ia = 1.0f / sta, stb = mb > 0.f ? mb * (1.0f / 127.0f) : 1.0f, ib = 1.0f / stb;
        v4u wa, wb;
#pragma unroll
        for (int j = 0; j < 4; ++j) {
            wa[j] = ((unsigned)(int)(rintf(va[j].x * ia) + offs) & 0xffu) | (((unsigned)(int)(rintf(va[j].y * ia) + offs) & 0xffu) << 8) | (((unsigned)(int)(rintf(va[j].z * ia) + offs) & 0xffu) << 16) | (((unsigned)(int)(rintf(va[j].w * ia) + offs) & 0xffu) << 24);
            wb[j] = ((unsigned)(int)(rintf(vb[j].x * ib) + offs) & 0xffu) | (((unsigned)(int)(rintf(vb[j].y * ib) + offs) & 0xffu) << 8) | (((unsigned)(int)(rintf(vb[j].z * ib) + offs) & 0xffu) << 16) | (((unsigned)(int)(rintf(vb[j].w * ib) + offs) & 0xffu) << 24); }
        ((v4u*)(dst + (size_t)e0 * 1024))[lane] = wa; ((v4u*)(dst + (size_t)e1 * 1024))[lane] = wb;
        if (lane == 0) { steps[e0] = sta; steps[e1] = stb; }
    }
}

__device__ __forceinline__ void quant_table4(Frame& F, const float* src, unsigned char* dst, float* steps) {
    const int gw = F.bid * NWAVES + F.wave, NGW = F.G * NWAVES, lane = F.lane;
    for (int e0 = gw; e0 < 16384; e0 += 2 * NGW) {
        const int e1 = (e0 + NGW < 16384) ? e0 + NGW : e0;
        const f32x4* spa = (const f32x4*)(src + (size_t)e0 * 1024) + 4 * lane; const f32x4* spb = (const f32x4*)(src + (size_t)e1 * 1024) + 4 * lane;
        f32x4 va[4], vb[4];
#pragma unroll
        for (int j = 0; j < 4; ++j) { va[j] = spa[j]; vb[j] = spb[j]; }
        float ma = 0.f, mb = 0.f;
#pragma unroll
        for (int j = 0; j < 4; ++j) { ma = fmaxf(ma, fmaxf(fmaxf(fabsf(va[j].x), fabsf(va[j].y)), fmaxf(fabsf(va[j].z), fabsf(va[j].w)))); mb = fmaxf(mb, fmaxf(fmaxf(fabsf(vb[j].x), fabsf(vb[j].y)), fmaxf(fabsf(vb[j].z), fabsf(vb[j].w)))); }
#pragma unroll
        for (int o = 1; o < 64; o <<= 1) { ma = fmaxf(ma, __shfl_xor(ma, o)); mb = fmaxf(mb, __shfl_xor(mb, o)); }
        const float sta = ma > 0.f ? ma * (1.0f / 7.0f) : 1.0f, ia = 1.0f / sta, stb = mb > 0.f ? mb * (1.0f / 7.0f) : 1.0f, ib = 1.0f / stb;
        auto nib2 = [](float lo, float hi, float inv) -> unsigned {
            const int ql = (int)fminf(fmaxf(rintf(lo * inv), -7.f), 7.f) + 8, qh = (int)fminf(fmaxf(rintf(hi * inv), -7.f), 7.f);
            return (unsigned)ql | (((unsigned)qh & 15u) << 4); };
        v2u wa, wb;
#pragma unroll
        for (int j = 0; j < 2; ++j) {
            wa[j] = nib2(va[2 * j].x, va[2 * j].y, ia) | (nib2(va[2 * j].z, va[2 * j].w, ia) << 8) | (nib2(va[2 * j + 1].x, va[2 * j + 1].y, ia) << 16) | (nib2(va[2 * j + 1].z, va[2 * j + 1].w, ia) << 24);
            wb[j] = nib2(vb[2 * j].x, vb[2 * j].y, ib) | (nib2(vb[2 * j].z, vb[2 * j].w, ib) << 8) | (nib2(vb[2 * j + 1].x, vb[2 * j + 1].y, ib) << 16) | (nib2(vb[2 * j + 1].z, vb[2 * j + 1].w, ib) << 24); }
        ((v2u*)(dst + (size_t)e0 * 512))[lane] = wa; ((v2u*)(dst + (size_t)e1 * 512))[lane] = wb;
        if (lane == 0) { steps[e0] = sta; steps[e1] = stb; }
    }
}

namespace peer {
constexpr int TOK = 32;
constexpr int LSTR = 17;
constexpr int OFF_LISTV = 0, OFF_LISTK = 34816;
constexpr int OFF_ROUTE = 45056;
constexpr int OFF_SKB = 77824;
struct Ent { float v; unsigned k; };
__device__ __forceinline__ unsigned ordkey(float f) { const unsigned u = __float_as_uint(f); return u ^ ((u >> 31) ? 0xffffffffu : 0x80000000u); }
__device__ __forceinline__ float ordinv(unsigned k) { return __uint_as_float(k ^ ((k >> 31) ? 0x80000000u : 0xffffffffu)); }
__device__ __forceinline__ void swap2(int x, int& lo, int& hi) { auto rr = __builtin_amdgcn_permlane32_swap((unsigned)x, (unsigned)x, false, false); lo = (int)rr[0]; hi = (int)rr[1]; }

#define CE(a, b) do { const unsigned x_ = (a) > (b) ? (a) : (b), y_ = (a) > (b) ? (b) : (a); (a) = x_; (b) = y_; } while (0)
__device__ __forceinline__ void merge_top16(unsigned (&a)[16], const unsigned (&b)[16]) {
#pragma unroll
    for (int i = 0; i < 16; ++i) a[i] = a[i] > b[15 - i] ? a[i] : b[15 - i];
    NET_BMERGE16(a);
}
__device__ __forceinline__ void top16_of64(unsigned (&w)[4][16]) {
    NET_SORT16(w[0]); NET_SORT16(w[1]); NET_SORT16(w[2]); NET_SORT16(w[3]);
    merge_top16(w[0], w[1]); merge_top16(w[2], w[3]); merge_top16(w[0], w[2]);
}

#define PEER_CANDS(X) X(0,0) X(0,1) X(0,2) X(0,3) X(0,4) X(0,5) X(0,6) X(0,7) X(0,8) X(0,9) X(0,10) X(0,11) X(0,12) X(0,13) X(0,14) X(0,15) \
    X(1,0) X(1,1) X(1,2) X(1,3) X(1,4) X(1,5) X(1,6) X(1,7) X(2,0) X(2,1) X(2,2) X(2,3) X(2,4) X(3,0) X(3,1) X(3,2) X(3,3) X(4,0) X(4,1) X(4,2) \
    X(5,0) X(5,1) X(6,0) X(6,1) X(7,0) X(7,1) X(8,0) X(9,0) X(10,0) X(11,0) X(12,0) X(13,0) X(14,0) X(15,0)

__device__ __forceinline__ void route_task(Frame& F, int tok0) {
    int lane; asm volatile("v_and_b32_e32 %0, 63, %1" : "=v"(lane) : "v"(F.tid));
    const int wave = F.wave, r32 = lane & 31, hh = lane >> 5;
    const bf16* QP = (const bf16*)(F.ws + WS_QP);
    const size_t row = (size_t)tok0 + r32;
    LAS unsigned char* LK = F.lds + OFF_LISTK + (size_t)wave * 2 * TOK * LSTR;
    LAS unsigned char* SKB = F.lds + OFF_SKB;
    LAS unsigned char* CANDT = F.lds + OFF_LISTV;
    if (F.tid < 64) { int ci = 0; unsigned ab = 0u;
#define X(a, b) ab = ((int)F.tid == ci) ? (unsigned)((a) * 16 + (b)) : ab; ++ci;
        PEER_CANDS(X)
#undef X
        CANDT[F.tid] = (unsigned char)ab; }
    unsigned l1[16], l2[16];
#pragma unroll 1
    for (int half = 0; half < 2; ++half) {
        const bf16* SK = (const bf16*)(F.ws + (half ? WS_SK2 : WS_SK1));
        if (half) __syncthreads();
#pragma unroll
        for (int i = 0; i < 4; ++i) { const int pc = 4 * wave + i, c = pc >> 1, kbk = pc & 1;
            __builtin_amdgcn_global_load_lds((const unsigned*)(SK + (size_t)(64 * kbk + lane) * 128 + c * 8), (LAS unsigned*)(SKB + c * 2048 + kbk * 1024), 16, 0, 0); }
        bf16x8 qf[8];
#pragma unroll
        for (int d0 = 0; d0 < 8; ++d0) qf[d0] = *(const bf16x8*)(QP + row * 2048 + wave * 256 + half * 128 + d0 * 16 + hh * 8);
        __syncthreads();
        unsigned w[4][16];
#pragma unroll
        for (int kb = 0; kb < 4; ++kb) { f32x16 pacc = f32x16{};
#pragma unroll
            for (int d0 = 0; d0 < 8; ++d0) { const bf16x8 a = *(const LAS bf16x8*)(SKB + (2 * d0 + hh) * 2048 + (32 * kb + r32) * 16);
                pacc = __builtin_amdgcn_mfma_f32_32x32x16_bf16(a, qf[d0], pacc, 0, 0, 0); }
#pragma unroll
            for (int r = 0; r < 16; ++r) w[kb][r] = (ordkey(pacc[r]) & ~127u) | (unsigned)(127 - (32 * kb + (r & 3) + 8 * (r >> 2))); }
        top16_of64(w);
        unsigned la[16], lb[16];
#pragma unroll
        for (int i = 0; i < 16; ++i) { const unsigned x = w[0][i] ^ (unsigned)(4 * hh); auto rr = __builtin_amdgcn_permlane32_swap(x, x, false, false); la[i] = rr[0]; lb[i] = rr[1]; }
        merge_top16(la, lb);
        { LAS unsigned char* Lk = LK + ((size_t)half * TOK + r32) * LSTR + 8 * hh;
#pragma unroll
          for (int j = 0; j < 8; ++j) { const unsigned kx = hh ? la[8 + j] : la[j]; Lk[j] = (unsigned char)(127u - (kx & 127u)); } }
#pragma unroll
        for (int i = 0; i < 16; ++i) { if (half == 0) l1[i] = la[i]; else l2[i] = la[i]; }
    }
    asm volatile("s_waitcnt lgkmcnt(0)" ::: "memory");
    {
        const LAS unsigned char* L1k = LK + ((size_t)0 * TOK + r32) * LSTR; const LAS unsigned char* L2k = LK + ((size_t)1 * TOK + r32) * LSTR;
        float v1[16], v2[16];
#pragma unroll
        for (int a = 0; a < 16; ++a) { v1[a] = ordinv(l1[a] & ~127u); v2[a] = ordinv(l2[a] & ~127u); }
        unsigned w[4][16]; { int ci = 0;
#define X(a, b) w[ci >> 4][ci & 15] = (ordkey(v1[a] + v2[b]) & ~63u) | (unsigned)(63 - ci); ++ci;
        PEER_CANDS(X)
#undef X
#pragma unroll
          for (int i = 50; i < 64; ++i) w[i >> 4][i & 15] = 0u; }
        const float cmax = v1[0] + v2[0];
        top16_of64(w);
        float ge[8]; float gsum = 0.f; unsigned id[8];
#pragma unroll
        for (int j = 0; j < 8; ++j) { const unsigned kx = hh ? w[0][8 + j] : w[0][j]; id[j] = 63u - (kx & 63u); ge[j] = __expf(ordinv(kx & ~63u) - cmax); gsum += ge[j]; }
        { auto rr = __builtin_amdgcn_permlane32_swap(__float_as_uint(gsum), __float_as_uint(gsum), false, false); gsum = __uint_as_float(rr[0]) + __uint_as_float(rr[1]); }
        const float ginv = 1.0f / gsum;
        LAS Ent* R = (LAS Ent*)(F.lds + OFF_ROUTE) + ((size_t)wave * TOK + r32) * 16 + 8 * hh;
#pragma unroll
        for (int j = 0; j < 8; ++j) { const unsigned ab = CANDT[id[j]]; R[j].k = (unsigned)L1k[ab >> 4] * 128u + (unsigned)L2k[ab & 15u]; R[j].v = ge[j] * ginv; }
    }
}

constexpr int OFF_SORT = 77824;
constexpr int OFF_OFFS = 20480;
constexpr int NRANGE = 16, RSHIFT = 10;
__device__ __forceinline__ float ub0(unsigned w) { return (float)(w & 0xffu); }
__device__ __forceinline__ float ub1(unsigned w) { return (float)((w >> 8) & 0xffu); }
__device__ __forceinline__ float ub2(unsigned w) { return (float)((w >> 16) & 0xffu); }
__device__ __forceinline__ float ub3(unsigned w) { return (float)(w >> 24); }
__device__ __forceinline__ int mbcnt64(unsigned long long m) { return (int)__builtin_amdgcn_mbcnt_hi((unsigned)(m >> 32), __builtin_amdgcn_mbcnt_lo((unsigned)m, 0u)); }

constexpr int OFF_SDN = 0;
__device__ __forceinline__ void sort_token(Frame& F, int tl, int lane) {
    const LAS Ent* R = (const LAS Ent*)(F.lds + OFF_ROUTE); LAS Ent* SO = (LAS Ent*)(F.lds + OFF_SORT) + (size_t)tl * 128; LAS int* OF = (LAS int*)(F.lds + OFF_OFFS) + tl * 17;
    LAS float* SDN = (LAS float*)(F.lds + OFF_SDN) + tl * 128;
    const float* SD = (const float*)(F.ws + WS_EXPD_SC); const float* SU = (const float*)(F.ws + WS_EXPU_SC);
    const LAS Ent* p0 = R + ((size_t)(lane >> 4) * TOK + tl) * 16 + (lane & 15); const LAS Ent* p1 = R + ((size_t)(4 + (lane >> 4)) * TOK + tl) * 16 + (lane & 15);
    const unsigned e0 = p0->k, e1 = p1->k; const float g0 = p0->v * SU[e0], g1 = p1->v * SU[e1]; const float d0 = SD[e0], d1 = SD[e1];
    const int r0 = (int)(e0 >> RSHIFT), r1 = (int)(e1 >> RSHIFT);
    int base = 0, pos0 = 0, pos1 = 0;
#pragma unroll
    for (int r = 0; r < NRANGE; ++r) {
        const unsigned long long m0 = __ballot(r0 == r), m1 = __ballot(r1 == r);
        const int n0 = __popcll(m0), n1 = __popcll(m1);
        if (r0 == r) pos0 = base + mbcnt64(m0);
        if (r1 == r) pos1 = base + n0 + mbcnt64(m1);
        if (lane == 0) OF[r] = base;
        base += n0 + n1;
    }
    if (lane == 0) OF[NRANGE] = base;
    SO[pos0].k = e0; SO[pos0].v = g0; SO[pos1].k = e1; SO[pos1].v = g1; SDN[pos0] = d0; SDN[pos1] = d1;
}

struct Rows4 { v4u r[4]; };
__device__ __forceinline__ void fetch_rows(const unsigned char* tab, const LAS Ent* SO, Rows4& q, int lane) {
    unsigned ex[4];
#pragma unroll
    for (int k = 0; k < 4; ++k) ex[k] = (unsigned)__builtin_amdgcn_readfirstlane((int)SO[k].k);
#pragma unroll
    for (int k = 0; k < 4; ++k) q.r[k] = ((const v4u*)(tab + (size_t)ex[k] * 1024))[lane];
}
__device__ __forceinline__ void down_chunk(const Rows4& q, const int (&xq)[4], float sx, LAS Ent* SO, const LAS float* SDN, int lane) {
    int s[4];
#pragma unroll
    for (int k = 0; k < 4; ++k) { s[k] = 0;
#pragma unroll
        for (int c = 0; c < 4; ++c) s[k] = __builtin_amdgcn_sdot4((int)q.r[k][c], xq[c], s[k], false); }
#pragma unroll
    for (int k = 0; k < 4; ++k) s[k] += __builtin_amdgcn_update_dpp(0, s[k], 0xB1, 0xF, 0xF, true);
#pragma unroll
    for (int k = 0; k < 4; ++k) s[k] += __builtin_amdgcn_update_dpp(0, s[k], 0x4E, 0xF, 0xF, true);
#pragma unroll
    for (int k = 0; k < 4; ++k) s[k] += __builtin_amdgcn_update_dpp(0, s[k], 0x141, 0xF, 0xF, true);
#pragma unroll
    for (int k = 0; k < 4; ++k) s[k] += __builtin_amdgcn_update_dpp(0, s[k], 0x140, 0xF, 0xF, true);
    int dv = 0;
#pragma unroll
    for (int k = 0; k < 4; ++k) { const int dt = (__builtin_amdgcn_readlane(s[k], 0) + __builtin_amdgcn_readlane(s[k], 16)) + (__builtin_amdgcn_readlane(s[k], 32) + __builtin_amdgcn_readlane(s[k], 48)); dv = (lane == k) ? dt : dv; }
    if (lane < 4) { const float hk = SDN[lane] * sx * (float)dv; SO[lane].v = SO[lane].v * gelu_tanh(hk); }
}
struct Rows4h { v2u r[4]; };
__device__ __forceinline__ void fetch_rows_h(const unsigned char* tab, const LAS Ent* SO, Rows4h& q, int lane) {
    unsigned ex[4];
#pragma unroll
    for (int k = 0; k < 4; ++k) ex[k] = (unsigned)__builtin_amdgcn_readfirstlane((int)SO[k].k);
#pragma unroll
    for (int k = 0; k < 4; ++k) q.r[k] = ((const v2u*)(tab + (size_t)ex[k] * 512))[lane];
}
__device__ __forceinline__ void up_chunk_h(const Rows4h& q, unsigned wq4, int (&ya)[8], int (&yb)[8]) {
#pragma unroll
    for (int c = 0; c < 2; ++c) {
        const unsigned r0 = q.r[0][c], r1 = q.r[1][c], r2 = q.r[2][c], r3 = q.r[3][c];
        const unsigned a_lo = __builtin_amdgcn_perm(r1, r0, 0x05010400u), a_hi = __builtin_amdgcn_perm(r1, r0, 0x07030602u);
        const unsigned b_lo = __builtin_amdgcn_perm(r3, r2, 0x05010400u), b_hi = __builtin_amdgcn_perm(r3, r2, 0x07030602u);
        const unsigned t0 = __builtin_amdgcn_perm(b_lo, a_lo, 0x05040100u), t1 = __builtin_amdgcn_perm(b_lo, a_lo, 0x07060302u);
        const unsigned t2 = __builtin_amdgcn_perm(b_hi, a_hi, 0x05040100u), t3 = __builtin_amdgcn_perm(b_hi, a_hi, 0x07060302u);
        ya[4 * c + 0] = __builtin_amdgcn_sdot4((int)t0, (int)wq4, ya[4 * c + 0], false); yb[4 * c + 0] = __builtin_amdgcn_sdot4((int)(t0 & 0x0f0f0f0fu), (int)wq4, yb[4 * c + 0], false);
        ya[4 * c + 1] = __builtin_amdgcn_sdot4((int)t1, (int)wq4, ya[4 * c + 1], false); yb[4 * c + 1] = __builtin_amdgcn_sdot4((int)(t1 & 0x0f0f0f0fu), (int)wq4, yb[4 * c + 1], false);
        ya[4 * c + 2] = __builtin_amdgcn_sdot4((int)t2, (int)wq4, ya[4 * c + 2], false); yb[4 * c + 2] = __builtin_amdgcn_sdot4((int)(t2 & 0x0f0f0f0fu), (int)wq4, yb[4 * c + 2], false);
        ya[4 * c + 3] = __builtin_amdgcn_sdot4((int)t3, (int)wq4, ya[4 * c + 3], false); yb[4 * c + 3] = __builtin_amdgcn_sdot4((int)(t3 & 0x0f0f0f0fu), (int)wq4, yb[4 * c + 3], false);
    }
}

__device__ __forceinline__ void gather_sweep(Frame& F, int tok0) {
    int lane; asm volatile("v_and_b32_e32 %0, 63, %1" : "=v"(lane) : "v"(F.tid));
    const int wave = F.wave;
#pragma unroll 1
    for (int i = 0; i < 4; ++i) sort_token(F, 4 * wave + i, lane);
    const unsigned char* EXPD = F.ws + WS_EXPD; const unsigned char* EXPU = F.ws + WS_EXPU;
    LAS Ent* SOW = (LAS Ent*)(F.lds + OFF_SORT) + (size_t)(4 * wave) * 128; const LAS float* SDW = (const LAS float*)(F.lds + OFF_SDN) + (4 * wave) * 128;
    {
        int xq[4][4]; float sxs[4];
#pragma unroll
        for (int tk = 0; tk < 4; ++tk) {
            const size_t row = (size_t)tok0 + 4 * wave + tk;
            const v4u* hp = (const v4u*)((const bf16*)(F.ws + WS_XN2) + row * DM) + 2 * lane; const f32x4* gp = (const f32x4*)F.in[I_N2G] + 4 * lane;
            float xh[16]; float ss = 0.f;
#pragma unroll
            for (int c = 0; c < 2; ++c) { const v4u w = hp[c]; xh[8 * c] = bf_lo(w.x); xh[8 * c + 1] = bf_hi(w.x); xh[8 * c + 2] = bf_lo(w.y); xh[8 * c + 3] = bf_hi(w.y); xh[8 * c + 4] = bf_lo(w.z); xh[8 * c + 5] = bf_hi(w.z); xh[8 * c + 6] = bf_lo(w.w); xh[8 * c + 7] = bf_hi(w.w); }
#pragma unroll
            for (int e = 0; e < 16; ++e) ss += xh[e] * xh[e];
            const float r = __builtin_amdgcn_rsqf(wave_sum(ss) * (1.f / DM) + EPS);
            float mx = 0.f;
#pragma unroll
            for (int c = 0; c < 4; ++c) { const f32x4 g = gp[c]; xh[4 * c] *= r * g.x; xh[4 * c + 1] *= r * g.y; xh[4 * c + 2] *= r * g.z; xh[4 * c + 3] *= r * g.w;
                mx = fmaxf(mx, fmaxf(fmaxf(fabsf(xh[4 * c]), fabsf(xh[4 * c + 1])), fmaxf(fabsf(xh[4 * c + 2]), fabsf(xh[4 * c + 3])))); }
#pragma unroll
            for (int o = 1; o < 64; o <<= 1) mx = fmaxf(mx, __shfl_xor(mx, o));
            mx = __uint_as_float((unsigned)__builtin_amdgcn_readfirstlane((int)__float_as_uint(mx)));
            const float step = mx > 0.f ? mx * (1.0f / 127.0f) : 1.0f, inv = 1.0f / step;
            sxs[tk] = step;
#pragma unroll
            for (int c = 0; c < 4; ++c) { const unsigned b0 = (unsigned)(int)rintf(xh[4 * c] * inv) & 0xffu, b1 = (unsigned)(int)rintf(xh[4 * c + 1] * inv) & 0xffu, b2 = (unsigned)(int)rintf(xh[4 * c + 2] * inv) & 0xffu, b3 = (unsigned)(int)rintf(xh[4 * c + 3] * inv) & 0xffu;
                xq[tk][c] = (int)(b0 | (b1 << 8) | (b2 << 16) | (b3 << 24)); }
        }
        asm volatile("s_waitcnt lgkmcnt(0)" ::: "memory");
        Rows4 b0, b1, b2, b3, b4, b5, b6, b7;
#define P1_FETCH(buf, u, j) fetch_rows(EXPD, SOW + ((u) & 3) * 128 + 4 * (2 * (j) + ((u) >> 2)), buf, lane)
#define P1_STEP(buf, u) do { down_chunk(buf, xq[(u) & 3], sxs[(u) & 3], SOW + ((u) & 3) * 128 + 4 * (2 * j + ((u) >> 2)), SDW + ((u) & 3) * 128 + 4 * (2 * j + ((u) >> 2)), lane); \
        if (j < 15) P1_FETCH(buf, u, j + 1); } while (0)
        P1_FETCH(b0, 0, 0); P1_FETCH(b1, 1, 0); P1_FETCH(b2, 2, 0); P1_FETCH(b3, 3, 0); P1_FETCH(b4, 4, 0); P1_FETCH(b5, 5, 0); P1_FETCH(b6, 6, 0); P1_FETCH(b7, 7, 0);
#pragma unroll 1
        for (int j = 0; j < 16; ++j) { P1_STEP(b0, 0); P1_STEP(b1, 1); P1_STEP(b2, 2); P1_STEP(b3, 3); P1_STEP(b4, 4); P1_STEP(b5, 5); P1_STEP(b6, 6); P1_STEP(b7, 7); }
#undef P1_FETCH
#undef P1_STEP
    }
    asm volatile("s_waitcnt lgkmcnt(0)" ::: "memory");
    constexpr int OFF_W8 = 16384;
    float wsc[4]; int wsum[4];
#pragma unroll
    for (int tk = 0; tk < 4; ++tk) {
        const float w0 = SOW[tk * 128 + lane].v, w1 = SOW[tk * 128 + 64 + lane].v;
        float mx = fmaxf(fabsf(w0), fabsf(w1));
#pragma unroll
        for (int o = 1; o < 64; o <<= 1) mx = fmaxf(mx, __shfl_xor(mx, o));
        mx = __uint_as_float((unsigned)__builtin_amdgcn_readfirstlane((int)__float_as_uint(mx)));
        const float step = mx > 0.f ? mx * (1.0f / 127.0f) : 1.0f, inv = 1.0f / step; wsc[tk] = step;
        LAS unsigned char* W8 = F.lds + OFF_W8 + (4 * wave + tk) * 128;
        const int q0 = (int)rintf(w0 * inv), q1 = (int)rintf(w1 * inv);
        W8[lane] = (unsigned char)(q0 & 0xff); W8[64 + lane] = (unsigned char)(q1 & 0xff);
        int qs = q0 + q1;
#pragma unroll
        for (int o = 1; o < 64; o <<= 1) qs += __shfl_xor(qs, o);
        wsum[tk] = __builtin_amdgcn_readfirstlane(qs);
    }
    asm volatile("s_waitcnt lgkmcnt(0)" ::: "memory");
    { TMS_BEGIN(14);
        int ya[4][8], yb[4][8];
#pragma unroll
        for (int tk = 0; tk < 4; ++tk)
#pragma unroll
            for (int e = 0; e < 8; ++e) { ya[tk][e] = 0; yb[tk][e] = 0; }
        const LAS unsigned* W8W = (const LAS unsigned*)(F.lds + OFF_W8 + (4 * wave) * 128);
        Rows4h b0, b1, b2, b3, b4, b5, b6, b7;
#define P2_FETCH(buf, u, j) fetch_rows_h(EXPU, SOW + ((u) & 3) * 128 + 4 * (2 * (j) + ((u) >> 2)), buf, lane)
#define P2_STEP(buf, u) do { up_chunk_h(buf, (unsigned)__builtin_amdgcn_readfirstlane((int)W8W[((u) & 3) * 32 + 2 * j + ((u) >> 2)]), ya[(u) & 3], yb[(u) & 3]); if (j < 15) P2_FETCH(buf, u, j + 1); } while (0)
        P2_FETCH(b0, 0, 0); P2_FETCH(b1, 1, 0); P2_FETCH(b2, 2, 0); P2_FETCH(b3, 3, 0); P2_FETCH(b4, 4, 0); P2_FETCH(b5, 5, 0); P2_FETCH(b6, 6, 0); P2_FETCH(b7, 7, 0);
#pragma unroll 1
        for (int j = 0; j < 16; ++j) { P2_STEP(b0, 0); P2_STEP(b1, 1); P2_STEP(b2, 2); P2_STEP(b3, 3); P2_STEP(b4, 4); P2_STEP(b5, 5); P2_STEP(b6, 6); P2_STEP(b7, 7); }
#undef P2_FETCH
#undef P2_STEP
        int yi[4][16];
#pragma unroll
        for (int tk = 0; tk < 4; ++tk)
#pragma unroll
            for (int e = 0; e < 8; ++e) { yi[tk][2 * e] = yb[tk][e] - 8 * wsum[tk]; yi[tk][2 * e + 1] = (ya[tk][e] - yb[tk][e]) >> 4; }
#pragma unroll
        for (int tk = 0; tk < 4; ++tk) {
            const size_t row = (size_t)tok0 + 4 * wave + tk;
            const v4u* hb = (const v4u*)((const bf16*)(F.ws + WS_XN2) + row * DM) + 2 * lane; f32x4* hp = (f32x4*)(F.out + row * DM) + 4 * lane; const f32x4* gp = (const f32x4*)F.in[I_NFG] + 4 * lane;
            float hv[16]; float ss = 0.f; const float ws = wsc[tk];
#pragma unroll
            for (int c = 0; c < 2; ++c) { const v4u w = hb[c]; hv[8 * c] = bf_lo(w.x); hv[8 * c + 1] = bf_hi(w.x); hv[8 * c + 2] = bf_lo(w.y); hv[8 * c + 3] = bf_hi(w.y); hv[8 * c + 4] = bf_lo(w.z); hv[8 * c + 5] = bf_hi(w.z); hv[8 * c + 6] = bf_lo(w.w); hv[8 * c + 7] = bf_hi(w.w); }
#ifdef TIMER_PHASE
            float sy_ = 0.f;
#pragma unroll
            for (int e = 0; e < 16; ++e) { const float yy = ws * (float)yi[tk][e]; sy_ += yy * yy; }
            sy_ = wave_sum(sy_);
#endif
#pragma unroll
            for (int e = 0; e < 16; ++e) { hv[e] += ws * (float)yi[tk][e]; ss += hv[e] * hv[e]; }
#ifdef TIMER_PHASE
            const float st_ = wave_sum(ss);
            if (TIMER_PHASE == 15 && lane == 0) { atomicAdd((unsigned*)(F.lds + RING_BYTES + 512), (unsigned)(1e5f * sy_ / st_ * (1.f / 64.f))); }
#endif
            const float r = __builtin_amdgcn_rsqf(wave_sum(ss) * (1.f / DM) + EPS);
#pragma unroll
            for (int c = 0; c < 4; ++c) { const f32x4 g = gp[c]; hp[c] = (f32x4){hv[4 * c] * r * g.x, hv[4 * c + 1] * r * g.y, hv[4 * c + 2] * r * g.z, hv[4 * c + 3] * r * g.w}; }
        }
    TMS_END(14); }
}

__device__ __forceinline__ void peer_phase(Frame& F, bool never) {
    (void)never;
    for (int task = F.bid; task < MTOK / TOK; task += F.G) {
        const int tok0 = task * TOK;
        { TMS_BEGIN(10); route_task(F, tok0);
        __syncthreads(); TMS_END(10); }
        { TMS_BEGIN(11); gather_sweep(F, tok0);
        __syncthreads(); TMS_END(11); }
    }
}
}
#define XB_TMO      128
#define XB_XCNT(j)  (256  + 64 * (j))
#define XB_XSUB(j)  (1280 + 64 * (j))
#define XB_XGEN(j)  (2304 + 64 * (j))
#define XB_TOP      3328
#define XB_TOPGEN   3392
#define XCD_BAR_WORDS 3456
#define XB_SPIN_CAP (1u << 18)

__device__ __forceinline__ unsigned xb_ld(unsigned* p)              { return __hip_atomic_load(p, __ATOMIC_RELAXED, __HIP_MEMORY_SCOPE_AGENT); }
__device__ __forceinline__ unsigned xb_add(unsigned* p, unsigned v) { return __hip_atomic_fetch_add(p, v, __ATOMIC_RELAXED, __HIP_MEMORY_SCOPE_AGENT); }
__device__ __forceinline__ unsigned xb_xcc_id() { return (unsigned)__builtin_amdgcn_s_getreg((3 << 11) | 20) & 0xFu; }
#define XB_SPIN(cond, bar) do { unsigned _sp = 0; while (cond) { __builtin_amdgcn_s_sleep(1); \
    if ((++_sp & 255u) == 0u) { if (xb_ld(&(bar)[XB_TMO])) break; if (_sp > XB_SPIN_CAP) { atomicAdd(&(bar)[XB_TMO], 1u); break; } } } } while (0)

struct XcdBarrier {
    unsigned* bar; unsigned x;
    volatile LAS unsigned* st;
};

__device__ __forceinline__ XcdBarrier xcd_barrier_post(unsigned* bar, volatile LAS unsigned* st) {
    XcdBarrier b; b.bar = bar; b.x = xb_xcc_id(); b.st = st;
    if (threadIdx.x == 0) (void)xb_add(&bar[XB_XCNT(b.x)], 1u);
    return b;
}
__device__ __forceinline__ void xcd_barrier_complete(unsigned* bar, unsigned x, unsigned& nloc, unsigned& nx) {
    const unsigned G = gridDim.x * gridDim.y * gridDim.z;
    unsigned sum, cnt, mine, sp = 0u;
    for (;;) {
        sum = 0u; cnt = 0u; mine = 0u;
#pragma unroll
        for (unsigned j = 0; j < 16; ++j) { const unsigned c = xb_ld(&bar[XB_XCNT(j)]); sum += c; cnt += (c > 0u) ? 1u : 0u; mine = (j == x) ? c : mine; }
        if (sum == G) break;
        __builtin_amdgcn_s_sleep(1);
        if ((++sp & 255u) == 0u) { if (xb_ld(&bar[XB_TMO])) break; if (sp > XB_SPIN_CAP) { atomicAdd(&bar[XB_TMO], 1u); break; } }
    }
    nloc = mine > 0u ? mine : 1u; nx = cnt > 0u ? cnt : 1u;
}

__device__ __forceinline__ void xcd_barrier(const XcdBarrier& b) {
    asm volatile("s_waitcnt vmcnt(0)" ::: "memory");
    __syncthreads();
    if (threadIdx.x == 0) {
        unsigned* bar = b.bar;
        __builtin_amdgcn_s_waitcnt(0);
        unsigned nloc = b.st[0], nx = b.st[1];
        if (nloc == 0u) { xcd_barrier_complete(bar, b.x, nloc, nx); b.st[0] = nloc; b.st[1] = nx; }
        const unsigned old = xb_add(&bar[XB_XSUB(b.x)], 1u);
        const unsigned gen = old / nloc;
        if (old + 1u == (gen + 1u) * nloc) {
            __builtin_amdgcn_fence(__ATOMIC_RELEASE, "agent");
            asm volatile("s_waitcnt vmcnt(0)" ::: "memory");
            const unsigned og = xb_add(&bar[XB_TOP], 1u);
            const unsigned tg = og / nx;
            if (og + 1u == (tg + 1u) * nx) xb_add(&bar[XB_TOPGEN], 1u);
            else XB_SPIN(xb_ld(&bar[XB_TOPGEN]) == tg, bar);
            __builtin_amdgcn_fence(__ATOMIC_ACQUIRE, "agent");
            xb_add(&bar[XB_XGEN(b.x)], 1u);
            asm volatile("s_waitcnt vmcnt(0)" ::: "memory");
        } else {
            XB_SPIN(xb_ld(&bar[XB_XGEN(b.x)]) == gen, bar);
            __builtin_amdgcn_fence(__ATOMIC_ACQUIRE, "agent");
            asm volatile("s_waitcnt vmcnt(0)" ::: "memory");
        }
    }
    __syncthreads();
}

#ifndef MK_ONE_LAUNCH
#define MK_ONE_LAUNCH 1
#endif
#ifndef DBL_MASK
#define DBL_MASK 0
#endif
constexpr int N_PHASES = 9;
struct Args { const void* in[N_IN]; float* out; unsigned char* ws; int ph_lo, ph_hi; };
#define PHASE_FN __device__ __forceinline__ void
#define PHASE_FRAME \
    Frame F; F.lds = (LAS unsigned char*)(uintptr_t)(unsigned)__builtin_amdgcn_readfirstlane((int)ldsaddr); F.tid = threadIdx.x; F.lane = F.tid & 63; F.wave = __builtin_amdgcn_readfirstlane(F.tid >> 6); \
    F.G = gridDim.x; F.bid = blockIdx.x; F.in = (const float* const*)ap->in; F.pos = (const int*)ap->in[I_POS]; F.out = ap->out; F.ws = ap->ws; unsigned char* ws = F.ws; (void)ws;
#define REP(k) for (int rep_ = 0; rep_ < (((DBL_MASK >> (k)) & 1) ? 2 : 1); ++rep_)

PHASE_FN ph_prologue(const Args* ap, unsigned ldsaddr) { PHASE_FRAME REP(0) p0_prologue(F); }
PHASE_FN ph_inproj(const Args* ap, unsigned ldsaddr) { PHASE_FRAME REP(1) {
    pg8::StaticOrder S;
    pg8::Gemm g = pg8::make_gemm((const bf16*)(ws + WS_XN), 1024, (const bf16*)(ws + WS_WIN), 1024, MTOK, NPROJ, 1024);
    S.init(MTOK, NPROJ, F.G, F.bid);
    EpiInProj E{(bf16*)(ws + WS_QKV), (bf16*)(ws + WS_CQ), (bf16*)(ws + WS_MISC), (bf16*)(ws + WS_GATES), (float*)(ws + WS_SSQ), (float*)(ws + WS_SSKV)};
    pg8::gemm_phase<EpiInProj, pg8::StaticOrder, true>(F.lds, g, S, E); } }
PHASE_FN ph_upq(const Args* ap, unsigned ldsaddr) { PHASE_FRAME REP(2) {
    pg8::StaticOrder S;
    pg8::Gemm g = pg8::make_gemm((const bf16*)(ws + WS_CQ), 256, (const bf16*)(ws + WS_WUQ), 256, MTOK, 768, 256);
    S.init(MTOK, 768, F.G, F.bid);
    EpiRowScale<256> E{(const float*)(ws + WS_SSQ), (bf16*)(ws + WS_MLAQ), 768, QSCALE_MLA};
    pg8::gemm_phase<EpiRowScale<256>, pg8::StaticOrder, true>(F.lds, g, S, E); } }
PHASE_FN ph_upkv(const Args* ap, unsigned ldsaddr) { PHASE_FRAME REP(2) {
    pg8::StaticOrder S;
    pg8::Gemm g = pg8::make_gemm((const bf16*)(ws + WS_MISC), 256, (const bf16*)(ws + WS_WUKV), 256, MTOK, 1024, 256);
    S.init(MTOK, 1024, F.G, F.bid);
    EpiRowScale<128> E{(const float*)(ws + WS_SSKV), (bf16*)(ws + WS_MLAKV), 1024, 1.0f};
    pg8::gemm_phase<EpiRowScale<128>, pg8::StaticOrder, true>(F.lds, g, S, E); } }
PHASE_FN ph_cmpu(const Args* ap, unsigned ldsaddr) { PHASE_FRAME REP(2) {
    pg8::StaticOrder S;
#pragma unroll 1
    for (int ks = 0; ks < 8; ++ks) { const int kv = ks >> 2, s = ks & 3;
        pg8::Gemm g; g.A = (const bf16*)(ws + WS_QKV) + 512 + 128 * kv + (size_t)s * 4 * 1280; g.Bt = (const bf16*)(ws + (kv ? WS_WC1V : WS_WC1K)) + s * 256; g.M = 2048; g.N = 256; g.K = 256;
        g.aRow = (size_t)16 * 1280 * 2; g.aHalf = 128; g.aTile = (size_t)SEQ * 1280 * 2; g.aK = (size_t)1280 * 2; g.bRow = 1024 * 2;
        S.init(2048, 256, F.G, (F.bid + F.G - (192 + 8 * ks) % F.G) % F.G);
        EpiF32 E{(float*)(ws + WS_USLAB) + (size_t)ks * 2048 * 256, 256, nullptr};
        pg8::gemm_phase<EpiF32, pg8::StaticOrder, true>(F.lds, g, S, E);
    }
    kpe_pass(F); } }
PHASE_FN ph_cmpfin(const Args* ap, unsigned ldsaddr) { PHASE_FRAME REP(3) cmp_finalize(F); }
PHASE_FN ph_nsa(const Args* ap, unsigned ldsaddr) { PHASE_FRAME REP(10) { TMS_BEGIN(30); att::nsa_loop(F); TMS_END(30); } }
PHASE_FN ph_mla(const Args* ap, unsigned ldsaddr) { PHASE_FRAME REP(11) { TMS_BEGIN(31); att::mla_loop(F); TMS_END(31); } }
PHASE_FN ph_branch(const Args* ap, unsigned ldsaddr) { PHASE_FRAME REP(5) {
    pg8::ChainOrder S; S.init(MTOK, 1024, F.G, F.bid);
    pg8::Gemm g = pg8::make_gemm((const bf16*)(ws + WS_OCAT), 1024, (const bf16*)(ws + WS_WBR), 1024, MTOK, 1024, 512); g.aSeg = 1024; g.bSeg = 1024;
    EpiGateChain E{(const bf16*)(ws + WS_GATES), (bf16*)(ws + WS_MERGED)};
    pg8::gemm_phase<EpiGateChain, pg8::ChainOrder, true, true>(F.lds, g, S, E);
    quant_table<true>(F, F.in[I_EDN], ws + WS_EXPD, (float*)(ws + WS_EXPD_SC)); } }
PHASE_FN ph_outproj(const Args* ap, unsigned ldsaddr) { PHASE_FRAME REP(6) {
    pg8::StaticOrder S; S.init(MTOK, 1024, F.G, F.bid);
    pg8::Gemm g = pg8::make_gemm((const bf16*)(ws + WS_MERGED), 1024, (const bf16*)(ws + WS_WOUT), 1024, MTOK, 1024, 1024);
    EpiResid E{F.in[I_X], (bf16*)(ws + WS_XN2), (float*)(ws + WS_SS)};
    pg8::gemm_phase<EpiResid, pg8::StaticOrder, true>(F.lds, g, S, E);
    quant_table4(F, F.in[I_EUP], ws + WS_EXPU, (float*)(ws + WS_EXPU_SC)); } }
PHASE_FN ph_peerq(const Args* ap, unsigned ldsaddr) { PHASE_FRAME REP(8) {
    pg8::StaticOrder S; S.init(MTOK, 2048, F.G, F.bid);
    pg8::Gemm g = pg8::make_gemm((const bf16*)(ws + WS_XN2), 1024, (const bf16*)(ws + WS_WPQ), 1024, MTOK, 2048, 1024);
    EpiRowSS E{(const float*)(ws + WS_SS), (bf16*)(ws + WS_QP), 2048};
    pg8::gemm_phase<EpiRowSS, pg8::StaticOrder, true>(F.lds, g, S, E); } }
PHASE_FN ph_peer(const Args* ap, unsigned ldsaddr) { PHASE_FRAME peer::peer_phase(F, ap->ph_lo < 0); }

__global__ void __launch_bounds__(NTHREADS, 2) fwd(Args a) {
    extern __shared__ __attribute__((aligned(16))) unsigned char lds_raw[];
    const unsigned ldsaddr = (unsigned)(uintptr_t)(LAS unsigned char*)lds_raw;
    const int lo = a.ph_lo, hi = a.ph_hi;
#define IN(k) (lo <= (k) && (k) < hi)
    { LAS unsigned* misc = (LAS unsigned*)((LAS unsigned char*)lds_raw + RING_BYTES); if (threadIdx.x < 256) misc[threadIdx.x] = 0u; }
    __syncthreads();
    XcdBarrier bar = xcd_barrier_post((unsigned*)(a.ws + WS_CTL) + 4096, (volatile LAS unsigned*)((LAS unsigned char*)lds_raw + RING_BYTES) + 8);
#define SEAM(k) do { if (IN(k) && IN((k) + 1)) { if (MK_ONE_LAUNCH) xcd_barrier(bar); } } while (0)
#ifdef TIMER_PHASE
    unsigned long long tm_t0 = 0, tm_acc = 0;
#define TM_BEGIN(k) do { if ((k) == TIMER_PHASE) tm_t0 = __builtin_amdgcn_s_memrealtime(); } while (0)
#define TM_END(k) do { if ((k) == TIMER_PHASE) tm_acc += __builtin_amdgcn_s_memrealtime() - tm_t0; } while (0)
#else
#define TM_BEGIN(k) do {} while (0)
#define TM_END(k) do {} while (0)
#endif
    TM_BEGIN(0);
    if (IN(0)) ph_prologue(&a, ldsaddr);
    if (IN(0) && IN(1)) { if (MK_ONE_LAUNCH) xcd_barrier(bar); }
    TM_END(0); TM_BEGIN(1);
    if (IN(1)) ph_inproj(&a, ldsaddr);
    SEAM(1);
    TM_END(1); TM_BEGIN(2);
    if (IN(2)) { ph_upq(&a, ldsaddr); ph_upkv(&a, ldsaddr); ph_cmpu(&a, ldsaddr); }
    SEAM(2);
    TM_END(2); TM_BEGIN(3);
    if (IN(3)) ph_cmpfin(&a, ldsaddr);
    SEAM(3);
    TM_END(3); TM_BEGIN(4);
#ifdef TIMER_PHASE
    const unsigned long long clk0_ = (TIMER_PHASE == 9) ? __builtin_amdgcn_s_memtime() : 0ull;
#endif
    if (IN(4)) { ph_nsa(&a, ldsaddr); ph_mla(&a, ldsaddr); }
#ifdef TIMER_PHASE
    if (TIMER_PHASE == 9) tm_acc = (__builtin_amdgcn_s_memtime() - clk0_) / 100ull;
#endif
    SEAM(4);
    TM_END(4); TM_BEGIN(5);
    if (IN(5)) ph_branch(&a, ldsaddr);
    SEAM(5);
    TM_END(5); TM_BEGIN(6);
    if (IN(6)) ph_outproj(&a, ldsaddr);
    SEAM(6);
    TM_END(6); TM_BEGIN(7);
    if (IN(7)) ph_peerq(&a, ldsaddr);
    SEAM(7);
    TM_END(7); TM_BEGIN(8);
    if (IN(8)) ph_peer(&a, ldsaddr);
    TM_END(8);
#ifdef TIMER_PHASE
    if (TIMER_PHASE >= 10) tm_acc = *(LAS unsigned long long*)((LAS unsigned char*)lds_raw + RING_BYTES + 512);
    __syncthreads();
    if (blockIdx.x == 0 && threadIdx.x == 0) { asm volatile("s_waitcnt vmcnt(0)" ::: "memory"); a.out[0] += (float)tm_acc * 0.001f; }
#endif
#undef IN
#undef SEAM
}

extern "C" void kernel_launch(void* const* d_in, const int* in_sizes, int n_in, void* d_out, int out_size, void* d_ws, size_t ws_size, hipStream_t stream) {
    static int grid = 0;
    if (grid == 0) {
        if (n_in != N_IN || out_size != MTOK * DM || ws_size < WS_END) { fprintf(stderr, "kernel_launch: unexpected shapes (n_in %d, out %d, ws %zu)\n", n_in, out_size, ws_size); grid = -1; return; }
        int dev = 0, cus = 0, per_cu = 0;
        if (hipGetDevice(&dev) != hipSuccess || hipDeviceGetAttribute(&cus, hipDeviceAttributeMultiprocessorCount, dev) != hipSuccess) { grid = -1; return; }
        if (hipFuncSetAttribute((const void*)fwd, hipFuncAttributeMaxDynamicSharedMemorySize, LDS_BYTES) != hipSuccess) { fprintf(stderr, "kernel_launch: hipFuncSetAttribute failed\n"); grid = -1; return; }
        if (hipOccupancyMaxActiveBlocksPerMultiprocessor(&per_cu, (const void*)fwd, NTHREADS, LDS_BYTES) != hipSuccess || per_cu < 1) { fprintf(stderr, "kernel_launch: occupancy query says %d\n", per_cu); (void)hipGetLastError(); grid = -1; return; }
        grid = cus;
    }
    if (grid < 0) return;
    Args a{};
    for (int i = 0; i < N_IN; ++i) a.in[i] = d_in[i];
    a.out = (float*)d_out; a.ws = (unsigned char*)d_ws;
#if MK_ONE_LAUNCH
    if (hipMemsetAsync((char*)d_ws + WS_CTL, 0, 65536, stream) != hipSuccess) { fprintf(stderr, "kernel_launch: hipMemsetAsync failed\n"); return; }
    a.ph_lo = 0; a.ph_hi = N_PHASES;
    void* args[] = {&a};
    hipError_t e = hipLaunchCooperativeKernel((const void*)fwd, dim3(grid), dim3(NTHREADS), args, LDS_BYTES, stream);
    if (e != hipSuccess) fprintf(stderr, "kernel_launch: cooperative launch failed: %s (grid %d)\n", hipGetErrorString(e), grid);
#else
    for (int p = 0; p < N_PHASES; ++p) { a.ph_lo = p; a.ph_hi = p + 1; hipLaunchKernelGGL(fwd, dim3(grid), dim3(NTHREADS), LDS_BYTES, stream, a); }
#endif
}
```

```cpp
#define DBL_MASK 0
#include <hip/hip_runtime.h>
#include <cstdio>
#include <cstdint>
#include <cmath>
namespace pg8 {
#define PG8_LAS __attribute__((address_space(3)))
typedef unsigned short bf16_t;
typedef short bf16x8 __attribute__((ext_vector_type(8)));
typedef float f32x4 __attribute__((ext_vector_type(4)));
typedef unsigned u32x4 __attribute__((ext_vector_type(4)));
constexpr int BM = 256, BK = 64, HALF = 128, HTB = HALF * BK * 2  , STAGE_BYTES = 8 * HTB, NXCD = 8, WGM = 8;

__host__ __device__ __forceinline__ int lds_byte(int r, int c) { const int st = (r >> 4) * 2 + (c >> 5), rr = r & 15, cc = c & 31, ob = rr * 64 + cc * 2; return st * 1024 + (ob ^ (((ob >> 9) & 1) << 5)); }
__host__ __device__ __forceinline__ void stage_rc(int b, int& R, int& C) { const int st = b / 1024, sb = b % 1024, swz = sb ^ (((sb >> 9) & 1) << 5); R = (st >> 1) * 16 + swz / 64; C = (st & 1) * 32 + (swz % 64) / 2; }
__host__ __device__ __forceinline__ int perm32(int rho) { const int n = rho >> 4, i = rho & 15; return 8 * (i >> 2) + 4 * n + (i & 3); }

struct Unit { int pm, pn, seg; };
struct Gemm { const bf16_t* A; const bf16_t* Bt; int M, N, K; size_t aRow, aHalf, aTile, aK, bRow, aSeg, bSeg; };
__host__ __device__ __forceinline__ Gemm make_gemm(const bf16_t* A, int lda, const bf16_t* Bt, int ldb, int M, int N, int K) {
    Gemm g; g.A = A; g.Bt = Bt; g.M = M; g.N = N; g.K = K; g.aRow = (size_t)lda * 2; g.aHalf = (size_t)HALF * lda * 2; g.aTile = (size_t)BM * lda * 2; g.aK = BK * 2; g.bRow = (size_t)ldb * 2; g.aSeg = 0; g.bSeg = 0; return g; }

struct StaticOrder {
    int nM, nN, nwg, G, c;
    __host__ __device__ void init(int M, int N, int G_, int c_) { nM = M / BM; nN = N / BM; nwg = nM * nN; G = G_; c = c_; }
    __host__ __device__ bool next(int i, Unit& u) const {
        const long L = (long)i * G + c; if (L >= nwg) return false;
        int wgid = (int)L; { const int q = nwg / NXCD, r = nwg % NXCD, xcd = wgid % NXCD, off = wgid / NXCD; wgid = (xcd < r ? xcd * (q + 1) : r * (q + 1) + (xcd - r) * q) + off; }
        const int nig = WGM * nN, gid = wgid / nig, fm = gid * WGM, gsz = (nM - fm) < WGM ? (nM - fm) : WGM;
        u.pm = fm + ((wgid % nig) % gsz); u.pn = (wgid % nig) / gsz; u.seg = 0; return true;
    }
};
struct ChainOrder : StaticOrder {
    __host__ __device__ bool next(int i, Unit& u) const { if (!StaticOrder::next(i >> 1, u)) return false; u.seg = i & 1; return true; }
};

__device__ __forceinline__ unsigned cvt_pk_bf16(float lo, float hi) { unsigned r; asm volatile("v_cvt_pk_bf16_f32 %0, %1, %2" : "=v"(r) : "v"(lo), "v"(hi)); return r; }

template <class Epi, class Sched, bool ALIGN_EPI, bool CHAIN = false>
__device__ __forceinline__ void gemm_phase(PG8_LAS unsigned char* lds, const Gemm g, const Sched& S, const Epi& E) {
    const int tid = threadIdx.x, wid = __builtin_amdgcn_readfirstlane(tid >> 6), lane = tid & 63, wr = wid >> 2, wc = wid & 3, fr = lane & 15, fq = lane >> 4;
    const int K = g.K, nt = K / BK;
    unsigned voffA[2], voffB[2];
#pragma unroll
    for (int i = 0; i < 2; ++i) { int R, C; stage_rc(tid * 16 + i * 8192, R, C); const int Rb = Epi::PERM ? ((R & ~31) + perm32(R & 31)) : R;
        voffA[i] = (unsigned)((size_t)R * g.aRow + (size_t)C * 2); voffB[i] = (unsigned)((size_t)Rb * g.bRow + (size_t)C * 2); }
    const size_t kstepA = g.aK, kstepB = (size_t)(BK * 2);
    const size_t hstepA = g.aHalf, hstepB = (size_t)HALF * g.bRow;
    const size_t tstepA = g.aTile, tstepB = (size_t)BM * g.bRow;
    const unsigned ldsw = (unsigned)wid * 1024u;
    const int aoff = lds_byte(wr * 64 + fr, fq * 8), boff = lds_byte(wc * 32 + fr, fq * 8);
#define PG8_SA(b, h) (((b) * 2 + (h)) * HTB)
#define PG8_SB(b, h) ((4 + (b) * 2 + (h)) * HTB)
#define PG8_STAGE(bufoff, gbase, voff) do { _Pragma("unroll") for (int _i = 0; _i < 2; ++_i) \
        __builtin_amdgcn_global_load_lds((const unsigned*)((const char*)(gbase) + (voff)[_i]), (PG8_LAS unsigned*)(lds + (bufoff) + ldsw + _i * 8192), 16, 0, 0); } while (0)
#define PG8_LDA(dst, b, h) do { _Pragma("unroll") for (int m = 0; m < 4; ++m) _Pragma("unroll") for (int k = 0; k < 2; ++k) dst[m][k] = *(const PG8_LAS bf16x8*)(lds + PG8_SA(b, h) + aoff + m * 2048 + k * 1024); } while (0)
#define PG8_LDB(dst, b, h) do { _Pragma("unroll") for (int n = 0; n < 2; ++n) _Pragma("unroll") for (int k = 0; k < 2; ++k) dst[n][k] = *(const PG8_LAS bf16x8*)(lds + PG8_SB(b, h) + boff + n * 2048 + k * 1024); } while (0)
#define PG8_MMA(ai, bj, At, Bt) do { __builtin_amdgcn_s_setprio(1); _Pragma("unroll") for (int m = 0; m < 4; ++m) _Pragma("unroll") for (int n = 0; n < 2; ++n) _Pragma("unroll") for (int k = 0; k < 2; ++k) \
        acc[ai][bj][m][n] = __builtin_amdgcn_mfma_f32_16x16x32_bf16(Bt[n][k], At[m][k], acc[ai][bj][m][n], 0, 0, 0); __builtin_amdgcn_s_setprio(0); } while (0)
#define PG8_WAIT_V(n) asm volatile("s_waitcnt vmcnt(" #n ")" ::: "memory")
#define PG8_WAIT_L(n) asm volatile("s_waitcnt lgkmcnt(" #n ")" ::: "memory")
#define PG8_BAR __builtin_amdgcn_s_barrier()
#define PG8_SCHED __builtin_amdgcn_sched_barrier(0)
    Unit cur, nxt; int ui = 0;
    if (!S.next(0, cur)) return;
    f32x4 acc[2][2][4][2];
#pragma unroll
    for (int a = 0; a < 2; ++a)
#pragma unroll
        for (int b = 0; b < 2; ++b)
#pragma unroll
            for (int m = 0; m < 4; ++m)
#pragma unroll
                for (int n = 0; n < 2; ++n) acc[a][b][m][n] = (f32x4){0.f, 0.f, 0.f, 0.f};
    bf16x8 At[4][2], B0[2][2], B1[2][2];
    const char* cA = (const char*)g.A + (size_t)cur.pm * tstepA + ((CHAIN && cur.seg) ? g.aSeg : 0); const char* cB = (const char*)g.Bt + (size_t)cur.pn * tstepB + ((CHAIN && cur.seg) ? g.bSeg : 0);
    PG8_STAGE(PG8_SB(0, 0), cB, voffB); PG8_STAGE(PG8_SB(0, 1), cB + hstepB, voffB); PG8_STAGE(PG8_SA(0, 0), cA, voffA); PG8_STAGE(PG8_SA(0, 1), cA + hstepA, voffA);
    if (wr == 1) PG8_BAR;
    PG8_WAIT_V(2); PG8_BAR;
    PG8_STAGE(PG8_SB(1, 0), cB + kstepB, voffB); PG8_STAGE(PG8_SA(1, 0), cA + kstepA, voffA); PG8_STAGE(PG8_SB(1, 1), cB + hstepB + kstepB, voffB);
    PG8_WAIT_V(6); PG8_BAR;
    for (;;) {
        const bool has_next = S.next(ui + 1, nxt);
        const char* nA = has_next ? (const char*)g.A + (size_t)nxt.pm * tstepA + ((CHAIN && nxt.seg) ? g.aSeg : 0) : cA; const char* nB = has_next ? (const char*)g.Bt + (size_t)nxt.pn * tstepB + ((CHAIN && nxt.seg) ? g.bSeg : 0) : cB;
        for (int t = 0; t < nt; t += 2) {
            const bool last = (t == nt - 2);
            const char* a1 = cA + (size_t)(t + 1) * kstepA;
            const char* a2 = last ? nA : cA + (size_t)(t + 2) * kstepA; const char* b2 = last ? nB : cB + (size_t)(t + 2) * kstepB;
            const char* a3 = a2 + kstepA; const char* b3 = b2 + kstepB;
            PG8_LDB(B0, 0, 0); PG8_LDB(B1, 0, 1); PG8_SCHED; PG8_LDA(At, 0, 0); PG8_STAGE(PG8_SA(1, 1), a1 + hstepA, voffA);
            PG8_WAIT_V(8); PG8_WAIT_L(0); PG8_BAR; PG8_MMA(0, 0, At, B0); PG8_MMA(0, 1, At, B1); PG8_BAR; PG8_SCHED;
            PG8_LDA(At, 0, 1); PG8_STAGE(PG8_SB(0, 0), b2, voffB); PG8_STAGE(PG8_SB(0, 1), b2 + hstepB, voffB); PG8_STAGE(PG8_SA(0, 0), a2, voffA);
            PG8_WAIT_V(8); PG8_WAIT_L(0); PG8_BAR; PG8_MMA(1, 0, At, B0); PG8_MMA(1, 1, At, B1); PG8_BAR; PG8_SCHED;
            PG8_LDB(B0, 1, 0); PG8_LDB(B1, 1, 1); PG8_SCHED; PG8_LDA(At, 1, 0); PG8_STAGE(PG8_SA(0, 1), a2 + hstepA, voffA);
            PG8_WAIT_V(8); PG8_WAIT_L(0); PG8_BAR; PG8_MMA(0, 0, At, B0); PG8_MMA(0, 1, At, B1); PG8_BAR; PG8_SCHED;
            PG8_LDA(At, 1, 1); PG8_STAGE(PG8_SB(1, 0), b3, voffB); PG8_STAGE(PG8_SB(1, 1), b3 + hstepB, voffB); PG8_STAGE(PG8_SA(1, 0), a3, voffA);
            PG8_WAIT_V(8); PG8_WAIT_L(0); PG8_BAR; PG8_MMA(1, 0, At, B0); PG8_MMA(1, 1, At, B1); PG8_BAR; PG8_SCHED;
        }
        if constexpr (ALIGN_EPI) { if (wr == 0) PG8_BAR; }
        bool keep = false;
        if constexpr (CHAIN) { if (cur.seg == 0) { E.mid(acc, cur, wr, wc, fr, fq); keep = true; } else E(acc, cur, wr, wc, fr, fq); }
        else E(acc, cur, wr, wc, fr, fq);
        if (!has_next) break;
        if (!keep) {
#pragma unroll
        for (int a = 0; a < 2; ++a)
#pragma unroll
            for (int b = 0; b < 2; ++b)
#pragma unroll
                for (int m = 0; m < 4; ++m)
#pragma unroll
                    for (int n = 0; n < 2; ++n) acc[a][b][m][n] = (f32x4){0.f, 0.f, 0.f, 0.f};
        }
        cur = nxt; cA = nA; cB = nB; ++ui;
        if constexpr (ALIGN_EPI) { if (wr == 1) PG8_BAR; }
    }
    PG8_WAIT_V(0);
    if constexpr (!ALIGN_EPI) { if (wr == 0) PG8_BAR; }
    PG8_BAR;
#undef PG8_SA
#undef PG8_SB
#undef PG8_STAGE
#undef PG8_LDA
#undef PG8_LDB
#undef PG8_MMA
#undef PG8_WAIT_V
#undef PG8_WAIT_L
#undef PG8_BAR
#undef PG8_SCHED
}
}
constexpr int NWAVES = 8, NTHREADS = 512;
constexpr int BATCH = 8, SEQ = 2048, DM = 1024, MTOK = BATCH * SEQ;
constexpr int NPROJ = 3840;
constexpr float EPS = 1e-6f, LOG2E = 1.4426950408889634f;
constexpr float QSCALE_NSA = 0.125f * LOG2E;
constexpr float QSCALE_MLA = 0.10206207261596575f * LOG2E;
constexpr size_t MiB = 1u << 20;
enum { I_X = 0, I_POS, I_N1G, I_WIN, I_CPK, I_CW1K, I_CW2K, I_CPV, I_CW1V, I_CW2V, I_QNG, I_KVNG, I_WUQ, I_WUKV, I_WBN, I_WBM, I_WOUT, I_N2G, I_WPQ, I_SK1, I_SK2, I_EDN, I_EUP, I_NFG, N_IN };
constexpr size_t WS_CTL = 0;
constexpr size_t WS_WIN = 1 * MiB;
constexpr size_t WS_WUQ = WS_WIN + (size_t)NPROJ * 1024 * 2;
constexpr size_t WS_WUKV = WS_WUQ + 768 * 256 * 2;
constexpr size_t WS_WBR = 10 * MiB;
constexpr size_t WS_WOUT = 12 * MiB;
constexpr size_t WS_WPQ = 14 * MiB;
constexpr size_t WS_WC1K = 18 * MiB;
constexpr size_t WS_WC1V = WS_WC1K + 256 * 1024 * 2;
constexpr size_t WS_SMALL = 19 * MiB;
constexpr size_t WS_C1K = WS_SMALL;
constexpr size_t WS_C1V = WS_SMALL + 512;
constexpr size_t WS_ORDER = WS_SMALL + 1024;
constexpr size_t WS_SK1 = WS_SMALL + 4096;
constexpr size_t WS_SK2 = WS_SK1 + 32768;
constexpr size_t WS_XN = 20 * MiB;
constexpr size_t WS_MLAQ = WS_XN, WS_EXPD = WS_XN;
constexpr size_t WS_EXPD_SC = WS_EXPD + (size_t)16384 * 1024;
constexpr size_t WS_QKV = 52 * MiB;
constexpr size_t WS_MERGED = WS_QKV;
constexpr size_t WS_CQ = 92 * MiB;
constexpr size_t WS_MISC = 100 * MiB;
constexpr size_t WS_ROUTE = 92 * MiB;
constexpr size_t WS_GATES = 108 * MiB;
constexpr size_t WS_QP = WS_GATES;
constexpr size_t WS_MLAKV = 172 * MiB;
constexpr size_t WS_XN2 = WS_MLAKV;
constexpr size_t WS_KPE = 204 * MiB;
constexpr size_t WS_KC = 205 * MiB;
constexpr size_t WS_VC = WS_KC + 16 * 128 * 64 * 2;
constexpr size_t WS_SSQ = 207 * MiB, WS_SSKV = 207 * MiB + 262144;
constexpr size_t WS_SS = 206 * MiB;
constexpr size_t WS_OCAT = 210 * MiB;
constexpr size_t WS_USLAB = WS_OCAT;
constexpr size_t WS_EXPU = WS_OCAT;
constexpr size_t WS_EXPU_SC = WS_EXPU + (size_t)16384 * 1024;
constexpr size_t WS_END = 242 * MiB;
constexpr int RING_BYTES = 131072;
constexpr int LDS_BYTES = 147456;

#define GAS __attribute__((address_space(1)))
#define LAS __attribute__((address_space(3)))
typedef unsigned short bf16;
typedef unsigned v4u __attribute__((ext_vector_type(4)));
typedef unsigned v2u __attribute__((ext_vector_type(2)));
typedef float f32x4 __attribute__((ext_vector_type(4)));
typedef float f32x16 __attribute__((ext_vector_type(16)));
typedef short bf16x8 __attribute__((ext_vector_type(8)));
typedef short s16x4 __attribute__((ext_vector_type(4)));

__device__ __forceinline__ unsigned f2bf(float f) { unsigned u = __builtin_bit_cast(unsigned, f); return (u + 0x7fffu + ((u >> 16) & 1u)) >> 16; }
__device__ __forceinline__ unsigned pk2(float lo, float hi) { return f2bf(lo) | (f2bf(hi) << 16); }
__device__ __forceinline__ float bf_lo(unsigned u) { return __builtin_bit_cast(float, u << 16); }
__device__ __forceinline__ float bf_hi(unsigned u) { return __builtin_bit_cast(float, u & 0xffff0000u); }
__device__ __forceinline__ float bf2f(bf16 h) { return __builtin_bit_cast(float, (unsigned)h << 16); }
__device__ __forceinline__ float sigmoidf_(float v) { return __builtin_amdgcn_rcpf(1.0f + __expf(-v)); }
__device__ __forceinline__ float gelu_tanh(float v) { const float u = 0.7978845608028654f * (v + 0.044715f * v * v * v); const float e = __expf(2.0f * u); const float th = 1.0f - 2.0f * __builtin_amdgcn_rcpf(e + 1.0f); return 0.5f * v * (1.0f + th); }
__device__ __forceinline__ float rope_inv(int i) { return exp2f(-(float)i * (13.287712379549449f / 16.0f)); }
__device__ __forceinline__ void rope_sincos(float ang, float& sn, float& cs) { float t = ang * 0.15915494309189535f; t -= floorf(t); sn = __builtin_amdgcn_sinf(t); cs = __builtin_amdgcn_cosf(t); }
__device__ __forceinline__ float wave_sum(float v) {
#pragma unroll
    for (int o = 1; o < 64; o <<= 1) v += __shfl_xor(v, o);
    return v;
}

#ifdef TIMER_PHASE
#define TMS_BEGIN(id) unsigned long long tms_t0_ = ((id) == TIMER_PHASE) ? __builtin_amdgcn_s_memrealtime() : 0ull
#define TMS_DECL unsigned long long tms_m0_ = 0ull
#define TMS_MARK(id) do { if ((id) == TIMER_PHASE) tms_m0_ = __builtin_amdgcn_s_memrealtime(); } while (0)
#define TMS_MARKEND(id) do { if ((id) == TIMER_PHASE && threadIdx.x == 448) { *(LAS unsigned long long*)(F.lds + RING_BYTES + 512) += __builtin_amdgcn_s_memrealtime() - tms_m0_; } } while (0)
#define TMS_COUNT(id) do { if ((id) == TIMER_PHASE && threadIdx.x == 448) { *(LAS unsigned long long*)(F.lds + RING_BYTES + 512) += 100ull; } } while (0)
#define TMS_END(id) do { if ((id) == TIMER_PHASE && threadIdx.x == (((id) >= 41 && (id) <= 49) ? 448 : 0)) { *(LAS unsigned long long*)(F.lds + RING_BYTES + 512) += __builtin_amdgcn_s_memrealtime() - tms_t0_; } } while (0)
#else
#define TMS_BEGIN(id) do {} while (0)
#define TMS_COUNT(id) do {} while (0)
#define TMS_DECL do {} while (0)
#define TMS_MARK(id) do {} while (0)
#define TMS_MARKEND(id) do {} while (0)
#define TMS_END(id) do {} while (0)
#endif
struct Frame {
    LAS unsigned char* lds;
    int tid, lane, wave, G, bid;
    const float* const* in; const int* pos; float* out; unsigned char* ws;
};

__device__ __forceinline__ int win_srccol(int n) {
    if (n < 1280) return n;
    if (n < 1536) return 1304 + (n - 1280);
    if (n < 1664) return 1560 + (n - 1536);
    if (n < 1696) return 1688 + (n - 1664);
    if (n < 1720) return 1280 + (n - 1696);
    if (n < 1792) return -1;
    return 1720 + (n - 1792);
}
template <bool WIN_PERM>
__device__ __forceinline__ void tr_item(const float* src, int ld_src, int ksrc0, const float* kscale, bf16* dst, int ld_dst, int drow0, int dcol0, int N, LAS float* scr, int item, int lane) {
    const int nblk = N / 32, kb = item / nblk, nb = item % nblk, k0 = 64 * kb, n0 = 32 * nb;
    const int nn = n0 + 4 * (lane & 7); const int sc = WIN_PERM ? win_srccol(nn) : nn;
    f32x4 v[8];
#pragma unroll
    for (int i = 0; i < 8; ++i) { const int kk = 8 * i + (lane >> 3); v[i] = (f32x4){0.f, 0.f, 0.f, 0.f}; if (sc >= 0) v[i] = *(const f32x4*)(src + (size_t)(ksrc0 + k0 + kk) * ld_src + sc); }
#pragma unroll
    for (int i = 0; i < 8; ++i) { const int kk = 8 * i + (lane >> 3); const float ks = kscale ? kscale[k0 + kk] : 1.0f; LAS float* d = scr + kk * 33 + 4 * (lane & 7);
        d[0] = v[i].x * ks; d[1] = v[i].y * ks; d[2] = v[i].z * ks; d[3] = v[i].w * ks; }
    asm volatile("s_waitcnt lgkmcnt(0)" ::: "memory");
    const int c = lane & 7;
#pragma unroll
    for (int j = 0; j < 4; ++j) { const int n = (lane >> 3) + 8 * j; const LAS float* s = scr + (8 * c) * 33 + n;
        v4u o; o.x = pk2(s[0 * 33], s[1 * 33]); o.y = pk2(s[2 * 33], s[3 * 33]); o.z = pk2(s[4 * 33], s[5 * 33]); o.w = pk2(s[6 * 33], s[7 * 33]);
        *(v4u*)(dst + (size_t)(drow0 + n0 + n) * ld_dst + dcol0 + k0 + 8 * c) = o; }
    asm volatile("s_waitcnt lgkmcnt(0)" ::: "memory");
}
__device__ __forceinline__ void rms_row_to_bf16(const float* xrow, const float* gain, bf16* orow, int lane) {
    const f32x4* xr = (const f32x4*)xrow + lane; const f32x4* gr = (const f32x4*)gain + lane;
    f32x4 v[4]; float s = 0.f;
#pragma unroll
    for (int j = 0; j < 4; ++j) { v[j] = xr[64 * j]; s += (v[j].x * v[j].x + v[j].y * v[j].y) + (v[j].z * v[j].z + v[j].w * v[j].w); }
    const float r = 1.0f / sqrtf(wave_sum(s) * (1.f / DM) + EPS);
    unsigned long long* o8 = (unsigned long long*)orow + lane;
#pragma unroll
    for (int j = 0; j < 4; ++j) { const f32x4 g = gr[64 * j]; o8[64 * j] = (unsigned long long)pk2(v[j].x * r * g.x, v[j].y * r * g.y) | ((unsigned long long)pk2(v[j].z * r * g.z, v[j].w * r * g.w) << 32); }
}
__device__ __forceinline__ void p0_prologue(Frame& F) {
    LAS float* scr = (LAS float*)(F.lds + F.wave * 16384);
    const int gw = F.bid * NWAVES + F.wave, NGW = F.G * NWAVES, lane = F.lane;
    bf16* const Win_t = (bf16*)(F.ws + WS_WIN); bf16* const Wuq_t = (bf16*)(F.ws + WS_WUQ); bf16* const Wukv_t = (bf16*)(F.ws + WS_WUKV);
    bf16* const Wbr_t = (bf16*)(F.ws + WS_WBR); bf16* const Wout_t = (bf16*)(F.ws + WS_WOUT); bf16* const Wpq_t = (bf16*)(F.ws + WS_WPQ);
    bf16* const Wc1k_t = (bf16*)(F.ws + WS_WC1K); bf16* const Wc1v_t = (bf16*)(F.ws + WS_WC1V);
    constexpr int I_IN = 16 * (NPROJ / 32), I_UQ = 4 * 24, I_UKV = 2 * 32, I_BR = 8 * 32, I_OUT = 16 * 32, I_PQ = 16 * 64, I_C1 = 16 * 4;
    constexpr int NITEMS = I_IN + I_UQ + I_UKV + 2 * I_BR + I_OUT + I_PQ + 4 * I_C1;
    for (int it = gw; it < NITEMS; it += NGW) {
        int r = it;
        if (r < I_IN) { tr_item<true>(F.in[I_WIN], 3768, 0, nullptr, Win_t, 1024, 0, 0, NPROJ, scr, r, lane); continue; } r -= I_IN;
        if (r < I_UQ) { tr_item<false>(F.in[I_WUQ], 768, 0, F.in[I_QNG], Wuq_t, 256, 0, 0, 768, scr, r, lane); continue; } r -= I_UQ;
        if (r < I_UKV) { tr_item<false>(F.in[I_WUKV], 1024, 0, F.in[I_KVNG], Wukv_t, 256, 0, 0, 1024, scr, r, lane); continue; } r -= I_UKV;
        if (r < I_BR) { tr_item<false>(F.in[I_WBN], 1024, 0, nullptr, Wbr_t, 1024, 0, 0, 1024, scr, r, lane); continue; } r -= I_BR;
        if (r < I_BR) { tr_item<false>(F.in[I_WBM], 1024, 0, nullptr, Wbr_t, 1024, 0, 512, 1024, scr, r, lane); continue; } r -= I_BR;
        if (r < I_OUT) { tr_item<false>(F.in[I_WOUT], 1024, 0, nullptr, Wout_t, 1024, 0, 0, 1024, scr, r, lane); continue; } r -= I_OUT;
        if (r < I_PQ) { tr_item<false>(F.in[I_WPQ], 2048, 0, F.in[I_N2G], Wpq_t, 1024, 0, 0, 2048, scr, r, lane); continue; } r -= I_PQ;
        if (r < I_C1) { tr_item<false>(F.in[I_CW1K], 128, 0, nullptr, Wc1k_t, 1024, 0, 0, 128, scr, r, lane); continue; } r -= I_C1;
        if (r < I_C1) { tr_item<false>(F.in[I_CW1K], 128, 1024, nullptr, Wc1k_t, 1024, 128, 0, 128, scr, r, lane); continue; } r -= I_C1;
        if (r < I_C1) { tr_item<false>(F.in[I_CW1V], 128, 0, nullptr, Wc1v_t, 1024, 0, 0, 128, scr, r, lane); continue; } r -= I_C1;
        tr_item<false>(F.in[I_CW1V], 128, 1024, nullptr, Wc1v_t, 1024, 128, 0, 128, scr, r, lane);
    }
    { bf16* XN = (bf16*)(F.ws + WS_XN); const float* X = F.in[I_X]; const f32x4* gr = (const f32x4*)F.in[I_N1G] + lane;
      for (int m = gw; m < MTOK; m += 2 * NGW) {
          const int m2 = (m + NGW < MTOK) ? m + NGW : m;
          const f32x4* xa = (const f32x4*)(X + (size_t)m * DM) + lane; const f32x4* xb = (const f32x4*)(X + (size_t)m2 * DM) + lane;
          f32x4 va[4], vb[4]; float sa = 0.f, sb = 0.f;
#pragma unroll
          for (int j = 0; j < 4; ++j) { va[j] = xa[64 * j]; vb[j] = xb[64 * j]; }
#pragma unroll
          for (int j = 0; j < 4; ++j) { sa += (va[j].x * va[j].x + va[j].y * va[j].y) + (va[j].z * va[j].z + va[j].w * va[j].w); sb += (vb[j].x * vb[j].x + vb[j].y * vb[j].y) + (vb[j].z * vb[j].z + vb[j].w * vb[j].w); }
#pragma unroll
          for (int o = 1; o < 64; o <<= 1) { sa += __shfl_xor(sa, o); sb += __shfl_xor(sb, o); }
          const float ra = 1.0f / sqrtf(sa * (1.f / DM) + EPS), rb = 1.0f / sqrtf(sb * (1.f / DM) + EPS);
          unsigned long long* oa = (unsigned long long*)(XN + (size_t)m * DM) + lane; unsigned long long* ob = (unsigned long long*)(XN + (size_t)m2 * DM) + lane;
#pragma unroll
          for (int j = 0; j < 4; ++j) { const f32x4 g = gr[64 * j];
              oa[64 * j] = (unsigned long long)pk2(va[j].x * ra * g.x, va[j].y * ra * g.y) | ((unsigned long long)pk2(va[j].z * ra * g.z, va[j].w * ra * g.w) << 32);
              ob[64 * j] = (unsigned long long)pk2(vb[j].x * rb * g.x, vb[j].y * rb * g.y) | ((unsigned long long)pk2(vb[j].z * rb * g.z, vb[j].w * rb * g.w) << 32); }
      } }
    const int gt = F.bid * NTHREADS + F.tid, NGT = F.G * NTHREADS;
    for (int i = gt; i < 1024 * 128; i += NGT) { const int n = i >> 7, k = 128 + (i & 127); Wukv_t[n * 256 + k] = 0; }
    { bf16* S1 = (bf16*)(F.ws + WS_SK1); bf16* S2 = (bf16*)(F.ws + WS_SK2);
      for (int i = gt; i < 128 * 128; i += NGT) { S1[i] = (bf16)f2bf(F.in[I_SK1][i]); S2[i] = (bf16)f2bf(F.in[I_SK2][i]); } }
    for (int o = gw; o < 256; o += NGW) {
        const int kv = o >> 7, j = o & 127; const float* pe = F.in[kv ? I_CPV : I_CPK]; const float* w1 = F.in[kv ? I_CW1V : I_CW1K];
        float s = 0.f;
        for (int k = lane; k < 2048; k += 64) s += pe[k] * w1[(size_t)k * 128 + j];
        s = wave_sum(s);
        if (lane == 0) ((float*)(F.ws + (kv ? WS_C1V : WS_C1K)))[j] = s;
    }
}

using pg8::Unit; using pg8::cvt_pk_bf16;
constexpr int PG_HALF = 128, PG_BM = 256;
struct EpiInProj {
    static constexpr bool PERM = true;
    bf16 *QKV, *CQ, *MISC, *GATES; float *SSQ, *SSKV;
    __device__ __forceinline__ void operator()(const f32x4 (&acc)[2][2][4][2], const Unit& u, int wr, int wc, int fr, int fq) const {
        bf16* base; int ldc, colt; float sc = 1.f;
        if (u.pn < 5) { base = QKV; ldc = 1280; colt = u.pn * 256; if (u.pn < 2) sc = QSCALE_NSA; }
        else if (u.pn == 5) { base = CQ; ldc = 256; colt = 0; }
        else if (u.pn == 6) { base = MISC; ldc = 256; colt = 0; }
        else { base = GATES; ldc = 2048; colt = (u.pn - 7) * 256; }
        const int row0 = u.pm * PG_BM + wr * 64 + fr, col0 = colt + wc * 32 + 8 * fq;
#pragma unroll
        for (int ai = 0; ai < 2; ++ai)
#pragma unroll
            for (int m = 0; m < 4; ++m) { bf16* rowp = base + (size_t)(row0 + ai * PG_HALF + m * 16) * ldc + col0;
#pragma unroll
                for (int bj = 0; bj < 2; ++bj) { const f32x4 v0 = acc[ai][bj][m][0] * sc, v1 = acc[ai][bj][m][1] * sc;
                    v4u w; w.x = cvt_pk_bf16(v0[0], v0[1]); w.y = cvt_pk_bf16(v0[2], v0[3]); w.z = cvt_pk_bf16(v1[0], v1[1]); w.w = cvt_pk_bf16(v1[2], v1[3]);
                    *(v4u*)(rowp + bj * PG_HALF) = w; }
                if (u.pn == 5 || u.pn == 6) {
                    float ss = 0.f;
#pragma unroll
                    for (int bj = 0; bj < 2; ++bj) if (u.pn == 5 || bj == 0) {
#pragma unroll
                        for (int n = 0; n < 2; ++n) { const f32x4 v = acc[ai][bj][m][n]; ss += (v[0] * v[0] + v[1] * v[1]) + (v[2] * v[2] + v[3] * v[3]); } }
                    ss += __shfl_xor(ss, 16); ss += __shfl_xor(ss, 32);
                    if (fq == 0) (u.pn == 5 ? SSQ : SSKV)[(size_t)(row0 + ai * PG_HALF + m * 16) * 4 + wc] = ss; } }
    }
};
struct EpiBf16 {
    static constexpr bool PERM = true;
    bf16* O; int ldc;
    __device__ __forceinline__ void operator()(const f32x4 (&acc)[2][2][4][2], const Unit& u, int wr, int wc, int fr, int fq) const {
        const int row0 = u.pm * PG_BM + wr * 64 + fr, col0 = u.pn * PG_BM + wc * 32 + 8 * fq;
#pragma unroll
        for (int ai = 0; ai < 2; ++ai)
#pragma unroll
            for (int m = 0; m < 4; ++m) { bf16* rowp = O + (size_t)(row0 + ai * PG_HALF + m * 16) * ldc + col0;
#pragma unroll
                for (int bj = 0; bj < 2; ++bj) { const f32x4 v0 = acc[ai][bj][m][0], v1 = acc[ai][bj][m][1];
                    v4u w; w.x = cvt_pk_bf16(v0[0], v0[1]); w.y = cvt_pk_bf16(v0[2], v0[3]); w.z = cvt_pk_bf16(v1[0], v1[1]); w.w = cvt_pk_bf16(v1[2], v1[3]);
                    *(v4u*)(rowp + bj * PG_HALF) = w; } }
    }
};
template <int NSRC> struct EpiRowScale {
    static constexpr bool PERM = true;
    const float* SS; bf16* O; int ldc; float cscale;
    __device__ __forceinline__ void operator()(const f32x4 (&acc)[2][2][4][2], const Unit& u, int wr, int wc, int fr, int fq) const {
        const int row0 = u.pm * PG_BM + wr * 64 + fr, col0 = u.pn * PG_BM + wc * 32 + 8 * fq;
#pragma unroll
        for (int ai = 0; ai < 2; ++ai)
#pragma unroll
            for (int m = 0; m < 4; ++m) { const int row = row0 + ai * PG_HALF + m * 16;
                const f32x4 s4 = *(const f32x4*)(SS + (size_t)row * 4); const float ss = (s4[0] + s4[1]) + (s4[2] + s4[3]);
                const float sc = cscale * __builtin_amdgcn_rsqf(ss * (1.0f / NSRC) + EPS);
                bf16* rowp = O + (size_t)row * ldc + col0;
#pragma unroll
                for (int bj = 0; bj < 2; ++bj) { const f32x4 v0 = acc[ai][bj][m][0] * sc, v1 = acc[ai][bj][m][1] * sc;
                    v4u w; w.x = cvt_pk_bf16(v0[0], v0[1]); w.y = cvt_pk_bf16(v0[2], v0[3]); w.z = cvt_pk_bf16(v1[0], v1[1]); w.w = cvt_pk_bf16(v1[2], v1[3]);
                    *(v4u*)(rowp + bj * PG_HALF) = w; } }
    }
};
struct EpiF32 {
    static constexpr bool PERM = false;
    float* C; int ldc; const float* resid;
    __device__ __forceinline__ void operator()(const f32x4 (&acc)[2][2][4][2], const Unit& u, int wr, int wc, int fr, int fq) const {
        const int row0 = u.pm * PG_BM + wr * 64 + fr, col0 = u.pn * PG_BM + wc * 32 + 4 * fq;
#pragma unroll
        for (int ai = 0; ai < 2; ++ai)
#pragma unroll
            for (int m = 0; m < 4; ++m) { const size_t off = (size_t)(row0 + ai * PG_HALF + m * 16) * ldc + col0;
#pragma unroll
                for (int bj = 0; bj < 2; ++bj)
#pragma unroll
                    for (int n = 0; n < 2; ++n) { f32x4 v = acc[ai][bj][m][n]; if (resid) v += *(const f32x4*)(resid + off + bj * PG_HALF + n * 16); *(f32x4*)(C + off + bj * PG_HALF + n * 16) = v; } }
    }
};
struct EpiGateChain {
    static constexpr bool PERM = true;
    const bf16* G; bf16* MG;
    __device__ __forceinline__ void mid(f32x4 (&acc)[2][2][4][2], const Unit& u, int wr, int wc, int fr, int fq) const {
        const int row0 = u.pm * PG_BM + wr * 64 + fr, col0 = u.pn * PG_BM + wc * 32 + 8 * fq;
#pragma unroll
        for (int ai = 0; ai < 2; ++ai)
#pragma unroll
            for (int m = 0; m < 4; ++m) { const int row = row0 + ai * PG_HALF + m * 16;
#pragma unroll
                for (int bj = 0; bj < 2; ++bj) { const int col = col0 + bj * PG_HALF;
                    const v4u gn = *(const v4u*)(G + (size_t)row * 2048 + col), gm = *(const v4u*)(G + (size_t)row * 2048 + 1024 + col);
#define RATIO(a, b) ((1.0f + __expf(-(b))) * __builtin_amdgcn_rcpf(1.0f + __expf(-(a))))
                    acc[ai][bj][m][0][0] *= RATIO(bf_lo(gn.x), bf_lo(gm.x)); acc[ai][bj][m][0][1] *= RATIO(bf_hi(gn.x), bf_hi(gm.x)); acc[ai][bj][m][0][2] *= RATIO(bf_lo(gn.y), bf_lo(gm.y)); acc[ai][bj][m][0][3] *= RATIO(bf_hi(gn.y), bf_hi(gm.y));
                    acc[ai][bj][m][1][0] *= RATIO(bf_lo(gn.z), bf_lo(gm.z)); acc[ai][bj][m][1][1] *= RATIO(bf_hi(gn.z), bf_hi(gm.z)); acc[ai][bj][m][1][2] *= RATIO(bf_lo(gn.w), bf_lo(gm.w)); acc[ai][bj][m][1][3] *= RATIO(bf_hi(gn.w), bf_hi(gm.w));
#undef RATIO
                } }
    }
    __device__ __forceinline__ void operator()(const f32x4 (&acc)[2][2][4][2], const Unit& u, int wr, int wc, int fr, int fq) const {
        const int row0 = u.pm * PG_BM + wr * 64 + fr, col0 = u.pn * PG_BM + wc * 32 + 8 * fq;
#pragma unroll
        for (int ai = 0; ai < 2; ++ai)
#pragma unroll
            for (int m = 0; m < 4; ++m) { const int row = row0 + ai * PG_HALF + m * 16;
#pragma unroll
                for (int bj = 0; bj < 2; ++bj) { const int col = col0 + bj * PG_HALF;
                    const v4u gm = *(const v4u*)(G + (size_t)row * 2048 + 1024 + col); const f32x4 a0 = acc[ai][bj][m][0], a1 = acc[ai][bj][m][1];
                    v4u w; w.x = cvt_pk_bf16(sigmoidf_(bf_lo(gm.x)) * a0[0], sigmoidf_(bf_hi(gm.x)) * a0[1]); w.y = cvt_pk_bf16(sigmoidf_(bf_lo(gm.y)) * a0[2], sigmoidf_(bf_hi(gm.y)) * a0[3]);
                    w.z = cvt_pk_bf16(sigmoidf_(bf_lo(gm.z)) * a1[0], sigmoidf_(bf_hi(gm.z)) * a1[1]); w.w = cvt_pk_bf16(sigmoidf_(bf_lo(gm.w)) * a1[2], sigmoidf_(bf_hi(gm.w)) * a1[3]);
                    *(v4u*)(MG + (size_t)row * 1024 + col) = w; } }
    }
};
struct EpiResid {
    static constexpr bool PERM = false;
    const float* X; bf16* HB; float* SS;
    __device__ __forceinline__ void operator()(const f32x4 (&acc)[2][2][4][2], const Unit& u, int wr, int wc, int fr, int fq) const {
        const int row0 = u.pm * PG_BM + wr * 64 + fr, col0 = u.pn * PG_BM + wc * 32 + 4 * fq;
#pragma unroll
        for (int ai = 0; ai < 2; ++ai)
#pragma unroll
            for (int m = 0; m < 4; ++m) { const int row = row0 + ai * PG_HALF + m * 16; const size_t off = (size_t)row * 1024 + col0; float ss = 0.f;
#pragma unroll
                for (int bj = 0; bj < 2; ++bj)
#pragma unroll
                    for (int n = 0; n < 2; ++n) { const f32x4 v = acc[ai][bj][m][n] + *(const f32x4*)(X + off + bj * PG_HALF + n * 16);
                        const unsigned w0 = cvt_pk_bf16(v[0], v[1]), w1 = cvt_pk_bf16(v[2], v[3]); *(v2u*)(HB + off + bj * PG_HALF + n * 16) = (v2u){w0, w1};
                        const float r0 = bf_lo(w0), r1 = bf_hi(w0), r2 = bf_lo(w1), r3 = bf_hi(w1); ss += (r0 * r0 + r1 * r1) + (r2 * r2 + r3 * r3); }
                ss += __shfl_xor(ss, 16); ss += __shfl_xor(ss, 32);
                if (fq == 0) SS[(size_t)row * 16 + u.pn * 4 + wc] = ss; }
    }
};
struct EpiRowSS {
    static constexpr bool PERM = true;
    const float* SS; bf16* O; int ldc;
    __device__ __forceinline__ void operator()(const f32x4 (&acc)[2][2][4][2], const Unit& u, int wr, int wc, int fr, int fq) const {
        const int row0 = u.pm * PG_BM + wr * 64 + fr, col0 = u.pn * PG_BM + wc * 32 + 8 * fq;
#pragma unroll
        for (int ai = 0; ai < 2; ++ai)
#pragma unroll
            for (int m = 0; m < 4; ++m) { const int row = row0 + ai * PG_HALF + m * 16;
                const f32x4* sp = (const f32x4*)(SS + (size_t)row * 16); const f32x4 s0 = sp[0], s1 = sp[1], s2 = sp[2], s3 = sp[3];
                const float ss = (((s0[0] + s0[1]) + (s0[2] + s0[3])) + ((s1[0] + s1[1]) + (s1[2] + s1[3]))) + (((s2[0] + s2[1]) + (s2[2] + s2[3])) + ((s3[0] + s3[1]) + (s3[2] + s3[3])));
                const float sc = __builtin_amdgcn_rsqf(ss * (1.0f / DM) + EPS);
                bf16* rowp = O + (size_t)row * ldc + col0;
#pragma unroll
                for (int bj = 0; bj < 2; ++bj) { const f32x4 v0 = acc[ai][bj][m][0] * sc, v1 = acc[ai][bj][m][1] * sc;
                    v4u w; w.x = cvt_pk_bf16(v0[0], v0[1]); w.y = cvt_pk_bf16(v0[2], v0[3]); w.z = cvt_pk_bf16(v1[0], v1[1]); w.w = cvt_pk_bf16(v1[2], v1[3]);
                    *(v4u*)(rowp + bj * PG_HALF) = w; } }
    }
};
namespace att {
constexpr int KB_BYTES = 12288, VB_BYTES = 12288, BUF_BYTES = KB_BYTES + VB_BYTES;
constexpr int NBUF = 4;
constexpr int OFF_IMP = 2 * BUF_BYTES;
constexpr int OFF_SC = OFF_IMP + 32768;
constexpr int OFF_IMP2 = 0, OFF_SC2 = 32768;
constexpr int OFF_SEL = NBUF * BUF_BYTES;
constexpr int OFF_END = OFF_SEL + 512;
static_assert(OFF_SC + 8192 <= NBUF * BUF_BYTES, "selection scratch must stay inside the aliased buffers");
static_assert(OFF_END <= RING_BYTES, "attention LDS map");

__device__ __forceinline__ int crow(int r, int hi) { return (r & 3) + 8 * (r >> 2) + 4 * hi; }
__device__ __forceinline__ s16x4 vtr(const LAS unsigned char* p) { typedef short v4i16_t __attribute__((ext_vector_type(4))); return __builtin_bit_cast(s16x4, __builtin_amdgcn_ds_read_tr16_b64_v4i16((LAS v4i16_t*)p)); }
__device__ __forceinline__ unsigned cvtpk(float lo, float hi) { typedef float f2 __attribute__((ext_vector_type(2))); typedef __bf16 b2 __attribute__((ext_vector_type(2))); f2 v = {lo, hi}; b2 b = __builtin_convertvector(v, b2); return __builtin_bit_cast(unsigned, b); }
__device__ __forceinline__ float swapmax(float m) { auto rr = __builtin_amdgcn_permlane32_swap(__float_as_uint(m), __float_as_uint(m), false, false); return fmaxf(__uint_as_float(rr[0]), __uint_as_float(rr[1])); }
__device__ __forceinline__ float swapsum(float m) { auto rr = __builtin_amdgcn_permlane32_swap(__float_as_uint(m), __float_as_uint(m), false, false); return __uint_as_float(rr[0]) + __uint_as_float(rr[1]); }

__device__ __forceinline__ float max3f(float a, float b, float c) { float r; asm("v_max3_f32 %0, %1, %2, %3" : "=v"(r) : "v"(a), "v"(b), "v"(c)); return r; }
__device__ __forceinline__ float max2f(float a, float b) { float r; asm("v_max_f32_e32 %0, %1, %2" : "=v"(r) : "v"(a), "v"(b)); return r; }
struct Flash { f32x16 o[3]; float m, l; };
constexpr float FLASH_THR = 8.0f;
__device__ __forceinline__ void flash_init(Flash& f) { f.o[0] = f32x16{}; f.o[1] = f32x16{}; f.o[2] = f32x16{}; f.m = 0.f; f.l = 0.f; }

template <int NKC>
__device__ __forceinline__ void issue_tile(LAS unsigned char* lds, int buf, const bf16* Kg, int ldk, const bf16* Kpe, const bf16* Vg, int ldv, int wave, int lane) {
    LAS unsigned char* kb = lds + buf * BUF_BYTES; LAS unsigned char* vb = kb + KB_BYTES;
    { const int row = 8 * wave + (lane >> 3), chunk = (lane & 7) ^ ((row >> 1) & 7);
      __builtin_amdgcn_global_load_lds((const unsigned*)(Kg + (size_t)row * ldk + chunk * 8), (LAS unsigned*)(kb + wave * 1024), 16, 0, 0); }
    if (NKC == 12) { if (wave < 4) { const int row = 16 * wave + (lane >> 2), chunk = (lane & 3) ^ ((row >> 2) & 3);
      __builtin_amdgcn_global_load_lds((const unsigned*)(Kpe + (size_t)row * 32 + chunk * 8), (LAS unsigned*)(kb + 8192 + wave * 1024), 16, 0, 0); } }
    __builtin_amdgcn_global_load_lds((const unsigned*)(Vg + (size_t)(16 * (wave & 3) + (lane >> 2)) * ldv + (wave >> 2) * 32 + (lane & 3) * 8), (LAS unsigned*)(vb + wave * 1024), 16, 0, 0);
}

template <int NKS, int NVB, bool HAS_BIAS>
__device__ __forceinline__ void tile_compute(Flash& f, const LAS unsigned char* kb, const LAS unsigned char* vb, const bf16x8* qr, float slope, float cb,
                                             int lo, int hi_, bool need_mask, bool set_ref, int r32, int hh, int lane) {
    const LAS unsigned char* vp = vb + ((lane >> 4) & 1) * 32 + (lane & 3) * 8 + (4 * hh + ((lane & 15) >> 2)) * 64;
    s16x4 vl[NVB][4], vh[NVB][4];
    f32x16 p0, p1;
    if (HAS_BIAS) {
        const float cb0 = (cb - f.m) + slope * (float)(4 * hh), cb1 = cb0 + slope * 32.f;
#pragma unroll
        for (int r = 0; r < 16; ++r) { const float cr = (float)((r & 3) + 8 * (r >> 2)); p0[r] = __builtin_fmaf(slope, cr, cb0); p1[r] = __builtin_fmaf(slope, cr, cb1); }
    } else {
        const float nm = -f.m;
#pragma unroll
        for (int r = 0; r < 16; ++r) { p0[r] = nm; p1[r] = nm; }
    }
    const LAS unsigned char* kp = kb + r32 * 128; const int sw = (r32 >> 1) & 7;
    const LAS unsigned char* kpe = kb + 8192 + r32 * 64; const int swe = (r32 >> 2) & 3;
    bf16x8 kf0[NKS], kf1[NKS];
    auto kload = [&](int d0) {
        const LAS unsigned char* a0 = (d0 < 4) ? kp + (((2 * d0 + hh) ^ sw) << 4) : kpe + (((2 * (d0 - 4) + hh) ^ swe) << 4);
        kf0[d0] = *(const LAS bf16x8*)(a0); kf1[d0] = *(const LAS bf16x8*)(a0 + ((d0 < 4) ? 4096 : 2048)); };
#pragma unroll
    for (int d0 = 0; d0 < 4; ++d0) kload(d0);
    __builtin_amdgcn_sched_barrier(0);
#pragma unroll
    for (int d0 = 0; d0 < NKS; ++d0) {
        p0 = __builtin_amdgcn_mfma_f32_32x32x16_bf16(kf0[d0], qr[d0], p0, 0, 0, 0);
        p1 = __builtin_amdgcn_mfma_f32_32x32x16_bf16(kf1[d0], qr[d0], p1, 0, 0, 0);
        if (d0 + 4 < NKS) { kload(d0 + 4); __builtin_amdgcn_sched_barrier(0); }
    }
#pragma unroll
    for (int b = 0; b < NVB; ++b)
#pragma unroll
        for (int ks = 0; ks < 4; ++ks) {
            asm volatile("ds_read_b64_tr_b16 %0, %1 offset:%c2" : "=&v"(vl[b][ks]) : "v"(vp), "i"(b * 4096 + ks * 1024) : "memory");
            asm volatile("ds_read_b64_tr_b16 %0, %1 offset:%c2" : "=&v"(vh[b][ks]) : "v"(vp), "i"(b * 4096 + ks * 1024 + 512) : "memory"); }
    if (need_mask) {
        asm volatile("" ::: "memory");
        const int l0 = lo - 4 * hh, h0 = hi_ - 4 * hh;
#pragma unroll
        for (int r = 0; r < 16; ++r) { const int c = (r & 3) + 8 * (r >> 2);
            if (c < l0 || c > h0) p0[r] = -INFINITY;
            if (c + 32 < l0 || c + 32 > h0) p1[r] = -INFINITY; }
    }
    if (set_ref) {
        asm volatile("s_nop 15\n\ts_nop 7" : "+v"(p0), "+v"(p1));
        float mt;
        { float a = max3f(p0[0], p0[1], p1[0]), b = max3f(p0[2], p0[3], p1[1]); a = max3f(a, p1[2], p1[3]);
#pragma unroll
          for (int r = 4; r < 16; r += 4) { a = max3f(a, p0[r], p0[r + 1]); b = max3f(b, p0[r + 2], p0[r + 3]); a = max3f(a, p1[r], p1[r + 1]); b = max3f(b, p1[r + 2], p1[r + 3]); }
          mt = max2f(a, b); }
        { auto rr = __builtin_amdgcn_permlane32_swap(__float_as_uint(mt), __float_as_uint(mt), false, false); mt = max2f(__uint_as_float(rr[0]), __uint_as_float(rr[1])); }
        if (__any(mt > FLASH_THR)) {
            const float delta = fmaxf(mt, 0.f), alpha = __builtin_amdgcn_exp2f(-delta);
            f.m += delta; f.l *= alpha;
#pragma unroll
            for (int r = 0; r < 16; ++r) { p0[r] -= delta; p1[r] -= delta; }
#pragma unroll
            for (int b = 0; b < NVB; ++b)
#pragma unroll
                for (int r = 0; r < 16; ++r) f.o[b][r] *= alpha;
        }
    }
    float sum = 0.f;
#pragma unroll
    for (int r = 0; r < 16; ++r) { p0[r] = __builtin_amdgcn_exp2f(p0[r]); p1[r] = __builtin_amdgcn_exp2f(p1[r]); sum += p0[r] + p1[r]; }
    f.l += sum;
    if (__any(f.l > 0x1p60f)) {
        asm volatile("" ::: "memory");
        f.m += 60.f; f.l *= 0x1p-60f;
#pragma unroll
        for (int b = 0; b < NVB; ++b)
#pragma unroll
            for (int r = 0; r < 16; ++r) f.o[b][r] *= 0x1p-60f;
    }
    v4u pw[4];
    pw[0] = (v4u){cvtpk(p0[0], p0[1]), cvtpk(p0[2], p0[3]), cvtpk(p0[4], p0[5]), cvtpk(p0[6], p0[7])};
    pw[1] = (v4u){cvtpk(p0[8], p0[9]), cvtpk(p0[10], p0[11]), cvtpk(p0[12], p0[13]), cvtpk(p0[14], p0[15])};
    pw[2] = (v4u){cvtpk(p1[0], p1[1]), cvtpk(p1[2], p1[3]), cvtpk(p1[4], p1[5]), cvtpk(p1[6], p1[7])};
    pw[3] = (v4u){cvtpk(p1[8], p1[9]), cvtpk(p1[10], p1[11]), cvtpk(p1[12], p1[13]), cvtpk(p1[14], p1[15])};
    if (NVB == 3) asm volatile("s_waitcnt lgkmcnt(0)" : "+v"(vl[0][0]), "+v"(vl[0][1]), "+v"(vl[0][2]), "+v"(vl[0][3]), "+v"(vh[0][0]), "+v"(vh[0][1]), "+v"(vh[0][2]), "+v"(vh[0][3]),
                                                         "+v"(vl[1][0]), "+v"(vl[1][1]), "+v"(vl[1][2]), "+v"(vl[1][3]), "+v"(vh[1][0]), "+v"(vh[1][1]), "+v"(vh[1][2]), "+v"(vh[1][3]),
                                                         "+v"(vl[NVB - 1][0]), "+v"(vl[NVB - 1][1]), "+v"(vl[NVB - 1][2]), "+v"(vl[NVB - 1][3]), "+v"(vh[NVB - 1][0]), "+v"(vh[NVB - 1][1]), "+v"(vh[NVB - 1][2]), "+v"(vh[NVB - 1][3]) :: "memory");
    else          asm volatile("s_waitcnt lgkmcnt(0)" : "+v"(vl[0][0]), "+v"(vl[0][1]), "+v"(vl[0][2]), "+v"(vl[0][3]), "+v"(vh[0][0]), "+v"(vh[0][1]), "+v"(vh[0][2]), "+v"(vh[0][3]),
                                                         "+v"(vl[1][0]), "+v"(vl[1][1]), "+v"(vl[1][2]), "+v"(vl[1][3]), "+v"(vh[1][0]), "+v"(vh[1][1]), "+v"(vh[1][2]), "+v"(vh[1][3]) :: "memory");
    __builtin_amdgcn_sched_barrier(0);
#pragma unroll
    for (int b = 0; b < NVB; ++b)
#pragma unroll
        for (int ks = 0; ks < 4; ++ks) {
            const bf16x8 va = (bf16x8){vl[b][ks][0], vl[b][ks][1], vl[b][ks][2], vl[b][ks][3], vh[b][ks][0], vh[b][ks][1], vh[b][ks][2], vh[b][ks][3]};
            f.o[b] = __builtin_amdgcn_mfma_f32_32x32x16_bf16(va, __builtin_bit_cast(bf16x8, pw[ks]), f.o[b], 0, 0, 0);
        }
}
__device__ __forceinline__ void dma_wait_bar(int outstanding) {
    if (outstanding == 3) asm volatile("s_waitcnt vmcnt(3) lgkmcnt(0)\n\ts_barrier" ::: "memory");
    else if (outstanding == 2) asm volatile("s_waitcnt vmcnt(2) lgkmcnt(0)\n\ts_barrier" ::: "memory");
    else asm volatile("s_waitcnt vmcnt(0) lgkmcnt(0)\n\ts_barrier" ::: "memory");
}
template <bool DESC> __device__ __forceinline__ int pick_tile(unsigned m) { return DESC ? 31 - __builtin_clz(m) : __builtin_ctz(m); }
struct NoNext { __device__ __forceinline__ void operator()(int, int) const {} };
template <int NKS, int NVB, bool HAS_BIAS, bool DESC, bool NDESC, bool MAXALL, class Src, class Par, class NSrc>
__device__ __forceinline__ int flash_run(Flash& f, LAS unsigned char* lds, unsigned tm, const bf16x8* qr, float slope, const Src& src, const Par& par, bool pre, int slot0, unsigned ntm, const NSrc& nsrc, int r32, int hh, int lane) {
#ifdef TIMER_PHASE
    struct { LAS unsigned char* lds; } F{lds};
#endif
    unsigned rem = tm, ahead = tm;
    int islot = slot0, cslot = slot0, nslot = -1;
    bool first = true;
    auto issue_pair = [&]() {
        if (ahead) { const int j = pick_tile<DESC>(ahead); src(j, 2 * islot); ahead &= ~(1u << j);
            if (ahead) { const int j2 = pick_tile<DESC>(ahead); src(j2, 2 * islot + 1); ahead &= ~(1u << j2); } }
        else if (ntm && nslot < 0) { unsigned nm = ntm; const int j = pick_tile<NDESC>(nm); nsrc(j, 2 * islot); nm &= ~(1u << j);
            if (nm) { const int j2 = pick_tile<NDESC>(nm); nsrc(j2, 2 * islot + 1); } nslot = islot; }
        islot ^= 1; };
    if (pre) { int n = 0; unsigned a2 = ahead; while (a2 && n < 2) { const int j = pick_tile<DESC>(a2); a2 &= ~(1u << j); ++n; } ahead = a2; islot ^= 1; }
    else { TMS_BEGIN(44); issue_pair(); TMS_END(44); }
#pragma unroll 1
    while (rem) {
        const int ja = pick_tile<DESC>(rem); rem &= ~(1u << ja);
        int jb = -1; if (rem) { jb = pick_tile<DESC>(rem); rem &= ~(1u << jb); }
#ifdef TIMER_PHASE
        const unsigned long long tb0_ = (TIMER_PHASE == 40 || TIMER_PHASE == 41) ? __builtin_amdgcn_s_memrealtime() : 0ull;
#endif
        asm volatile("s_waitcnt vmcnt(0) lgkmcnt(0)\n\ts_barrier" ::: "memory");
#ifdef TIMER_PHASE
        if ((TIMER_PHASE == 40 && threadIdx.x == 0) || (TIMER_PHASE == 41 && threadIdx.x == 448)) *(LAS unsigned long long*)(lds + RING_BYTES + 512) += __builtin_amdgcn_s_memrealtime() - tb0_;
#endif
        { TMS_BEGIN(44); issue_pair(); TMS_END(44); }
        int lo, hi_; bool need; float cb;
        if (par(ja, lo, hi_, need, cb)) { const LAS unsigned char* kb = lds + (2 * cslot) * BUF_BYTES;
            TMS_BEGIN(43); tile_compute<NKS, NVB, HAS_BIAS>(f, kb, kb + KB_BYTES, qr, slope, cb, lo, hi_, need, MAXALL || first, r32, hh, lane); first = false; TMS_END(43); TMS_COUNT(42); }
        if (jb >= 0 && par(jb, lo, hi_, need, cb)) { const LAS unsigned char* kb = lds + (2 * cslot + 1) * BUF_BYTES;
            TMS_BEGIN(43); tile_compute<NKS, NVB, HAS_BIAS>(f, kb, kb + KB_BYTES, qr, slope, cb, lo, hi_, need, MAXALL || first, r32, hh, lane); first = false; TMS_END(43); TMS_COUNT(42); }
        cslot ^= 1;
    }
    if (nslot < 0) asm volatile("s_waitcnt lgkmcnt(0)\n\ts_barrier" ::: "memory");
    return nslot;
}

__device__ __forceinline__ void flash_finish(Flash& f, int nvb) {
    const float lt = swapsum(f.l); const float inv = lt > 0.f ? 1.0f / lt : 0.f;
#pragma unroll
    for (int b = 0; b < 3; ++b) if (b < nvb) {
#pragma unroll
        for (int r = 0; r < 16; ++r) f.o[b][r] *= inv; }
}

__device__ __forceinline__ void nsa_unit(Frame& F, int b, int g, int qc) {
    int lane; asm volatile("v_and_b32_e32 %0, 63, %1" : "=v"(lane) : "v"(F.tid));
    LAS unsigned char* lds = F.lds; const int wave = F.wave, r32 = lane & 31, hh = lane >> 5;
    const int head = g * 4 + (wave >> 1);
    const int qloc = 32 * (wave & 1) + r32;
    const int t = 64 * qc + qloc;
    const size_t row = (size_t)b * SEQ + t;
    const bf16* QKV = (const bf16*)(F.ws + WS_QKV); const bf16* MISC = (const bf16*)(F.ws + WS_MISC);
    bf16x8 qr[4];
#pragma unroll
    for (int d0 = 0; d0 < 4; ++d0) qr[d0] = *(const bf16x8*)(QKV + row * 1280 + head * 64 + d0 * 16 + hh * 8);
    float graw_c = bf2f(MISC[row * 256 + 160 + head]), graw_s = bf2f(MISC[row * 256 + 160 + 8 + head]), graw_w = bf2f(MISC[row * 256 + 160 + 16 + head]);
    asm volatile("" : "+v"(graw_c), "+v"(graw_s), "+v"(graw_w) : "v"(qr[0]), "v"(qr[1]), "v"(qr[2]), "v"(qr[3]));
    const float slope2 = exp2f(-(float)(head + 1)) * LOG2E;
    LAS unsigned* selw = (LAS unsigned*)(lds + OFF_SEL);
    if (F.tid < 80) selw[F.tid] = 0u;
    f32x16 ot0, ot1;
    const bf16* Kw = QKV + (size_t)b * SEQ * 1280 + 1024 + g * 64; const bf16* Vw = QKV + (size_t)b * SEQ * 1280 + 1152 + g * 64;
    const bf16* Ks = QKV + (size_t)b * SEQ * 1280 + 768 + g * 64; const bf16* Vs = QKV + (size_t)b * SEQ * 1280 + 896 + g * 64;
    auto src_win = [&](int j, int buf) { issue_tile<8>(lds, buf, Kw + (size_t)j * 64 * 1280, 1280, nullptr, Vw + (size_t)j * 64 * 1280, 1280, wave, lane); };
    auto src_sel = [&](int j, int buf) { issue_tile<8>(lds, buf, Ks + (size_t)j * 64 * 1280, 1280, nullptr, Vs + (size_t)j * 64 * 1280, 1280, wave, lane); };
    const int j0w = qc >= 8 ? qc - 8 : 0;
    const unsigned tm_win = (qc == 31 ? 0xffffffffu : ((2u << qc) - 1u)) & ~((1u << j0w) - 1u);
    TMS_DECL;
    int hand;
    {
        const bf16* KC = (const bf16*)(F.ws + WS_KC) + (size_t)(b * 2 + g) * 128 * 64; const bf16* VC = (const bf16*)(F.ws + WS_VC) + (size_t)(b * 2 + g) * 128 * 64;
        Flash f; flash_init(f);
        int nmax = (t >= 31) ? ((t - 31) >> 4) : -1; if (nmax > 126) nmax = 126;
        const int tid = F.tid;
        auto src = [&](int ti, int buf) {
            issue_tile<8>(lds, buf, KC + (size_t)ti * 64 * 64, 64, nullptr, VC + (size_t)ti * 64 * 64, 64, wave, lane);
            LAS bf16* ov = (LAS bf16*)(lds + buf * BUF_BYTES + KB_BYTES + 2 * 4096);
#pragma unroll
            for (int e = 0; e < 4; ++e) { const int idx = tid * 4 + e, nl = idx >> 5, s_ = idx & 31, n = 64 * ti + nl;
                float v = 0.f; if (s_ == (n >> 2)) v = ((n & 3) == 3) ? 0.5f : 1.0f; else if (s_ == (n >> 2) + 1 && (n & 3) == 3) v = 0.5f;
                ov[(nl >> 4) * 512 + (nl & 15) * 32 + s_] = (bf16)f2bf(v); } };
        auto par = [&](int ti, int& lo, int& hi_, bool& need, float& cb) { lo = 0; hi_ = nmax - 64 * ti; need = true; cb = 16.f * slope2 * (float)(64 * ti); return true; };
        hand = flash_run<4, 3, true, true, true, true>(f, lds, 3u, qr, 16.f * slope2, src, par, false, 0, tm_win, src_win, r32, hh, lane);
        flash_finish(f, 3);
        TMS_MARK(45);
        asm volatile("s_waitcnt lgkmcnt(0)\n\ts_barrier" ::: "memory");
        LAS float* imp = (LAS float*)(lds + OFF_IMP2) + (wave * 32 + r32) * 32;
#pragma unroll
        for (int r = 0; r < 16; ++r) imp[crow(r, hh)] = f.o[2][r];
        const float gc = sigmoidf_(graw_c);
        ot0 = f.o[0] * gc; ot1 = f.o[1] * gc;
    }
    asm volatile("s_waitcnt lgkmcnt(0)\n\ts_barrier" ::: "memory");
    if (qc < 16) { if (F.tid <= 64) selw[F.tid] = (2u << qc) - 1u; }
    else {
        LAS float* IMP = (LAS float*)(lds + OFF_IMP2); LAS float* SC = (LAS float*)(lds + OFF_SC2);
        const int q = F.tid >> 3, s4 = (F.tid & 7) * 4;
#pragma unroll
        for (int e = 0; e < 4; ++e) { const int s_ = s4 + e; float v = 0.f;
#pragma unroll
            for (int h4 = 0; h4 < 4; ++h4) v += IMP[((2 * h4 + (q >> 5)) * 32 + (q & 31)) * 32 + s_];
            const bool causal = s_ <= qc, forced = causal && (s_ == 0 || s_ + 2 > qc);
            SC[q * 32 + s_] = causal ? (v + (forced ? 1e4f : 0.f)) : -1e30f; }
        asm volatile("s_waitcnt lgkmcnt(0)\n\ts_barrier" ::: "memory");
        float sc[32];
#pragma unroll
        for (int s_ = 0; s_ < 32; ++s_) sc[s_] = SC[q * 32 + s_];
        unsigned bits = 0u;
#pragma unroll
        for (int e = 0; e < 4; ++e) { const int s_ = s4 + e; const float me = SC[q * 32 + s_]; int rank = 0;
#pragma unroll
            for (int s2 = 0; s2 < 32; ++s2) rank += (sc[s2] > me || (sc[s2] == me && s2 < s_)) ? 1 : 0;
            if (s_ <= qc && rank < 16) bits |= 1u << s_; }
        atomicOr((unsigned*)&selw[q], bits); atomicOr((unsigned*)&selw[64], bits);
    }
    asm volatile("s_waitcnt lgkmcnt(0)\n\ts_barrier" ::: "memory");
    const unsigned mymask = selw[qloc], anymask = selw[64];
    TMS_MARKEND(45);
    {
        Flash f; flash_init(f);
        auto par = [&](int j, int& lo, int& hi_, bool& need, float& cb) { lo = t - 511 - 64 * j; if (lo < 0) lo = 0; hi_ = t - 64 * j; if (hi_ > 63) hi_ = 63;
            need = (j == qc) || (j + 8 == qc); cb = slope2 * (float)(64 * j); return slope2 * (float)(64 * qc + 32 * (wave & 1) - (64 * j + 63)) < 256.f; };
        hand = flash_run<4, 2, true, true, true, false>(f, lds, tm_win, qr, slope2, src_win, par, true, hand, anymask, src_sel, r32, hh, lane);
        flash_finish(f, 2);
        const float gw = sigmoidf_(graw_w);
        ot0 += f.o[0] * gw; ot1 += f.o[1] * gw;
    }
    {
        Flash f; flash_init(f);
        const int tmin_w = 64 * qc + 32 * (wave & 1);
        auto par = [&](int j, int& lo, int& hi_, bool& need, float& cb) { const bool sel = (mymask >> j) & 1u; lo = 0; hi_ = (j == qc) ? (t - 64 * j) : 63;
            need = (j == qc); cb = sel ? slope2 * (float)(64 * j) : -INFINITY;
            return __any(sel) && slope2 * (float)(tmin_w - (64 * j + 63)) < 256.f; };
        (void)flash_run<4, 2, true, true, true, false>(f, lds, anymask, qr, slope2, src_sel, par, true, hand, 0u, NoNext(), r32, hh, lane);
        flash_finish(f, 2);
        const float gs = sigmoidf_(graw_s);
        ot0 += f.o[0] * gs; ot1 += f.o[1] * gs;
    }
    { bf16* op = (bf16*)(F.ws + WS_OCAT) + row * 1024 + head * 64 + 4 * hh;
#pragma unroll
      for (int k = 0; k < 4; ++k) {
          *(v2u*)(op + 8 * k) = (v2u){cvtpk(ot0[4 * k], ot0[4 * k + 1]), cvtpk(ot0[4 * k + 2], ot0[4 * k + 3])};
          *(v2u*)(op + 32 + 8 * k) = (v2u){cvtpk(ot1[4 * k], ot1[4 * k + 1]), cvtpk(ot1[4 * k + 2], ot1[4 * k + 3])}; } }
}

__device__ __forceinline__ void mla_unit(Frame& F, int b, int h, int qb) {
    int lane; asm volatile("v_and_b32_e32 %0, 63, %1" : "=v"(lane) : "v"(F.tid));
    LAS unsigned char* lds = F.lds; const int wave = F.wave, r32 = lane & 31, hh = lane >> 5;
    const int t = 256 * qb + 32 * wave + r32;
    const size_t row = (size_t)b * SEQ + t;
    const bf16* MQ = (const bf16*)(F.ws + WS_MLAQ); const bf16* MKV = (const bf16*)(F.ws + WS_MLAKV); const bf16* KPE = (const bf16*)(F.ws + WS_KPE);
    bf16x8 qr[6];
#pragma unroll
    for (int d0 = 0; d0 < 6; ++d0) qr[d0] = *(const bf16x8*)(MQ + row * 768 + h * 96 + d0 * 16 + hh * 8);
    {
        const float pos = (float)F.pos[row];
        v4u a = __builtin_bit_cast(v4u, qr[4]), c = __builtin_bit_cast(v4u, qr[5]);
        float x1[8], x2[8];
        x1[0] = bf_lo(a.x); x1[1] = bf_hi(a.x); x1[2] = bf_lo(a.y); x1[3] = bf_hi(a.y); x1[4] = bf_lo(a.z); x1[5] = bf_hi(a.z); x1[6] = bf_lo(a.w); x1[7] = bf_hi(a.w);
        x2[0] = bf_lo(c.x); x2[1] = bf_hi(c.x); x2[2] = bf_lo(c.y); x2[3] = bf_hi(c.y); x2[4] = bf_lo(c.z); x2[5] = bf_hi(c.z); x2[6] = bf_lo(c.w); x2[7] = bf_hi(c.w);
        float y1[8], y2[8];
#pragma unroll
        for (int j = 0; j < 8; ++j) { const float ang = pos * rope_inv(8 * hh + j); float sn, cs; rope_sincos(ang, sn, cs);
            y1[j] = x1[j] * cs - x2[j] * sn; y2[j] = x1[j] * sn + x2[j] * cs; }
        a = (v4u){cvtpk(y1[0], y1[1]), cvtpk(y1[2], y1[3]), cvtpk(y1[4], y1[5]), cvtpk(y1[6], y1[7])};
        c = (v4u){cvtpk(y2[0], y2[1]), cvtpk(y2[2], y2[3]), cvtpk(y2[4], y2[5]), cvtpk(y2[6], y2[7])};
        qr[4] = __builtin_bit_cast(bf16x8, a); qr[5] = __builtin_bit_cast(bf16x8, c);
    }
    asm volatile("" :: "v"(qr[0]), "v"(qr[1]), "v"(qr[2]), "v"(qr[3]), "v"(qr[4]), "v"(qr[5]));
    const bf16* Kg = MKV + (size_t)b * SEQ * 1024 + h * 128; const bf16* Vg = Kg + 64; const bf16* Pg = KPE + (size_t)b * SEQ * 32;
    Flash f; flash_init(f);
    const int NT = 4 * qb + 4;
    const int tmin_w = 256 * qb + 32 * wave, tmax_w = tmin_w + 31;
    auto src = [&](int j, int buf) { issue_tile<12>(lds, buf, Kg + (size_t)j * 64 * 1024, 1024, Pg + (size_t)j * 64 * 32, Vg + (size_t)j * 64 * 1024, 1024, wave, lane); };
    auto par = [&](int j, int& lo, int& hi_, bool& need, float& cb) { lo = 0; hi_ = t - 64 * j; if (hi_ > 63) hi_ = 63; need = (64 * j + 63 > tmin_w); cb = 0.f; return 64 * j <= tmax_w; };
    (void)flash_run<6, 2, false, false, false, false>(f, lds, NT == 32 ? 0xffffffffu : ((1u << NT) - 1u), qr, 0.f, src, par, false, 0, 0u, NoNext(), r32, hh, lane);
    flash_finish(f, 2);
    { bf16* op = (bf16*)(F.ws + WS_OCAT) + row * 1024 + 512 + h * 64 + 4 * hh;
#pragma unroll
      for (int k = 0; k < 4; ++k) {
          *(v2u*)(op + 8 * k) = (v2u){cvtpk(f.o[0][4 * k], f.o[0][4 * k + 1]), cvtpk(f.o[0][4 * k + 2], f.o[0][4 * k + 3])};
          *(v2u*)(op + 32 + 8 * k) = (v2u){cvtpk(f.o[1][4 * k], f.o[1][4 * k + 1]), cvtpk(f.o[1][4 * k + 2], f.o[1][4 * k + 3])}; } }
}

__device__ __forceinline__ int draw_unit(Frame& F, unsigned* ctr) {
    TMS_BEGIN(46);
    LAS int* slot = (LAS int*)(F.lds + OFF_SEL + 384);
    if (F.tid == 0) *slot = (int)__hip_atomic_fetch_add(ctr, 1u, __ATOMIC_RELAXED, __HIP_MEMORY_SCOPE_AGENT);
    __syncthreads();
    const int v = *slot;
    __syncthreads();
    TMS_END(46);
    return __builtin_amdgcn_readfirstlane(v);
}
__device__ __forceinline__ void nsa_loop(Frame& F) {
    unsigned* ctr = (unsigned*)(F.ws + WS_CTL) + 8192;
#pragma unroll 1
    for (int first = 1;; first = 0) { const int idx = (first && F.bid < 256) ? F.bid : 256 + draw_unit(F, ctr); if (idx >= 512) break; const int qc = 31 - (idx >> 4), bg = idx & 15; nsa_unit(F, bg >> 1, bg & 1, qc); }
}
__device__ __forceinline__ void mla_loop(Frame& F) {
    unsigned* ctr = (unsigned*)(F.ws + WS_CTL) + 8192 + 64;
#pragma unroll 1
    for (int first = 1;; first = 0) { const int idx = (first && F.bid < 256) ? F.bid : 256 + draw_unit(F, ctr); if (idx >= 512) break; const int qb = 7 - (idx >> 6), bh = idx & 63; mla_unit(F, bh >> 3, bh & 7, qb); }
}
}
#define NET_SORT16(K) do { CE(K[0], K[1]); CE(K[2], K[3]); CE(K[0], K[2]); CE(K[1], K[3]); CE(K[1], K[2]); CE(K[4], K[5]); CE(K[6], K[7]); CE(K[4], K[6]); CE(K[5], K[7]); CE(K[5], K[6]); CE(K[0], K[4]); CE(K[2], K[6]); CE(K[2], K[4]); CE(K[1], K[5]); CE(K[3], K[7]); CE(K[3], K[5]); CE(K[1], K[2]); CE(K[3], K[4]); CE(K[5], K[6]); CE(K[8], K[9]); CE(K[10], K[11]); CE(K[8], K[10]); CE(K[9], K[11]); CE(K[9], K[10]); CE(K[12], K[13]); CE(K[14], K[15]); CE(K[12], K[14]); CE(K[13], K[15]); CE(K[13], K[14]); CE(K[8], K[12]); CE(K[10], K[14]); CE(K[10], K[12]); CE(K[9], K[13]); CE(K[11], K[15]); CE(K[11], K[13]); CE(K[9], K[10]); CE(K[11], K[12]); CE(K[13], K[14]); CE(K[0], K[8]); CE(K[4], K[12]); CE(K[4], K[8]); CE(K[2], K[10]); CE(K[6], K[14]); CE(K[6], K[10]); CE(K[2], K[4]); CE(K[6], K[8]); CE(K[10], K[12]); CE(K[1], K[9]); CE(K[5], K[13]); CE(K[5], K[9]); CE(K[3], K[11]); CE(K[7], K[15]); CE(K[7], K[11]); CE(K[3], K[5]); CE(K[7], K[9]); CE(K[11], K[13]); CE(K[1], K[2]); CE(K[3], K[4]); CE(K[5], K[6]); CE(K[7], K[8]); CE(K[9], K[10]); CE(K[11], K[12]); CE(K[13], K[14]); } while (0)
#define NET_BMERGE16(K) do { CE(K[0], K[8]); CE(K[1], K[9]); CE(K[2], K[10]); CE(K[3], K[11]); CE(K[4], K[12]); CE(K[5], K[13]); CE(K[6], K[14]); CE(K[7], K[15]); CE(K[0], K[4]); CE(K[1], K[5]); CE(K[2], K[6]); CE(K[3], K[7]); CE(K[8], K[12]); CE(K[9], K[13]); CE(K[10], K[14]); CE(K[11], K[15]); CE(K[0], K[2]); CE(K[1], K[3]); CE(K[4], K[6]); CE(K[5], K[7]); CE(K[8], K[10]); CE(K[9], K[11]); CE(K[12], K[14]); CE(K[13], K[15]); CE(K[0], K[1]); CE(K[2], K[3]); CE(K[4], K[5]); CE(K[6], K[7]); CE(K[8], K[9]); CE(K[10], K[11]); CE(K[12], K[13]); CE(K[14], K[15]); } while (0)
__device__ __forceinline__ void kpe_pass(Frame& F) {
    const bf16* MISC = (const bf16*)(F.ws + WS_MISC); bf16* KPE = (bf16*)(F.ws + WS_KPE);
    const int gt = F.bid * NTHREADS + F.tid, NGT = F.G * NTHREADS;
    for (int it = gt; it < MTOK * 16; it += NGT) { const int t = it >> 4, i = it & 15;
        const float x1 = bf2f(MISC[(size_t)t * 256 + 128 + i]), x2 = bf2f(MISC[(size_t)t * 256 + 144 + i]);
        const float ang = (float)F.pos[t] * rope_inv(i); float sn, cs; rope_sincos(ang, sn, cs);
        KPE[(size_t)t * 32 + i] = (bf16)f2bf(x1 * cs - x2 * sn); KPE[(size_t)t * 32 + 16 + i] = (bf16)f2bf(x1 * sn + x2 * cs); }
}
__device__ __forceinline__ void cmp_finalize(Frame& F) {
    const int gw = F.bid * NWAVES + F.wave, NGW = F.G * NWAVES, lane = F.lane;
    LAS float* W2S = (LAS float*)(F.lds + 16384);
    LAS float* hid = (LAS float*)(F.lds + F.wave * 1024);
    for (int i = F.tid; i < 2 * 128 * 64 / 4; i += NTHREADS) { const int kv = i >> 11, j = i & 2047; ((LAS f32x4*)W2S)[i] = ((const f32x4*)F.in[kv ? I_CW2V : I_CW2K])[j]; }
    __syncthreads();
    for (int it = gw; it < 2 * 16 * 128; it += NGW) {
        const int kv = it >> 11, bg = (it >> 7) & 15, n = it & 127;
        bf16* dst = (bf16*)(F.ws + (kv ? WS_VC : WS_KC)) + ((size_t)bg * 128 + n) * 64;
        if (n == 127) { dst[lane] = 0; continue; }
        const float* U = (const float*)(F.ws + WS_USLAB) + (size_t)kv * 4 * 2048 * 256 + (size_t)(bg * 128 + n) * 256; const float* c1 = (const float*)(F.ws + (kv ? WS_C1V : WS_C1K));
        float a0 = c1[lane], a1 = c1[64 + lane];
#pragma unroll
        for (int s = 0; s < 4; ++s) { const float* Us = U + (size_t)s * 2048 * 256; a0 += Us[lane] + Us[256 + 128 + lane]; a1 += Us[64 + lane] + Us[256 + 192 + lane]; }
        hid[lane] = gelu_tanh(a0); hid[64 + lane] = gelu_tanh(a1);
        asm volatile("s_waitcnt lgkmcnt(0)" ::: "memory");
        const LAS float* w2 = W2S + kv * 8192 + lane;
        float s0 = 0.f, s1 = 0.f, s2 = 0.f, s3 = 0.f;
#pragma unroll 8
        for (int i = 0; i < 128; i += 4) { s0 += hid[i] * w2[i * 64]; s1 += hid[i + 1] * w2[(i + 1) * 64]; s2 += hid[i + 2] * w2[(i + 2) * 64]; s3 += hid[i + 3] * w2[(i + 3) * 64]; }
        dst[lane] = (bf16)f2bf((s0 + s1) + (s2 + s3));
        asm volatile("s_waitcnt lgkmcnt(0)" ::: "memory");
    }
}
template <bool SIGNED>
__device__ __forceinline__ void quant_table(Frame& F, const float* src, unsigned char* dst, float* steps) {
    const int gw = F.bid * NWAVES + F.wave, NGW = F.G * NWAVES, lane = F.lane;
    for (int e0 = gw; e0 < 16384; e0 += 2 * NGW) {
        const int e1 = (e0 + NGW < 16384) ? e0 + NGW : e0;
        const f32x4* spa = (const f32x4*)(src + (size_t)e0 * 1024) + 4 * lane; const f32x4* spb = (const f32x4*)(src + (size_t)e1 * 1024) + 4 * lane;
        f32x4 va[4], vb[4];
#pragma unroll
        for (int j = 0; j < 4; ++j) { va[j] = spa[j]; vb[j] = spb[j]; }
        float ma = 0.f, mb = 0.f;
#pragma unroll
        for (int j = 0; j < 4; ++j) { ma = fmaxf(ma, fmaxf(fmaxf(fabsf(va[j].x), fabsf(va[j].y)), fmaxf(fabsf(va[j].z), fabsf(va[j].w)))); mb = fmaxf(mb, fmaxf(fmaxf(fabsf(vb[j].x), fabsf(vb[j].y)), fmaxf(fabsf(vb[j].z), fabsf(vb[j].w)))); }
#pragma unroll
        for (int o = 1; o < 64; o <<= 1) { ma = fmaxf(ma, __shfl_xor(ma, o)); mb = fmaxf(mb, __shfl_xor(mb, o)); }
        const float offs = SIGNED ? 0.f : 128.f;
        const float sta = ma > 0.f ? ma * (1.0f / 127.0f) : 1.0f, ia = 1.0f / sta, stb = mb > 0.f ? mb * (1.0f / 127.0f) : 1.0f, ib = 1.0f / stb;
        v4u wa, wb;
#pragma unroll
        for (int j = 0; j < 4; ++j) {
            wa[j] = ((unsigned)(int)(rintf(va[j].x * ia) + offs) & 0xffu) | (((unsigned)(int)(rintf(va[j].y * ia) + offs) & 0xffu) << 8) | (((unsigned)(int)(rintf(va[j].z * ia) + offs) & 0xffu) << 16) | (((unsigned)(int)(rintf(va[j].w * ia) + offs) & 0xffu) << 24);
            wb[j] = ((unsigned)(int)(rintf(vb[j].x * ib) + offs) & 0xffu) | (((unsigned)(int)(rintf(vb[j].y * ib) + offs) & 0xffu) << 8) | (((unsigned)(int)(rintf(vb[j].z * ib) + offs) & 0xffu) << 16) | (((unsigned)(int)(rintf(vb[j].w * ib) + offs) & 0xffu) << 24); }
        ((v4u*)(dst + (size_t)e0 * 1024))[lane] = wa; ((v4u*)(dst + (size_t)e1 * 1024))[lane] = wb;
        if (lane == 0) { steps[e0] = sta; steps[e1] = stb; }
    }
}

__device__ __forceinline__ void quant_table4(Frame& F, const float* src, unsigned char* dst, float* steps) {
    const int gw = F.bid * NWAVES + F.wave, NGW = F.G * NWAVES, lane = F.lane;
    for (int e0 = gw; e0 < 16384; e0 += 2 * NGW) {
        const int e1 = (e0 + NGW < 16384) ? e0 + NGW : e0;
        const f32x4* spa = (const f32x4*)(src + (size_t)e0 * 1024) + 4 * lane; const f32x4* spb = (const f32x4*)(src + (size_t)e1 * 1024) + 4 * lane;
        f32x4 va[4], vb[4];
#pragma unroll
        for (int j = 0; j < 4; ++j) { va[j] = spa[j]; vb[j] = spb[j]; }
        float ma = 0.f, mb = 0.f, qa = 0.f, qb = 0.f;
#pragma unroll
        for (int j = 0; j < 4; ++j) { ma = fmaxf(ma, fmaxf(fmaxf(fabsf(va[j].x), fabsf(va[j].y)), fmaxf(fabsf(va[j].z), fabsf(va[j].w)))); mb = fmaxf(mb, fmaxf(fmaxf(fabsf(vb[j].x), fabsf(vb[j].y)), fmaxf(fabsf(vb[j].z), fabsf(vb[j].w))));
            qa += va[j].x * va[j].x + va[j].y * va[j].y + va[j].z * va[j].z + va[j].w * va[j].w; qb += vb[j].x * vb[j].x + vb[j].y * vb[j].y + vb[j].z * vb[j].z + vb[j].w * vb[j].w; }
#pragma unroll
        for (int o = 1; o < 64; o <<= 1) { ma = fmaxf(ma, __shfl_xor(ma, o)); mb = fmaxf(mb, __shfl_xor(mb, o)); qa += __shfl_xor(qa, o); qb += __shfl_xor(qb, o); }
        const float ra = fminf(0.35f * sqrtf(qa * (1.0f / 1024.0f)), ma * (1.0f / 7.0f)), rb = fminf(0.35f * sqrtf(qb * (1.0f / 1024.0f)), mb * (1.0f / 7.0f));
        const float sta = ra > 0.f ? ra : 1.0f, ia = 1.0f / sta, stb = rb > 0.f ? rb : 1.0f, ib = 1.0f / stb;
        auto nib2 = [](float lo, float hi, float inv) -> unsigned {
            const int ql = (int)fminf(fmaxf(rintf(lo * inv), -7.f), 7.f) + 8, qh = (int)fminf(fmaxf(rintf(hi * inv), -7.f), 7.f);
            return (unsigned)ql | (((unsigned)qh & 15u) << 4); };
        v2u wa, wb;
#pragma unroll
        for (int j = 0; j < 2; ++j) {
            wa[j] = nib2(va[2 * j].x, va[2 * j].y, ia) | (nib2(va[2 * j].z, va[2 * j].w, ia) << 8) | (nib2(va[2 * j + 1].x, va[2 * j + 1].y, ia) << 16) | (nib2(va[2 * j + 1].z, va[2 * j + 1].w, ia) << 24);
            wb[j] = nib2(vb[2 * j].x, vb[2 * j].y, ib) | (nib2(vb[2 * j].z, vb[2 * j].w, ib) << 8) | (nib2(vb[2 * j + 1].x, vb[2 * j + 1].y, ib) << 16) | (nib2(vb[2 * j + 1].z, vb[2 * j + 1].w, ib) << 24); }
        ((v2u*)(dst + (size_t)e0 * 512))[lane] = wa; ((v2u*)(dst + (size_t)e1 * 512))[lane] = wb;
        if (lane == 0) { steps[e0] = sta; steps[e1] = stb; }
    }
}

namespace peer {
constexpr int TOK = 32;
constexpr int LSTR = 17;
constexpr int OFF_LISTV = 0, OFF_LISTK = 34816;
constexpr int OFF_ROUTE = 45056;
constexpr int OFF_SKB = 77824;
struct Ent { float v; unsigned k; };
__device__ __forceinline__ unsigned ordkey(float f) { const unsigned u = __float_as_uint(f); return u ^ ((u >> 31) ? 0xffffffffu : 0x80000000u); }
__device__ __forceinline__ float ordinv(unsigned k) { return __uint_as_float(k ^ ((k >> 31) ? 0x80000000u : 0xffffffffu)); }
__device__ __forceinline__ void swap2(int x, int& lo, int& hi) { auto rr = __builtin_amdgcn_permlane32_swap((unsigned)x, (unsigned)x, false, false); lo = (int)rr[0]; hi = (int)rr[1]; }

#define CE(a, b) do { const unsigned x_ = (a) > (b) ? (a) : (b), y_ = (a) > (b) ? (b) : (a); (a) = x_; (b) = y_; } while (0)
__device__ __forceinline__ void merge_top16(unsigned (&a)[16], const unsigned (&b)[16]) {
#pragma unroll
    for (int i = 0; i < 16; ++i) a[i] = a[i] > b[15 - i] ? a[i] : b[15 - i];
    NET_BMERGE16(a);
}
__device__ __forceinline__ void top16_of64(unsigned (&w)[4][16]) {
    NET_SORT16(w[0]); NET_SORT16(w[1]); NET_SORT16(w[2]); NET_SORT16(w[3]);
    merge_top16(w[0], w[1]); merge_top16(w[2], w[3]); merge_top16(w[0], w[2]);
}

#define PEER_CANDS(X) X(0,0) X(0,1) X(0,2) X(0,3) X(0,4) X(0,5) X(0,6) X(0,7) X(0,8) X(0,9) X(0,10) X(0,11) X(0,12) X(0,13) X(0,14) X(0,15) \
    X(1,0) X(1,1) X(1,2) X(1,3) X(1,4) X(1,5) X(1,6) X(1,7) X(2,0) X(2,1) X(2,2) X(2,3) X(2,4) X(3,0) X(3,1) X(3,2) X(3,3) X(4,0) X(4,1) X(4,2) \
    X(5,0) X(5,1) X(6,0) X(6,1) X(7,0) X(7,1) X(8,0) X(9,0) X(10,0) X(11,0) X(12,0) X(13,0) X(14,0) X(15,0)

__device__ __forceinline__ void route_task(Frame& F, int tok0) {
    int lane; asm volatile("v_and_b32_e32 %0, 63, %1" : "=v"(lane) : "v"(F.tid));
    const int wave = F.wave, r32 = lane & 31, hh = lane >> 5;
    const bf16* QP = (const bf16*)(F.ws + WS_QP);
    const size_t row = (size_t)tok0 + r32;
    LAS unsigned char* LK = F.lds + OFF_LISTK + (size_t)wave * 2 * TOK * LSTR;
    LAS unsigned char* SKB = F.lds + OFF_SKB;
    LAS unsigned char* CANDT = F.lds + OFF_LISTV;
    if (F.tid < 64) { int ci = 0; unsigned ab = 0u;
#define X(a, b) ab = ((int)F.tid == ci) ? (unsigned)((a) * 16 + (b)) : ab; ++ci;
        PEER_CANDS(X)
#undef X
        CANDT[F.tid] = (unsigned char)ab; }
    unsigned l1[16], l2[16];
#pragma unroll 1
    for (int half = 0; half < 2; ++half) {
        const bf16* SK = (const bf16*)(F.ws + (half ? WS_SK2 : WS_SK1));
        if (half) __syncthreads();
#pragma unroll
        for (int i = 0; i < 4; ++i) { const int pc = 4 * wave + i, c = pc >> 1, kbk = pc & 1;
            __builtin_amdgcn_global_load_lds((const unsigned*)(SK + (size_t)(64 * kbk + lane) * 128 + c * 8), (LAS unsigned*)(SKB + c * 2048 + kbk * 1024), 16, 0, 0); }
        bf16x8 qf[8];
#pragma unroll
        for (int d0 = 0; d0 < 8; ++d0) qf[d0] = *(const bf16x8*)(QP + row * 2048 + wave * 256 + half * 128 + d0 * 16 + hh * 8);
        __syncthreads();
        unsigned w[4][16];
#pragma unroll
        for (int kb = 0; kb < 4; ++kb) { f32x16 pacc = f32x16{};
#pragma unroll
            for (int d0 = 0; d0 < 8; ++d0) { const bf16x8 a = *(const LAS bf16x8*)(SKB + (2 * d0 + hh) * 2048 + (32 * kb + r32) * 16);
                pacc = __builtin_amdgcn_mfma_f32_32x32x16_bf16(a, qf[d0], pacc, 0, 0, 0); }
#pragma unroll
            for (int r = 0; r < 16; ++r) w[kb][r] = (ordkey(pacc[r]) & ~127u) | (unsigned)(127 - (32 * kb + (r & 3) + 8 * (r >> 2))); }
        top16_of64(w);
        unsigned la[16], lb[16];
#pragma unroll
        for (int i = 0; i < 16; ++i) { const unsigned x = w[0][i] ^ (unsigned)(4 * hh); auto rr = __builtin_amdgcn_permlane32_swap(x, x, false, false); la[i] = rr[0]; lb[i] = rr[1]; }
        merge_top16(la, lb);
        { LAS unsigned char* Lk = LK + ((size_t)half * TOK + r32) * LSTR + 8 * hh;
#pragma unroll
          for (int j = 0; j < 8; ++j) { const unsigned kx = hh ? la[8 + j] : la[j]; Lk[j] = (unsigned char)(127u - (kx & 127u)); } }
#pragma unroll
        for (int i = 0; i < 16; ++i) { if (half == 0) l1[i] = la[i]; else l2[i] = la[i]; }
    }
    asm volatile("s_waitcnt lgkmcnt(0)" ::: "memory");
    {
        const LAS unsigned char* L1k = LK + ((size_t)0 * TOK + r32) * LSTR; const LAS unsigned char* L2k = LK + ((size_t)1 * TOK + r32) * LSTR;
        float v1[16], v2[16];
#pragma unroll
        for (int a = 0; a < 16; ++a) { v1[a] = ordinv(l1[a] & ~127u); v2[a] = ordinv(l2[a] & ~127u); }
        unsigned w[4][16]; { int ci = 0;
#define X(a, b) w[ci >> 4][ci & 15] = (ordkey(v1[a] + v2[b]) & ~63u) | (unsigned)(63 - ci); ++ci;
        PEER_CANDS(X)
#undef X
#pragma unroll
          for (int i = 50; i < 64; ++i) w[i >> 4][i & 15] = 0u; }
        const float cmax = v1[0] + v2[0];
        top16_of64(w);
        float ge[8]; float gsum = 0.f; unsigned id[8];
#pragma unroll
        for (int j = 0; j < 8; ++j) { const unsigned kx = hh ? w[0][8 + j] : w[0][j]; id[j] = 63u - (kx & 63u); ge[j] = __expf(ordinv(kx & ~63u) - cmax); gsum += ge[j]; }
        { auto rr = __builtin_amdgcn_permlane32_swap(__float_as_uint(gsum), __float_as_uint(gsum), false, false); gsum = __uint_as_float(rr[0]) + __uint_as_float(rr[1]); }
        const float ginv = 1.0f / gsum;
        LAS Ent* R = (LAS Ent*)(F.lds + OFF_ROUTE) + ((size_t)wave * TOK + r32) * 16 + 8 * hh;
#pragma unroll
        for (int j = 0; j < 8; ++j) { const unsigned ab = CANDT[id[j]]; R[j].k = (unsigned)L1k[ab >> 4] * 128u + (unsigned)L2k[ab & 15u]; R[j].v = ge[j] * ginv; }
    }
}

constexpr int OFF_SORT = 77824;
constexpr int OFF_OFFS = 20480;
constexpr int NRANGE = 16, RSHIFT = 10;
__device__ __forceinline__ float ub0(unsigned w) { return (float)(w & 0xffu); }
__device__ __forceinline__ float ub1(unsigned w) { return (float)((w >> 8) & 0xffu); }
__device__ __forceinline__ float ub2(unsigned w) { return (float)((w >> 16) & 0xffu); }
__device__ __forceinline__ float ub3(unsigned w) { return (float)(w >> 24); }
__device__ __forceinline__ int mbcnt64(unsigned long long m) { return (int)__builtin_amdgcn_mbcnt_hi((unsigned)(m >> 32), __builtin_amdgcn_mbcnt_lo((unsigned)m, 0u)); }

constexpr int OFF_SDN = 0;
__device__ __forceinline__ void sort_token(Frame& F, int tl, int lane) {
    const LAS Ent* R = (const LAS Ent*)(F.lds + OFF_ROUTE); LAS Ent* SO = (LAS Ent*)(F.lds + OFF_SORT) + (size_t)tl * 128; LAS int* OF = (LAS int*)(F.lds + OFF_OFFS) + tl * 17;
    LAS float* SDN = (LAS float*)(F.lds + OFF_SDN) + tl * 128;
    const float* SD = (const float*)(F.ws + WS_EXPD_SC); const float* SU = (const float*)(F.ws + WS_EXPU_SC);
    const LAS Ent* p0 = R + ((size_t)(lane >> 4) * TOK + tl) * 16 + (lane & 15); const LAS Ent* p1 = R + ((size_t)(4 + (lane >> 4)) * TOK + tl) * 16 + (lane & 15);
    const unsigned e0 = p0->k, e1 = p1->k; const float g0 = p0->v * SU[e0], g1 = p1->v * SU[e1]; const float d0 = SD[e0], d1 = SD[e1];
    const int r0 = (int)(e0 >> RSHIFT), r1 = (int)(e1 >> RSHIFT);
    int base = 0, pos0 = 0, pos1 = 0;
#pragma unroll
    for (int r = 0; r < NRANGE; ++r) {
        const unsigned long long m0 = __ballot(r0 == r), m1 = __ballot(r1 == r);
        const int n0 = __popcll(m0), n1 = __popcll(m1);
        if (r0 == r) pos0 = base + mbcnt64(m0);
        if (r1 == r) pos1 = base + n0 + mbcnt64(m1);
        if (lane == 0) OF[r] = base;
        base += n0 + n1;
    }
    if (lane == 0) OF[NRANGE] = base;
    SO[pos0].k = e0; SO[pos0].v = g0; SO[pos1].k = e1; SO[pos1].v = g1; SDN[pos0] = d0; SDN[pos1] = d1;
}

struct Rows4 { v4u r[4]; };
__device__ __forceinline__ void fetch_rows(const unsigned char* tab, const LAS Ent* SO, Rows4& q, int lane) {
    unsigned ex[4];
#pragma unroll
    for (int k = 0; k < 4; ++k) ex[k] = (unsigned)__builtin_amdgcn_readfirstlane((int)SO[k].k);
#pragma unroll
    for (int k = 0; k < 4; ++k) q.r[k] = ((const v4u*)(tab + (size_t)ex[k] * 1024))[lane];
}
__device__ __forceinline__ void down_chunk(const Rows4& q, const int (&xq)[4], float sx, LAS Ent* SO, const LAS float* SDN, int lane) {
    int s[4];
#pragma unroll
    for (int k = 0; k < 4; ++k) { s[k] = 0;
#pragma unroll
        for (int c = 0; c < 4; ++c) s[k] = __builtin_amdgcn_sdot4((int)q.r[k][c], xq[c], s[k], false); }
#pragma unroll
    for (int k = 0; k < 4; ++k) s[k] += __builtin_amdgcn_update_dpp(0, s[k], 0xB1, 0xF, 0xF, true);
#pragma unroll
    for (int k = 0; k < 4; ++k) s[k] += __builtin_amdgcn_update_dpp(0, s[k], 0x4E, 0xF, 0xF, true);
#pragma unroll
    for (int k = 0; k < 4; ++k) s[k] += __builtin_amdgcn_update_dpp(0, s[k], 0x141, 0xF, 0xF, true);
#pragma unroll
    for (int k = 0; k < 4; ++k) s[k] += __builtin_amdgcn_update_dpp(0, s[k], 0x140, 0xF, 0xF, true);
    int dv = 0;
#pragma unroll
    for (int k = 0; k < 4; ++k) { const int dt = (__builtin_amdgcn_readlane(s[k], 0) + __builtin_amdgcn_readlane(s[k], 16)) + (__builtin_amdgcn_readlane(s[k], 32) + __builtin_amdgcn_readlane(s[k], 48)); dv = (lane == k) ? dt : dv; }
    if (lane < 4) { const float hk = SDN[lane] * sx * (float)dv; SO[lane].v = SO[lane].v * gelu_tanh(hk); }
}
struct Rows4h { v2u r[4]; };
__device__ __forceinline__ void fetch_rows_h(const unsigned char* tab, const LAS Ent* SO, Rows4h& q, int lane) {
    unsigned ex[4];
#pragma unroll
    for (int k = 0; k < 4; ++k) ex[k] = (unsigned)__builtin_amdgcn_readfirstlane((int)SO[k].k);
#pragma unroll
    for (int k = 0; k < 4; ++k) q.r[k] = ((const v2u*)(tab + (size_t)ex[k] * 512))[lane];
}
__device__ __forceinline__ void up_chunk_h(const Rows4h& q, unsigned wq4, int (&ya)[8], int (&yb)[8]) {
#pragma unroll
    for (int c = 0; c < 2; ++c) {
        const unsigned r0 = q.r[0][c], r1 = q.r[1][c], r2 = q.r[2][c], r3 = q.r[3][c];
        const unsigned a_lo = __builtin_amdgcn_perm(r1, r0, 0x05010400u), a_hi = __builtin_amdgcn_perm(r1, r0, 0x07030602u);
        const unsigned b_lo = __builtin_amdgcn_perm(r3, r2, 0x05010400u), b_hi = __builtin_amdgcn_perm(r3, r2, 0x07030602u);
        const unsigned t0 = __builtin_amdgcn_perm(b_lo, a_lo, 0x05040100u), t1 = __builtin_amdgcn_perm(b_lo, a_lo, 0x07060302u);
        const unsigned t2 = __builtin_amdgcn_perm(b_hi, a_hi, 0x05040100u), t3 = __builtin_amdgcn_perm(b_hi, a_hi, 0x07060302u);
        ya[4 * c + 0] = __builtin_amdgcn_sdot4((int)t0, (int)wq4, ya[4 * c + 0], false); yb[4 * c + 0] = __builtin_amdgcn_sdot4((int)(t0 & 0x0f0f0f0fu), (int)wq4, yb[4 * c + 0], false);
        ya[4 * c + 1] = __builtin_amdgcn_sdot4((int)t1, (int)wq4, ya[4 * c + 1], false); yb[4 * c + 1] = __builtin_amdgcn_sdot4((int)(t1 & 0x0f0f0f0fu), (int)wq4, yb[4 * c + 1], false);
        ya[4 * c + 2] = __builtin_amdgcn_sdot4((int)t2, (int)wq4, ya[4 * c + 2], false); yb[4 * c + 2] = __builtin_amdgcn_sdot4((int)(t2 & 0x0f0f0f0fu), (int)wq4, yb[4 * c + 2], false);
        ya[4 * c + 3] = __builtin_amdgcn_sdot4((int)t3, (int)wq4, ya[4 * c + 3], false); yb[4 * c + 3] = __builtin_amdgcn_sdot4((int)(t3 & 0x0f0f0f0fu), (int)wq4, yb[4 * c + 3], false);
    }
}

__device__ __forceinline__ void gather_sweep(Frame& F, int tok0) {
    int lane; asm volatile("v_and_b32_e32 %0, 63, %1" : "=v"(lane) : "v"(F.tid));
    const int wave = F.wave;
    { TMS_BEGIN(12);
#pragma unroll 1
    for (int i = 0; i < 4; ++i) sort_token(F, 4 * wave + i, lane);
    TMS_END(12); }
    const unsigned char* EXPD = F.ws + WS_EXPD; const unsigned char* EXPU = F.ws + WS_EXPU;
    LAS Ent* SOW = (LAS Ent*)(F.lds + OFF_SORT) + (size_t)(4 * wave) * 128; const LAS float* SDW = (const LAS float*)(F.lds + OFF_SDN) + (4 * wave) * 128;
    { TMS_BEGIN(13); TMS_DECL; TMS_MARK(47);
        int xq[4][4]; float sxs[4];
#pragma unroll
        for (int tk = 0; tk < 4; ++tk) {
            const size_t row = (size_t)tok0 + 4 * wave + tk;
            const v4u* hp = (const v4u*)((const bf16*)(F.ws + WS_XN2) + row * DM) + 2 * lane; const f32x4* gp = (const f32x4*)F.in[I_N2G] + 4 * lane;
            float xh[16]; float ss = 0.f;
#pragma unroll
            for (int c = 0; c < 2; ++c) { const v4u w = hp[c]; xh[8 * c] = bf_lo(w.x); xh[8 * c + 1] = bf_hi(w.x); xh[8 * c + 2] = bf_lo(w.y); xh[8 * c + 3] = bf_hi(w.y); xh[8 * c + 4] = bf_lo(w.z); xh[8 * c + 5] = bf_hi(w.z); xh[8 * c + 6] = bf_lo(w.w); xh[8 * c + 7] = bf_hi(w.w); }
#pragma unroll
            for (int e = 0; e < 16; ++e) ss += xh[e] * xh[e];
            const float r = __builtin_amdgcn_rsqf(wave_sum(ss) * (1.f / DM) + EPS);
            float mx = 0.f;
#pragma unroll
            for (int c = 0; c < 4; ++c) { const f32x4 g = gp[c]; xh[4 * c] *= r * g.x; xh[4 * c + 1] *= r * g.y; xh[4 * c + 2] *= r * g.z; xh[4 * c + 3] *= r * g.w;
                mx = fmaxf(mx, fmaxf(fmaxf(fabsf(xh[4 * c]), fabsf(xh[4 * c + 1])), fmaxf(fabsf(xh[4 * c + 2]), fabsf(xh[4 * c + 3])))); }
#pragma unroll
            for (int o = 1; o < 64; o <<= 1) mx = fmaxf(mx, __shfl_xor(mx, o));
            mx = __uint_as_float((unsigned)__builtin_amdgcn_readfirstlane((int)__float_as_uint(mx)));
            const float step = mx > 0.f ? mx * (1.0f / 127.0f) : 1.0f, inv = 1.0f / step;
            sxs[tk] = step;
#pragma unroll
            for (int c = 0; c < 4; ++c) { const unsigned b0 = (unsigned)(int)rintf(xh[4 * c] * inv) & 0xffu, b1 = (unsigned)(int)rintf(xh[4 * c + 1] * inv) & 0xffu, b2 = (unsigned)(int)rintf(xh[4 * c + 2] * inv) & 0xffu, b3 = (unsigned)(int)rintf(xh[4 * c + 3] * inv) & 0xffu;
                xq[tk][c] = (int)(b0 | (b1 << 8) | (b2 << 16) | (b3 << 24)); }
        }
        asm volatile("s_waitcnt lgkmcnt(0)" ::: "memory");
        Rows4 b0, b1, b2, b3, b4, b5, b6, b7;
#define P1_FETCH(buf, u, j) fetch_rows(EXPD, SOW + ((u) & 3) * 128 + 4 * (2 * (j) + ((u) >> 2)), buf, lane)
#define P1_STEP(buf, u) do { down_chunk(buf, xq[(u) & 3], sxs[(u) & 3], SOW + ((u) & 3) * 128 + 4 * (2 * j + ((u) >> 2)), SDW + ((u) & 3) * 128 + 4 * (2 * j + ((u) >> 2)), lane); \
        if (j < 15) P1_FETCH(buf, u, j + 1); } while (0)
        P1_FETCH(b0, 0, 0); P1_FETCH(b1, 1, 0); P1_FETCH(b2, 2, 0); P1_FETCH(b3, 3, 0); P1_FETCH(b4, 4, 0); P1_FETCH(b5, 5, 0); P1_FETCH(b6, 6, 0); P1_FETCH(b7, 7, 0);
#pragma unroll 1
        for (int j = 0; j < 16; ++j) { P1_STEP(b0, 0); P1_STEP(b1, 1); P1_STEP(b2, 2); P1_STEP(b3, 3); P1_STEP(b4, 4); P1_STEP(b5, 5); P1_STEP(b6, 6); P1_STEP(b7, 7); }
#undef P1_FETCH
#undef P1_STEP
    TMS_END(13); TMS_MARKEND(47); }
    asm volatile("s_waitcnt lgkmcnt(0)" ::: "memory");
    constexpr int OFF_W8 = 16384;
    float wsc[4]; int wsum[4];
#pragma unroll
    for (int tk = 0; tk < 4; ++tk) {
        const float w0 = SOW[tk * 128 + lane].v, w1 = SOW[tk * 128 + 64 + lane].v;
        float mx = fmaxf(fabsf(w0), fabsf(w1));
#pragma unroll
        for (int o = 1; o < 64; o <<= 1) mx = fmaxf(mx, __shfl_xor(mx, o));
        mx = __uint_as_float((unsigned)__builtin_amdgcn_readfirstlane((int)__float_as_uint(mx)));
        const float step = mx > 0.f ? mx * (1.0f / 127.0f) : 1.0f, inv = 1.0f / step; wsc[tk] = step;
        LAS unsigned char* W8 = F.lds + OFF_W8 + (4 * wave + tk) * 128;
        const int q0 = (int)rintf(w0 * inv), q1 = (int)rintf(w1 * inv);
        W8[lane] = (unsigned char)(q0 & 0xff); W8[64 + lane] = (unsigned char)(q1 & 0xff);
        int qs = q0 + q1;
#pragma unroll
        for (int o = 1; o < 64; o <<= 1) qs += __shfl_xor(qs, o);
        wsum[tk] = __builtin_amdgcn_readfirstlane(qs);
    }
    asm volatile("s_waitcnt lgkmcnt(0)" ::: "memory");
    { TMS_BEGIN(14); TMS_DECL; TMS_MARK(48);
        int ya[4][8], yb[4][8];
#pragma unroll
        for (int tk = 0; tk < 4; ++tk)
#pragma unroll
            for (int e = 0; e < 8; ++e) { ya[tk][e] = 0; yb[tk][e] = 0; }
        const LAS unsigned* W8W = (const LAS unsigned*)(F.lds + OFF_W8 + (4 * wave) * 128);
        Rows4h b0, b1, b2, b3, b4, b5, b6, b7;
#define P2_FETCH(buf, u, j) fetch_rows_h(EXPU, SOW + ((u) & 3) * 128 + 4 * (2 * (j) + ((u) >> 2)), buf, lane)
#define P2_STEP(buf, u) do { up_chunk_h(buf, (unsigned)__builtin_amdgcn_readfirstlane((int)W8W[((u) & 3) * 32 + 2 * j + ((u) >> 2)]), ya[(u) & 3], yb[(u) & 3]); if (j < 15) P2_FETCH(buf, u, j + 1); } while (0)
        P2_FETCH(b0, 0, 0); P2_FETCH(b1, 1, 0); P2_FETCH(b2, 2, 0); P2_FETCH(b3, 3, 0); P2_FETCH(b4, 4, 0); P2_FETCH(b5, 5, 0); P2_FETCH(b6, 6, 0); P2_FETCH(b7, 7, 0);
#pragma unroll 1
        for (int j = 0; j < 16; ++j) { P2_STEP(b0, 0); P2_STEP(b1, 1); P2_STEP(b2, 2); P2_STEP(b3, 3); P2_STEP(b4, 4); P2_STEP(b5, 5); P2_STEP(b6, 6); P2_STEP(b7, 7); }
#undef P2_FETCH
#undef P2_STEP
        int yi[4][16];
#pragma unroll
        for (int tk = 0; tk < 4; ++tk)
#pragma unroll
            for (int e = 0; e < 8; ++e) { yi[tk][2 * e] = yb[tk][e] - 8 * wsum[tk]; yi[tk][2 * e + 1] = (ya[tk][e] - yb[tk][e]) >> 4; }
#pragma unroll
        for (int tk = 0; tk < 4; ++tk) {
            const size_t row = (size_t)tok0 + 4 * wave + tk;
            const v4u* hb = (const v4u*)((const bf16*)(F.ws + WS_XN2) + row * DM) + 2 * lane; f32x4* hp = (f32x4*)(F.out + row * DM) + 4 * lane; const f32x4* gp = (const f32x4*)F.in[I_NFG] + 4 * lane;
            float hv[16]; float ss = 0.f; const float ws = wsc[tk];
#pragma unroll
            for (int c = 0; c < 2; ++c) { const v4u w = hb[c]; hv[8 * c] = bf_lo(w.x); hv[8 * c + 1] = bf_hi(w.x); hv[8 * c + 2] = bf_lo(w.y); hv[8 * c + 3] = bf_hi(w.y); hv[8 * c + 4] = bf_lo(w.z); hv[8 * c + 5] = bf_hi(w.z); hv[8 * c + 6] = bf_lo(w.w); hv[8 * c + 7] = bf_hi(w.w); }
#ifdef TIMER_PHASE
            float sy_ = 0.f;
#pragma unroll
            for (int e = 0; e < 16; ++e) { const float yy = ws * (float)yi[tk][e]; sy_ += yy * yy; }
            sy_ = wave_sum(sy_);
#endif
#pragma unroll
            for (int e = 0; e < 16; ++e) { hv[e] += ws * (float)yi[tk][e]; ss += hv[e] * hv[e]; }
#ifdef TIMER_PHASE
            const float st_ = wave_sum(ss);
            if (TIMER_PHASE == 15 && lane == 0) { atomicAdd((unsigned*)(F.lds + RING_BYTES + 512), (unsigned)(1e5f * sy_ / st_ * (1.f / 64.f))); }
#endif
            const float r = __builtin_amdgcn_rsqf(wave_sum(ss) * (1.f / DM) + EPS);
#pragma unroll
            for (int c = 0; c < 4; ++c) { const f32x4 g = gp[c]; hp[c] = (f32x4){hv[4 * c] * r * g.x, hv[4 * c + 1] * r * g.y, hv[4 * c + 2] * r * g.z, hv[4 * c + 3] * r * g.w}; }
        }
    TMS_END(14); TMS_MARKEND(48); }
}

__device__ __forceinline__ void peer_phase(Frame& F, bool never) {
    (void)never;
    for (int task = F.bid; task < MTOK / TOK; task += F.G) {
        const int tok0 = task * TOK;
        { TMS_BEGIN(10); route_task(F, tok0);
        __syncthreads(); TMS_END(10); }
        { TMS_BEGIN(11); gather_sweep(F, tok0);
        __syncthreads(); TMS_END(11); }
    }
}
}
#define XB_TMO      128
#define XB_XCNT(j)  (256  + 64 * (j))
#define XB_XSUB(j)  (1280 + 64 * (j))
#define XB_XGEN(j)  (2304 + 64 * (j))
#define XB_TOP      3328
#define XB_TOPGEN   3392
#define XCD_BAR_WORDS 3456
#define XB_SPIN_CAP (1u << 18)

__device__ __forceinline__ unsigned xb_ld(unsigned* p)              { return __hip_atomic_load(p, __ATOMIC_RELAXED, __HIP_MEMORY_SCOPE_AGENT); }
__device__ __forceinline__ unsigned xb_add(unsigned* p, unsigned v) { return __hip_atomic_fetch_add(p, v, __ATOMIC_RELAXED, __HIP_MEMORY_SCOPE_AGENT); }
__device__ __forceinline__ unsigned xb_xcc_id() { return (unsigned)__builtin_amdgcn_s_getreg((3 << 11) | 20) & 0xFu; }
#define XB_SPIN(cond, bar) do { unsigned _sp = 0; while (cond) { __builtin_amdgcn_s_sleep(1); \
    if ((++_sp & 255u) == 0u) { if (xb_ld(&(bar)[XB_TMO])) break; if (_sp > XB_SPIN_CAP) { atomicAdd(&(bar)[XB_TMO], 1u); break; } } } } while (0)

struct XcdBarrier {
    unsigned* bar; unsigned x;
    volatile LAS unsigned* st;
};

__device__ __forceinline__ XcdBarrier xcd_barrier_post(unsigned* bar, volatile LAS unsigned* st) {
    XcdBarrier b; b.bar = bar; b.x = xb_xcc_id(); b.st = st;
    if (threadIdx.x == 0) (void)xb_add(&bar[XB_XCNT(b.x)], 1u);
    return b;
}
__device__ __forceinline__ void xcd_barrier_complete(unsigned* bar, unsigned x, unsigned& nloc, unsigned& nx) {
    const unsigned G = gridDim.x * gridDim.y * gridDim.z;
    unsigned sum, cnt, mine, sp = 0u;
    for (;;) {
        sum = 0u; cnt = 0u; mine = 0u;
#pragma unroll
        for (unsigned j = 0; j < 16; ++j) { const unsigned c = xb_ld(&bar[XB_XCNT(j)]); sum += c; cnt += (c > 0u) ? 1u : 0u; mine = (j == x) ? c : mine; }
        if (sum == G) break;
        __builtin_amdgcn_s_sleep(1);
        if ((++sp & 255u) == 0u) { if (xb_ld(&bar[XB_TMO])) break; if (sp > XB_SPIN_CAP) { atomicAdd(&bar[XB_TMO], 1u); break; } }
    }
    nloc = mine > 0u ? mine : 1u; nx = cnt > 0u ? cnt : 1u;
}

__device__ __forceinline__ void xcd_barrier(const XcdBarrier& b) {
    asm volatile("s_waitcnt vmcnt(0)" ::: "memory");
    __syncthreads();
    if (threadIdx.x == 0) {
        unsigned* bar = b.bar;
        __builtin_amdgcn_s_waitcnt(0);
        unsigned nloc = b.st[0], nx = b.st[1];
        if (nloc == 0u) { xcd_barrier_complete(bar, b.x, nloc, nx); b.st[0] = nloc; b.st[1] = nx; }
        const unsigned old = xb_add(&bar[XB_XSUB(b.x)], 1u);
        const unsigned gen = old / nloc;
        if (old + 1u == (gen + 1u) * nloc) {
            __builtin_amdgcn_fence(__ATOMIC_RELEASE, "agent");
            asm volatile("s_waitcnt vmcnt(0)" ::: "memory");
            const unsigned og = xb_add(&bar[XB_TOP], 1u);
            const unsigned tg = og / nx;
            if (og + 1u == (tg + 1u) * nx) xb_add(&bar[XB_TOPGEN], 1u);
            else XB_SPIN(xb_ld(&bar[XB_TOPGEN]) == tg, bar);
            __builtin_amdgcn_fence(__ATOMIC_ACQUIRE, "agent");
            xb_add(&bar[XB_XGEN(b.x)], 1u);
            asm volatile("s_waitcnt vmcnt(0)" ::: "memory");
        } else {
            XB_SPIN(xb_ld(&bar[XB_XGEN(b.x)]) == gen, bar);
            __builtin_amdgcn_fence(__ATOMIC_ACQUIRE, "agent");
            asm volatile("s_waitcnt vmcnt(0)" ::: "memory");
        }
    }
    __syncthreads();
}

#ifndef MK_ONE_LAUNCH
#define MK_ONE_LAUNCH 1
#endif
#ifndef DBL_MASK
#define DBL_MASK 0
#endif
constexpr int N_PHASES = 9;
struct Args { const void* in[N_IN]; float* out; unsigned char* ws; int ph_lo, ph_hi; };
#define PHASE_FN __device__ __forceinline__ void
#define PHASE_FRAME \
    Frame F; F.lds = (LAS unsigned char*)(uintptr_t)(unsigned)__builtin_amdgcn_readfirstlane((int)ldsaddr); F.tid = threadIdx.x; F.lane = F.tid & 63; F.wave = __builtin_amdgcn_readfirstlane(F.tid >> 6); \
    F.G = gridDim.x; F.bid = blockIdx.x; F.in = (const float* const*)ap->in; F.pos = (const int*)ap->in[I_POS]; F.out = ap->out; F.ws = ap->ws; unsigned char* ws = F.ws; (void)ws;
#define REP(k) for (int rep_ = 0; rep_ < (((DBL_MASK >> (k)) & 1) ? 2 : 1); ++rep_)

PHASE_FN ph_prologue(const Args* ap, unsigned ldsaddr) { PHASE_FRAME REP(0) p0_prologue(F); }
PHASE_FN ph_inproj(const Args* ap, unsigned ldsaddr) { PHASE_FRAME REP(1) {
    pg8::StaticOrder S;
    pg8::Gemm g = pg8::make_gemm((const bf16*)(ws + WS_XN), 1024, (const bf16*)(ws + WS_WIN), 1024, MTOK, NPROJ, 1024);
    S.init(MTOK, NPROJ, F.G, F.bid);
    EpiInProj E{(bf16*)(ws + WS_QKV), (bf16*)(ws + WS_CQ), (bf16*)(ws + WS_MISC), (bf16*)(ws + WS_GATES), (float*)(ws + WS_SSQ), (float*)(ws + WS_SSKV)};
    pg8::gemm_phase<EpiInProj, pg8::StaticOrder, true>(F.lds, g, S, E); } }
PHASE_FN ph_upq(const Args* ap, unsigned ldsaddr) { PHASE_FRAME REP(2) {
    pg8::StaticOrder S;
    pg8::Gemm g = pg8::make_gemm((const bf16*)(ws + WS_CQ), 256, (const bf16*)(ws + WS_WUQ), 256, MTOK, 768, 256);
    S.init(MTOK, 768, F.G, F.bid);
    EpiRowScale<256> E{(const float*)(ws + WS_SSQ), (bf16*)(ws + WS_MLAQ), 768, QSCALE_MLA};
    pg8::gemm_phase<EpiRowScale<256>, pg8::StaticOrder, true>(F.lds, g, S, E); } }
PHASE_FN ph_upkv(const Args* ap, unsigned ldsaddr) { PHASE_FRAME REP(2) {
    pg8::StaticOrder S;
    pg8::Gemm g = pg8::make_gemm((const bf16*)(ws + WS_MISC), 256, (const bf16*)(ws + WS_WUKV), 256, MTOK, 1024, 256);
    S.init(MTOK, 1024, F.G, F.bid);
    EpiRowScale<128> E{(const float*)(ws + WS_SSKV), (bf16*)(ws + WS_MLAKV), 1024, 1.0f};
    pg8::gemm_phase<EpiRowScale<128>, pg8::StaticOrder, true>(F.lds, g, S, E); } }
PHASE_FN ph_cmpu(const Args* ap, unsigned ldsaddr) { PHASE_FRAME REP(2) {
    pg8::StaticOrder S;
#pragma unroll 1
    for (int ks = 0; ks < 8; ++ks) { const int kv = ks >> 2, s = ks & 3;
        pg8::Gemm g; g.A = (const bf16*)(ws + WS_QKV) + 512 + 128 * kv + (size_t)s * 4 * 1280; g.Bt = (const bf16*)(ws + (kv ? WS_WC1V : WS_WC1K)) + s * 256; g.M = 2048; g.N = 256; g.K = 256;
        g.aRow = (size_t)16 * 1280 * 2; g.aHalf = 128; g.aTile = (size_t)SEQ * 1280 * 2; g.aK = (size_t)1280 * 2; g.bRow = 1024 * 2;
        S.init(2048, 256, F.G, (F.bid + F.G - (192 + 8 * ks) % F.G) % F.G);
        EpiF32 E{(float*)(ws + WS_USLAB) + (size_t)ks * 2048 * 256, 256, nullptr};
        pg8::gemm_phase<EpiF32, pg8::StaticOrder, true>(F.lds, g, S, E);
    }
    kpe_pass(F); } }
PHASE_FN ph_cmpfin(const Args* ap, unsigned ldsaddr) { PHASE_FRAME REP(3) cmp_finalize(F); }
PHASE_FN ph_nsa(const Args* ap, unsigned ldsaddr) { PHASE_FRAME REP(10) { TMS_BEGIN(30); att::nsa_loop(F); TMS_END(30); } }
PHASE_FN ph_mla(const Args* ap, unsigned ldsaddr) { PHASE_FRAME REP(11) { TMS_BEGIN(31); att::mla_loop(F); TMS_END(31); } }
PHASE_FN ph_branch(const Args* ap, unsigned ldsaddr) { PHASE_FRAME REP(5) {
    pg8::ChainOrder S; S.init(MTOK, 1024, F.G, F.bid);
    pg8::Gemm g = pg8::make_gemm((const bf16*)(ws + WS_OCAT), 1024, (const bf16*)(ws + WS_WBR), 1024, MTOK, 1024, 512); g.aSeg = 1024; g.bSeg = 1024;
    EpiGateChain E{(const bf16*)(ws + WS_GATES), (bf16*)(ws + WS_MERGED)};
    pg8::gemm_phase<EpiGateChain, pg8::ChainOrder, true, true>(F.lds, g, S, E);
    quant_table<true>(F, F.in[I_EDN], ws + WS_EXPD, (float*)(ws + WS_EXPD_SC)); } }
PHASE_FN ph_outproj(const Args* ap, unsigned ldsaddr) { PHASE_FRAME REP(6) {
    pg8::StaticOrder S; S.init(MTOK, 1024, F.G, F.bid);
    pg8::Gemm g = pg8::make_gemm((const bf16*)(ws + WS_MERGED), 1024, (const bf16*)(ws + WS_WOUT), 1024, MTOK, 1024, 1024);
    EpiResid E{F.in[I_X], (bf16*)(ws + WS_XN2), (float*)(ws + WS_SS)};
    pg8::gemm_phase<EpiResid, pg8::StaticOrder, true>(F.lds, g, S, E);
    quant_table4(F, F.in[I_EUP], ws + WS_EXPU, (float*)(ws + WS_EXPU_SC)); } }
PHASE_FN ph_peerq(const Args* ap, unsigned ldsaddr) { PHASE_FRAME REP(8) {
    pg8::StaticOrder S; S.init(MTOK, 2048, F.G, F.bid);
    pg8::Gemm g = pg8::make_gemm((const bf16*)(ws + WS_XN2), 1024, (const bf16*)(ws + WS_WPQ), 1024, MTOK, 2048, 1024);
    EpiRowSS E{(const float*)(ws + WS_SS), (bf16*)(ws + WS_QP), 2048};
    pg8::gemm_phase<EpiRowSS, pg8::StaticOrder, true>(F.lds, g, S, E); } }
PHASE_FN ph_peer(const Args* ap, unsigned ldsaddr) { PHASE_FRAME peer::peer_phase(F, ap->ph_lo < 0); }

__global__ void __launch_bounds__(NTHREADS, 2) fwd(Args a) {
    extern __shared__ __attribute__((aligned(16))) unsigned char lds_raw[];
    const unsigned ldsaddr = (unsigned)(uintptr_t)(LAS unsigned char*)lds_raw;
    const int lo = a.ph_lo, hi = a.ph_hi;
#define IN(k) (lo <= (k) && (k) < hi)
    { LAS unsigned* misc = (LAS unsigned*)((LAS unsigned char*)lds_raw + RING_BYTES); if (threadIdx.x < 256) misc[threadIdx.x] = 0u; }
    __syncthreads();
    XcdBarrier bar = xcd_barrier_post((unsigned*)(a.ws + WS_CTL) + 4096, (volatile LAS unsigned*)((LAS unsigned char*)lds_raw + RING_BYTES) + 8);
#define SEAM(k) do { if (IN(k) && IN((k) + 1)) { if (MK_ONE_LAUNCH) xcd_barrier(bar); } } while (0)
#ifdef TIMER_PHASE
    unsigned long long tm_t0 = 0, tm_acc = 0;
#define TM_BEGIN(k) do { if ((k) == TIMER_PHASE) tm_t0 = __builtin_amdgcn_s_memrealtime(); } while (0)
#define TM_END(k) do { if ((k) == TIMER_PHASE) tm_acc += __builtin_amdgcn_s_memrealtime() - tm_t0; } while (0)
#else
#define TM_BEGIN(k) do {} while (0)
#define TM_END(k) do {} while (0)
#endif
    TM_BEGIN(0);
    if (IN(0)) ph_prologue(&a, ldsaddr);
    if (IN(0) && IN(1)) { if (MK_ONE_LAUNCH) xcd_barrier(bar); }
    TM_END(0); TM_BEGIN(1);
    if (IN(1)) ph_inproj(&a, ldsaddr);
    SEAM(1);
    TM_END(1); TM_BEGIN(2);
    if (IN(2)) { ph_upq(&a, ldsaddr); ph_upkv(&a, ldsaddr); ph_cmpu(&a, ldsaddr); }
    SEAM(2);
    TM_END(2); TM_BEGIN(3);
    if (IN(3)) ph_cmpfin(&a, ldsaddr);
    SEAM(3);
    TM_END(3); TM_BEGIN(4);
#ifdef TIMER_PHASE
    const unsigned long long clk0_ = (TIMER_PHASE == 9) ? __builtin_amdgcn_s_memtime() : 0ull;
#endif
    if (IN(4)) { ph_nsa(&a, ldsaddr); ph_mla(&a, ldsaddr); }
#ifdef TIMER_PHASE
    if (TIMER_PHASE == 9) tm_acc = (__builtin_amdgcn_s_memtime() - clk0_) / 100ull;
#endif
    SEAM(4);
    TM_END(4); TM_BEGIN(5);
    if (IN(5)) ph_branch(&a, ldsaddr);
    SEAM(5);
    TM_END(5); TM_BEGIN(6);
    if (IN(6)) ph_outproj(&a, ldsaddr);
    SEAM(6);
    TM_END(6); TM_BEGIN(7);
    if (IN(7)) ph_peerq(&a, ldsaddr);
    SEAM(7);
    TM_END(7); TM_BEGIN(8);
    if (IN(8)) ph_peer(&a, ldsaddr);
    TM_END(8);
#ifdef TIMER_PHASE
    if (TIMER_PHASE >= 10) tm_acc = *(LAS unsigned long long*)((LAS unsigned char*)lds_raw + RING_BYTES + 512);
    __syncthreads();
    if (blockIdx.x == 0 && threadIdx.x == 0) { asm volatile("s_waitcnt vmcnt(0)" ::: "memory"); a.out[0] += (float)tm_acc * 0.001f; }
#endif
#undef IN
#undef SEAM
}

extern "C" void kernel_launch(void* const* d_in, const int* in_sizes, int n_in, void* d_out, int out_size, void* d_ws, size_t ws_size, hipStream_t stream) {
    static int grid = 0;
    if (grid == 0) {
        if (n_in != N_IN || out_size != MTOK * DM || ws_size < WS_END) { fprintf(stderr, "kernel_launch: unexpected shapes (n_in %d, out %d, ws %zu)\n", n_in, out_size, ws_size); grid = -1; return; }
        int dev = 0, cus = 0, per_cu = 0;
        if (hipGetDevice(&dev) != hipSuccess || hipDeviceGetAttribute(&cus, hipDeviceAttributeMultiprocessorCount, dev) != hipSuccess) { grid = -1; return; }
        if (hipFuncSetAttribute((const void*)fwd, hipFuncAttributeMaxDynamicSharedMemorySize, LDS_BYTES) != hipSuccess) { fprintf(stderr, "kernel_launch: hipFuncSetAttribute failed\n"); grid = -1; return; }
        if (hipOccupancyMaxActiveBlocksPerMultiprocessor(&per_cu, (const void*)fwd, NTHREADS, LDS_BYTES) != hipSuccess || per_cu < 1) { fprintf(stderr, "kernel_launch: occupancy query says %d\n", per_cu); (void)hipGetLastError(); grid = -1; return; }
        grid = cus;
    }
    if (grid < 0) return;
    Args a{};
    for (int i = 0; i < N_IN; ++i) a.in[i] = d_in[i];
    a.out = (float*)d_out; a.ws = (unsigned char*)d_ws;
#if MK_ONE_LAUNCH
    if (hipMemsetAsync((char*)d_ws + WS_CTL, 0, 65536, stream) != hipSuccess) { fprintf(stderr, "kernel_launch: hipMemsetAsync failed\n"); return; }
    a.ph_lo = 0; a.ph_hi = N_PHASES;
    void* args[] = {&a};
    hipError_t e = hipLaunchCooperativeKernel((const void*)fwd, dim3(grid), dim3(NTHREADS), args, LDS_BYTES, stream);
    if (e != hipSuccess) fprintf(stderr, "kernel_launch: cooperative launch failed: %s (grid %d)\n", hipGetErrorString(e), grid);
#else
    for (int p = 0; p < N_PHASES; ++p) { a.ph_lo = p; a.ph_hi = p + 1; hipLaunchKernelGGL(fwd, dim3(grid), dim3(NTHREADS), LDS_BYTES, stream, a); }
#endif
}
```
